# Optimizing an MI355X kernel written in HIP

```python
import math
import jax, jax.numpy as jnp
from jax import lax
import numpy as np


D_MODEL = 1024
BATCH = 16
SEQ = 2048
DEPTH = 4

GRID_W = 64
CTX_LEN = 256
EPS = 1e-6
ROPE_THETA = 10000.0
Q_BLOCK = 128

D_MIX = D_MODEL
DA_HEADS = 4
DA_QK = 32
DA_V = 2 * DA_QK
DA_WIDTH = DA_HEADS * DA_V
DA_IN = 2 * DA_HEADS * 2 * DA_QK + DA_HEADS * DA_V
SSD_HEADS = 8
SSD_P = 64
SSD_INNER = SSD_HEADS * SSD_P
SSD_GROUPS = 2
SSD_STATE = 64
SSD_CONV = 3
SSD_CHUNK = 128
SSD_CONV_DIM = SSD_INNER + 2 * SSD_GROUPS * SSD_STATE
SSD_IN = SSD_INNER + SSD_CONV_DIM + 2 * SSD_HEADS
MLA_HEADS = 4
MLA_Q_RANK = 256
MLA_KV_RANK = 128
MLA_NOPE = 64
MLA_ROPE = 32
MLA_V = 64
MLA_WIDTH = MLA_HEADS * MLA_V
MLA_IN = MLA_Q_RANK + MLA_KV_RANK + MLA_ROPE
MLA_SCALE = (MLA_NOPE + MLA_ROPE) ** -0.5
IN_WIDTH = DA_IN + SSD_IN + MLA_IN
N_EXPERTS = 16
N_GROUPS = 4
TOP_K = 2
D_EXPERT = 512

kernel_name = 'hybrid_dit_diffattn_ssd_mla_moe'


def rms_norm(x, g):
    xf = x.astype(jnp.float32)
    y = xf * lax.rsqrt(jnp.mean(xf * xf, axis=-1, keepdims=True) + EPS)
    return (y * g.astype(jnp.float32)).astype(x.dtype)


def ada_norm(x, g, shift, scale):
    return rms_norm(x, g) * (1 + scale) + shift


def axial_rope_tables(length, dim):
    rows = length // GRID_W
    row = jnp.repeat(jnp.arange(rows), GRID_W).astype(jnp.float32)
    col = jnp.tile(jnp.arange(GRID_W), rows).astype(jnp.float32)
    n_freq = dim // 4
    inv_freq = ROPE_THETA ** (-jnp.arange(n_freq, dtype=jnp.float32) / n_freq)
    ang = jnp.concatenate([row[:, None] * inv_freq, col[:, None] * inv_freq], axis=-1)
    return jnp.cos(ang), jnp.sin(ang)


def apply_rope(x, cos, sin):
    half = x.shape[-1] // 2
    shape = (1, x.shape[1]) + (1,) * (x.ndim - 3) + (half,)
    cos = cos.reshape(shape)
    sin = sin.reshape(shape)
    xf = x.astype(jnp.float32)
    x1, x2 = xf[..., :half], xf[..., half:]
    return jnp.concatenate([x1 * cos - x2 * sin, x2 * cos + x1 * sin], axis=-1).astype(x.dtype)


def sweep_query_blocks(fn, *qs):
    b, l = qs[0].shape[:2]
    nb = l // Q_BLOCK
    blocks = tuple(jnp.moveaxis(q.reshape((b, nb, Q_BLOCK) + q.shape[2:]), 1, 0) for q in qs)
    out = lax.map(lambda qb: fn(*qb), blocks)
    return jnp.moveaxis(out, 0, 1).reshape((b, l) + out.shape[3:])


def diff_attend(q, k, v, lam):
    s = jnp.einsum('bqhmd,bkhmd->bhmqk', q, k).astype(jnp.float32) * (DA_QK ** -0.5)
    p = jax.nn.softmax(s, axis=-1)
    a = p[:, :, 0] - lam * p[:, :, 1]
    return jnp.einsum('bhqk,bkhv->bqhv', a.astype(v.dtype), v)


def mla_attend(q_nope, q_rope, k_nope, k_rope, v):
    s = (jnp.einsum('bqhd,bkhd->bhqk', q_nope, k_nope)
         + jnp.einsum('bqhr,bkr->bhqk', q_rope, k_rope)).astype(jnp.float32) * MLA_SCALE
    p = jax.nn.softmax(s, axis=-1)
    return jnp.einsum('bhqk,bkhv->bqhv', p.astype(v.dtype), v)


def diff_attention_mixer(p_da, n_ctx, cos, sin, lam_vec, subln_g, lam_init):
    b, t, _ = p_da.shape
    q, k, v = jnp.split(p_da, 3, axis=-1)
    q = q.reshape(b, t, DA_HEADS, 2, DA_QK)
    k = k.reshape(b, t, DA_HEADS, 2, DA_QK)
    v = v.reshape(b, t, DA_HEADS, DA_V)
    lv = lam_vec.astype(jnp.float32)
    lam = jnp.exp(jnp.sum(lv[0] * lv[1])) - jnp.exp(jnp.sum(lv[2] * lv[3])) + lam_init
    q_c, q_x = q[:, :n_ctx], apply_rope(q[:, n_ctx:], cos, sin)
    k_c = k[:, :n_ctx]
    k_all = jnp.concatenate([k_c, apply_rope(k[:, n_ctx:], cos, sin)], axis=1)
    o_c = diff_attend(q_c, k_c, v[:, :n_ctx], lam)
    o_x = sweep_query_blocks(lambda qb: diff_attend(qb, k_all, v, lam), q_x)
    o = rms_norm(jnp.concatenate([o_c, o_x], axis=1), subln_g) * (1.0 - lam_init)
    return o.reshape(b, t, DA_WIDTH)


def depthwise_conv(u, w, bias):
    pad = SSD_CONV // 2
    y = lax.conv_general_dilated(u, w[:, None, :].astype(u.dtype), (1,), [(pad, pad)],
                                 dimension_numbers=('NWC', 'WIO', 'NWC'),
                                 feature_group_count=u.shape[-1])
    return y + bias


def ssd_chunked_scan(xh, dt, a, bm, cm, h0):
    b, l, h, p = xh.shape
    n = bm.shape[-1]
    q = SSD_CHUNK
    nc = l // q
    x_c = xh.reshape(b, nc, q, h, p)
    dt_c = dt.reshape(b, nc, q, h)
    b_c = bm.reshape(b, nc, q, h, n)
    c_c = cm.reshape(b, nc, q, h, n)
    a_cum = jnp.cumsum(dt_c * a, axis=2)
    seg = a_cum[:, :, :, None, :] - a_cum[:, :, None, :, :]
    lower = jnp.tril(jnp.ones((q, q), dtype=bool))[None, None, :, :, None]
    decay = jnp.exp(jnp.where(lower, seg, -jnp.inf))
    scores = jnp.einsum('bcihn,bcjhn->bcijh', c_c, b_c) * decay * dt_c[:, :, None, :, :]
    y_diag = jnp.einsum('bcijh,bcjhp->bcihp', scores, x_c)
    decay_to_end = jnp.exp(a_cum[:, :, -1:, :] - a_cum)
    states = jnp.einsum('bcjhn,bcjh,bcjhp->bchpn', b_c, decay_to_end * dt_c, x_c)
    chunk_decay = jnp.exp(a_cum[:, :, -1, :])

    def step(h_prev, inp):
        st, dec = inp
        return h_prev * dec[:, :, None, None] + st, h_prev

    h_final, h_in = lax.scan(step, h0, (jnp.moveaxis(states, 1, 0), jnp.moveaxis(chunk_decay, 1, 0)))
    h_in = jnp.moveaxis(h_in, 0, 1)
    y_off = jnp.einsum('bcihn,bchpn,bcih->bcihp', c_c, h_in, jnp.exp(a_cum))
    return (y_diag + y_off).reshape(b, l, h, p), h_final


def ssd_bidirectional(xbc, dt, a, d_skip, h0_fwd, h0_bwd):
    b, l, _ = xbc.shape
    u = xbc.astype(jnp.float32)
    rep = SSD_HEADS // SSD_GROUPS
    xh = u[..., :SSD_INNER].reshape(b, l, SSD_HEADS, SSD_P)
    gn = SSD_GROUPS * SSD_STATE
    bm = jnp.repeat(u[..., SSD_INNER:SSD_INNER + gn].reshape(b, l, SSD_GROUPS, SSD_STATE), rep, axis=2)
    cm = jnp.repeat(u[..., SSD_INNER + gn:].reshape(b, l, SSD_GROUPS, SSD_STATE), rep, axis=2)
    flip = lambda arr: jnp.flip(arr, axis=1)
    y_f, h_f = ssd_chunked_scan(xh, dt[:, :, 0], a[0], bm, cm, h0_fwd)
    y_b, h_b = ssd_chunked_scan(flip(xh), flip(dt[:, :, 1]), a[1], flip(bm), flip(cm), h0_bwd)
    y = y_f + flip(y_b) + d_skip.astype(jnp.float32)[:, None] * xh
    return y, h_f, h_b


def ssd_mixer(p_ssd, n_ctx, conv_w, conv_b, dt_bias, a_log, d_skip, norm_g):
    b, t, _ = p_ssd.shape
    z = p_ssd[..., :SSD_INNER]
    xbc = p_ssd[..., SSD_INNER:SSD_INNER + SSD_CONV_DIM]
    dt_raw = p_ssd[..., SSD_INNER + SSD_CONV_DIM:]
    a = -jnp.exp(a_log.astype(jnp.float32))
    dt = jax.nn.softplus(dt_raw.astype(jnp.float32).reshape(b, t, 2, SSD_HEADS) + dt_bias.astype(jnp.float32))
    xbc_c = jax.nn.silu(depthwise_conv(xbc[:, :n_ctx], conv_w, conv_b))
    xbc_x = jax.nn.silu(depthwise_conv(xbc[:, n_ctx:], conv_w, conv_b))
    h_zero = jnp.zeros((b, SSD_HEADS, SSD_P, SSD_STATE), jnp.float32)
    y_c, h_f, h_b = ssd_bidirectional(xbc_c, dt[:, :n_ctx], a, d_skip, h_zero, h_zero)
    y_x, _, _ = ssd_bidirectional(xbc_x, dt[:, n_ctx:], a, d_skip, h_f, h_b)
    y = jnp.concatenate([y_c, y_x], axis=1).reshape(b, t, SSD_INNER).astype(p_ssd.dtype)
    return rms_norm(y * jax.nn.silu(z), norm_g)


def mla_mixer(p_mla, n_ctx, cos, sin, q_norm_g, kv_norm_g, w_uq, w_ukv):
    b, t, _ = p_mla.shape
    cq = p_mla[..., :MLA_Q_RANK]
    ckv = p_mla[..., MLA_Q_RANK:MLA_Q_RANK + MLA_KV_RANK]
    kr = p_mla[..., MLA_Q_RANK + MLA_KV_RANK:]
    q = (rms_norm(cq, q_norm_g) @ w_uq).reshape(b, t, MLA_HEADS, MLA_NOPE + MLA_ROPE)
    kv = (rms_norm(ckv, kv_norm_g) @ w_ukv).reshape(b, t, MLA_HEADS, MLA_NOPE + MLA_V)
    q_nope, q_rope = q[..., :MLA_NOPE], q[..., MLA_NOPE:]
    k_nope, v = kv[..., :MLA_NOPE], kv[..., MLA_NOPE:]
    q_rope_x = apply_rope(q_rope[:, n_ctx:], cos, sin)
    k_rope = jnp.concatenate([kr[:, :n_ctx], apply_rope(kr[:, n_ctx:], cos, sin)], axis=1)
    o_c = mla_attend(q_nope[:, :n_ctx], q_rope[:, :n_ctx], k_nope[:, :n_ctx], k_rope[:, :n_ctx], v[:, :n_ctx])
    o_x = sweep_query_blocks(lambda qn, qr: mla_attend(qn, qr, k_nope, k_rope, v), q_nope[:, n_ctx:], q_rope_x)
    return jnp.concatenate([o_c, o_x], axis=1).reshape(b, t, MLA_WIDTH)


def moe_ffn(h, router_w, router_bias, w_gate, w_up, w_down):
    b, t, _ = h.shape
    per_group = N_EXPERTS // N_GROUPS
    aff = jax.nn.sigmoid((h @ router_w).astype(jnp.float32))
    sel = aff + router_bias.astype(jnp.float32)
    group_score = jnp.sum(lax.top_k(sel.reshape(b, t, N_GROUPS, per_group), 2)[0], axis=-1)
    best = jnp.argmax(group_score, axis=-1)
    in_group = jnp.repeat(jax.nn.one_hot(best, N_GROUPS, dtype=jnp.float32), per_group, axis=-1) > 0
    _, idx = lax.top_k(jnp.where(in_group, sel, -jnp.inf), TOP_K)
    w = jnp.take_along_axis(aff, idx, axis=-1)
    w = w / jnp.sum(w, axis=-1, keepdims=True)
    gates = jnp.einsum('btk,btke->bte', w, jax.nn.one_hot(idx, N_EXPERTS, dtype=jnp.float32)).astype(h.dtype)
    y = jnp.zeros_like(h)
    for e in range(N_EXPERTS):
        he = jax.nn.silu(h @ w_gate[e]) * (h @ w_up[e])
        y = y + gates[..., e:e + 1] * (he @ w_down[e])
    return y


def setup_inputs(seed: int = 0) -> dict:
    key = jax.random.key(seed)
    ks = jax.random.split(key, 32)
    f32 = jnp.float32
    nrm = lambda k, shape, s: jax.random.normal(k, shape, f32) * s
    gain = lambda k, shape: 1.0 + 0.02 * jax.random.normal(k, shape, f32)
    dt = jnp.exp(jax.random.uniform(ks[14], (DEPTH, 2, SSD_HEADS), f32, math.log(1e-3), math.log(1e-1)))
    return {
        'x': nrm(ks[0], (BATCH, SEQ, D_MODEL), 1.0),
        'c': nrm(ks[1], (BATCH, D_MODEL), 1.0),
        'ctx': nrm(ks[2], (BATCH, CTX_LEN, D_MODEL), 1.0),
        'c_ctx': nrm(ks[3], (D_MODEL,), 1.0),
        'norm_mix_g': gain(ks[4], (DEPTH, D_MODEL)),
        'norm_ffn_g': gain(ks[5], (DEPTH, D_MODEL)),
        'w_mod': nrm(ks[6], (DEPTH, D_MODEL, 6 * D_MODEL), 0.5 * D_MODEL ** -0.5),
        'b_mod': nrm(ks[7], (DEPTH, 6 * D_MODEL), 0.02),
        'w_in': nrm(ks[8], (DEPTH, D_MODEL, IN_WIDTH), D_MODEL ** -0.5),
        'w_out': nrm(ks[9], (DEPTH, D_MIX, D_MODEL), D_MIX ** -0.5),
        'da_lambda': nrm(ks[10], (DEPTH, 4, DA_QK), 0.1),
        'da_subln_g': gain(ks[11], (DEPTH, DA_V)),
        'ssd_conv_w': nrm(ks[12], (DEPTH, SSD_CONV, SSD_CONV_DIM), SSD_CONV ** -0.5),
        'ssd_conv_b': nrm(ks[13], (DEPTH, SSD_CONV_DIM), 0.02),
        'ssd_dt_bias': dt + jnp.log(-jnp.expm1(-dt)),
        'ssd_a_log': jnp.log(jax.random.uniform(ks[15], (DEPTH, 2, SSD_HEADS), f32, 1.0, 16.0)),
        'ssd_d': 1.0 + 0.1 * jax.random.normal(ks[16], (DEPTH, SSD_HEADS), f32),
        'ssd_norm_g': gain(ks[17], (DEPTH, SSD_INNER)),
        'mla_q_norm_g': gain(ks[18], (DEPTH, MLA_Q_RANK)),
        'mla_kv_norm_g': gain(ks[19], (DEPTH, MLA_KV_RANK)),
        'mla_w_uq': nrm(ks[20], (DEPTH, MLA_Q_RANK, MLA_HEADS * (MLA_NOPE + MLA_ROPE)), MLA_Q_RANK ** -0.5),
        'mla_w_ukv': nrm(ks[21], (DEPTH, MLA_KV_RANK, MLA_HEADS * (MLA_NOPE + MLA_V)), MLA_KV_RANK ** -0.5),
        'router_w': nrm(ks[22], (D_MODEL, N_EXPERTS), D_MODEL ** -0.5),
        'router_bias': nrm(ks[23], (N_EXPERTS,), 0.01),
        'exp_w_gate': nrm(ks[24], (DEPTH, N_EXPERTS, D_MODEL, D_EXPERT), D_MODEL ** -0.5),
        'exp_w_up': nrm(ks[25], (DEPTH, N_EXPERTS, D_MODEL, D_EXPERT), D_MODEL ** -0.5),
        'exp_w_down': nrm(ks[26], (DEPTH, N_EXPERTS, D_EXPERT, D_MODEL), D_EXPERT ** -0.5),
        'final_norm_g': gain(ks[27], (D_MODEL,)),
    }


def reference(x, c, ctx, c_ctx, norm_mix_g, norm_ffn_g, w_mod, b_mod, w_in, w_out, da_lambda, da_subln_g,
              ssd_conv_w, ssd_conv_b, ssd_dt_bias, ssd_a_log, ssd_d, ssd_norm_g, mla_q_norm_g, mla_kv_norm_g,
              mla_w_uq, mla_w_ukv, router_w, router_bias, exp_w_gate, exp_w_up, exp_w_down, final_norm_g):
    n_ctx = ctx.shape[1]
    n_lat = x.shape[1]
    da_cos, da_sin = axial_rope_tables(n_lat, DA_QK)
    mla_cos, mla_sin = axial_rope_tables(n_lat, MLA_ROPE)
    c_act = jax.nn.silu(c)
    cc_act = jax.nn.silu(c_ctx)
    hx, hc = x, ctx
    for i in range(DEPTH):
        lam_init = 0.8 - 0.6 * math.exp(-0.3 * i)
        mod_x = jnp.split((c_act @ w_mod[i] + b_mod[i])[:, None, :], 6, axis=-1)
        mod_c = jnp.split(cc_act @ w_mod[i] + b_mod[i], 6, axis=-1)
        u = jnp.concatenate([ada_norm(hc, norm_mix_g[i], mod_c[0], mod_c[1]),
                             ada_norm(hx, norm_mix_g[i], mod_x[0], mod_x[1])], axis=1)
        proj = u @ w_in[i]
        o_da = diff_attention_mixer(proj[..., :DA_IN], n_ctx, da_cos, da_sin, da_lambda[i], da_subln_g[i], lam_init)
        o_ssd = ssd_mixer(proj[..., DA_IN:DA_IN + SSD_IN], n_ctx, ssd_conv_w[i], ssd_conv_b[i],
                          ssd_dt_bias[i], ssd_a_log[i], ssd_d[i], ssd_norm_g[i])
        o_mla = mla_mixer(proj[..., DA_IN + SSD_IN:], n_ctx, mla_cos, mla_sin, mla_q_norm_g[i], mla_kv_norm_g[i],
                          mla_w_uq[i], mla_w_ukv[i])
        mix = jnp.concatenate([o_da, o_ssd, o_mla], axis=-1) @ w_out[i]
        hc = hc + mod_c[2] * mix[:, :n_ctx]
        hx = hx + mod_x[2] * mix[:, n_ctx:]
        u_x = ada_norm(hx, norm_ffn_g[i], mod_x[3], mod_x[4])
        if i < DEPTH - 1:
            u_c = ada_norm(hc, norm_ffn_g[i], mod_c[3], mod_c[4])
            y = moe_ffn(jnp.concatenate([u_c, u_x], axis=1), router_w, router_bias,
                        exp_w_gate[i], exp_w_up[i], exp_w_down[i])
            hc = hc + mod_c[5] * y[:, :n_ctx]
            y_x = y[:, n_ctx:]
        else:
            y_x = moe_ffn(u_x, router_w, router_bias, exp_w_gate[i], exp_w_up[i], exp_w_down[i])
        hx = hx + mod_x[5] * y_x
    return rms_norm(hx, final_norm_g)
```

```cpp
#include <hip/hip_runtime.h>
#include <cstdio>
#include <cstdint>

namespace mk {
#define LAS __attribute__((address_space(3)))
#define DI __device__ __forceinline__
typedef unsigned short bf16_t;
typedef short bf16x8 __attribute__((ext_vector_type(8)));
typedef short s16x4 __attribute__((ext_vector_type(4)));
typedef float f32x2 __attribute__((ext_vector_type(2)));
typedef float f32x4 __attribute__((ext_vector_type(4)));
typedef float f32x16 __attribute__((ext_vector_type(16)));
typedef unsigned u32x2 __attribute__((ext_vector_type(2)));
typedef unsigned u32x4 __attribute__((ext_vector_type(4)));
typedef __bf16 bf16x2_t __attribute__((ext_vector_type(2)));

constexpr int DM = 1024, NB = 16, SEQ = 2048, CTX = 256, T = SEQ + CTX, M = NB * T, DEPTH = 4;
constexpr int PW = 2560, INW = 2480;
constexpr int C_DAQ = 0, C_DAK = 256, C_DAV = 512, C_Z = 768, C_XBC = 1280, C_DT = 2048, C_CQ = 2064, C_CKV = 2320, C_KR = 2448;
constexpr float EPS = 1e-6f, LOG2E = 1.4426950408889634f;
constexpr float DA_QS = 0.17677669529663687f * LOG2E, MLA_QS = 0.10206207261596577f * LOG2E;
constexpr int NSLOT = 2 * M + 4096;
constexpr int NTHR = 512, NWAVE = 8;

constexpr size_t MiB = 1u << 20;
constexpr size_t WS_CTL = 0, CTL_BYTES = 1 * MiB;
constexpr size_t WS_MOD = 1 * MiB, WS_ROPE = 3 * MiB, WS_HC = 4 * MiB;
constexpr size_t WS_WIN = 20 * MiB, WS_WOUT = 25 * MiB, WS_WUQ = 27 * MiB, WS_WUKV = 27 * MiB + 512 * 1024, WS_WGU = 28 * MiB, WS_WD = 60 * MiB;
constexpr size_t WS_ACT = 76 * MiB, WS_PROJ = 148 * MiB;
constexpr size_t WS_MLAQ = 328 * MiB, WS_MLAK = 355 * MiB, WS_VTM = 382 * MiB, WS_VTD = 400 * MiB;
constexpr size_t WS_XBC = 418 * MiB, WS_DT = 472 * MiB, WS_YF = 475 * MiB, WS_YB = 511 * MiB, WS_TOK = 547 * MiB, WS_LIST = 548 * MiB, WS_END = 551 * MiB;
constexpr size_t WS_HE = WS_MLAQ, WS_YS = WS_PROJ;
static_assert((size_t)NSLOT * 512 * 2 <= WS_XBC - WS_MLAQ, "HE alias");
static_assert((size_t)NSLOT * 1024 * 2 <= WS_MLAQ - WS_PROJ, "YS alias");
constexpr int CW_BAR = 4096, CW_CNT = 8192;

constexpr int LDS_MISC = 131072, LDS_BYTES = 135168;

struct Params {
    const float *x, *c, *ctx, *c_ctx, *g_mix, *g_ffn, *w_mod, *b_mod, *w_in, *w_out, *da_lam, *da_g, *conv_w, *conv_b, *dt_bias, *a_log, *ssd_d, *ssd_g,
                *mq_g, *mkv_g, *w_uq, *w_ukv, *r_w, *r_b, *wg, *wu, *wd, *fin_g;
    float* out; unsigned char* ws; int ph_lo, ph_hi;
};

DI unsigned pk2(float lo, float hi) { f32x2 v = {lo, hi}; bf16x2_t b = __builtin_convertvector(v, bf16x2_t); return __builtin_bit_cast(unsigned, b); }
DI float bflo(unsigned w) { return __uint_as_float(w << 16); }
DI float bfhi(unsigned w) { return __uint_as_float(w & 0xffff0000u); }
DI float wave_sum(float v) {
#pragma unroll
    for (int o = 1; o < 64; o <<= 1) v += __shfl_xor(v, o);
    return v;
}
DI float silu(float x) { return x / (1.f + __expf(-x)); }
DI float fexp2(float x) { return __builtin_amdgcn_exp2f(x); }
#define LDS_WAIT() asm volatile("s_waitcnt lgkmcnt(0)" ::: "memory")
#define MFMA32(a, b, c) __builtin_amdgcn_mfma_f32_32x32x16_bf16((a), (b), (c), 0, 0, 0)
#define MFMA16(a, b, c) __builtin_amdgcn_mfma_f32_16x16x32_bf16((a), (b), (c), 0, 0, 0)
DI int crow(int reg, int h) { return (reg & 3) + 8 * (reg >> 2) + 4 * h; }

#define XB_TMO      128
#define XB_XCNT(j)  (256  + 64 * (j))
#define XB_XSUB(j)  (1280 + 64 * (j))
#define XB_XGEN(j)  (2304 + 64 * (j))
#define XB_TOP      3328
#define XB_TOPGEN   3392
#define XCD_BAR_WORDS 3456
#define XB_SPIN_CAP (1u << 22)
DI unsigned xb_ld(unsigned* p)              { return __hip_atomic_load(p, __ATOMIC_RELAXED, __HIP_MEMORY_SCOPE_AGENT); }
DI unsigned xb_add(unsigned* p, unsigned v) { return __hip_atomic_fetch_add(p, v, __ATOMIC_RELAXED, __HIP_MEMORY_SCOPE_AGENT); }
DI unsigned xb_xcc_id() { return (unsigned)__builtin_amdgcn_s_getreg((3 << 11) | 20) & 0xFu; }
#define XB_SPIN(cond, bar) do { unsigned _sp = 0; while (cond) { __builtin_amdgcn_s_sleep(1); \
    if ((++_sp & 255u) == 0u) { if (xb_ld(&(bar)[XB_TMO])) break; if (_sp > XB_SPIN_CAP) { atomicAdd(&(bar)[XB_TMO], 1u); break; } } } } while (0)
struct XcdBarrier { unsigned* bar; unsigned x; volatile LAS unsigned* st; };
DI XcdBarrier xcd_barrier_post(unsigned* bar, volatile LAS unsigned* st) {
    XcdBarrier b; b.bar = bar; b.x = xb_xcc_id(); b.st = st;
    if (threadIdx.x == 0) (void)xb_add(&bar[XB_XCNT(b.x)], 1u);
    return b;
}
DI void xcd_barrier_complete(unsigned* bar, unsigned x, unsigned& nloc, unsigned& nx) {
    const unsigned G = gridDim.x * gridDim.y * gridDim.z;
    unsigned sum, cnt, mine, sp = 0u;
    for (;;) {
        sum = 0u; cnt = 0u; mine = 0u;
#pragma unroll
        for (unsigned j = 0; j < 16; ++j) { const unsigned c = xb_ld(&bar[XB_XCNT(j)]); sum += c; cnt += (c > 0u) ? 1u : 0u; mine = (j == x) ? c : mine; }
        if (sum == G) break;
        __builtin_amdgcn_s_sleep(1);
        if ((++sp & 255u) == 0u) { if (xb_ld(&bar[XB_TMO])) break; if (sp > XB_SPIN_CAP) { atomicAdd(&bar[XB_TMO], 1u); break; } }
    }
    nloc = mine > 0u ? mine : 1u; nx = cnt > 0u ? cnt : 1u;
}
DI void xcd_barrier(const XcdBarrier& b) {
    asm volatile("s_waitcnt vmcnt(0)" ::: "memory");
    __syncthreads();
    if (threadIdx.x == 0) {
        unsigned* bar = b.bar;
        __builtin_amdgcn_s_waitcnt(0);
        unsigned nloc = b.st[0], nx = b.st[1];
        if (nloc == 0u) { xcd_barrier_complete(bar, b.x, nloc, nx); b.st[0] = nloc; b.st[1] = nx; }
        const unsigned old = xb_add(&bar[XB_XSUB(b.x)], 1u);
        const unsigned gen = old / nloc;
        if (old + 1u == (gen + 1u) * nloc) {
            __builtin_amdgcn_fence(__ATOMIC_RELEASE, "agent");
            asm volatile("s_waitcnt vmcnt(0)" ::: "memory");
            const unsigned og = xb_add(&bar[XB_TOP], 1u);
            const unsigned tg = og / nx;
            if (og + 1u == (tg + 1u) * nx) xb_add(&bar[XB_TOPGEN], 1u);
            else XB_SPIN(xb_ld(&bar[XB_TOPGEN]) == tg, bar);
            __builtin_amdgcn_fence(__ATOMIC_ACQUIRE, "agent");
            xb_add(&bar[XB_XGEN(b.x)], 1u);
            asm volatile("s_waitcnt vmcnt(0)" ::: "memory");
        } else {
            XB_SPIN(xb_ld(&bar[XB_XGEN(b.x)]) == gen, bar);
            __builtin_amdgcn_fence(__ATOMIC_ACQUIRE, "agent");
            asm volatile("s_waitcnt vmcnt(0)" ::: "memory");
        }
    }
    __syncthreads();
}

constexpr int HTB = 128 * 64 * 2;
DI int lds_byte(int r, int c) { const int st = (r >> 4) * 2 + (c >> 5), rr = r & 15, cc = c & 31, ob = rr * 64 + cc * 2; return st * 1024 + (ob ^ (((ob >> 9) & 1) << 5)); }
DI void stage_rc(int b, int& R, int& C) { const int st = b / 1024, sb = b % 1024, swz = sb ^ (((sb >> 9) & 1) << 5); R = (st >> 1) * 16 + swz / 64; C = (st & 1) * 32 + (swz % 64) / 2; }
DI int perm32(int rho) { const int n = rho >> 4, i = rho & 15; return 8 * (i >> 2) + 4 * n + (i & 3); }

struct GUnit { const char* A; const char* B; int pm, pn, e, row0; };

template <class Epi, class Sched>
DI void gemm8(LAS unsigned char* lds, const int K, const Sched& S, const Epi& E) {
    int tid_ = threadIdx.x; asm volatile("" : "+v"(tid_));
    const int tid = tid_, wid = __builtin_amdgcn_readfirstlane(tid >> 6), lane = tid & 63, wr = wid >> 2, wc = wid & 3, fr = lane & 15, fq = lane >> 4;
    const int nt = K / 64;
    int R[2], C[2]; unsigned voffB[2];
#pragma unroll
    for (int i = 0; i < 2; ++i) { stage_rc(tid * 16 + i * 8192, R[i], C[i]); const int Rb = Epi::PERM ? ((R[i] & ~31) + perm32(R[i] & 31)) : R[i]; voffB[i] = (unsigned)(Rb * K + C[i]) * 2u; }
    const size_t kstep = 128;
    const size_t hstepB = (size_t)128 * K * 2;
    const unsigned ldsw = (unsigned)wid * 1024u;
    const int aoff = lds_byte(wr * 64 + fr, fq * 8), boff = lds_byte(wc * 32 + fr, fq * 8);
#define G8_SA(b, h) (((b) * 2 + (h)) * HTB)
#define G8_SB(b, h) ((4 + (b) * 2 + (h)) * HTB)
#define G8_STAGE(bufoff, gbase, voff) do { _Pragma("unroll") for (int _i = 0; _i < 2; ++_i) \
        __builtin_amdgcn_global_load_lds((const unsigned*)((const char*)(gbase) + (voff)[_i]), (LAS unsigned*)(lds + (bufoff) + ldsw + _i * 8192), 16, 0, 0); } while (0)
#define G8_LDA(dst, b, h) do { _Pragma("unroll") for (int m = 0; m < 4; ++m) _Pragma("unroll") for (int k = 0; k < 2; ++k) dst[m][k] = *(const LAS bf16x8*)(lds + G8_SA(b, h) + aoff + m * 2048 + k * 1024); } while (0)
#define G8_LDB(dst, b, h) do { _Pragma("unroll") for (int n = 0; n < 2; ++n) _Pragma("unroll") for (int k = 0; k < 2; ++k) dst[n][k] = *(const LAS bf16x8*)(lds + G8_SB(b, h) + boff + n * 2048 + k * 1024); } while (0)
#define G8_MMA(ai, bj, At, Bt) do { __builtin_amdgcn_s_setprio(1); _Pragma("unroll") for (int m = 0; m < 4; ++m) _Pragma("unroll") for (int n = 0; n < 2; ++n) _Pragma("unroll") for (int k = 0; k < 2; ++k) \
        acc[ai][bj][m][n] = __builtin_amdgcn_mfma_f32_16x16x32_bf16(Bt[n][k], At[m][k], acc[ai][bj][m][n], 0, 0, 0); __builtin_amdgcn_s_setprio(0); } while (0)
#define G8_WAIT_V(n) asm volatile("s_waitcnt vmcnt(" #n ")" ::: "memory")
#define G8_WAIT_L(n) asm volatile("s_waitcnt lgkmcnt(" #n ")" ::: "memory")
#define G8_BAR __builtin_amdgcn_s_barrier()
#define G8_SCHED __builtin_amdgcn_sched_barrier(0)
    GUnit cur, nxt; int ui = 0;
    if (!S.next(0, cur)) return;
    unsigned aoC[2][2], aoN[2][2];
    S.aoff(cur, R, C, aoC);
    if constexpr (Sched::UNIFORM_AOFF) {
#pragma unroll
        for (int h = 0; h < 2; ++h)
#pragma unroll
            for (int i = 0; i < 2; ++i) aoN[h][i] = aoC[h][i]; }
    f32x4 acc[2][2][4][2];
#pragma unroll
    for (int a = 0; a < 2; ++a)
#pragma unroll
        for (int b = 0; b < 2; ++b)
#pragma unroll
            for (int m = 0; m < 4; ++m)
#pragma unroll
                for (int n = 0; n < 2; ++n) acc[a][b][m][n] = (f32x4){0.f, 0.f, 0.f, 0.f};
    bf16x8 At[4][2], B0[2][2], B1[2][2];
    const char* cA = cur.A; const char* cB = cur.B;
    asm volatile("s_waitcnt vmcnt(0)" ::: "memory");
    G8_STAGE(G8_SB(0, 0), cB, voffB); G8_STAGE(G8_SA(0, 0), cA, aoC[0]); G8_STAGE(G8_SB(0, 1), cB + hstepB, voffB); G8_STAGE(G8_SA(0, 1), cA, aoC[1]);
    if (wr == 1) G8_BAR;
    G8_WAIT_V(4); G8_BAR;
    G8_STAGE(G8_SB(1, 0), cB + kstep, voffB); G8_STAGE(G8_SA(1, 0), cA + kstep, aoC[0]); G8_STAGE(G8_SB(1, 1), cB + hstepB + kstep, voffB);
    G8_WAIT_V(6); G8_BAR;
    for (;;) {
        const bool has_next = S.next(ui + 1, nxt);
        if constexpr (!Sched::UNIFORM_AOFF) {
        if (has_next) S.aoff(nxt, R, C, aoN);
        else {
#pragma unroll
            for (int h = 0; h < 2; ++h)
#pragma unroll
                for (int i = 0; i < 2; ++i) aoN[h][i] = aoC[h][i]; } }
        const char* nA = has_next ? nxt.A : cA; const char* nB = has_next ? nxt.B : cB;
        for (int t = 0; t < nt; t += 2) {
            const bool last = (t == nt - 2);
            const char* a1 = cA + (size_t)(t + 1) * kstep;
            const char* a2 = last ? nA : cA + (size_t)(t + 2) * kstep; const char* b2 = last ? nB : cB + (size_t)(t + 2) * kstep;
            const char* a3 = a2 + kstep; const char* b3 = b2 + kstep;
            unsigned ao2[2][2];
#pragma unroll
            for (int h = 0; h < 2; ++h)
#pragma unroll
                for (int i = 0; i < 2; ++i) ao2[h][i] = (!Sched::UNIFORM_AOFF && last) ? aoN[h][i] : aoC[h][i];
            G8_LDB(B0, 0, 0); G8_SCHED; G8_LDA(At, 0, 0); G8_STAGE(G8_SA(1, 1), a1, aoC[1]);
            G8_WAIT_L(8); G8_BAR; G8_WAIT_L(0); G8_MMA(0, 0, At, B0); G8_BAR; G8_SCHED;
            G8_LDB(B1, 0, 1); G8_STAGE(G8_SB(0, 0), b2, voffB);
            G8_BAR; G8_WAIT_L(0); G8_MMA(0, 1, At, B1); G8_BAR;
            G8_LDA(At, 0, 1); G8_STAGE(G8_SA(0, 0), a2, ao2[0]);
            G8_BAR; G8_WAIT_L(0); G8_MMA(1, 0, At, B0); G8_BAR; G8_SCHED;
            G8_STAGE(G8_SB(0, 1), b2 + hstepB, voffB);
            G8_WAIT_V(6); G8_BAR; G8_MMA(1, 1, At, B1); G8_BAR;
            G8_LDB(B0, 1, 0); G8_SCHED; G8_LDA(At, 1, 0); G8_STAGE(G8_SA(0, 1), a2, ao2[1]);
            G8_WAIT_L(8); G8_BAR; G8_WAIT_L(0); G8_MMA(0, 0, At, B0); G8_BAR; G8_SCHED;
            G8_LDB(B1, 1, 1); G8_STAGE(G8_SB(1, 0), b3, voffB);
            G8_BAR; G8_WAIT_L(0); G8_MMA(0, 1, At, B1); G8_BAR;
            G8_LDA(At, 1, 1); G8_STAGE(G8_SA(1, 0), a3, ao2[0]);
            G8_BAR; G8_WAIT_L(0); G8_MMA(1, 0, At, B0); G8_BAR; G8_SCHED;
            G8_STAGE(G8_SB(1, 1), b3 + hstepB, voffB);
            G8_WAIT_V(6); G8_BAR; G8_MMA(1, 1, At, B1); G8_BAR;
        }
        E(acc, cur, wr, wc, fr, fq);
        if (!has_next) break;
#pragma unroll
        for (int a = 0; a < 2; ++a)
#pragma unroll
            for (int b = 0; b < 2; ++b)
#pragma unroll
                for (int m = 0; m < 4; ++m)
#pragma unroll
                    for (int n = 0; n < 2; ++n) acc[a][b][m][n] = (f32x4){0.f, 0.f, 0.f, 0.f};
        cur = nxt; cA = nA; cB = nB; ++ui;
        if constexpr (!Sched::UNIFORM_AOFF) {
#pragma unroll
        for (int h = 0; h < 2; ++h)
#pragma unroll
            for (int i = 0; i < 2; ++i) aoC[h][i] = aoN[h][i]; }
    }
    G8_WAIT_V(0);
    if (wr == 0) G8_BAR;
    G8_BAR;
#undef G8_SA
#undef G8_SB
#undef G8_STAGE
#undef G8_LDA
#undef G8_LDB
#undef G8_MMA
#undef G8_WAIT_V
#undef G8_WAIT_L
#undef G8_BAR
#undef G8_SCHED
}

constexpr int NXCD = 8, WGM = 8;
struct DenseSched {
    static constexpr bool UNIFORM_AOFF = true;
    const char* A; const char* Bt; int K, nM, nN, nwg, G, c;
    DI void init(const void* A_, const void* Bt_, int Mrows, int N, int K_, int G_, int c_) { A = (const char*)A_; Bt = (const char*)Bt_; K = K_; nM = Mrows / 256; nN = N / 256; nwg = nM * nN; G = G_; c = c_; }
    DI bool next(int i, GUnit& u) const {
        const long L = (long)i * G + c; if (L >= nwg) return false;
        int wgid = (int)L; { const int q = nwg / NXCD, r = nwg % NXCD, xcd = wgid % NXCD, off = wgid / NXCD; wgid = (xcd < r ? xcd * (q + 1) : r * (q + 1) + (xcd - r) * q) + off; }
        const int nig = WGM * nN, gid = wgid / nig, fm = gid * WGM, gsz = (nM - fm) < WGM ? (nM - fm) : WGM;
        u.pm = fm + ((wgid % nig) % gsz); u.pn = (wgid % nig) / gsz; u.e = 0; u.row0 = u.pm * 256;
        u.A = A + (size_t)u.pm * 256 * K * 2; u.B = Bt + (size_t)u.pn * 256 * K * 2; return true;
    }
    DI void aoff(const GUnit&, const int (&R)[2], const int (&C)[2], unsigned (&off)[2][2]) const {
#pragma unroll
        for (int h = 0; h < 2; ++h)
#pragma unroll
            for (int i = 0; i < 2; ++i) off[h][i] = (unsigned)((h * 128 + R[i]) * K + C[i]) * 2u;
    }
};
template <bool GATHER>
struct MoeSched {
    static constexpr bool UNIFORM_AOFF = !GATHER;
    const char* A; const char* W; const int* list; volatile LAS int* misc; int K, G, c;
    DI bool next(int i, GUnit& u) const {
        const int L = i * G + c;
        const int RT = __builtin_amdgcn_readfirstlane(misc[32 + 16]);
        if (L >= RT * 4) return false;
        const int rt = L >> 2; u.pn = L & 3;
        int e = 0;
#pragma unroll
        for (int j = 1; j < 16; ++j) { const int tp = __builtin_amdgcn_readfirstlane(misc[32 + j]); if (tp <= rt) e = j; }
        const int tp = __builtin_amdgcn_readfirstlane(misc[32 + e]);
        u.e = e; u.pm = rt - tp; u.row0 = __builtin_amdgcn_readfirstlane(misc[64 + e]) + u.pm * 256;
        u.A = GATHER ? A : A + (size_t)u.row0 * K * 2;
        u.B = W + ((size_t)e * 1024 + (size_t)u.pn * 256) * K * 2;
        return true;
    }
    DI void aoff(const GUnit& u, const int (&R)[2], const int (&C)[2], unsigned (&off)[2][2]) const {
        if (GATHER) {
            const int cnt = __builtin_amdgcn_readfirstlane(misc[16 + u.e]);
#pragma unroll
            for (int h = 0; h < 2; ++h)
#pragma unroll
                for (int i = 0; i < 2; ++i) { const int idx = u.pm * 256 + h * 128 + R[i]; const int tok = (idx < cnt) ? list[(size_t)u.e * M + idx] : 0; off[h][i] = (unsigned)(tok * K + C[i]) * 2u; }
        } else {
#pragma unroll
            for (int h = 0; h < 2; ++h)
#pragma unroll
                for (int i = 0; i < 2; ++i) off[h][i] = (unsigned)((h * 128 + R[i]) * K + C[i]) * 2u;
        }
    }
};

struct EpiStoreBf16 {
    static constexpr bool PERM = true;
    bf16_t* O; int ldc;
    DI void operator()(const f32x4 (&acc)[2][2][4][2], const GUnit& u, int wr, int wc, int fr, int fq) const {
        const int row0 = u.row0 + wr * 64 + fr, col0 = u.pn * 256 + wc * 32 + 8 * fq;
#pragma unroll
        for (int ai = 0; ai < 2; ++ai)
#pragma unroll
            for (int m = 0; m < 4; ++m) { bf16_t* rowp = O + (size_t)(row0 + ai * 128 + m * 16) * ldc + col0;
#pragma unroll
                for (int bj = 0; bj < 2; ++bj) { const f32x4 v0 = acc[ai][bj][m][0], v1 = acc[ai][bj][m][1];
                    u32x4 w; w.x = pk2(v0[0], v0[1]); w.y = pk2(v0[2], v0[3]); w.z = pk2(v1[0], v1[1]); w.w = pk2(v1[2], v1[3]);
                    *(u32x4*)(rowp + bj * 128) = w; } }
    }
};
struct EpiGateUp {
    static constexpr bool PERM = true;
    bf16_t* O;
    DI void operator()(const f32x4 (&acc)[2][2][4][2], const GUnit& u, int wr, int wc, int fr, int fq) const {
        const int row0 = u.row0 + wr * 64 + fr, col0 = u.pn * 128 + wc * 32 + 8 * fq;
#pragma unroll
        for (int ai = 0; ai < 2; ++ai)
#pragma unroll
            for (int m = 0; m < 4; ++m) { bf16_t* rowp = O + (size_t)(row0 + ai * 128 + m * 16) * 512 + col0;
                float hv[8];
#pragma unroll
                for (int n = 0; n < 2; ++n)
#pragma unroll
                    for (int i = 0; i < 4; ++i) hv[n * 4 + i] = silu(acc[ai][0][m][n][i]) * acc[ai][1][m][n][i];
                u32x4 w; w.x = pk2(hv[0], hv[1]); w.y = pk2(hv[2], hv[3]); w.z = pk2(hv[4], hv[5]); w.w = pk2(hv[6], hv[7]);
                *(u32x4*)rowp = w; }
    }
};
struct EpiResidual {
    static constexpr bool PERM = false;
    float* hc; float* hx; const float* modl;
    DI void operator()(const f32x4 (&acc)[2][2][4][2], const GUnit& u, int wr, int wc, int fr, int fq) const {
        const int b = u.pm / 9, tt = u.pm % 9;
        float* base = (tt == 0) ? hc + (size_t)b * CTX * DM : hx + ((size_t)b * SEQ + (size_t)(tt - 1) * 256) * DM;
        const float* gate = modl + (size_t)((tt == 0) ? 16 : b) * 6144 + 2 * DM;
        const int row0 = wr * 64 + fr, col0 = u.pn * 256 + wc * 32 + 4 * fq;
#pragma unroll
        for (int ai = 0; ai < 2; ++ai)
#pragma unroll
            for (int m = 0; m < 4; ++m) { float* rowp = base + (size_t)(row0 + ai * 128 + m * 16) * DM + col0;
#pragma unroll
                for (int bj = 0; bj < 2; ++bj)
#pragma unroll
                    for (int n = 0; n < 2; ++n) { f32x4* p = (f32x4*)(rowp + bj * 128 + n * 16); const f32x4 gv = *(const f32x4*)(gate + col0 + bj * 128 + n * 16); *p = *p + gv * acc[ai][bj][m][n]; }
                asm volatile("" ::: "memory"); }
    }
};

struct Ctx {
    LAS unsigned char* L; volatile LAS int* misc; unsigned char* ws; int tid, lane, wave, G, bid;
};
DI float* hrow(const Params& P, int m) { const int b = m / T, t = m - b * T; return (t < CTX) ? (float*)(P.ws + WS_HC) + ((size_t)b * CTX + t) * DM : P.out + ((size_t)b * SEQ + (t - CTX)) * DM; }

DI void phase_prologue(const Params& P, Ctx& X) {
    float* MOD = (float*)(P.ws + WS_MOD);
    LAS float* tab = (LAS float*)(X.L + X.wave * 8704);
    for (int u = X.bid; u < 4 * 48; u += X.G) {
        const int l = u / 48, jc = u % 48;
        __syncthreads();
        for (int idx = X.lane; idx < 17 * 128; idx += 64) { const int r = idx >> 7, kk = idx & 127; const float* src = (r < 16) ? P.c + r * DM : P.c_ctx; tab[idx] = silu(src[X.wave * 128 + kk]); }
        __syncthreads();
        float a0[17], a1[17];
#pragma unroll
        for (int r = 0; r < 17; ++r) { a0[r] = 0.f; a1[r] = 0.f; }
        const float* wp = P.w_mod + ((size_t)l * DM + X.wave * 128) * 6144 + jc * 128 + 2 * X.lane;
#pragma unroll 4
        for (int kk = 0; kk < 128; ++kk) { const f32x2 w2 = *(const f32x2*)(wp + (size_t)kk * 6144);
#pragma unroll
            for (int r = 0; r < 17; ++r) { const float a = tab[r * 128 + kk]; a0[r] += a * w2.x; a1[r] += a * w2.y; } }
        __syncthreads();
#pragma unroll
        for (int r = 0; r < 17; ++r) { tab[r * 128 + 2 * X.lane] = a0[r]; tab[r * 128 + 2 * X.lane + 1] = a1[r]; }
        __syncthreads();
        for (int idx = X.tid; idx < 17 * 128; idx += NTHR) { const int r = idx >> 7, j = idx & 127; float s = P.b_mod[l * 6144 + jc * 128 + j];
#pragma unroll
            for (int w = 0; w < 8; ++w) s += ((LAS float*)(X.L + w * 8704))[idx];
            MOD[((size_t)l * 17 + r) * 6144 + jc * 128 + j] = s; }
    }
    __syncthreads();
    f32x2* rope = (f32x2*)(P.ws + WS_ROPE);
    for (int e = X.bid * NTHR + X.tid; e < SEQ * 16; e += X.G * NTHR) { const int p = e >> 4, d = e & 15; const int row = p >> 6, col = p & 63;
        const float inv = powf(10000.f, -(float)(d & 7) / 8.f); const float ang = (float)((d < 8) ? row : col) * inv; rope[e] = (f32x2){cosf(ang), sinf(ang)}; }
    u32x4* wz = (u32x4*)((bf16_t*)(P.ws + WS_WIN) + (size_t)2496 * DM);
    for (int e = X.bid * NTHR + X.tid; e < 64 * DM * 2 / 16; e += X.G * NTHR) wz[e] = (u32x4){0u, 0u, 0u, 0u};
}

DI void cvt_item(const float* W, int ldw, int N, int k0, int n0, bf16_t* WT, int K, int row0, const float* kscale, float mul, LAS float* scr, int lane) {
#pragma unroll 8
    for (int i = 0; i < 32; ++i) { const int kk = 2 * i + (lane >> 5), n = n0 + (lane & 31);
        float v = (n < N) ? W[(size_t)(k0 + kk) * ldw + n] : 0.f; if (kscale) v *= kscale[k0 + kk];
        scr[kk * 33 + (lane & 31)] = v * mul; }
    LDS_WAIT(); asm volatile("" ::: "memory");
    const int c = lane & 7;
#pragma unroll
    for (int j = 0; j < 4; ++j) { const int nn = (lane >> 3) + 8 * j; const LAS float* s = scr + (8 * c) * 33 + nn;
        u32x4 o; o.x = pk2(s[0 * 33], s[1 * 33]); o.y = pk2(s[2 * 33], s[3 * 33]); o.z = pk2(s[4 * 33], s[5 * 33]); o.w = pk2(s[6 * 33], s[7 * 33]);
        *(u32x4*)(WT + (size_t)(row0 + nn) * K + k0 + 8 * c) = o; }
    LDS_WAIT(); asm volatile("" ::: "memory");
}
DI void convert_weights(const Params& P, Ctx& X, int l) {
    LAS float* scr = (LAS float*)(X.L + X.wave * 8704);
    const int gw = X.bid * NWAVE + X.wave, NGW = X.G * NWAVE;
    constexpr int I_IN = 16 * 78, I_OUT = 16 * 32, I_UQ = 4 * 12, I_UKV = 2 * 16, I_E = 768, NIT = I_IN + I_OUT + I_UQ + I_UKV + 16 * I_E;
    for (int it = gw; it < NIT; it += NGW) {
        int r = it;
        if (r < I_IN) { cvt_item(P.w_in + (size_t)l * DM * INW, INW, INW, 64 * (r / 78), 32 * (r % 78), (bf16_t*)(P.ws + WS_WIN), DM, 32 * (r % 78), nullptr, 1.f, scr, X.lane); continue; } r -= I_IN;
        if (r < I_OUT) { cvt_item(P.w_out + (size_t)l * DM * DM, DM, DM, 64 * (r / 32), 32 * (r % 32), (bf16_t*)(P.ws + WS_WOUT), DM, 32 * (r % 32), nullptr, 1.f, scr, X.lane); continue; } r -= I_OUT;
        if (r < I_UQ) { cvt_item(P.w_uq + (size_t)l * 256 * 384, 384, 384, 64 * (r / 12), 32 * (r % 12), (bf16_t*)(P.ws + WS_WUQ), 256, 32 * (r % 12), P.mq_g + l * 256, MLA_QS, scr, X.lane); continue; } r -= I_UQ;
        if (r < I_UKV) { cvt_item(P.w_ukv + (size_t)l * 128 * 512, 512, 512, 64 * (r / 16), 32 * (r % 16), (bf16_t*)(P.ws + WS_WUKV), 128, 32 * (r % 16), P.mkv_g + l * 128, 1.f, scr, X.lane); continue; } r -= I_UKV;
        const int e = r / I_E; r -= e * I_E;
        if (r < 256) { const int kb = r / 16, nb = r % 16;
            cvt_item(P.wg + ((size_t)l * 16 + e) * DM * 512, 512, 512, 64 * kb, 32 * nb, (bf16_t*)(P.ws + WS_WGU) + (size_t)e * 1024 * DM, DM, 256 * (nb >> 2) + 32 * (nb & 3), nullptr, 1.f, scr, X.lane); continue; } r -= 256;
        if (r < 256) { const int kb = r / 16, nb = r % 16;
            cvt_item(P.wu + ((size_t)l * 16 + e) * DM * 512, 512, 512, 64 * kb, 32 * nb, (bf16_t*)(P.ws + WS_WGU) + (size_t)e * 1024 * DM, DM, 256 * (nb >> 2) + 128 + 32 * (nb & 3), nullptr, 1.f, scr, X.lane); continue; } r -= 256;
        { const int kb = r / 32, nb = r % 32;
            cvt_item(P.wd + ((size_t)l * 16 + e) * 512 * DM, DM, DM, 64 * kb, 32 * nb, (bf16_t*)(P.ws + WS_WD) + (size_t)e * 1024 * 512, 512, 32 * nb, nullptr, 1.f, scr, X.lane); }
    }
}

DI int slot_base_lane(const unsigned* cnt, int lane) {
    int c = (lane < 16) ? (int)cnt[lane] : 0;
    int tiles = (c + 255) >> 8;
    int incl = tiles;
#pragma unroll
    for (int o = 1; o < 16; o <<= 1) { const int v = __shfl_up(incl, o); if (lane >= o) incl += v; }
    return (incl - tiles) * 256;
}

DI void phase_norm1(const Params& P, Ctx& X, int l) {
    convert_weights(P, X, l);
    const float* MOD = (const float*)(P.ws + WS_MOD);
    bf16_t* ACT = (bf16_t*)(P.ws + WS_ACT);
    const bf16_t* YS = (const bf16_t*)(P.ws + WS_YS);
    const u32x4* TOK = (const u32x4*)(P.ws + WS_TOK);
    const unsigned* cnt = (const unsigned*)(P.ws + WS_CTL) + CW_CNT + (l > 0 ? (l - 1) * 16 : 0);
    const int sbase = (l > 0) ? slot_base_lane(cnt, X.lane) : 0;
    const int gw = X.bid * NWAVE + X.wave, NGW = X.G * NWAVE;
    const float* g = P.g_mix + l * DM;
    for (int m = gw; m < M; m += NGW) {
        const int b = m / T, t = m - b * T;
        f32x4 v[4];
        float* hp = hrow(P, m);
        if (l == 0) {
            const float* src = (t < CTX) ? P.ctx + ((size_t)b * CTX + t) * DM : P.x + ((size_t)b * SEQ + (t - CTX)) * DM;
#pragma unroll
            for (int j = 0; j < 4; ++j) v[j] = *(const f32x4*)(src + 256 * j + 4 * X.lane);
        } else {
            const float* gate = MOD + ((size_t)(l - 1) * 17 + ((t < CTX) ? 16 : b)) * 6144 + 5 * DM;
            const u32x4 ti = TOK[m];
            const int s0 = __shfl(sbase, (int)(ti.x & 15u)) + (int)(ti.x >> 4), s1 = __shfl(sbase, (int)(ti.y & 15u)) + (int)(ti.y >> 4);
            const float w0 = __uint_as_float(ti.z), w1 = __uint_as_float(ti.w);
            const bf16_t* y0 = YS + (size_t)s0 * DM; const bf16_t* y1 = YS + (size_t)s1 * DM;
#pragma unroll
            for (int j = 0; j < 4; ++j) { const int cidx = 256 * j + 4 * X.lane;
                const f32x4 hv = *(const f32x4*)(hp + cidx); const f32x4 gv = *(const f32x4*)(gate + cidx);
                const u32x2 a = *(const u32x2*)(y0 + cidx), bb = *(const u32x2*)(y1 + cidx);
                f32x4 yv; yv[0] = w0 * bflo(a.x) + w1 * bflo(bb.x); yv[1] = w0 * bfhi(a.x) + w1 * bfhi(bb.x); yv[2] = w0 * bflo(a.y) + w1 * bflo(bb.y); yv[3] = w0 * bfhi(a.y) + w1 * bfhi(bb.y);
                v[j] = hv + gv * yv; }
        }
        float ss = 0.f;
#pragma unroll
        for (int j = 0; j < 4; ++j) { *(f32x4*)(hp + 256 * j + 4 * X.lane) = v[j]; ss += v[j][0] * v[j][0] + v[j][1] * v[j][1] + v[j][2] * v[j][2] + v[j][3] * v[j][3]; }
        const float rstd = rsqrtf(wave_sum(ss) * (1.f / DM) + EPS);
        const float* mrow = MOD + ((size_t)l * 17 + ((t < CTX) ? 16 : b)) * 6144;
#pragma unroll
        for (int j = 0; j < 4; ++j) { const int cidx = 256 * j + 4 * X.lane;
            const f32x4 gg = *(const f32x4*)(g + cidx), sh = *(const f32x4*)(mrow + cidx), sc = *(const f32x4*)(mrow + DM + cidx);
            const f32x4 uu = v[j] * rstd * gg * (sc + 1.f) + sh;
            u32x2 o; o.x = pk2(uu[0], uu[1]); o.y = pk2(uu[2], uu[3]);
            *(u32x2*)(ACT + (size_t)m * DM + cidx) = o; }
    }
}
DI void phase_final(const Params& P, Ctx& X) {
    const float* MOD = (const float*)(P.ws + WS_MOD);
    const bf16_t* YS = (const bf16_t*)(P.ws + WS_YS);
    const u32x4* TOK = (const u32x4*)(P.ws + WS_TOK);
    const unsigned* cnt = (const unsigned*)(P.ws + WS_CTL) + CW_CNT + 3 * 16;
    const int sbase = slot_base_lane(cnt, X.lane);
    const int gw = X.bid * NWAVE + X.wave, NGW = X.G * NWAVE;
    for (int r = gw; r < NB * SEQ; r += NGW) {
        const int b = r / SEQ, p = r - b * SEQ, m = b * T + CTX + p;
        float* hp = P.out + (size_t)r * DM;
        const float* gate = MOD + ((size_t)3 * 17 + b) * 6144 + 5 * DM;
        const u32x4 ti = TOK[m];
        const int s0 = __shfl(sbase, (int)(ti.x & 15u)) + (int)(ti.x >> 4), s1 = __shfl(sbase, (int)(ti.y & 15u)) + (int)(ti.y >> 4);
        const float w0 = __uint_as_float(ti.z), w1 = __uint_as_float(ti.w);
        const bf16_t* y0 = YS + (size_t)s0 * DM; const bf16_t* y1 = YS + (size_t)s1 * DM;
        f32x4 v[4]; float ss = 0.f;
#pragma unroll
        for (int j = 0; j < 4; ++j) { const int cidx = 256 * j + 4 * X.lane;
            const f32x4 hv = *(const f32x4*)(hp + cidx); const f32x4 gv = *(const f32x4*)(gate + cidx);
            const u32x2 a = *(const u32x2*)(y0 + cidx), bb = *(const u32x2*)(y1 + cidx);
            f32x4 yv; yv[0] = w0 * bflo(a.x) + w1 * bflo(bb.x); yv[1] = w0 * bfhi(a.x) + w1 * bfhi(bb.x); yv[2] = w0 * bflo(a.y) + w1 * bflo(bb.y); yv[3] = w0 * bfhi(a.y) + w1 * bfhi(bb.y);
            v[j] = hv + gv * yv; ss += v[j][0] * v[j][0] + v[j][1] * v[j][1] + v[j][2] * v[j][2] + v[j][3] * v[j][3]; }
        const float rstd = rsqrtf(wave_sum(ss) * (1.f / DM) + EPS);
#pragma unroll
        for (int j = 0; j < 4; ++j) { const int cidx = 256 * j + 4 * X.lane; *(f32x4*)(hp + cidx) = v[j] * rstd * *(const f32x4*)(P.fin_g + cidx); }
    }
}

DI void phase_postproj(const Params& P, Ctx& X, int l) {
    bf16_t* PROJ = (bf16_t*)(P.ws + WS_PROJ);
    const f32x2* rope = (const f32x2*)(P.ws + WS_ROPE);
    bf16_t* XBC = (bf16_t*)(P.ws + WS_XBC); float* DT = (float*)(P.ws + WS_DT);
    bf16_t* MLAQ = (bf16_t*)(P.ws + WS_MLAQ); bf16_t* MLAK = (bf16_t*)(P.ws + WS_MLAK);
    bf16_t* VTM = (bf16_t*)(P.ws + WS_VTM); bf16_t* VTD = (bf16_t*)(P.ws + WS_VTD);
    const bf16_t* WUQ = (const bf16_t*)(P.ws + WS_WUQ); const bf16_t* WUKV = (const bf16_t*)(P.ws + WS_WUKV);
    const int lane = X.lane, wave = X.wave;
    for (int u = X.bid; u < M / 144; u += X.G) {
        const int m0 = u * 144, b = m0 / T, t0 = m0 - b * T;
        __syncthreads();
        float cw[3][12], cb[12];
#pragma unroll
        for (int g3 = 0; g3 < 3; ++g3)
#pragma unroll
            for (int i = 0; i < 4; ++i) { const int ch = 256 * g3 + 4 * lane + i; cb[g3 * 4 + i] = P.conv_b[l * 768 + ch];
#pragma unroll
                for (int k = 0; k < 3; ++k) cw[k][g3 * 4 + i] = P.conv_w[((size_t)l * 3 + k) * 768 + ch]; }
        for (int rr = 0; rr < 18; ++rr) {
            const int t = t0 + wave * 18 + rr; const size_t m = (size_t)b * T + t;
            bf16_t* prow = PROJ + m * PW;
            { const int vv = lane >> 2, d0 = 4 * (lane & 3);
              bf16_t* p1 = prow + vv * 32 + d0;
              const u32x2 a = *(const u32x2*)p1, bq = *(const u32x2*)(p1 + 16);
              float x1[4] = {bflo(a.x), bfhi(a.x), bflo(a.y), bfhi(a.y)}, x2[4] = {bflo(bq.x), bfhi(bq.x), bflo(bq.y), bfhi(bq.y)};
              const float qs = (vv < 8) ? DA_QS : 1.f;
              float o1[4], o2[4];
              if (t >= CTX) { const f32x2* rp = rope + (size_t)(t - CTX) * 16 + d0;
#pragma unroll
                  for (int i = 0; i < 4; ++i) { const f32x2 cs = rp[i]; o1[i] = (x1[i] * cs.x - x2[i] * cs.y) * qs; o2[i] = (x2[i] * cs.x + x1[i] * cs.y) * qs; } }
              else {
#pragma unroll
                  for (int i = 0; i < 4; ++i) { o1[i] = x1[i] * qs; o2[i] = x2[i] * qs; } }
              u32x2 w1, w2; w1.x = pk2(o1[0], o1[1]); w1.y = pk2(o1[2], o1[3]); w2.x = pk2(o2[0], o2[1]); w2.y = pk2(o2[2], o2[3]);
              *(u32x2*)p1 = w1; *(u32x2*)(p1 + 16) = w2; }
            { const u32x2 vv = *(const u32x2*)(prow + C_DAV + 4 * lane);
              *(LAS u32x2*)(X.L + (size_t)(wave * 18 + rr) * 520 + lane * 8) = vv; }
            { const int lo = (t < CTX) ? 0 : CTX, hi = (t < CTX) ? CTX : T;
#pragma unroll
              for (int g3 = 0; g3 < 3; ++g3) { const int ch = 256 * g3 + 4 * lane;
                  const u32x2 c0 = *(const u32x2*)(prow + C_XBC + ch);
                  u32x2 cm = {0u, 0u}, cp = {0u, 0u};
                  if (t - 1 >= lo) cm = *(const u32x2*)(prow - PW + C_XBC + ch);
                  if (t + 1 < hi) cp = *(const u32x2*)(prow + PW + C_XBC + ch);
                  const float xm[4] = {bflo(cm.x), bfhi(cm.x), bflo(cm.y), bfhi(cm.y)}, x0[4] = {bflo(c0.x), bfhi(c0.x), bflo(c0.y), bfhi(c0.y)}, xp[4] = {bflo(cp.x), bfhi(cp.x), bflo(cp.y), bfhi(cp.y)};
                  float o[4];
#pragma unroll
                  for (int i = 0; i < 4; ++i) o[i] = silu(cb[g3 * 4 + i] + cw[0][g3 * 4 + i] * xm[i] + cw[1][g3 * 4 + i] * x0[i] + cw[2][g3 * 4 + i] * xp[i]);
                  u32x2 w; w.x = pk2(o[0], o[1]); w.y = pk2(o[2], o[3]);
                  *(u32x2*)(XBC + m * 768 + ch) = w; } }
            if (lane < 16) { const float v = __uint_as_float(((unsigned)prow[C_DT + lane]) << 16) + P.dt_bias[l * 16 + lane]; DT[m * 16 + lane] = (v > 20.f) ? v : log1pf(__expf(v)); }
            if (lane < 16) { const float x1 = __uint_as_float(((unsigned)prow[C_KR + lane]) << 16), x2 = __uint_as_float(((unsigned)prow[C_KR + 16 + lane]) << 16);
                float o1 = x1, o2 = x2;
                if (t >= CTX) { const f32x2 cs = rope[(size_t)(t - CTX) * 16 + lane]; o1 = x1 * cs.x - x2 * cs.y; o2 = x2 * cs.x + x1 * cs.y; }
                const bf16_t b1 = (bf16_t)(pk2(o1, 0.f) & 0xffffu), b2 = (bf16_t)(pk2(o2, 0.f) & 0xffffu);
#pragma unroll
                for (int h = 0; h < 4; ++h) { MLAK[(m * 4 + h) * 96 + 64 + lane] = b1; MLAK[(m * 4 + h) * 96 + 80 + lane] = b2; } }
        }
        __syncthreads();
        { const int vr = X.tid >> 1, th = X.tid & 1;
          bf16_t* dst = VTD + ((size_t)b * 256 + vr) * T + t0 + th * 72;
#pragma unroll 1
          for (int q8 = 0; q8 < 9; ++q8) { unsigned w[4];
#pragma unroll
              for (int i = 0; i < 4; ++i) { const int tt = th * 72 + q8 * 8 + 2 * i;
                  const unsigned lo = *(const LAS unsigned short*)(X.L + (size_t)tt * 520 + vr * 2), hi = *(const LAS unsigned short*)(X.L + (size_t)(tt + 1) * 520 + vr * 2);
                  w[i] = lo | (hi << 16); }
              *(u32x4*)(dst + q8 * 8) = (u32x4){w[0], w[1], w[2], w[3]}; } }
        { const int tk = lane & 15, q4 = lane >> 4;
          bf16x8 bw[3][8];
#pragma unroll
          for (int ct = 0; ct < 3; ++ct)
#pragma unroll
              for (int s = 0; s < 8; ++s) bw[ct][s] = *(const bf16x8*)(WUQ + (size_t)((3 * wave + ct) * 16 + tk) * 256 + 32 * s + 8 * q4);
          for (int rt = 0; rt < 9; ++rt) {
              const int t = t0 + rt * 16 + tk; const size_t m = (size_t)b * T + t;
              bf16x8 af[8]; float ss = 0.f;
#pragma unroll
              for (int s = 0; s < 8; ++s) { af[s] = *(const bf16x8*)(PROJ + m * PW + C_CQ + 32 * s + 8 * q4);
#pragma unroll
                  for (int j = 0; j < 8; ++j) { const float f = __uint_as_float(((unsigned)(unsigned short)af[s][j]) << 16); ss += f * f; } }
              ss += __shfl_xor(ss, 16); ss += __shfl_xor(ss, 32);
              const float rstd = rsqrtf(ss * (1.f / 256.f) + EPS);
              f32x4 acc[3];
#pragma unroll
              for (int ct = 0; ct < 3; ++ct) { acc[ct] = (f32x4){0.f, 0.f, 0.f, 0.f};
#pragma unroll
                  for (int s = 0; s < 8; ++s) acc[ct] = MFMA16(bw[ct][s], af[s], acc[ct]);
                  acc[ct] = acc[ct] * rstd; }
              if ((wave & 1) && t >= CTX) {
                  const f32x2* rp = rope + (size_t)(t - CTX) * 16 + 4 * q4;
#pragma unroll
                  for (int i = 0; i < 4; ++i) { const f32x2 cs = rp[i]; const float x1 = acc[1][i], x2 = acc[2][i]; acc[1][i] = x1 * cs.x - x2 * cs.y; acc[2][i] = x2 * cs.x + x1 * cs.y; } }
#pragma unroll
              for (int ct = 0; ct < 3; ++ct) { u32x2 w; w.x = pk2(acc[ct][0], acc[ct][1]); w.y = pk2(acc[ct][2], acc[ct][3]);
                  *(u32x2*)(MLAQ + m * 384 + (3 * wave + ct) * 16 + 4 * q4) = w; }
          }
        }
        { const int tk = lane & 15, q4 = lane >> 4, hh = wave >> 1;
          bf16x8 bw[4][4];
#pragma unroll
          for (int ct = 0; ct < 4; ++ct)
#pragma unroll
              for (int s = 0; s < 4; ++s) bw[ct][s] = *(const bf16x8*)(WUKV + (size_t)((4 * wave + ct) * 16 + tk) * 128 + 32 * s + 8 * q4);
          for (int rt = 0; rt < 9; ++rt) {
              const int t = t0 + rt * 16 + tk; const size_t m = (size_t)b * T + t;
              bf16x8 af[4]; float ss = 0.f;
#pragma unroll
              for (int s = 0; s < 4; ++s) { af[s] = *(const bf16x8*)(PROJ + m * PW + C_CKV + 32 * s + 8 * q4);
#pragma unroll
                  for (int j = 0; j < 8; ++j) { const float f = __uint_as_float(((unsigned)(unsigned short)af[s][j]) << 16); ss += f * f; } }
              ss += __shfl_xor(ss, 16); ss += __shfl_xor(ss, 32);
              const float rstd = rsqrtf(ss * (1.f / 128.f) + EPS);
              if ((wave & 1) == 0) {
#pragma unroll
                  for (int ct = 0; ct < 4; ++ct) { f32x4 acc = {0.f, 0.f, 0.f, 0.f};
#pragma unroll
                      for (int s = 0; s < 4; ++s) acc = MFMA16(bw[ct][s], af[s], acc);
                      acc = acc * rstd;
                      u32x2 w; w.x = pk2(acc[0], acc[1]); w.y = pk2(acc[2], acc[3]);
                      *(u32x2*)(MLAK + (m * 4 + hh) * 96 + ct * 16 + 4 * q4) = w; }
              } else {
                  float rs[4];
#pragma unroll
                  for (int i = 0; i < 4; ++i) rs[i] = __shfl(rstd, 4 * q4 + i);
#pragma unroll
                  for (int ct = 0; ct < 4; ++ct) { f32x4 acc = {0.f, 0.f, 0.f, 0.f};
#pragma unroll
                      for (int s = 0; s < 4; ++s) acc = MFMA16(af[s], bw[ct][s], acc);
                      u32x2 w; w.x = pk2(acc[0] * rs[0], acc[1] * rs[1]); w.y = pk2(acc[2] * rs[2], acc[3] * rs[3]);
                      *(u32x2*)(VTM + (((size_t)b * 4 + hh) * 64 + ct * 16 + tk) * T + t0 + rt * 16 + 4 * q4) = w; }
              }
          }
        }
    }
}

template <int KIND>
DI void attn_unit(const Params& P, Ctx& X, int l, int b, int h, int qt, float lam, float lam_init) {
    constexpr int DK = KIND ? 96 : 64, KROW = DK * 2 + 16, NS = KIND ? 6 : 2;
    constexpr int KBUF = 64 * KROW, VROW = 136, VBUF = 64 * VROW;
    constexpr int OFF_K = 0, OFF_V = 2 * KBUF, OFF_X = 36864;
    const bf16_t* PROJ = (const bf16_t*)(P.ws + WS_PROJ);
    const bf16_t* MLAQ = (const bf16_t*)(P.ws + WS_MLAQ); const bf16_t* MLAK = (const bf16_t*)(P.ws + WS_MLAK);
    const bf16_t* VT = (const bf16_t*)(P.ws + (KIND ? WS_VTM : WS_VTD)) + ((size_t)b * 4 + h) * 64 * T;
    bf16_t* ACT = (bf16_t*)(P.ws + WS_ACT);
    const int tid = X.tid, lane = X.lane, wave = X.wave, r = lane & 31, hh = lane >> 5;
    const int mmw = KIND ? 0 : (wave & 1), qg = KIND ? wave : (wave >> 1);
    const bool is_ctx = KIND ? (qt == 0) : (qt < 2);
    const int nk = is_ctx ? CTX : T, ntile = nk / 64;
    const size_t mrow = (size_t)b * T + qt * (KIND ? 256 : 128) + qg * 32 + r;
    bf16x8 qf[NS];
#pragma unroll
    for (int s = 0; s < NS; ++s)
        qf[s] = KIND ? *(const bf16x8*)(MLAQ + mrow * 384 + h * 96 + 16 * s + 8 * hh) : *(const bf16x8*)(PROJ + mrow * PW + C_DAQ + h * 64 + mmw * 32 + 16 * s + 8 * hh);
    const int kcol = mmw * 64 + 16 * hh;
    const int kkey = KIND ? (tid / 12) : (tid >> 3), kpc = KIND ? (tid % 12) : (tid & 7);
    const int kkey2 = (512 + tid) / 12, kpc2 = (512 + tid) % 12;
    const int vdv = tid >> 3, vpc = tid & 7;
    u32x4 kr0, kr1 = {0u, 0u, 0u, 0u}, vr0;
    auto gload = [&](int it) {
        const int key0 = it * 64;
        if (KIND) { kr0 = *(const u32x4*)(MLAK + (((size_t)b * T + key0 + kkey) * 4 + h) * 96 + kpc * 8);
                    if (tid < 256) kr1 = *(const u32x4*)(MLAK + (((size_t)b * T + key0 + kkey2) * 4 + h) * 96 + kpc2 * 8); }
        else kr0 = *(const u32x4*)(PROJ + ((size_t)b * T + key0 + kkey) * PW + C_DAK + h * 64 + kpc * 8);
        vr0 = *(const u32x4*)(VT + (size_t)vdv * T + key0 + vpc * 8);
    };
    auto lstore = [&](int buf) {
        *(LAS u32x4*)(X.L + OFF_K + buf * KBUF + kkey * KROW + kpc * 16) = kr0;
        if (KIND && tid < 256) *(LAS u32x4*)(X.L + OFF_K + buf * KBUF + kkey2 * KROW + kpc2 * 16) = kr1;
        LAS unsigned char* vp = X.L + OFF_V + buf * VBUF + vdv * VROW + vpc * 16;
        *(LAS u32x2*)vp = (u32x2){vr0.x, vr0.y}; *(LAS u32x2*)(vp + 8) = (u32x2){vr0.z, vr0.w};
    };
    f32x16 O[2]; float mrun = -1e30f, lsum = 0.f;
#pragma unroll
    for (int d = 0; d < 2; ++d)
#pragma unroll
        for (int i = 0; i < 16; ++i) O[d][i] = 0.f;
    __syncthreads();
    gload(0); lstore(0);
    __syncthreads();
    for (int it = 0; it < ntile; ++it) {
        const int buf = it & 1;
        if (it + 1 < ntile) gload(it + 1);
        const LAS unsigned char* Kb = X.L + OFF_K + buf * KBUF; const LAS unsigned char* Vb = X.L + OFF_V + buf * VBUF;
        f32x16 S0, S1;
#pragma unroll
        for (int i = 0; i < 16; ++i) { S0[i] = 0.f; S1[i] = 0.f; }
#pragma unroll
        for (int s = 0; s < NS; ++s) {
            const bf16x8 k0 = *(const LAS bf16x8*)(Kb + r * KROW + kcol + 32 * s);
            const bf16x8 k1 = *(const LAS bf16x8*)(Kb + (32 + r) * KROW + kcol + 32 * s);
            S0 = MFMA32(k0, qf[s], S0); S1 = MFMA32(k1, qf[s], S1);
        }
        float mx = S0[0];
#pragma unroll
        for (int i = 1; i < 16; ++i) mx = fmaxf(mx, S0[i]);
#pragma unroll
        for (int i = 0; i < 16; ++i) mx = fmaxf(mx, S1[i]);
        mx = fmaxf(mx, __shfl_xor(mx, 32));
        const float mnew = fmaxf(mrun, mx), alpha = fexp2(mrun - mnew);
        mrun = mnew;
        float ps = 0.f;
#pragma unroll
        for (int i = 0; i < 16; ++i) { S0[i] = fexp2(S0[i] - mnew); S1[i] = fexp2(S1[i] - mnew); ps += S0[i] + S1[i]; }
        lsum = lsum * alpha + ps;
#pragma unroll
        for (int d = 0; d < 2; ++d)
#pragma unroll
            for (int i = 0; i < 16; ++i) O[d][i] *= alpha;
        bf16x8 pf[2][2];
#pragma unroll
        for (int s = 0; s < 2; ++s) {
            u32x4 w0, w1;
            w0.x = pk2(S0[8 * s + 0], S0[8 * s + 1]); w0.y = pk2(S0[8 * s + 2], S0[8 * s + 3]); w0.z = pk2(S0[8 * s + 4], S0[8 * s + 5]); w0.w = pk2(S0[8 * s + 6], S0[8 * s + 7]);
            w1.x = pk2(S1[8 * s + 0], S1[8 * s + 1]); w1.y = pk2(S1[8 * s + 2], S1[8 * s + 3]); w1.z = pk2(S1[8 * s + 4], S1[8 * s + 5]); w1.w = pk2(S1[8 * s + 6], S1[8 * s + 7]);
            pf[0][s] = __builtin_bit_cast(bf16x8, w0); pf[1][s] = __builtin_bit_cast(bf16x8, w1);
        }
#pragma unroll
        for (int d = 0; d < 2; ++d)
#pragma unroll
            for (int kb = 0; kb < 2; ++kb)
#pragma unroll
                for (int s = 0; s < 2; ++s) {
                    const LAS unsigned char* vp = Vb + (32 * d + r) * VROW + (32 * kb + 16 * s + 4 * hh) * 2;
                    const s16x4 lo = *(const LAS s16x4*)vp, hi = *(const LAS s16x4*)(vp + 16);
                    const bf16x8 vf = __builtin_shufflevector(lo, hi, 0, 1, 2, 3, 4, 5, 6, 7);
                    O[d] = MFMA32(vf, pf[kb][s], O[d]);
                }
        if (it + 1 < ntile) lstore(buf ^ 1);
        __syncthreads();
    }
    const float inv = 1.f / (lsum + __shfl_xor(lsum, 32));
    if (KIND == 0) {
        LAS float* xb = (LAS float*)(X.L + OFF_X) + qg * 2048 + lane;
        if (mmw == 1) {
#pragma unroll
            for (int d = 0; d < 2; ++d)
#pragma unroll
                for (int i = 0; i < 16; ++i) xb[(d * 16 + i) * 64] = O[d][i] * inv;
        }
        __syncthreads();
        if (mmw == 0) {
            float ss = 0.f;
#pragma unroll
            for (int d = 0; d < 2; ++d)
#pragma unroll
                for (int i = 0; i < 16; ++i) { const float o = O[d][i] * inv - lam * xb[(d * 16 + i) * 64]; O[d][i] = o; ss += o * o; }
            ss += __shfl_xor(ss, 32);
            const float rstd = rsqrtf(ss * (1.f / 64.f) + EPS) * (1.f - lam_init);
#pragma unroll
            for (int d = 0; d < 2; ++d)
#pragma unroll
                for (int g4 = 0; g4 < 4; ++g4) { const int dv = 32 * d + 8 * g4 + 4 * hh; const f32x4 gg = *(const f32x4*)(P.da_g + l * 64 + dv);
                    u32x2 w; w.x = pk2(O[d][4 * g4] * rstd * gg[0], O[d][4 * g4 + 1] * rstd * gg[1]); w.y = pk2(O[d][4 * g4 + 2] * rstd * gg[2], O[d][4 * g4 + 3] * rstd * gg[3]);
                    *(u32x2*)(ACT + mrow * DM + h * 64 + dv) = w; }
        }
    } else {
#pragma unroll
        for (int d = 0; d < 2; ++d)
#pragma unroll
            for (int g4 = 0; g4 < 4; ++g4) { const int dv = 32 * d + 8 * g4 + 4 * hh;
                u32x2 w; w.x = pk2(O[d][4 * g4] * inv, O[d][4 * g4 + 1] * inv); w.y = pk2(O[d][4 * g4 + 2] * inv, O[d][4 * g4 + 3] * inv);
                *(u32x2*)(ACT + mrow * DM + 768 + h * 64 + dv) = w; }
    }
}

DI void ssd_unit(const Params& P, Ctx& X, int l, int b, int hd, int dir) {
    constexpr int OFF_BR = 0, OFF_CR = 18432, OFF_XT = 36864, OFF_XS = 53760, OFF_BT = 71168, OFF_SB = 88576, OFF_DA = 97792, OFF_AC = 98304, OFF_DTT = 98816;
    const bf16_t* XBC = (const bf16_t*)(P.ws + WS_XBC); const float* DT = (const float*)(P.ws + WS_DT);
    bf16_t* Y = (bf16_t*)(P.ws + (dir ? WS_YB : WS_YF));
    const int tid = X.tid, lane = X.lane, wave = X.wave, r = lane & 31, hh = lane >> 5, grp = hd >> 2;
    const float a = -__expf(P.a_log[l * 16 + dir * 8 + hd]);
    LAS unsigned char* L = X.L;
    LAS float* t_da = (LAS float*)(L + OFF_DA); LAS float* t_ac = (LAS float*)(L + OFF_AC); LAS float* t_dt = (LAS float*)(L + OFF_DTT);
    f32x4 Sacc[2] = {{0.f, 0.f, 0.f, 0.f}, {0.f, 0.f, 0.f, 0.f}};
    __syncthreads();
    for (int c = 0; c < 18; ++c) {
        const int seg0 = (c < 2) ? 0 : CTX, seg1 = (c < 2) ? CTX : T, cc = (c < 2) ? c : c - 2;
        const int tbase = dir ? (seg1 - 1 - 128 * cc) : (seg0 + 128 * cc), tstep = dir ? -1 : 1;
        const size_t rb = (size_t)b * T;
        if (tid < 128) { const float dtv = DT[(rb + tbase + tstep * tid) * 16 + dir * 8 + hd]; t_dt[tid] = dtv; t_da[tid] = dtv * a; }
        __syncthreads();
        if (wave == 0) { const float v0 = t_da[2 * lane], v1 = t_da[2 * lane + 1]; const float s = v0 + v1; float incl = s;
#pragma unroll
            for (int o = 1; o < 64; o <<= 1) { const float v = __shfl_up(incl, o); if (lane >= o) incl += v; }
            const float ex = incl - s; t_ac[2 * lane] = ex + v0; t_ac[2 * lane + 1] = ex + v0 + v1; }
        __syncthreads();
        const float alast = t_ac[127];
        {
            const int tau = tid >> 2, q2 = tid & 3;
            const bf16_t* rowp = XBC + (rb + tbase + tstep * tau) * 768;
            const float wj = __expf(alast - t_ac[tau]) * t_dt[tau];
#pragma unroll
            for (int k = 0; k < 2; ++k) { const int pc = 2 * q2 + k;
                const u32x4 xv = *(const u32x4*)(rowp + hd * 64 + 8 * pc), bv = *(const u32x4*)(rowp + 512 + grp * 64 + 8 * pc), cv = *(const u32x4*)(rowp + 640 + grp * 64 + 8 * pc);
                *(LAS u32x4*)(L + OFF_BR + tau * 144 + pc * 16) = bv; *(LAS u32x4*)(L + OFF_CR + tau * 144 + pc * 16) = cv;
                const unsigned xw[4] = {xv.x, xv.y, xv.z, xv.w}, bw[4] = {bv.x, bv.y, bv.z, bv.w};
#pragma unroll
                for (int i = 0; i < 4; ++i) { const int p0 = 8 * pc + 2 * i;
                    *(LAS unsigned short*)(L + OFF_XT + p0 * 264 + tau * 2) = (unsigned short)(xw[i] & 0xffffu);
                    *(LAS unsigned short*)(L + OFF_XT + (p0 + 1) * 264 + tau * 2) = (unsigned short)(xw[i] >> 16);
                    const unsigned sc = pk2(bflo(xw[i]) * wj, bfhi(xw[i]) * wj);
                    *(LAS unsigned short*)(L + OFF_XS + p0 * 272 + tau * 2) = (unsigned short)(sc & 0xffffu);
                    *(LAS unsigned short*)(L + OFF_XS + (p0 + 1) * 272 + tau * 2) = (unsigned short)(sc >> 16);
                    *(LAS unsigned short*)(L + OFF_BT + p0 * 272 + tau * 2) = (unsigned short)(bw[i] & 0xffffu);
                    *(LAS unsigned short*)(L + OFF_BT + (p0 + 1) * 272 + tau * 2) = (unsigned short)(bw[i] >> 16); } }
#pragma unroll
            for (int k = 0; k < 2; ++k) { const int tl = 2 * wave + k, pt = tl >> 2, nt = tl & 3, n = 16 * nt + (lane & 15), p = 16 * pt + 4 * (lane >> 4);
#pragma unroll
                for (int i = 0; i < 4; ++i) *(LAS unsigned short*)(L + OFF_SB + (p + i) * 144 + n * 2) = (unsigned short)(pk2(Sacc[k][i], 0.f) & 0xffffu); }
        }
        __syncthreads();
        {
            const int ib = wave >> 1, pb = wave & 1, i_tok = 32 * ib + r;
            const float acum_i = t_ac[i_tok];
            bf16x8 cf[4];
#pragma unroll
            for (int s = 0; s < 4; ++s) cf[s] = *(const LAS bf16x8*)(L + OFF_CR + i_tok * 144 + (16 * s + 8 * hh) * 2);
            f32x16 accO, accD;
#pragma unroll
            for (int i = 0; i < 16; ++i) { accO[i] = 0.f; accD[i] = 0.f; }
#pragma unroll
            for (int s = 0; s < 4; ++s) { const bf16x8 sa = *(const LAS bf16x8*)(L + OFF_SB + (32 * pb + r) * 144 + (16 * s + 8 * hh) * 2); accO = MFMA32(sa, cf[s], accO); }
            for (int jb = 0; jb <= ib; ++jb) {
                f32x16 g;
#pragma unroll
                for (int i = 0; i < 16; ++i) g[i] = 0.f;
#pragma unroll
                for (int s = 0; s < 4; ++s) { const bf16x8 ba = *(const LAS bf16x8*)(L + OFF_BR + (32 * jb + r) * 144 + (16 * s + 8 * hh) * 2); g = MFMA32(ba, cf[s], g); }
#pragma unroll
                for (int g4 = 0; g4 < 4; ++g4) { const int j0 = 32 * jb + 8 * g4 + 4 * hh;
                    const f32x4 aj = *(const LAS f32x4*)(L + OFF_AC + j0 * 4), dj = *(const LAS f32x4*)(L + OFF_DTT + j0 * 4);
#pragma unroll
                    for (int i = 0; i < 4; ++i) { const float arg = fminf(acum_i - aj[i], 0.f); const float wv = __expf(arg) * dj[i] * g[4 * g4 + i]; g[4 * g4 + i] = (j0 + i <= i_tok) ? wv : 0.f; } }
#pragma unroll
                for (int s = 0; s < 2; ++s) {
                    u32x4 w; w.x = pk2(g[8 * s + 0], g[8 * s + 1]); w.y = pk2(g[8 * s + 2], g[8 * s + 3]); w.z = pk2(g[8 * s + 4], g[8 * s + 5]); w.w = pk2(g[8 * s + 6], g[8 * s + 7]);
                    const bf16x8 wf = __builtin_bit_cast(bf16x8, w);
                    const LAS unsigned char* xp = L + OFF_XT + (32 * pb + r) * 264 + (32 * jb + 16 * s + 4 * hh) * 2;
                    const s16x4 lo = *(const LAS s16x4*)xp, hi = *(const LAS s16x4*)(xp + 16);
                    const bf16x8 xf = __builtin_shufflevector(lo, hi, 0, 1, 2, 3, 4, 5, 6, 7);
                    accD = MFMA32(xf, wf, accD);
                }
            }
            const float ei = __expf(acum_i);
            bf16_t* yp = Y + (rb + tbase + tstep * i_tok) * 512 + hd * 64 + 32 * pb + 4 * hh;
#pragma unroll
            for (int g4 = 0; g4 < 4; ++g4) { u32x2 w; w.x = pk2(accD[4 * g4] + ei * accO[4 * g4], accD[4 * g4 + 1] + ei * accO[4 * g4 + 1]); w.y = pk2(accD[4 * g4 + 2] + ei * accO[4 * g4 + 2], accD[4 * g4 + 3] + ei * accO[4 * g4 + 3]);
                *(u32x2*)(yp + 8 * g4) = w; }
        }
        {
            const float dec = __expf(alast);
#pragma unroll
            for (int k = 0; k < 2; ++k) { const int tl = 2 * wave + k, pt = tl >> 2, nt = tl & 3;
                f32x4 acc = Sacc[k] * dec;
#pragma unroll
                for (int s = 0; s < 4; ++s) {
                    const bf16x8 xa = *(const LAS bf16x8*)(L + OFF_XS + (16 * pt + (lane & 15)) * 272 + (32 * s + 8 * (lane >> 4)) * 2);
                    const bf16x8 bb = *(const LAS bf16x8*)(L + OFF_BT + (16 * nt + (lane & 15)) * 272 + (32 * s + 8 * (lane >> 4)) * 2);
                    acc = MFMA16(xa, bb, acc); }
                Sacc[k] = acc; }
        }
        __syncthreads();
    }
}

DI void phase_mixers(const Params& P, Ctx& X, int l) {
    const float lam_init = 0.8f - 0.6f * __expf(-0.3f * (float)l);
    float l01 = 0.f, l23 = 0.f;
    if (X.lane < 32) { const float* lv = P.da_lam + l * 128; l01 = lv[X.lane] * lv[32 + X.lane]; l23 = lv[64 + X.lane] * lv[96 + X.lane]; }
    const float lam = __expf(wave_sum(l01)) - __expf(wave_sum(l23)) + lam_init;
    for (int u = X.bid; u < NB * 8 * 2; u += X.G) ssd_unit(P, X, l, u >> 4, (u >> 1) & 7, u & 1);
    for (int u = X.bid; u < 1024; u += X.G) attn_unit<0>(P, X, l, u >> 6, (u >> 4) & 3, 2 + (u & 15), lam, lam_init);
    for (int u = X.bid; u < 512; u += X.G) attn_unit<1>(P, X, l, u >> 5, (u >> 3) & 3, 1 + (u & 7), lam, lam_init);
    for (int u = X.bid; u < 192; u += X.G) { if (u < 128) attn_unit<0>(P, X, l, u >> 3, (u >> 1) & 3, u & 1, lam, lam_init); else attn_unit<1>(P, X, l, (u - 128) >> 2, u & 3, 0, lam, lam_init); }
}

DI void phase_ssdgate(const Params& P, Ctx& X, int l) {
    const bf16_t* PROJ = (const bf16_t*)(P.ws + WS_PROJ); const bf16_t* XBC = (const bf16_t*)(P.ws + WS_XBC);
    const bf16_t* YF = (const bf16_t*)(P.ws + WS_YF); const bf16_t* YB = (const bf16_t*)(P.ws + WS_YB);
    bf16_t* ACT = (bf16_t*)(P.ws + WS_ACT);
    const int gw = X.bid * NWAVE + X.wave, NGW = X.G * NWAVE, c0 = 8 * X.lane;
    const float dsk = P.ssd_d[l * 8 + (X.lane >> 3)];
    const f32x4 g0 = *(const f32x4*)(P.ssd_g + l * 512 + c0), g1 = *(const f32x4*)(P.ssd_g + l * 512 + c0 + 4);
    for (int m = gw; m < M; m += NGW) {
        const u32x4 yf = *(const u32x4*)(YF + (size_t)m * 512 + c0), yb = *(const u32x4*)(YB + (size_t)m * 512 + c0), xv = *(const u32x4*)(XBC + (size_t)m * 768 + c0), zv = *(const u32x4*)(PROJ + (size_t)m * PW + C_Z + c0);
        const unsigned yfw[4] = {yf.x, yf.y, yf.z, yf.w}, ybw[4] = {yb.x, yb.y, yb.z, yb.w}, xw[4] = {xv.x, xv.y, xv.z, xv.w}, zw[4] = {zv.x, zv.y, zv.z, zv.w};
        float v[8]; float ss = 0.f;
#pragma unroll
        for (int i = 0; i < 4; ++i) {
            v[2 * i] = (bflo(yfw[i]) + bflo(ybw[i]) + dsk * bflo(xw[i])) * silu(bflo(zw[i]));
            v[2 * i + 1] = (bfhi(yfw[i]) + bfhi(ybw[i]) + dsk * bfhi(xw[i])) * silu(bfhi(zw[i]));
            ss += v[2 * i] * v[2 * i] + v[2 * i + 1] * v[2 * i + 1]; }
        const float rstd = rsqrtf(wave_sum(ss) * (1.f / 512.f) + EPS);
        u32x4 w; w.x = pk2(v[0] * rstd * g0[0], v[1] * rstd * g0[1]); w.y = pk2(v[2] * rstd * g0[2], v[3] * rstd * g0[3]); w.z = pk2(v[4] * rstd * g1[0], v[5] * rstd * g1[1]); w.w = pk2(v[6] * rstd * g1[2], v[7] * rstd * g1[3]);
        *(u32x4*)(ACT + (size_t)m * DM + 256 + c0) = w;
    }
}

DI void phase_norm2_route(const Params& P, Ctx& X, int l) {
    const float* MOD = (const float*)(P.ws + WS_MOD);
    bf16_t* ACT = (bf16_t*)(P.ws + WS_ACT);
    u32x4* TOK = (u32x4*)(P.ws + WS_TOK); int* LIST = (int*)(P.ws + WS_LIST);
    unsigned* cnt = (unsigned*)(P.ws + WS_CTL) + CW_CNT + l * 16;
    __syncthreads();
    for (int k = X.tid; k < DM; k += NTHR) { const int j = k >> 8, ln = (k >> 2) & 63, i = k & 3, slot = (4 * j + i) * 64 + ln;
#pragma unroll
        for (int e4 = 0; e4 < 4; ++e4) *(LAS f32x4*)(X.L + ((size_t)e4 * 1024 + slot) * 16) = *(const f32x4*)(P.r_w + k * 16 + 4 * e4); }
    __syncthreads();
    float rb[16];
#pragma unroll
    for (int e = 0; e < 16; ++e) rb[e] = P.r_b[e];
    const int gw = X.bid * NWAVE + X.wave, NGW = X.G * NWAVE;
    const float* g = P.g_ffn + l * DM;
    for (int m = gw; m < M; m += NGW) {
        const int b = m / T, t = m - b * T;
        if (l == DEPTH - 1 && t < CTX) continue;
        const float* hp = hrow(P, m);
        f32x4 v[4]; float ss = 0.f;
#pragma unroll
        for (int j = 0; j < 4; ++j) { v[j] = *(const f32x4*)(hp + 256 * j + 4 * X.lane); ss += v[j][0] * v[j][0] + v[j][1] * v[j][1] + v[j][2] * v[j][2] + v[j][3] * v[j][3]; }
        const float rstd = rsqrtf(wave_sum(ss) * (1.f / DM) + EPS);
        const float* mrow = MOD + ((size_t)l * 17 + ((t < CTX) ? 16 : b)) * 6144;
        float lg[16];
#pragma unroll
        for (int e = 0; e < 16; ++e) lg[e] = 0.f;
#pragma unroll
        for (int j = 0; j < 4; ++j) { const int cidx = 256 * j + 4 * X.lane;
            const f32x4 gg = *(const f32x4*)(g + cidx), sh = *(const f32x4*)(mrow + 3 * DM + cidx), sc = *(const f32x4*)(mrow + 4 * DM + cidx);
            const f32x4 uu = v[j] * rstd * gg * (sc + 1.f) + sh;
            u32x2 o; o.x = pk2(uu[0], uu[1]); o.y = pk2(uu[2], uu[3]);
            *(u32x2*)(ACT + (size_t)m * DM + cidx) = o;
#pragma unroll
            for (int i = 0; i < 4; ++i) { const int slot = (4 * j + i) * 64 + X.lane;
#pragma unroll
                for (int e4 = 0; e4 < 4; ++e4) { const f32x4 rw = *(const LAS f32x4*)(X.L + ((size_t)e4 * 1024 + slot) * 16);
                    lg[4 * e4] += uu[i] * rw[0]; lg[4 * e4 + 1] += uu[i] * rw[1]; lg[4 * e4 + 2] += uu[i] * rw[2]; lg[4 * e4 + 3] += uu[i] * rw[3]; } } }
        float aff[16], sel[16];
#pragma unroll
        for (int e = 0; e < 16; ++e) { const float x = wave_sum(lg[e]); aff[e] = 1.f / (1.f + expf(-x)); sel[e] = aff[e] + rb[e]; }
        int best = 0; float bests = -1e30f;
#pragma unroll
        for (int gi = 0; gi < 4; ++gi) { float m1 = -1e30f, m2 = -1e30f;
#pragma unroll
            for (int j = 0; j < 4; ++j) { const float x = sel[gi * 4 + j]; if (x > m1) { m2 = m1; m1 = x; } else if (x > m2) m2 = x; }
            const float gs = m1 + m2; if (gs > bests) { bests = gs; best = gi; } }
        int i1 = 0, i2 = 0; float v1 = -1e30f, v2 = -1e30f, a1 = 0.f, a2 = 0.f;
#pragma unroll
        for (int e = 0; e < 16; ++e) if ((e >> 2) == best) { const float x = sel[e]; if (x > v1) { v2 = v1; i2 = i1; a2 = a1; v1 = x; i1 = e; a1 = aff[e]; } else if (x > v2) { v2 = x; i2 = e; a2 = aff[e]; } }
        if (X.lane == 0) {
            const unsigned p1 = atomicAdd(&cnt[i1], 1u), p2 = atomicAdd(&cnt[i2], 1u);
            LIST[(size_t)i1 * M + p1] = m; LIST[(size_t)i2 * M + p2] = m;
            u32x4 ti; ti.x = (unsigned)i1 | (p1 << 4); ti.y = (unsigned)i2 | (p2 << 4); ti.z = __float_as_uint(a1 / (a1 + a2)); ti.w = __float_as_uint(a2 / (a1 + a2));
            TOK[m] = ti;
        }
    }
}
DI void moe_tables(const Params& P, Ctx& X, int l) {
    __syncthreads();
    if (X.tid < 64) { const unsigned* cnt = (const unsigned*)(P.ws + WS_CTL) + CW_CNT + l * 16;
        const int c = (X.lane < 16) ? (int)__hip_atomic_load(cnt + (X.lane & 15), __ATOMIC_RELAXED, __HIP_MEMORY_SCOPE_AGENT) : 0;
        const int tiles = (c + 255) >> 8; int incl = tiles;
#pragma unroll
        for (int o = 1; o < 16; o <<= 1) { const int v = __shfl_up(incl, o); if (X.lane >= o) incl += v; }
        if (X.lane < 16) { X.misc[16 + X.lane] = c; X.misc[32 + X.lane] = incl - tiles; X.misc[64 + X.lane] = (incl - tiles) * 256; }
        if (X.lane == 15) X.misc[32 + 16] = incl; }
    __syncthreads();
}

constexpr int N_PHASES = 38;
__global__ void __launch_bounds__(NTHR, 2) mk_fwd(Params P) {
    extern __shared__ __attribute__((aligned(16))) unsigned char lds_raw[];
    Ctx X;
    X.L = (LAS unsigned char*)lds_raw; X.misc = (volatile LAS int*)(X.L + LDS_MISC); X.ws = P.ws;
    X.tid = threadIdx.x; X.lane = X.tid & 63; X.wave = __builtin_amdgcn_readfirstlane(X.tid >> 6); X.G = gridDim.x; X.bid = blockIdx.x;
    if (X.tid < 128) X.misc[X.tid] = 0;
    __syncthreads();
    unsigned* ctl = (unsigned*)(P.ws + WS_CTL);
    XcdBarrier bar; bar.bar = ctl + CW_BAR; bar.x = 0; bar.st = (volatile LAS unsigned*)X.misc;
    const bool multi = (P.ph_hi - P.ph_lo) > 1;
    if (multi) bar = xcd_barrier_post(ctl + CW_BAR, (volatile LAS unsigned*)X.misc);
#ifndef PHMASK
#define PHMASK 0xFFFF
#endif
#define RUN(ph) (P.ph_lo <= (ph) && (ph) < P.ph_hi)
#define HAS(k) ((PHMASK >> (k)) & 1)
#define SEAM(ph) do { if (RUN(ph) && RUN((ph) + 1)) xcd_barrier(bar); } while (0)
    if (HAS(9) && RUN(0)) phase_prologue(P, X);
    SEAM(0);
#define FRESH() do { int _t = threadIdx.x; asm volatile("" : "+v"(_t)); X.tid = _t; X.lane = _t & 63; X.wave = __builtin_amdgcn_readfirstlane(_t >> 6); } while (0)
#pragma unroll 1
    for (int l = 0; l < DEPTH; ++l) {
        const int pb = 1 + 9 * l;
        FRESH(); if (HAS(0) && RUN(pb + 0)) phase_norm1(P, X, l);
        SEAM(pb + 0);
        FRESH(); if (HAS(1) && RUN(pb + 1)) { DenseSched S; S.init(P.ws + WS_ACT, P.ws + WS_WIN, M, PW, DM, X.G, X.bid); EpiStoreBf16 E{(bf16_t*)(P.ws + WS_PROJ), PW}; gemm8(X.L, DM, S, E); }
        SEAM(pb + 1);
        FRESH(); if (HAS(2) && RUN(pb + 2)) phase_postproj(P, X, l);
        SEAM(pb + 2);
        FRESH(); if (HAS(3) && RUN(pb + 3)) phase_mixers(P, X, l);
        SEAM(pb + 3);
        FRESH(); if (HAS(4) && RUN(pb + 4)) phase_ssdgate(P, X, l);
        SEAM(pb + 4);
        FRESH(); if (HAS(5) && RUN(pb + 5)) { DenseSched S; S.init(P.ws + WS_ACT, P.ws + WS_WOUT, M, DM, DM, X.G, X.bid);
            EpiResidual E{(float*)(P.ws + WS_HC), P.out, (const float*)(P.ws + WS_MOD) + (size_t)l * 17 * 6144}; gemm8(X.L, DM, S, E); }
        SEAM(pb + 5);
        FRESH(); if (HAS(6) && RUN(pb + 6)) phase_norm2_route(P, X, l);
        SEAM(pb + 6);
        FRESH(); if (HAS(7) && RUN(pb + 7)) { moe_tables(P, X, l);
            MoeSched<true> S{(const char*)(P.ws + WS_ACT), (const char*)(P.ws + WS_WGU), (const int*)(P.ws + WS_LIST), X.misc, DM, X.G, X.bid};
            EpiGateUp E{(bf16_t*)(P.ws + WS_HE)}; gemm8(X.L, DM, S, E); }
        SEAM(pb + 7);
        FRESH(); if (HAS(8) && RUN(pb + 8)) { moe_tables(P, X, l);
            MoeSched<false> S{(const char*)(P.ws + WS_HE), (const char*)(P.ws + WS_WD), nullptr, X.misc, 512, X.G, X.bid};
            EpiStoreBf16 E{(bf16_t*)(P.ws + WS_YS), DM}; gemm8(X.L, 512, S, E); }
        SEAM(pb + 8);
    }
    FRESH(); if (HAS(10) && RUN(37)) phase_final(P, X);
#undef RUN
#undef SEAM
}
}

#ifndef MK_MODE
#define MK_MODE 1
#endif
extern "C" void kernel_launch(void* const* d_in, const int* in_sizes, int n_in, void* d_out, int out_size, void* d_ws, size_t ws_size, hipStream_t stream) {
    using namespace mk;
    static int grid = 0;
    if (grid == 0) {
        if (n_in != 28 || ws_size < WS_END) { fprintf(stderr, "kernel_launch: unexpected inputs (n_in %d, ws %zu < %zu)\n", n_in, ws_size, (size_t)WS_END); grid = -1; return; }
        int dev = 0, cus = 0, per_cu = 0;
        if (hipGetDevice(&dev) != hipSuccess || hipDeviceGetAttribute(&cus, hipDeviceAttributeMultiprocessorCount, dev) != hipSuccess) { grid = -1; return; }
        if (hipFuncSetAttribute((const void*)mk_fwd, hipFuncAttributeMaxDynamicSharedMemorySize, LDS_BYTES) != hipSuccess) { fprintf(stderr, "kernel_launch: hipFuncSetAttribute failed\n"); grid = -1; return; }
        if (hipOccupancyMaxActiveBlocksPerMultiprocessor(&per_cu, (const void*)mk_fwd, NTHR, LDS_BYTES) != hipSuccess || per_cu < 1) { fprintf(stderr, "kernel_launch: occupancy query says %d\n", per_cu); (void)hipGetLastError(); grid = -1; return; }
        grid = cus;
    }
    if (grid < 0) return;
    (void)hipMemsetAsync((char*)d_ws + WS_CTL, 0, CTL_BYTES, stream);
    Params p{};
    const float** pp = (const float**)&p;
    for (int i = 0; i < 28; ++i) pp[i] = (const float*)d_in[i];
    p.out = (float*)d_out; p.ws = (unsigned char*)d_ws;
#if MK_MODE == 1
    p.ph_lo = 0; p.ph_hi = N_PHASES;
    hipLaunchKernelGGL(mk_fwd, dim3(grid), dim3(NTHR), LDS_BYTES, stream, p);
#else
    for (int ph = 0; ph < N_PHASES; ++ph) { p.ph_lo = ph; p.ph_hi = ph + 1; hipLaunchKernelGGL(mk_fwd, dim3(grid), dim3(NTHR), LDS_BYTES, stream, p); }
#endif
}
```

```cpp
#include <hip/hip_runtime.h>
#include <cstdio>
#include <cstdint>

namespace mk {
#define LAS __attribute__((address_space(3)))
#define DI __device__ __forceinline__
typedef unsigned short bf16_t;
typedef short bf16x8 __attribute__((ext_vector_type(8)));
typedef short s16x4 __attribute__((ext_vector_type(4)));
typedef float f32x2 __attribute__((ext_vector_type(2)));
typedef float f32x4 __attribute__((ext_vector_type(4)));
typedef float f32x16 __attribute__((ext_vector_type(16)));
typedef unsigned u32x2 __attribute__((ext_vector_type(2)));
typedef unsigned u32x4 __attribute__((ext_vector_type(4)));
typedef __bf16 bf16x2_t __attribute__((ext_vector_type(2)));

constexpr int DM = 1024, NB = 16, SEQ = 2048, CTX = 256, T = SEQ + CTX, M = NB * T, DEPTH = 4;
constexpr int PW = 2560, INW = 2480;
constexpr int C_DAQ = 0, C_DAK = 256, C_DAV = 512, C_Z = 768, C_XBC = 1280, C_DT = 2048, C_CQ = 2064, C_CKV = 2320, C_KR = 2448;
constexpr float EPS = 1e-6f, LOG2E = 1.4426950408889634f;
constexpr float DA_QS = 0.17677669529663687f * LOG2E, MLA_QS = 0.10206207261596577f * LOG2E;
constexpr int NSLOT = 2 * M + 4096;
constexpr int NTHR = 512, NWAVE = 8;

constexpr size_t MiB = 1u << 20;
constexpr size_t WS_CTL = 0, CTL_BYTES = 1 * MiB;
constexpr size_t WS_MOD = 1 * MiB, WS_ROPE = 3 * MiB, WS_HC = 4 * MiB;
constexpr size_t WS_WIN = 20 * MiB, WS_WOUT = 25 * MiB, WS_WUQ = 27 * MiB, WS_WUKV = 27 * MiB + 512 * 1024, WS_WGU = 28 * MiB, WS_WD = 60 * MiB;
constexpr size_t WS_ACT = 76 * MiB, WS_PROJ = 148 * MiB;
constexpr size_t WS_MLAQ = 328 * MiB, WS_MLAK = 355 * MiB, WS_VTM = 382 * MiB, WS_VTD = 400 * MiB;
constexpr size_t WS_XBC = 418 * MiB, WS_DT = 472 * MiB, WS_YF = 475 * MiB, WS_YB = 511 * MiB, WS_TOK = 547 * MiB, WS_LIST = 548 * MiB, WS_END = 551 * MiB;
constexpr size_t WS_HE = WS_MLAQ, WS_YS = WS_PROJ;
static_assert((size_t)NSLOT * 512 * 2 <= WS_XBC - WS_MLAQ, "HE alias");
static_assert((size_t)NSLOT * 1024 * 2 <= WS_MLAQ - WS_PROJ, "YS alias");
constexpr int CW_BAR = 4096, CW_CNT = 8192;

constexpr int LDS_MISC = 131072, LDS_BYTES = 135168;

struct Params {
    const float *x, *c, *ctx, *c_ctx, *g_mix, *g_ffn, *w_mod, *b_mod, *w_in, *w_out, *da_lam, *da_g, *conv_w, *conv_b, *dt_bias, *a_log, *ssd_d, *ssd_g,
                *mq_g, *mkv_g, *w_uq, *w_ukv, *r_w, *r_b, *wg, *wu, *wd, *fin_g;
    float* out; unsigned char* ws; int ph_lo, ph_hi;
};

DI unsigned pk2(float lo, float hi) { f32x2 v = {lo, hi}; bf16x2_t b = __builtin_convertvector(v, bf16x2_t); return __builtin_bit_cast(unsigned, b); }
DI float bflo(unsigned w) { return __uint_as_float(w << 16); }
DI float bfhi(unsigned w) { return __uint_as_float(w & 0xffff0000u); }
DI float wave_sum(float v) {
#pragma unroll
    for (int o = 1; o < 64; o <<= 1) v += __shfl_xor(v, o);
    return v;
}
DI float silu(float x) { return x / (1.f + __expf(-x)); }
DI float fexp2(float x) { return __builtin_amdgcn_exp2f(x); }
#define LDS_WAIT() asm volatile("s_waitcnt lgkmcnt(0)" ::: "memory")
#define MFMA32(a, b, c) __builtin_amdgcn_mfma_f32_32x32x16_bf16((a), (b), (c), 0, 0, 0)
#define MFMA16(a, b, c) __builtin_amdgcn_mfma_f32_16x16x32_bf16((a), (b), (c), 0, 0, 0)
DI int crow(int reg, int h) { return (reg & 3) + 8 * (reg >> 2) + 4 * h; }

#define XB_TMO      128
#define XB_XCNT(j)  (256  + 64 * (j))
#define XB_XSUB(j)  (1280 + 64 * (j))
#define XB_XGEN(j)  (2304 + 64 * (j))
#define XB_TOP      3328
#define XB_TOPGEN   3392
#define XCD_BAR_WORDS 3456
#define XB_SPIN_CAP (1u << 22)
DI unsigned xb_ld(unsigned* p)              { return __hip_atomic_load(p, __ATOMIC_RELAXED, __HIP_MEMORY_SCOPE_AGENT); }
DI unsigned xb_add(unsigned* p, unsigned v) { return __hip_atomic_fetch_add(p, v, __ATOMIC_RELAXED, __HIP_MEMORY_SCOPE_AGENT); }
DI unsigned xb_xcc_id() { return (unsigned)__builtin_amdgcn_s_getreg((3 << 11) | 20) & 0xFu; }
#define XB_SPIN(cond, bar) do { unsigned _sp = 0; while (cond) { __builtin_amdgcn_s_sleep(1); \
    if ((++_sp & 255u) == 0u) { if (xb_ld(&(bar)[XB_TMO])) break; if (_sp > XB_SPIN_CAP) { atomicAdd(&(bar)[XB_TMO], 1u); break; } } } } while (0)
struct XcdBarrier { unsigned* bar; unsigned x; volatile LAS unsigned* st; };
DI XcdBarrier xcd_barrier_post(unsigned* bar, volatile LAS unsigned* st) {
    XcdBarrier b; b.bar = bar; b.x = xb_xcc_id(); b.st = st;
    if (threadIdx.x == 0) (void)xb_add(&bar[XB_XCNT(b.x)], 1u);
    return b;
}
DI void xcd_barrier_complete(unsigned* bar, unsigned x, unsigned& nloc, unsigned& nx) {
    const unsigned G = gridDim.x * gridDim.y * gridDim.z;
    unsigned sum, cnt, mine, sp = 0u;
    for (;;) {
        sum = 0u; cnt = 0u; mine = 0u;
#pragma unroll
        for (unsigned j = 0; j < 16; ++j) { const unsigned c = xb_ld(&bar[XB_XCNT(j)]); sum += c; cnt += (c > 0u) ? 1u : 0u; mine = (j == x) ? c : mine; }
        if (sum == G) break;
        __builtin_amdgcn_s_sleep(1);
        if ((++sp & 255u) == 0u) { if (xb_ld(&bar[XB_TMO])) break; if (sp > XB_SPIN_CAP) { atomicAdd(&bar[XB_TMO], 1u); break; } }
    }
    nloc = mine > 0u ? mine : 1u; nx = cnt > 0u ? cnt : 1u;
}
DI void xcd_barrier(const XcdBarrier& b) {
    asm volatile("s_waitcnt vmcnt(0)" ::: "memory");
    __syncthreads();
    if (threadIdx.x == 0) {
        unsigned* bar = b.bar;
        __builtin_amdgcn_s_waitcnt(0);
        unsigned nloc = b.st[0], nx = b.st[1];
        if (nloc == 0u) { xcd_barrier_complete(bar, b.x, nloc, nx); b.st[0] = nloc; b.st[1] = nx; }
        const unsigned old = xb_add(&bar[XB_XSUB(b.x)], 1u);
        const unsigned gen = old / nloc;
        if (old + 1u == (gen + 1u) * nloc) {
            __builtin_amdgcn_fence(__ATOMIC_RELEASE, "agent");
            asm volatile("s_waitcnt vmcnt(0)" ::: "memory");
            const unsigned og = xb_add(&bar[XB_TOP], 1u);
            const unsigned tg = og / nx;
            if (og + 1u == (tg + 1u) * nx) xb_add(&bar[XB_TOPGEN], 1u);
            else XB_SPIN(xb_ld(&bar[XB_TOPGEN]) == tg, bar);
            __builtin_amdgcn_fence(__ATOMIC_ACQUIRE, "agent");
            xb_add(&bar[XB_XGEN(b.x)], 1u);
            asm volatile("s_waitcnt vmcnt(0)" ::: "memory");
        } else {
            XB_SPIN(xb_ld(&bar[XB_XGEN(b.x)]) == gen, bar);
            __builtin_amdgcn_fence(__ATOMIC_ACQUIRE, "agent");
            asm volatile("s_waitcnt vmcnt(0)" ::: "memory");
        }
    }
    __syncthreads();
}

constexpr int HTB = 128 * 64 * 2;
DI int lds_byte(int r, int c) { const int st = (r >> 4) * 2 + (c >> 5), rr = r & 15, cc = c & 31, ob = rr * 64 + cc * 2; return st * 1024 + (ob ^ (((ob >> 9) & 1) << 5)); }
DI void stage_rc(int b, int& R, int& C) { const int st = b / 1024, sb = b % 1024, swz = sb ^ (((sb >> 9) & 1) << 5); R = (st >> 1) * 16 + swz / 64; C = (st & 1) * 32 + (swz % 64) / 2; }
DI int perm32(int rho) { const int n = rho >> 4, i = rho & 15; return 8 * (i >> 2) + 4 * n + (i & 3); }

struct GUnit { const char* A; const char* B; int pm, pn, e, row0; };

template <class Epi, class Sched>
DI void gemm8(LAS unsigned char* lds, const int K, const Sched& S, const Epi& E) {
    int tid_ = threadIdx.x; asm volatile("" : "+v"(tid_));
    const int tid = tid_, wid = __builtin_amdgcn_readfirstlane(tid >> 6), lane = tid & 63, wr = wid >> 2, wc = wid & 3, fr = lane & 15, fq = lane >> 4;
    const int nt = K / 64;
    int R[2], C[2]; unsigned voffB[2];
#pragma unroll
    for (int i = 0; i < 2; ++i) { stage_rc(tid * 16 + i * 8192, R[i], C[i]); const int Rb = Epi::PERM ? ((R[i] & ~31) + perm32(R[i] & 31)) : R[i]; voffB[i] = (unsigned)(Rb * K + C[i]) * 2u; }
    const size_t kstep = 128;
    const size_t hstepB = (size_t)128 * K * 2;
    const unsigned ldsw = (unsigned)wid * 1024u;
    const int aoff = lds_byte(wr * 64 + fr, fq * 8), boff = lds_byte(wc * 32 + fr, fq * 8);
#define G8_SA(b, h) (((b) * 2 + (h)) * HTB)
#define G8_SB(b, h) ((4 + (b) * 2 + (h)) * HTB)
#define G8_STAGE(bufoff, gbase, voff) do { _Pragma("unroll") for (int _i = 0; _i < 2; ++_i) \
        __builtin_amdgcn_global_load_lds((const unsigned*)((const char*)(gbase) + (voff)[_i]), (LAS unsigned*)(lds + (bufoff) + ldsw + _i * 8192), 16, 0, 0); } while (0)
#define G8_LDA(dst, b, h) do { _Pragma("unroll") for (int m = 0; m < 4; ++m) _Pragma("unroll") for (int k = 0; k < 2; ++k) dst[m][k] = *(const LAS bf16x8*)(lds + G8_SA(b, h) + aoff + m * 2048 + k * 1024); } while (0)
#define G8_LDB(dst, b, h) do { _Pragma("unroll") for (int n = 0; n < 2; ++n) _Pragma("unroll") for (int k = 0; k < 2; ++k) dst[n][k] = *(const LAS bf16x8*)(lds + G8_SB(b, h) + boff + n * 2048 + k * 1024); } while (0)
#define G8_MMA(ai, bj, At, Bt) do { __builtin_amdgcn_s_setprio(1); _Pragma("unroll") for (int m = 0; m < 4; ++m) _Pragma("unroll") for (int n = 0; n < 2; ++n) _Pragma("unroll") for (int k = 0; k < 2; ++k) \
        acc[ai][bj][m][n] = __builtin_amdgcn_mfma_f32_16x16x32_bf16(Bt[n][k], At[m][k], acc[ai][bj][m][n], 0, 0, 0); __builtin_amdgcn_s_setprio(0); } while (0)
#define G8_WAIT_V(n) asm volatile("s_waitcnt vmcnt(" #n ")" ::: "memory")
#define G8_WAIT_L(n) asm volatile("s_waitcnt lgkmcnt(" #n ")" ::: "memory")
#define G8_BAR __builtin_amdgcn_s_barrier()
#define G8_SCHED __builtin_amdgcn_sched_barrier(0)
    GUnit cur, nxt; int ui = 0;
    if (!S.next(0, cur)) return;
    unsigned aoC[2][2], aoN[2][2];
    S.aoff(cur, R, C, aoC);
    if constexpr (Sched::UNIFORM_AOFF) {
#pragma unroll
        for (int h = 0; h < 2; ++h)
#pragma unroll
            for (int i = 0; i < 2; ++i) aoN[h][i] = aoC[h][i]; }
    f32x4 acc[2][2][4][2];
#pragma unroll
    for (int a = 0; a < 2; ++a)
#pragma unroll
        for (int b = 0; b < 2; ++b)
#pragma unroll
            for (int m = 0; m < 4; ++m)
#pragma unroll
                for (int n = 0; n < 2; ++n) acc[a][b][m][n] = (f32x4){0.f, 0.f, 0.f, 0.f};
    bf16x8 At[4][2], B0[2][2], B1[2][2];
    const char* cA = cur.A; const char* cB = cur.B;
    asm volatile("s_waitcnt vmcnt(0)" ::: "memory");
    G8_STAGE(G8_SB(0, 0), cB, voffB); G8_STAGE(G8_SA(0, 0), cA, aoC[0]); G8_STAGE(G8_SB(0, 1), cB + hstepB, voffB); G8_STAGE(G8_SA(0, 1), cA, aoC[1]);
    if (wr == 1) G8_BAR;
    G8_WAIT_V(4); G8_BAR;
    G8_STAGE(G8_SB(1, 0), cB + kstep, voffB); G8_STAGE(G8_SA(1, 0), cA + kstep, aoC[0]); G8_STAGE(G8_SB(1, 1), cB + hstepB + kstep, voffB);
    G8_WAIT_V(6); G8_BAR;
    for (;;) {
        const bool has_next = S.next(ui + 1, nxt);
        if constexpr (!Sched::UNIFORM_AOFF) {
        if (has_next) S.aoff(nxt, R, C, aoN);
        else {
#pragma unroll
            for (int h = 0; h < 2; ++h)
#pragma unroll
                for (int i = 0; i < 2; ++i) aoN[h][i] = aoC[h][i]; } }
        const char* nA = has_next ? nxt.A : cA; const char* nB = has_next ? nxt.B : cB;
        for (int t = 0; t < nt; t += 2) {
            const bool last = (t == nt - 2);
            const char* a1 = cA + (size_t)(t + 1) * kstep;
            const char* a2 = last ? nA : cA + (size_t)(t + 2) * kstep; const char* b2 = last ? nB : cB + (size_t)(t + 2) * kstep;
            const char* a3 = a2 + kstep; const char* b3 = b2 + kstep;
            unsigned ao2[2][2];
#pragma unroll
            for (int h = 0; h < 2; ++h)
#pragma unroll
                for (int i = 0; i < 2; ++i) ao2[h][i] = (!Sched::UNIFORM_AOFF && last) ? aoN[h][i] : aoC[h][i];
            G8_LDB(B0, 0, 0); G8_SCHED; G8_LDA(At, 0, 0); G8_STAGE(G8_SA(1, 1), a1, aoC[1]);
            G8_WAIT_L(8); G8_BAR; G8_WAIT_L(0); G8_MMA(0, 0, At, B0); G8_BAR; G8_SCHED;
            G8_LDB(B1, 0, 1); G8_STAGE(G8_SB(0, 0), b2, voffB);
            G8_BAR; G8_WAIT_L(0); G8_MMA(0, 1, At, B1); G8_BAR;
            G8_LDA(At, 0, 1); G8_STAGE(G8_SA(0, 0), a2, ao2[0]);
            G8_BAR; G8_WAIT_L(0); G8_MMA(1, 0, At, B0); G8_BAR; G8_SCHED;
            G8_STAGE(G8_SB(0, 1), b2 + hstepB, voffB);
            G8_WAIT_V(6); G8_BAR; G8_MMA(1, 1, At, B1); G8_BAR;
            G8_LDB(B0, 1, 0); G8_SCHED; G8_LDA(At, 1, 0); G8_STAGE(G8_SA(0, 1), a2, ao2[1]);
            G8_WAIT_L(8); G8_BAR; G8_WAIT_L(0); G8_MMA(0, 0, At, B0); G8_BAR; G8_SCHED;
            G8_LDB(B1, 1, 1); G8_STAGE(G8_SB(1, 0), b3, voffB);
            G8_BAR; G8_WAIT_L(0); G8_MMA(0, 1, At, B1); G8_BAR;
            G8_LDA(At, 1, 1); G8_STAGE(G8_SA(1, 0), a3, ao2[0]);
            G8_BAR; G8_WAIT_L(0); G8_MMA(1, 0, At, B0); G8_BAR; G8_SCHED;
            G8_STAGE(G8_SB(1, 1), b3 + hstepB, voffB);
            G8_WAIT_V(6); G8_BAR; G8_MMA(1, 1, At, B1); G8_BAR;
        }
        E(acc, cur, wr, wc, fr, fq);
        if (!has_next) break;
#pragma unroll
        for (int a = 0; a < 2; ++a)
#pragma unroll
            for (int b = 0; b < 2; ++b)
#pragma unroll
                for (int m = 0; m < 4; ++m)
#pragma unroll
                    for (int n = 0; n < 2; ++n) acc[a][b][m][n] = (f32x4){0.f, 0.f, 0.f, 0.f};
        cur = nxt; cA = nA; cB = nB; ++ui;
        if constexpr (!Sched::UNIFORM_AOFF) {
#pragma unroll
        for (int h = 0; h < 2; ++h)
#pragma unroll
            for (int i = 0; i < 2; ++i) aoC[h][i] = aoN[h][i]; }
    }
    G8_WAIT_V(0);
    if (wr == 0) G8_BAR;
    G8_BAR;
#undef G8_SA
#undef G8_SB
#undef G8_STAGE
#undef G8_LDA
#undef G8_LDB
#undef G8_MMA
#undef G8_WAIT_V
#undef G8_WAIT_L
#undef G8_BAR
#undef G8_SCHED
}

constexpr int NXCD = 8, WGM = 8;
struct DenseSched {
    static constexpr bool UNIFORM_AOFF = true;
    const char* A; const char* Bt; int K, nM, nN, nwg, G, c;
    DI void init(const void* A_, const void* Bt_, int Mrows, int N, int K_, int G_, int c_) { A = (const char*)A_; Bt = (const char*)Bt_; K = K_; nM = Mrows / 256; nN = N / 256; nwg = nM * nN; G = G_; c = c_; }
    DI bool next(int i, GUnit& u) const {
        const long L = (long)i * G + c; if (L >= nwg) return false;
        int wgid = (int)L; { const int q = nwg / NXCD, r = nwg % NXCD, xcd = wgid % NXCD, off = wgid / NXCD; wgid = (xcd < r ? xcd * (q + 1) : r * (q + 1) + (xcd - r) * q) + off; }
        const int nig = WGM * nN, gid = wgid / nig, fm = gid * WGM, gsz = (nM - fm) < WGM ? (nM - fm) : WGM;
        u.pm = fm + ((wgid % nig) % gsz); u.pn = (wgid % nig) / gsz; u.e = 0; u.row0 = u.pm * 256;
        u.A = A + (size_t)u.pm * 256 * K * 2; u.B = Bt + (size_t)u.pn * 256 * K * 2; return true;
    }
    DI void aoff(const GUnit&, const int (&R)[2], const int (&C)[2], unsigned (&off)[2][2]) const {
#pragma unroll
        for (int h = 0; h < 2; ++h)
#pragma unroll
            for (int i = 0; i < 2; ++i) off[h][i] = (unsigned)((h * 128 + R[i]) * K + C[i]) * 2u;
    }
};
template <bool GATHER>
struct MoeSched {
    static constexpr bool UNIFORM_AOFF = !GATHER;
    const char* A; const char* W; const int* list; volatile LAS int* misc; int K, G, c;
    DI bool next(int i, GUnit& u) const {
        const int L = i * G + c;
        const int RT = __builtin_amdgcn_readfirstlane(misc[32 + 16]);
        if (L >= RT * 4) return false;
        const int rt = L >> 2; u.pn = L & 3;
        int e = 0;
#pragma unroll
        for (int j = 1; j < 16; ++j) { const int tp = __builtin_amdgcn_readfirstlane(misc[32 + j]); if (tp <= rt) e = j; }
        const int tp = __builtin_amdgcn_readfirstlane(misc[32 + e]);
        u.e = e; u.pm = rt - tp; u.row0 = __builtin_amdgcn_readfirstlane(misc[64 + e]) + u.pm * 256;
        u.A = GATHER ? A : A + (size_t)u.row0 * K * 2;
        u.B = W + ((size_t)e * 1024 + (size_t)u.pn * 256) * K * 2;
        return true;
    }
    DI void aoff(const GUnit& u, const int (&R)[2], const int (&C)[2], unsigned (&off)[2][2]) const {
        if (GATHER) {
            const int cnt = __builtin_amdgcn_readfirstlane(misc[16 + u.e]);
#pragma unroll
            for (int h = 0; h < 2; ++h)
#pragma unroll
                for (int i = 0; i < 2; ++i) { const int idx = u.pm * 256 + h * 128 + R[i]; const int tok = (idx < cnt) ? list[(size_t)u.e * M + idx] : 0; off[h][i] = (unsigned)(tok * K + C[i]) * 2u; }
        } else {
#pragma unroll
            for (int h = 0; h < 2; ++h)
#pragma unroll
                for (int i = 0; i < 2; ++i) off[h][i] = (unsigned)((h * 128 + R[i]) * K + C[i]) * 2u;
        }
    }
};

struct EpiStoreBf16 {
    static constexpr bool PERM = true;
    bf16_t* O; int ldc;
    DI void operator()(const f32x4 (&acc)[2][2][4][2], const GUnit& u, int wr, int wc, int fr, int fq) const {
        const int row0 = u.row0 + wr * 64 + fr, col0 = u.pn * 256 + wc * 32 + 8 * fq;
#pragma unroll
        for (int ai = 0; ai < 2; ++ai)
#pragma unroll
            for (int m = 0; m < 4; ++m) { bf16_t* rowp = O + (size_t)(row0 + ai * 128 + m * 16) * ldc + col0;
#pragma unroll
                for (int bj = 0; bj < 2; ++bj) { const f32x4 v0 = acc[ai][bj][m][0], v1 = acc[ai][bj][m][1];
                    u32x4 w; w.x = pk2(v0[0], v0[1]); w.y = pk2(v0[2], v0[3]); w.z = pk2(v1[0], v1[1]); w.w = pk2(v1[2], v1[3]);
                    *(u32x4*)(rowp + bj * 128) = w; } }
    }
};
struct EpiGateUp {
    static constexpr bool PERM = true;
    bf16_t* O;
    DI void operator()(const f32x4 (&acc)[2][2][4][2], const GUnit& u, int wr, int wc, int fr, int fq) const {
        const int row0 = u.row0 + wr * 64 + fr, col0 = u.pn * 128 + wc * 32 + 8 * fq;
#pragma unroll
        for (int ai = 0; ai < 2; ++ai)
#pragma unroll
            for (int m = 0; m < 4; ++m) { bf16_t* rowp = O + (size_t)(row0 + ai * 128 + m * 16) * 512 + col0;
                float hv[8];
#pragma unroll
                for (int n = 0; n < 2; ++n)
#pragma unroll
                    for (int i = 0; i < 4; ++i) hv[n * 4 + i] = silu(acc[ai][0][m][n][i]) * acc[ai][1][m][n][i];
                u32x4 w; w.x = pk2(hv[0], hv[1]); w.y = pk2(hv[2], hv[3]); w.z = pk2(hv[4], hv[5]); w.w = pk2(hv[6], hv[7]);
                *(u32x4*)rowp = w; }
    }
};
struct EpiResidual {
    static constexpr bool PERM = false;
    float* hc; float* hx; const float* modl;
    DI void operator()(const f32x4 (&acc)[2][2][4][2], const GUnit& u, int wr, int wc, int fr, int fq) const {
        const int b = u.pm / 9, tt = u.pm % 9;
        float* base = (tt == 0) ? hc + (size_t)b * CTX * DM : hx + ((size_t)b * SEQ + (size_t)(tt - 1) * 256) * DM;
        const float* gate = modl + (size_t)((tt == 0) ? 16 : b) * 6144 + 2 * DM;
        const int row0 = wr * 64 + fr, col0 = u.pn * 256 + wc * 32 + 4 * fq;
#pragma unroll
        for (int ai = 0; ai < 2; ++ai)
#pragma unroll
            for (int m = 0; m < 4; ++m) { float* rowp = base + (size_t)(row0 + ai * 128 + m * 16) * DM + col0;
#pragma unroll
                for (int bj = 0; bj < 2; ++bj)
#pragma unroll
                    for (int n = 0; n < 2; ++n) { f32x4* p = (f32x4*)(rowp + bj * 128 + n * 16); const f32x4 gv = *(const f32x4*)(gate + col0 + bj * 128 + n * 16); *p = *p + gv * acc[ai][bj][m][n]; }
                asm volatile("" ::: "memory"); }
    }
};

struct Ctx {
    LAS unsigned char* L; volatile LAS int* misc; unsigned char* ws; int tid, lane, wave, G, bid;
};
DI float* hrow(const Params& P, int m) { const int b = m / T, t = m - b * T; return (t < CTX) ? (float*)(P.ws + WS_HC) + ((size_t)b * CTX + t) * DM : P.out + ((size_t)b * SEQ + (t - CTX)) * DM; }

DI void phase_prologue(const Params& P, Ctx& X) {
    float* MOD = (float*)(P.ws + WS_MOD);
    LAS float* tab = (LAS float*)(X.L + X.wave * 8704);
    for (int u = X.bid; u < 4 * 48; u += X.G) {
        const int l = u / 48, jc = u % 48;
        __syncthreads();
        for (int idx = X.lane; idx < 17 * 128; idx += 64) { const int r = idx >> 7, kk = idx & 127; const float* src = (r < 16) ? P.c + r * DM : P.c_ctx; tab[idx] = silu(src[X.wave * 128 + kk]); }
        __syncthreads();
        float a0[17], a1[17];
#pragma unroll
        for (int r = 0; r < 17; ++r) { a0[r] = 0.f; a1[r] = 0.f; }
        const float* wp = P.w_mod + ((size_t)l * DM + X.wave * 128) * 6144 + jc * 128 + 2 * X.lane;
#pragma unroll 4
        for (int kk = 0; kk < 128; ++kk) { const f32x2 w2 = *(const f32x2*)(wp + (size_t)kk * 6144);
#pragma unroll
            for (int r = 0; r < 17; ++r) { const float a = tab[r * 128 + kk]; a0[r] += a * w2.x; a1[r] += a * w2.y; } }
        __syncthreads();
#pragma unroll
        for (int r = 0; r < 17; ++r) { tab[r * 128 + 2 * X.lane] = a0[r]; tab[r * 128 + 2 * X.lane + 1] = a1[r]; }
        __syncthreads();
        for (int idx = X.tid; idx < 17 * 128; idx += NTHR) { const int r = idx >> 7, j = idx & 127; float s = P.b_mod[l * 6144 + jc * 128 + j];
#pragma unroll
            for (int w = 0; w < 8; ++w) s += ((LAS float*)(X.L + w * 8704))[idx];
            MOD[((size_t)l * 17 + r) * 6144 + jc * 128 + j] = s; }
    }
    __syncthreads();
    f32x2* rope = (f32x2*)(P.ws + WS_ROPE);
    for (int e = X.bid * NTHR + X.tid; e < SEQ * 16; e += X.G * NTHR) { const int p = e >> 4, d = e & 15; const int row = p >> 6, col = p & 63;
        const float inv = powf(10000.f, -(float)(d & 7) / 8.f); const float ang = (float)((d < 8) ? row : col) * inv; rope[e] = (f32x2){cosf(ang), sinf(ang)}; }
    u32x4* wz = (u32x4*)((bf16_t*)(P.ws + WS_WIN) + (size_t)2496 * DM);
    for (int e = X.bid * NTHR + X.tid; e < 64 * DM * 2 / 16; e += X.G * NTHR) wz[e] = (u32x4){0u, 0u, 0u, 0u};
}

DI void cvt_item(const float* W, int ldw, int N, int k0, int n0, bf16_t* WT, int K, int row0, const float* kscale, float mul, LAS float* scr, int lane) {
#pragma unroll 8
    for (int i = 0; i < 32; ++i) { const int kk = 2 * i + (lane >> 5), n = n0 + (lane & 31);
        float v = (n < N) ? W[(size_t)(k0 + kk) * ldw + n] : 0.f; if (kscale) v *= kscale[k0 + kk];
        scr[kk * 33 + (lane & 31)] = v * mul; }
    LDS_WAIT(); asm volatile("" ::: "memory");
    const int c = lane & 7;
#pragma unroll
    for (int j = 0; j < 4; ++j) { const int nn = (lane >> 3) + 8 * j; const LAS float* s = scr + (8 * c) * 33 + nn;
        u32x4 o; o.x = pk2(s[0 * 33], s[1 * 33]); o.y = pk2(s[2 * 33], s[3 * 33]); o.z = pk2(s[4 * 33], s[5 * 33]); o.w = pk2(s[6 * 33], s[7 * 33]);
        *(u32x4*)(WT + (size_t)(row0 + nn) * K + k0 + 8 * c) = o; }
    LDS_WAIT(); asm volatile("" ::: "memory");
}
DI void convert_weights(const Params& P, Ctx& X, int l) {
    LAS float* scr = (LAS float*)(X.L + X.wave * 8704);
    const int gw = X.bid * NWAVE + X.wave, NGW = X.G * NWAVE;
    constexpr int I_IN = 16 * 78, I_OUT = 16 * 32, I_UQ = 4 * 12, I_UKV = 2 * 16, I_E = 768, NIT = I_IN + I_OUT + I_UQ + I_UKV + 16 * I_E;
    for (int it = gw; it < NIT; it += NGW) {
        int r = it;
        if (r < I_IN) { cvt_item(P.w_in + (size_t)l * DM * INW, INW, INW, 64 * (r / 78), 32 * (r % 78), (bf16_t*)(P.ws + WS_WIN), DM, 32 * (r % 78), nullptr, 1.f, scr, X.lane); continue; } r -= I_IN;
        if (r < I_OUT) { cvt_item(P.w_out + (size_t)l * DM * DM, DM, DM, 64 * (r / 32), 32 * (r % 32), (bf16_t*)(P.ws + WS_WOUT), DM, 32 * (r % 32), nullptr, 1.f, scr, X.lane); continue; } r -= I_OUT;
        if (r < I_UQ) { cvt_item(P.w_uq + (size_t)l * 256 * 384, 384, 384, 64 * (r / 12), 32 * (r % 12), (bf16_t*)(P.ws + WS_WUQ), 256, 32 * (r % 12), P.mq_g + l * 256, MLA_QS, scr, X.lane); continue; } r -= I_UQ;
        if (r < I_UKV) { cvt_item(P.w_ukv + (size_t)l * 128 * 512, 512, 512, 64 * (r / 16), 32 * (r % 16), (bf16_t*)(P.ws + WS_WUKV), 128, 32 * (r % 16), P.mkv_g + l * 128, 1.f, scr, X.lane); continue; } r -= I_UKV;
        const int e = r / I_E; r -= e * I_E;
        if (r < 256) { const int kb = r / 16, nb = r % 16;
            cvt_item(P.wg + ((size_t)l * 16 + e) * DM * 512, 512, 512, 64 * kb, 32 * nb, (bf16_t*)(P.ws + WS_WGU) + (size_t)e * 1024 * DM, DM, 256 * (nb >> 2) + 32 * (nb & 3), nullptr, 1.f, scr, X.lane); continue; } r -= 256;
        if (r < 256) { const int kb = r / 16, nb = r % 16;
            cvt_item(P.wu + ((size_t)l * 16 + e) * DM * 512, 512, 512, 64 * kb, 32 * nb, (bf16_t*)(P.ws + WS_WGU) + (size_t)e * 1024 * DM, DM, 256 * (nb >> 2) + 128 + 32 * (nb & 3), nullptr, 1.f, scr, X.lane); continue; } r -= 256;
        { const int kb = r / 32, nb = r % 32;
            cvt_item(P.wd + ((size_t)l * 16 + e) * 512 * DM, DM, DM, 64 * kb, 32 * nb, (bf16_t*)(P.ws + WS_WD) + (size_t)e * 1024 * 512, 512, 32 * nb, nullptr, 1.f, scr, X.lane); }
    }
}

DI int slot_base_lane(const unsigned* cnt, int lane) {
    int c = (lane < 16) ? (int)cnt[lane] : 0;
    int tiles = (c + 255) >> 8;
    int incl = tiles;
#pragma unroll
    for (int o = 1; o < 16; o <<= 1) { const int v = __shfl_up(incl, o); if (lane >= o) incl += v; }
    return (incl - tiles) * 256;
}

DI void phase_norm1(const Params& P, Ctx& X, int l) {
    convert_weights(P, X, l);
    const float* MOD = (const float*)(P.ws + WS_MOD);
    bf16_t* ACT = (bf16_t*)(P.ws + WS_ACT);
    const bf16_t* YS = (const bf16_t*)(P.ws + WS_YS);
    const u32x4* TOK = (const u32x4*)(P.ws + WS_TOK);
    const unsigned* cnt = (const unsigned*)(P.ws + WS_CTL) + CW_CNT + (l > 0 ? (l - 1) * 16 : 0);
    const int sbase = (l > 0) ? slot_base_lane(cnt, X.lane) : 0;
    const int gw = X.bid * NWAVE + X.wave, NGW = X.G * NWAVE;
    const float* g = P.g_mix + l * DM;
    for (int m = gw; m < M; m += NGW) {
        const int b = m / T, t = m - b * T;
        f32x4 v[4];
        float* hp = hrow(P, m);
        if (l == 0) {
            const float* src = (t < CTX) ? P.ctx + ((size_t)b * CTX + t) * DM : P.x + ((size_t)b * SEQ + (t - CTX)) * DM;
#pragma unroll
            for (int j = 0; j < 4; ++j) v[j] = *(const f32x4*)(src + 256 * j + 4 * X.lane);
        } else {
            const float* gate = MOD + ((size_t)(l - 1) * 17 + ((t < CTX) ? 16 : b)) * 6144 + 5 * DM;
            const u32x4 ti = TOK[m];
            const int s0 = __shfl(sbase, (int)(ti.x & 15u)) + (int)(ti.x >> 4), s1 = __shfl(sbase, (int)(ti.y & 15u)) + (int)(ti.y >> 4);
            const float w0 = __uint_as_float(ti.z), w1 = __uint_as_float(ti.w);
            const bf16_t* y0 = YS + (size_t)s0 * DM; const bf16_t* y1 = YS + (size_t)s1 * DM;
#pragma unroll
            for (int j = 0; j < 4; ++j) { const int cidx = 256 * j + 4 * X.lane;
                const f32x4 hv = *(const f32x4*)(hp + cidx); const f32x4 gv = *(const f32x4*)(gate + cidx);
                const u32x2 a = *(const u32x2*)(y0 + cidx), bb = *(const u32x2*)(y1 + cidx);
                f32x4 yv; yv[0] = w0 * bflo(a.x) + w1 * bflo(bb.x); yv[1] = w0 * bfhi(a.x) + w1 * bfhi(bb.x); yv[2] = w0 * bflo(a.y) + w1 * bflo(bb.y); yv[3] = w0 * bfhi(a.y) + w1 * bfhi(bb.y);
                v[j] = hv + gv * yv; }
        }
        float ss = 0.f;
#pragma unroll
        for (int j = 0; j < 4; ++j) { *(f32x4*)(hp + 256 * j + 4 * X.lane) = v[j]; ss += v[j][0] * v[j][0] + v[j][1] * v[j][1] + v[j][2] * v[j][2] + v[j][3] * v[j][3]; }
        const float rstd = rsqrtf(wave_sum(ss) * (1.f / DM) + EPS);
        const float* mrow = MOD + ((size_t)l * 17 + ((t < CTX) ? 16 : b)) * 6144;
#pragma unroll
        for (int j = 0; j < 4; ++j) { const int cidx = 256 * j + 4 * X.lane;
            const f32x4 gg = *(const f32x4*)(g + cidx), sh = *(const f32x4*)(mrow + cidx), sc = *(const f32x4*)(mrow + DM + cidx);
            const f32x4 uu = v[j] * rstd * gg * (sc + 1.f) + sh;
            u32x2 o; o.x = pk2(uu[0], uu[1]); o.y = pk2(uu[2], uu[3]);
            *(u32x2*)(ACT + (size_t)m * DM + cidx) = o; }
    }
}
DI void phase_final(const Params& P, Ctx& X) {
    const float* MOD = (const float*)(P.ws + WS_MOD);
    const bf16_t* YS = (const bf16_t*)(P.ws + WS_YS);
    const u32x4* TOK = (const u32x4*)(P.ws + WS_TOK);
    const unsigned* cnt = (const unsigned*)(P.ws + WS_CTL) + CW_CNT + 3 * 16;
    const int sbase = slot_base_lane(cnt, X.lane);
    const int gw = X.bid * NWAVE + X.wave, NGW = X.G * NWAVE;
    for (int r = gw; r < NB * SEQ; r += NGW) {
        const int b = r / SEQ, p = r - b * SEQ, m = b * T + CTX + p;
        float* hp = P.out + (size_t)r * DM;
        const float* gate = MOD + ((size_t)3 * 17 + b) * 6144 + 5 * DM;
        const u32x4 ti = TOK[m];
        const int s0 = __shfl(sbase, (int)(ti.x & 15u)) + (int)(ti.x >> 4), s1 = __shfl(sbase, (int)(ti.y & 15u)) + (int)(ti.y >> 4);
        const float w0 = __uint_as_float(ti.z), w1 = __uint_as_float(ti.w);
        const bf16_t* y0 = YS + (size_t)s0 * DM; const bf16_t* y1 = YS + (size_t)s1 * DM;
        f32x4 v[4]; float ss = 0.f;
#pragma unroll
        for (int j = 0; j < 4; ++j) { const int cidx = 256 * j + 4 * X.lane;
            const f32x4 hv = *(const f32x4*)(hp + cidx); const f32x4 gv = *(const f32x4*)(gate + cidx);
            const u32x2 a = *(const u32x2*)(y0 + cidx), bb = *(const u32x2*)(y1 + cidx);
            f32x4 yv; yv[0] = w0 * bflo(a.x) + w1 * bflo(bb.x); yv[1] = w0 * bfhi(a.x) + w1 * bfhi(bb.x); yv[2] = w0 * bflo(a.y) + w1 * bflo(bb.y); yv[3] = w0 * bfhi(a.y) + w1 * bfhi(bb.y);
            v[j] = hv + gv * yv; ss += v[j][0] * v[j][0] + v[j][1] * v[j][1] + v[j][2] * v[j][2] + v[j][3] * v[j][3]; }
        const float rstd = rsqrtf(wave_sum(ss) * (1.f / DM) + EPS);
#pragma unroll
        for (int j = 0; j < 4; ++j) { const int cidx = 256 * j + 4 * X.lane; *(f32x4*)(hp + cidx) = v[j] * rstd * *(const f32x4*)(P.fin_g + cidx); }
    }
}

DI void phase_postproj(const Params& P, Ctx& X, int l) {
    bf16_t* PROJ = (bf16_t*)(P.ws + WS_PROJ);
    const f32x2* rope = (const f32x2*)(P.ws + WS_ROPE);
    bf16_t* XBC = (bf16_t*)(P.ws + WS_XBC); float* DT = (float*)(P.ws + WS_DT);
    bf16_t* MLAQ = (bf16_t*)(P.ws + WS_MLAQ); bf16_t* MLAK = (bf16_t*)(P.ws + WS_MLAK);
    bf16_t* VTM = (bf16_t*)(P.ws + WS_VTM); bf16_t* VTD = (bf16_t*)(P.ws + WS_VTD);
    const bf16_t* WUQ = (const bf16_t*)(P.ws + WS_WUQ); const bf16_t* WUKV = (const bf16_t*)(P.ws + WS_WUKV);
    const int lane = X.lane, wave = X.wave;
    for (int u = X.bid; u < M / 144; u += X.G) {
        const int m0 = u * 144, b = m0 / T, t0 = m0 - b * T;
        __syncthreads();
        float cw[3][12], cb[12];
#pragma unroll
        for (int g3 = 0; g3 < 3; ++g3)
#pragma unroll
            for (int i = 0; i < 4; ++i) { const int ch = 256 * g3 + 4 * lane + i; cb[g3 * 4 + i] = P.conv_b[l * 768 + ch];
#pragma unroll
                for (int k = 0; k < 3; ++k) cw[k][g3 * 4 + i] = P.conv_w[((size_t)l * 3 + k) * 768 + ch]; }
        for (int rr = 0; rr < 18; ++rr) {
            const int t = t0 + wave * 18 + rr; const size_t m = (size_t)b * T + t;
            bf16_t* prow = PROJ + m * PW;
            { const int vv = lane >> 2, d0 = 4 * (lane & 3);
              bf16_t* p1 = prow + vv * 32 + d0;
              const u32x2 a = *(const u32x2*)p1, bq = *(const u32x2*)(p1 + 16);
              float x1[4] = {bflo(a.x), bfhi(a.x), bflo(a.y), bfhi(a.y)}, x2[4] = {bflo(bq.x), bfhi(bq.x), bflo(bq.y), bfhi(bq.y)};
              const float qs = (vv < 8) ? DA_QS : 1.f;
              float o1[4], o2[4];
              if (t >= CTX) { const f32x2* rp = rope + (size_t)(t - CTX) * 16 + d0;
#pragma unroll
                  for (int i = 0; i < 4; ++i) { const f32x2 cs = rp[i]; o1[i] = (x1[i] * cs.x - x2[i] * cs.y) * qs; o2[i] = (x2[i] * cs.x + x1[i] * cs.y) * qs; } }
              else {
#pragma unroll
                  for (int i = 0; i < 4; ++i) { o1[i] = x1[i] * qs; o2[i] = x2[i] * qs; } }
              u32x2 w1, w2; w1.x = pk2(o1[0], o1[1]); w1.y = pk2(o1[2], o1[3]); w2.x = pk2(o2[0], o2[1]); w2.y = pk2(o2[2], o2[3]);
              *(u32x2*)p1 = w1; *(u32x2*)(p1 + 16) = w2; }
            { const u32x2 vv = *(const u32x2*)(prow + C_DAV + 4 * lane);
              *(LAS u32x2*)(X.L + (size_t)(wave * 18 + rr) * 520 + lane * 8) = vv; }
            { const int lo = (t < CTX) ? 0 : CTX, hi = (t < CTX) ? CTX : T;
#pragma unroll
              for (int g3 = 0; g3 < 3; ++g3) { const int ch = 256 * g3 + 4 * lane;
                  const u32x2 c0 = *(const u32x2*)(prow + C_XBC + ch);
                  u32x2 cm = {0u, 0u}, cp = {0u, 0u};
                  if (t - 1 >= lo) cm = *(const u32x2*)(prow - PW + C_XBC + ch);
                  if (t + 1 < hi) cp = *(const u32x2*)(prow + PW + C_XBC + ch);
                  const float xm[4] = {bflo(cm.x), bfhi(cm.x), bflo(cm.y), bfhi(cm.y)}, x0[4] = {bflo(c0.x), bfhi(c0.x), bflo(c0.y), bfhi(c0.y)}, xp[4] = {bflo(cp.x), bfhi(cp.x), bflo(cp.y), bfhi(cp.y)};
                  float o[4];
#pragma unroll
                  for (int i = 0; i < 4; ++i) o[i] = silu(cb[g3 * 4 + i] + cw[0][g3 * 4 + i] * xm[i] + cw[1][g3 * 4 + i] * x0[i] + cw[2][g3 * 4 + i] * xp[i]);
                  u32x2 w; w.x = pk2(o[0], o[1]); w.y = pk2(o[2], o[3]);
                  *(u32x2*)(XBC + m * 768 + ch) = w; } }
            if (lane < 16) { const float v = __uint_as_float(((unsigned)prow[C_DT + lane]) << 16) + P.dt_bias[l * 16 + lane]; DT[m * 16 + lane] = (v > 20.f) ? v : log1pf(__expf(v)); }
            if (lane < 16) { const float x1 = __uint_as_float(((unsigned)prow[C_KR + lane]) << 16), x2 = __uint_as_float(((unsigned)prow[C_KR + 16 + lane]) << 16);
                float o1 = x1, o2 = x2;
                if (t >= CTX) { const f32x2 cs = rope[(size_t)(t - CTX) * 16 + lane]; o1 = x1 * cs.x - x2 * cs.y; o2 = x2 * cs.x + x1 * cs.y; }
                const bf16_t b1 = (bf16_t)(pk2(o1, 0.f) & 0xffffu), b2 = (bf16_t)(pk2(o2, 0.f) & 0xffffu);
#pragma unroll
                for (int h = 0; h < 4; ++h) { MLAK[(m * 4 + h) * 96 + 64 + lane] = b1; MLAK[(m * 4 + h) * 96 + 80 + lane] = b2; } }
        }
        __syncthreads();
        { const int vr = X.tid >> 1, th = X.tid & 1;
          bf16_t* dst = VTD + ((size_t)b * 256 + vr) * T + t0 + th * 72;
#pragma unroll 1
          for (int q8 = 0; q8 < 9; ++q8) { unsigned w[4];
#pragma unroll
              for (int i = 0; i < 4; ++i) { const int tt = th * 72 + q8 * 8 + 2 * i;
                  const unsigned lo = *(const LAS unsigned short*)(X.L + (size_t)tt * 520 + vr * 2), hi = *(const LAS unsigned short*)(X.L + (size_t)(tt + 1) * 520 + vr * 2);
                  w[i] = lo | (hi << 16); }
              *(u32x4*)(dst + q8 * 8) = (u32x4){w[0], w[1], w[2], w[3]}; } }
        { const int tk = lane & 15, q4 = lane >> 4;
          bf16x8 bw[3][8];
#pragma unroll
          for (int ct = 0; ct < 3; ++ct)
#pragma unroll
              for (int s = 0; s < 8; ++s) bw[ct][s] = *(const bf16x8*)(WUQ + (size_t)((3 * wave + ct) * 16 + tk) * 256 + 32 * s + 8 * q4);
          for (int rt = 0; rt < 9; ++rt) {
              const int t = t0 + rt * 16 + tk; const size_t m = (size_t)b * T + t;
              bf16x8 af[8]; float ss = 0.f;
#pragma unroll
              for (int s = 0; s < 8; ++s) { af[s] = *(const bf16x8*)(PROJ + m * PW + C_CQ + 32 * s + 8 * q4);
#pragma unroll
                  for (int j = 0; j < 8; ++j) { const float f = __uint_as_float(((unsigned)(unsigned short)af[s][j]) << 16); ss += f * f; } }
              ss += __shfl_xor(ss, 16); ss += __shfl_xor(ss, 32);
              const float rstd = rsqrtf(ss * (1.f / 256.f) + EPS);
              f32x4 acc[3];
#pragma unroll
              for (int ct = 0; ct < 3; ++ct) { acc[ct] = (f32x4){0.f, 0.f, 0.f, 0.f};
#pragma unroll
                  for (int s = 0; s < 8; ++s) acc[ct] = MFMA16(bw[ct][s], af[s], acc[ct]);
                  acc[ct] = acc[ct] * rstd; }
              if ((wave & 1) && t >= CTX) {
                  const f32x2* rp = rope + (size_t)(t - CTX) * 16 + 4 * q4;
#pragma unroll
                  for (int i = 0; i < 4; ++i) { const f32x2 cs = rp[i]; const float x1 = acc[1][i], x2 = acc[2][i]; acc[1][i] = x1 * cs.x - x2 * cs.y; acc[2][i] = x2 * cs.x + x1 * cs.y; } }
#pragma unroll
              for (int ct = 0; ct < 3; ++ct) { u32x2 w; w.x = pk2(acc[ct][0], acc[ct][1]); w.y = pk2(acc[ct][2], acc[ct][3]);
                  *(u32x2*)(MLAQ + m * 384 + (3 * wave + ct) * 16 + 4 * q4) = w; }
          }
        }
        { const int tk = lane & 15, q4 = lane >> 4, hh = wave >> 1;
          bf16x8 bw[4][4];
#pragma unroll
          for (int ct = 0; ct < 4; ++ct)
#pragma unroll
              for (int s = 0; s < 4; ++s) bw[ct][s] = *(const bf16x8*)(WUKV + (size_t)((4 * wave + ct) * 16 + tk) * 128 + 32 * s + 8 * q4);
          for (int rt = 0; rt < 9; ++rt) {
              const int t = t0 + rt * 16 + tk; const size_t m = (size_t)b * T + t;
              bf16x8 af[4]; float ss = 0.f;
#pragma unroll
              for (int s = 0; s < 4; ++s) { af[s] = *(const bf16x8*)(PROJ + m * PW + C_CKV + 32 * s + 8 * q4);
#pragma unroll
                  for (int j = 0; j < 8; ++j) { const float f = __uint_as_float(((unsigned)(unsigned short)af[s][j]) << 16); ss += f * f; } }
              ss += __shfl_xor(ss, 16); ss += __shfl_xor(ss, 32);
              const float rstd = rsqrtf(ss * (1.f / 128.f) + EPS);
              if ((wave & 1) == 0) {
#pragma unroll
                  for (int ct = 0; ct < 4; ++ct) { f32x4 acc = {0.f, 0.f, 0.f, 0.f};
#pragma unroll
                      for (int s = 0; s < 4; ++s) acc = MFMA16(bw[ct][s], af[s], acc);
                      acc = acc * rstd;
                      u32x2 w; w.x = pk2(acc[0], acc[1]); w.y = pk2(acc[2], acc[3]);
                      *(u32x2*)(MLAK + (m * 4 + hh) * 96 + ct * 16 + 4 * q4) = w; }
              } else {
                  float rs[4];
#pragma unroll
                  for (int i = 0; i < 4; ++i) rs[i] = __shfl(rstd, 4 * q4 + i);
#pragma unroll
                  for (int ct = 0; ct < 4; ++ct) { f32x4 acc = {0.f, 0.f, 0.f, 0.f};
#pragma unroll
                      for (int s = 0; s < 4; ++s) acc = MFMA16(af[s], bw[ct][s], acc);
                      u32x2 w; w.x = pk2(acc[0] * rs[0], acc[1] * rs[1]); w.y = pk2(acc[2] * rs[2], acc[3] * rs[3]);
                      *(u32x2*)(VTM + (((size_t)b * 4 + hh) * 64 + ct * 16 + tk) * T + t0 + rt * 16 + 4 * q4) = w; }
              }
          }
        }
    }
}

template <int KIND>
DI void attn_unit(const Params& P, Ctx& X, int l, int b, int h, int qt, float lam, float lam_init) {
    constexpr int DK = KIND ? 96 : 64, KROW = DK * 2 + 16, NS = KIND ? 6 : 2;
    constexpr int KBUF = 64 * KROW, VROW = 136, VBUF = 64 * VROW;
    constexpr int OFF_K = 0, OFF_V = 2 * KBUF, OFF_X = 36864;
    const bf16_t* PROJ = (const bf16_t*)(P.ws + WS_PROJ);
    const bf16_t* MLAQ = (const bf16_t*)(P.ws + WS_MLAQ); const bf16_t* MLAK = (const bf16_t*)(P.ws + WS_MLAK);
    const bf16_t* VT = (const bf16_t*)(P.ws + (KIND ? WS_VTM : WS_VTD)) + ((size_t)b * 4 + h) * 64 * T;
    bf16_t* ACT = (bf16_t*)(P.ws + WS_ACT);
    const int tid = X.tid, lane = X.lane, wave = X.wave, r = lane & 31, hh = lane >> 5;
    const int mmw = KIND ? 0 : (wave & 1), qg = KIND ? wave : (wave >> 1);
    const bool is_ctx = KIND ? (qt == 0) : (qt < 2);
    const int nk = is_ctx ? CTX : T, ntile = nk / 64;
    const size_t mrow = (size_t)b * T + qt * (KIND ? 256 : 128) + qg * 32 + r;
    bf16x8 qf[NS];
#pragma unroll
    for (int s = 0; s < NS; ++s)
        qf[s] = KIND ? *(const bf16x8*)(MLAQ + mrow * 384 + h * 96 + 16 * s + 8 * hh) : *(const bf16x8*)(PROJ + mrow * PW + C_DAQ + h * 64 + mmw * 32 + 16 * s + 8 * hh);
    const int kcol = mmw * 64 + 16 * hh;
    const int kkey = KIND ? (tid / 12) : (tid >> 3), kpc = KIND ? (tid % 12) : (tid & 7);
    const int kkey2 = (512 + tid) / 12, kpc2 = (512 + tid) % 12;
    const int vdv = tid >> 3, vpc = tid & 7;
    u32x4 kr0, kr1 = {0u, 0u, 0u, 0u}, vr0;
    auto gload = [&](int it) {
        const int key0 = it * 64;
        if (KIND) { kr0 = *(const u32x4*)(MLAK + (((size_t)b * T + key0 + kkey) * 4 + h) * 96 + kpc * 8);
                    if (tid < 256) kr1 = *(const u32x4*)(MLAK + (((size_t)b * T + key0 + kkey2) * 4 + h) * 96 + kpc2 * 8); }
        else kr0 = *(const u32x4*)(PROJ + ((size_t)b * T + key0 + kkey) * PW + C_DAK + h * 64 + kpc * 8);
        vr0 = *(const u32x4*)(VT + (size_t)vdv * T + key0 + vpc * 8);
    };
    auto lstore = [&](int buf) {
        *(LAS u32x4*)(X.L + OFF_K + buf * KBUF + kkey * KROW + kpc * 16) = kr0;
        if (KIND && tid < 256) *(LAS u32x4*)(X.L + OFF_K + buf * KBUF + kkey2 * KROW + kpc2 * 16) = kr1;
        LAS unsigned char* vp = X.L + OFF_V + buf * VBUF + vdv * VROW + vpc * 16;
        *(LAS u32x2*)vp = (u32x2){vr0.x, vr0.y}; *(LAS u32x2*)(vp + 8) = (u32x2){vr0.z, vr0.w};
    };
    f32x16 O[2]; float mrun = -1e30f, lsum = 0.f;
#pragma unroll
    for (int d = 0; d < 2; ++d)
#pragma unroll
        for (int i = 0; i < 16; ++i) O[d][i] = 0.f;
    __syncthreads();
    gload(0); lstore(0);
    __syncthreads();
    for (int it = 0; it < ntile; ++it) {
        const int buf = it & 1;
        if (it + 1 < ntile) gload(it + 1);
        const LAS unsigned char* Kb = X.L + OFF_K + buf * KBUF; const LAS unsigned char* Vb = X.L + OFF_V + buf * VBUF;
        f32x16 S0, S1;
#pragma unroll
        for (int i = 0; i < 16; ++i) { S0[i] = 0.f; S1[i] = 0.f; }
#pragma unroll
        for (int s = 0; s < NS; ++s) {
            const bf16x8 k0 = *(const LAS bf16x8*)(Kb + r * KROW + kcol + 32 * s);
            const bf16x8 k1 = *(const LAS bf16x8*)(Kb + (32 + r) * KROW + kcol + 32 * s);
            S0 = MFMA32(k0, qf[s], S0); S1 = MFMA32(k1, qf[s], S1);
        }
        float mx = S0[0];
#pragma unroll
        for (int i = 1; i < 16; ++i) mx = fmaxf(mx, S0[i]);
#pragma unroll
        for (int i = 0; i < 16; ++i) mx = fmaxf(mx, S1[i]);
        mx = fmaxf(mx, __shfl_xor(mx, 32));
        const float mnew = fmaxf(mrun, mx), alpha = fexp2(mrun - mnew);
        mrun = mnew;
        float ps = 0.f;
#pragma unroll
        for (int i = 0; i < 16; ++i) { S0[i] = fexp2(S0[i] - mnew); S1[i] = fexp2(S1[i] - mnew); ps += S0[i] + S1[i]; }
        lsum = lsum * alpha + ps;
#pragma unroll
        for (int d = 0; d < 2; ++d)
#pragma unroll
            for (int i = 0; i < 16; ++i) O[d][i] *= alpha;
        bf16x8 pf[2][2];
#pragma unroll
        for (int s = 0; s < 2; ++s) {
            u32x4 w0, w1;
            w0.x = pk2(S0[8 * s + 0], S0[8 * s + 1]); w0.y = pk2(S0[8 * s + 2], S0[8 * s + 3]); w0.z = pk2(S0[8 * s + 4], S0[8 * s + 5]); w0.w = pk2(S0[8 * s + 6], S0[8 * s + 7]);
            w1.x = pk2(S1[8 * s + 0], S1[8 * s + 1]); w1.y = pk2(S1[8 * s + 2], S1[8 * s + 3]); w1.z = pk2(S1[8 * s + 4], S1[8 * s + 5]); w1.w = pk2(S1[8 * s + 6], S1[8 * s + 7]);
            pf[0][s] = __builtin_bit_cast(bf16x8, w0); pf[1][s] = __builtin_bit_cast(bf16x8, w1);
        }
#pragma unroll
        for (int d = 0; d < 2; ++d)
#pragma unroll
            for (int kb = 0; kb < 2; ++kb)
#pragma unroll
                for (int s = 0; s < 2; ++s) {
                    const LAS unsigned char* vp = Vb + (32 * d + r) * VROW + (32 * kb + 16 * s + 4 * hh) * 2;
                    const s16x4 lo = *(const LAS s16x4*)vp, hi = *(const LAS s16x4*)(vp + 16);
                    const bf16x8 vf = __builtin_shufflevector(lo, hi, 0, 1, 2, 3, 4, 5, 6, 7);
                    O[d] = MFMA32(vf, pf[kb][s], O[d]);
                }
        if (it + 1 < ntile) lstore(buf ^ 1);
        __syncthreads();
    }
    const float inv = 1.f / (lsum + __shfl_xor(lsum, 32));
    if (KIND == 0) {
        LAS float* xb = (LAS float*)(X.L + OFF_X) + qg * 2048 + lane;
        if (mmw == 1) {
#pragma unroll
            for (int d = 0; d < 2; ++d)
#pragma unroll
                for (int i = 0; i < 16; ++i) xb[(d * 16 + i) * 64] = O[d][i] * inv;
        }
        __syncthreads();
        if (mmw == 0) {
            float ss = 0.f;
#pragma unroll
            for (int d = 0; d < 2; ++d)
#pragma unroll
                for (int i = 0; i < 16; ++i) { const float o = O[d][i] * inv - lam * xb[(d * 16 + i) * 64]; O[d][i] = o; ss += o * o; }
            ss += __shfl_xor(ss, 32);
            const float rstd = rsqrtf(ss * (1.f / 64.f) + EPS) * (1.f - lam_init);
#pragma unroll
            for (int d = 0; d < 2; ++d)
#pragma unroll
                for (int g4 = 0; g4 < 4; ++g4) { const int dv = 32 * d + 8 * g4 + 4 * hh; const f32x4 gg = *(const f32x4*)(P.da_g + l * 64 + dv);
                    u32x2 w; w.x = pk2(O[d][4 * g4] * rstd * gg[0], O[d][4 * g4 + 1] * rstd * gg[1]); w.y = pk2(O[d][4 * g4 + 2] * rstd * gg[2], O[d][4 * g4 + 3] * rstd * gg[3]);
                    *(u32x2*)(ACT + mrow * DM + h * 64 + dv) = w; }
        }
    } else {
#pragma unroll
        for (int d = 0; d < 2; ++d)
#pragma unroll
            for (int g4 = 0; g4 < 4; ++g4) { const int dv = 32 * d + 8 * g4 + 4 * hh;
                u32x2 w; w.x = pk2(O[d][4 * g4] * inv, O[d][4 * g4 + 1] * inv); w.y = pk2(O[d][4 * g4 + 2] * inv, O[d][4 * g4 + 3] * inv);
                *(u32x2*)(ACT + mrow * DM + 768 + h * 64 + dv) = w; }
    }
}

DI void ssd_unit(const Params& P, Ctx& X, int l, int b, int hd, int dir) {
    constexpr int OFF_BR = 0, OFF_CR = 18432, OFF_XT = 36864, OFF_XS = 53760, OFF_BT = 71168, OFF_SB = 88576, OFF_DA = 97792, OFF_AC = 98304, OFF_DTT = 98816;
    const bf16_t* XBC = (const bf16_t*)(P.ws + WS_XBC); const float* DT = (const float*)(P.ws + WS_DT);
    bf16_t* Y = (bf16_t*)(P.ws + (dir ? WS_YB : WS_YF));
    const int tid = X.tid, lane = X.lane, wave = X.wave, r = lane & 31, hh = lane >> 5, grp = hd >> 2;
    const float a = -__expf(P.a_log[l * 16 + dir * 8 + hd]);
    LAS unsigned char* L = X.L;
    LAS float* t_da = (LAS float*)(L + OFF_DA); LAS float* t_ac = (LAS float*)(L + OFF_AC); LAS float* t_dt = (LAS float*)(L + OFF_DTT);
    f32x4 Sacc[2] = {{0.f, 0.f, 0.f, 0.f}, {0.f, 0.f, 0.f, 0.f}};
    __syncthreads();
    for (int c = 0; c < 18; ++c) {
        const int seg0 = (c < 2) ? 0 : CTX, seg1 = (c < 2) ? CTX : T, cc = (c < 2) ? c : c - 2;
        const int tbase = dir ? (seg1 - 1 - 128 * cc) : (seg0 + 128 * cc), tstep = dir ? -1 : 1;
        const size_t rb = (size_t)b * T;
        if (tid < 128) { const float dtv = DT[(rb + tbase + tstep * tid) * 16 + dir * 8 + hd]; t_dt[tid] = dtv; t_da[tid] = dtv * a; }
        __syncthreads();
        if (wave == 0) { const float v0 = t_da[2 * lane], v1 = t_da[2 * lane + 1]; const float s = v0 + v1; float incl = s;
#pragma unroll
            for (int o = 1; o < 64; o <<= 1) { const float v = __shfl_up(incl, o); if (lane >= o) incl += v; }
            const float ex = incl - s; t_ac[2 * lane] = ex + v0; t_ac[2 * lane + 1] = ex + v0 + v1; }
        __syncthreads();
        const float alast = t_ac[127];
        {
            const int tau = tid >> 2, q2 = tid & 3;
            const bf16_t* rowp = XBC + (rb + tbase + tstep * tau) * 768;
            const float wj = __expf(alast - t_ac[tau]) * t_dt[tau];
#pragma unroll
            for (int k = 0; k < 2; ++k) { const int pc = 2 * q2 + k;
                const u32x4 xv = *(const u32x4*)(rowp + hd * 64 + 8 * pc), bv = *(const u32x4*)(rowp + 512 + grp * 64 + 8 * pc), cv = *(const u32x4*)(rowp + 640 + grp * 64 + 8 * pc);
                *(LAS u32x4*)(L + OFF_BR + tau * 144 + pc * 16) = bv; *(LAS u32x4*)(L + OFF_CR + tau * 144 + pc * 16) = cv;
                const unsigned xw[4] = {xv.x, xv.y, xv.z, xv.w}, bw[4] = {bv.x, bv.y, bv.z, bv.w};
#pragma unroll
                for (int i = 0; i < 4; ++i) { const int p0 = 8 * pc + 2 * i;
                    *(LAS unsigned short*)(L + OFF_XT + p0 * 264 + tau * 2) = (unsigned short)(xw[i] & 0xffffu);
                    *(LAS unsigned short*)(L + OFF_XT + (p0 + 1) * 264 + tau * 2) = (unsigned short)(xw[i] >> 16);
                    const unsigned sc = pk2(bflo(xw[i]) * wj, bfhi(xw[i]) * wj);
                    *(LAS unsigned short*)(L + OFF_XS + p0 * 272 + tau * 2) = (unsigned short)(sc & 0xffffu);
                    *(LAS unsigned short*)(L + OFF_XS + (p0 + 1) * 272 + tau * 2) = (unsigned short)(sc >> 16);
                    *(LAS unsigned short*)(L + OFF_BT + p0 * 272 + tau * 2) = (unsigned short)(bw[i] & 0xffffu);
                    *(LAS unsigned short*)(L + OFF_BT + (p0 + 1) * 272 + tau * 2) = (unsigned short)(bw[i] >> 16); } }
#pragma unroll
            for (int k = 0; k < 2; ++k) { const int tl = 2 * wave + k, pt = tl >> 2, nt = tl & 3, n = 16 * nt + (lane & 15), p = 16 * pt + 4 * (lane >> 4);
#pragma unroll
                for (int i = 0; i < 4; ++i) *(LAS unsigned short*)(L + OFF_SB + (p + i) * 144 + n * 2) = (unsigned short)(pk2(Sacc[k][i], 0.f) & 0xffffu); }
        }
        __syncthreads();
        {
            const int ib = wave >> 1, pb = wave & 1, i_tok = 32 * ib + r;
            const float acum_i = t_ac[i_tok];
            bf16x8 cf[4];
#pragma unroll
            for (int s = 0; s < 4; ++s) cf[s] = *(const LAS bf16x8*)(L + OFF_CR + i_tok * 144 + (16 * s + 8 * hh) * 2);
            f32x16 accO, accD;
#pragma unroll
            for (int i = 0; i < 16; ++i) { accO[i] = 0.f; accD[i] = 0.f; }
#pragma unroll
            for (int s = 0; s < 4; ++s) { const bf16x8 sa = *(const LAS bf16x8*)(L + OFF_SB + (32 * pb + r) * 144 + (16 * s + 8 * hh) * 2); accO = MFMA32(sa, cf[s], accO); }
            for (int jb = 0; jb <= ib; ++jb) {
                f32x16 g;
#pragma unroll
                for (int i = 0; i < 16; ++i) g[i] = 0.f;
#pragma unroll
                for (int s = 0; s < 4; ++s) { const bf16x8 ba = *(const LAS bf16x8*)(L + OFF_BR + (32 * jb + r) * 144 + (16 * s + 8 * hh) * 2); g = MFMA32(ba, cf[s], g); }
#pragma unroll
                for (int g4 = 0; g4 < 4; ++g4) { const int j0 = 32 * jb + 8 * g4 + 4 * hh;
                    const f32x4 aj = *(const LAS f32x4*)(L + OFF_AC + j0 * 4), dj = *(const LAS f32x4*)(L + OFF_DTT + j0 * 4);
#pragma unroll
                    for (int i = 0; i < 4; ++i) { const float arg = fminf(acum_i - aj[i], 0.f); const float wv = __expf(arg) * dj[i] * g[4 * g4 + i]; g[4 * g4 + i] = (j0 + i <= i_tok) ? wv : 0.f; } }
#pragma unroll
                for (int s = 0; s < 2; ++s) {
                    u32x4 w; w.x = pk2(g[8 * s + 0], g[8 * s + 1]); w.y = pk2(g[8 * s + 2], g[8 * s + 3]); w.z = pk2(g[8 * s + 4], g[8 * s + 5]); w.w = pk2(g[8 * s + 6], g[8 * s + 7]);
                    const bf16x8 wf = __builtin_bit_cast(bf16x8, w);
                    const LAS unsigned char* xp = L + OFF_XT + (32 * pb + r) * 264 + (32 * jb + 16 * s + 4 * hh) * 2;
                    const s16x4 lo = *(const LAS s16x4*)xp, hi = *(const LAS s16x4*)(xp + 16);
                    const bf16x8 xf = __builtin_shufflevector(lo, hi, 0, 1, 2, 3, 4, 5, 6, 7);
                    accD = MFMA32(xf, wf, accD);
                }
            }
            const float ei = __expf(acum_i);
            bf16_t* yp = Y + (rb + tbase + tstep * i_tok) * 512 + hd * 64 + 32 * pb + 4 * hh;
#pragma unroll
            for (int g4 = 0; g4 < 4; ++g4) { u32x2 w; w.x = pk2(accD[4 * g4] + ei * accO[4 * g4], accD[4 * g4 + 1] + ei * accO[4 * g4 + 1]); w.y = pk2(accD[4 * g4 + 2] + ei * accO[4 * g4 + 2], accD[4 * g4 + 3] + ei * accO[4 * g4 + 3]);
                *(u32x2*)(yp + 8 * g4) = w; }
        }
        {
            const float dec = __expf(alast);
#pragma unroll
            for (int k = 0; k < 2; ++k) { const int tl = 2 * wave + k, pt = tl >> 2, nt = tl & 3;
                f32x4 acc = Sacc[k] * dec;
#pragma unroll
                for (int s = 0; s < 4; ++s) {
                    const bf16x8 xa = *(const LAS bf16x8*)(L + OFF_XS + (16 * pt + (lane & 15)) * 272 + (32 * s + 8 * (lane >> 4)) * 2);
                    const bf16x8 bb = *(const LAS bf16x8*)(L + OFF_BT + (16 * nt + (lane & 15)) * 272 + (32 * s + 8 * (lane >> 4)) * 2);
                    acc = MFMA16(xa, bb, acc); }
                Sacc[k] = acc; }
        }
        __syncthreads();
    }
}

DI void phase_mixers(const Params& P, Ctx& X, int l, int sel = 7) {
    const float lam_init = 0.8f - 0.6f * __expf(-0.3f * (float)l);
    float l01 = 0.f, l23 = 0.f;
    if (X.lane < 32) { const float* lv = P.da_lam + l * 128; l01 = lv[X.lane] * lv[32 + X.lane]; l23 = lv[64 + X.lane] * lv[96 + X.lane]; }
    const float lam = __expf(wave_sum(l01)) - __expf(wave_sum(l23)) + lam_init;
    if (sel & 1) for (int u = X.bid; u < NB * 8 * 2; u += X.G) ssd_unit(P, X, l, u >> 4, (u >> 1) & 7, u & 1);
    if (sel & 2) for (int u = X.bid; u < 1024; u += X.G) attn_unit<0>(P, X, l, u >> 6, (u >> 4) & 3, 2 + (u & 15), lam, lam_init);
    if (sel & 4) for (int u = X.bid; u < 512; u += X.G) attn_unit<1>(P, X, l, u >> 5, (u >> 3) & 3, 1 + (u & 7), lam, lam_init);
    for (int u = X.bid; u < 192; u += X.G) { if (u < 128) { if (sel & 2) attn_unit<0>(P, X, l, u >> 3, (u >> 1) & 3, u & 1, lam, lam_init); } else { if (sel & 4) attn_unit<1>(P, X, l, (u - 128) >> 2, u & 3, 0, lam, lam_init); } }
}

DI void phase_ssdgate(const Params& P, Ctx& X, int l) {
    const bf16_t* PROJ = (const bf16_t*)(P.ws + WS_PROJ); const bf16_t* XBC = (const bf16_t*)(P.ws + WS_XBC);
    const bf16_t* YF = (const bf16_t*)(P.ws + WS_YF); const bf16_t* YB = (const bf16_t*)(P.ws + WS_YB);
    bf16_t* ACT = (bf16_t*)(P.ws + WS_ACT);
    const int gw = X.bid * NWAVE + X.wave, NGW = X.G * NWAVE, c0 = 8 * X.lane;
    const float dsk = P.ssd_d[l * 8 + (X.lane >> 3)];
    const f32x4 g0 = *(const f32x4*)(P.ssd_g + l * 512 + c0), g1 = *(const f32x4*)(P.ssd_g + l * 512 + c0 + 4);
    for (int m = gw; m < M; m += NGW) {
        const u32x4 yf = *(const u32x4*)(YF + (size_t)m * 512 + c0), yb = *(const u32x4*)(YB + (size_t)m * 512 + c0), xv = *(const u32x4*)(XBC + (size_t)m * 768 + c0), zv = *(const u32x4*)(PROJ + (size_t)m * PW + C_Z + c0);
        const unsigned yfw[4] = {yf.x, yf.y, yf.z, yf.w}, ybw[4] = {yb.x, yb.y, yb.z, yb.w}, xw[4] = {xv.x, xv.y, xv.z, xv.w}, zw[4] = {zv.x, zv.y, zv.z, zv.w};
        float v[8]; float ss = 0.f;
#pragma unroll
        for (int i = 0; i < 4; ++i) {
            v[2 * i] = (bflo(yfw[i]) + bflo(ybw[i]) + dsk * bflo(xw[i])) * silu(bflo(zw[i]));
            v[2 * i + 1] = (bfhi(yfw[i]) + bfhi(ybw[i]) + dsk * bfhi(xw[i])) * silu(bfhi(zw[i]));
            ss += v[2 * i] * v[2 * i] + v[2 * i + 1] * v[2 * i + 1]; }
        const float rstd = rsqrtf(wave_sum(ss) * (1.f / 512.f) + EPS);
        u32x4 w; w.x = pk2(v[0] * rstd * g0[0], v[1] * rstd * g0[1]); w.y = pk2(v[2] * rstd * g0[2], v[3] * rstd * g0[3]); w.z = pk2(v[4] * rstd * g1[0], v[5] * rstd * g1[1]); w.w = pk2(v[6] * rstd * g1[2], v[7] * rstd * g1[3]);
        *(u32x4*)(ACT + (size_t)m * DM + 256 + c0) = w;
    }
}

DI void phase_norm2_route(const Params& P, Ctx& X, int l) {
    const float* MOD = (const float*)(P.ws + WS_MOD);
    bf16_t* ACT = (bf16_t*)(P.ws + WS_ACT);
    u32x4* TOK = (u32x4*)(P.ws + WS_TOK); int* LIST = (int*)(P.ws + WS_LIST);
    unsigned* cnt = (unsigned*)(P.ws + WS_CTL) + CW_CNT + l * 16;
    __syncthreads();
    for (int k = X.tid; k < DM; k += NTHR) { const int j = k >> 8, ln = (k >> 2) & 63, i = k & 3, slot = (4 * j + i) * 64 + ln;
#pragma unroll
        for (int e4 = 0; e4 < 4; ++e4) *(LAS f32x4*)(X.L + ((size_t)e4 * 1024 + slot) * 16) = *(const f32x4*)(P.r_w + k * 16 + 4 * e4); }
    __syncthreads();
    float rb[16];
#pragma unroll
    for (int e = 0; e < 16; ++e) rb[e] = P.r_b[e];
    const int gw = X.bid * NWAVE + X.wave, NGW = X.G * NWAVE;
    const float* g = P.g_ffn + l * DM;
    constexpr int RPW = 32;
    LAS unsigned* lcnt = (LAS unsigned*)(X.L + 65536); LAS unsigned* lbase = lcnt + 16; LAS unsigned* ltab = lcnt + 64;
    if (X.tid < 32) lcnt[X.tid] = 0u;
    __syncthreads();
    int it = 0;
    for (int m = gw; m < M; m += NGW, ++it) {
        const int b = m / T, t = m - b * T;
        if (l == DEPTH - 1 && t < CTX) continue;
        const float* hp = hrow(P, m);
        f32x4 v[4]; float ss = 0.f;
#pragma unroll
        for (int j = 0; j < 4; ++j) { v[j] = *(const f32x4*)(hp + 256 * j + 4 * X.lane); ss += v[j][0] * v[j][0] + v[j][1] * v[j][1] + v[j][2] * v[j][2] + v[j][3] * v[j][3]; }
        const float rstd = rsqrtf(wave_sum(ss) * (1.f / DM) + EPS);
        const float* mrow = MOD + ((size_t)l * 17 + ((t < CTX) ? 16 : b)) * 6144;
        float lg[16];
#pragma unroll
        for (int e = 0; e < 16; ++e) lg[e] = 0.f;
#pragma unroll
        for (int j = 0; j < 4; ++j) { const int cidx = 256 * j + 4 * X.lane;
            const f32x4 gg = *(const f32x4*)(g + cidx), sh = *(const f32x4*)(mrow + 3 * DM + cidx), sc = *(const f32x4*)(mrow + 4 * DM + cidx);
            const f32x4 uu = v[j] * rstd * gg * (sc + 1.f) + sh;
            u32x2 o; o.x = pk2(uu[0], uu[1]); o.y = pk2(uu[2], uu[3]);
            *(u32x2*)(ACT + (size_t)m * DM + cidx) = o;
#pragma unroll
            for (int i = 0; i < 4; ++i) { const int slot = (4 * j + i) * 64 + X.lane;
#pragma unroll
                for (int e4 = 0; e4 < 4; ++e4) { const f32x4 rw = *(const LAS f32x4*)(X.L + ((size_t)e4 * 1024 + slot) * 16);
                    lg[4 * e4] += uu[i] * rw[0]; lg[4 * e4 + 1] += uu[i] * rw[1]; lg[4 * e4 + 2] += uu[i] * rw[2]; lg[4 * e4 + 3] += uu[i] * rw[3]; } } }
        float aff[16], sel[16];
#pragma unroll
        for (int e = 0; e < 16; ++e) { const float x = wave_sum(lg[e]); aff[e] = 1.f / (1.f + expf(-x)); sel[e] = aff[e] + rb[e]; }
        int best = 0; float bests = -1e30f;
#pragma unroll
        for (int gi = 0; gi < 4; ++gi) { float m1 = -1e30f, m2 = -1e30f;
#pragma unroll
            for (int j = 0; j < 4; ++j) { const float x = sel[gi * 4 + j]; if (x > m1) { m2 = m1; m1 = x; } else if (x > m2) m2 = x; }
            const float gs = m1 + m2; if (gs > bests) { bests = gs; best = gi; } }
        int i1 = 0, i2 = 0; float v1 = -1e30f, v2 = -1e30f, a1 = 0.f, a2 = 0.f;
#pragma unroll
        for (int e = 0; e < 16; ++e) if ((e >> 2) == best) { const float x = sel[e]; if (x > v1) { v2 = v1; i2 = i1; a2 = a1; v1 = x; i1 = e; a1 = aff[e]; } else if (x > v2) { v2 = x; i2 = e; a2 = aff[e]; } }
        if (X.lane == 0) {
            const unsigned r1 = __hip_atomic_fetch_add(lcnt + i1, 1u, __ATOMIC_RELAXED, __HIP_MEMORY_SCOPE_WORKGROUP), r2 = __hip_atomic_fetch_add(lcnt + i2, 1u, __ATOMIC_RELAXED, __HIP_MEMORY_SCOPE_WORKGROUP);
            LAS unsigned* rec = ltab + (X.wave * RPW + it) * 4;
            rec[0] = (unsigned)i1 | (r1 << 4); rec[1] = (unsigned)i2 | (r2 << 4); rec[2] = __float_as_uint(a1 / (a1 + a2)); rec[3] = __float_as_uint(a2 / (a1 + a2));
        }
    }
    __syncthreads();
    if (X.tid < 16) { const unsigned c = lcnt[X.tid]; lbase[X.tid] = c ? atomicAdd(&cnt[X.tid], c) : 0u; }
    __syncthreads();
    it = 0;
    for (int m = gw; m < M; m += NGW, ++it) {
        const int b = m / T, t = m - b * T;
        if (l == DEPTH - 1 && t < CTX) continue;
        if (X.lane == 0) {
            const LAS unsigned* rec = ltab + (X.wave * RPW + it) * 4;
            const unsigned e1 = rec[0] & 15u, e2 = rec[1] & 15u, p1 = lbase[e1] + (rec[0] >> 4), p2 = lbase[e2] + (rec[1] >> 4);
            LIST[(size_t)e1 * M + p1] = m; LIST[(size_t)e2 * M + p2] = m;
            u32x4 ti; ti.x = e1 | (p1 << 4); ti.y = e2 | (p2 << 4); ti.z = rec[2]; ti.w = rec[3];
            TOK[m] = ti;
        }
    }
}
DI void moe_tables(const Params& P, Ctx& X, int l) {
    __syncthreads();
    if (X.tid < 64) { const unsigned* cnt = (const unsigned*)(P.ws + WS_CTL) + CW_CNT + l * 16;
        const int c = (X.lane < 16) ? (int)__hip_atomic_load(cnt + (X.lane & 15), __ATOMIC_RELAXED, __HIP_MEMORY_SCOPE_AGENT) : 0;
        const int tiles = (c + 255) >> 8; int incl = tiles;
#pragma unroll
        for (int o = 1; o < 16; o <<= 1) { const int v = __shfl_up(incl, o); if (X.lane >= o) incl += v; }
        if (X.lane < 16) { X.misc[16 + X.lane] = c; X.misc[32 + X.lane] = incl - tiles; X.misc[64 + X.lane] = (incl - tiles) * 256; }
        if (X.lane == 15) X.misc[32 + 16] = incl; }
    __syncthreads();
}

constexpr int N_PHASES = 38;
__global__ void __launch_bounds__(NTHR, 2) mk_fwd(Params P) {
    extern __shared__ __attribute__((aligned(16))) unsigned char lds_raw[];
    Ctx X;
    X.L = (LAS unsigned char*)lds_raw; X.misc = (volatile LAS int*)(X.L + LDS_MISC); X.ws = P.ws;
    X.tid = threadIdx.x; X.lane = X.tid & 63; X.wave = __builtin_amdgcn_readfirstlane(X.tid >> 6); X.G = gridDim.x; X.bid = blockIdx.x;
    if (X.tid < 128) X.misc[X.tid] = 0;
    __syncthreads();
    unsigned* ctl = (unsigned*)(P.ws + WS_CTL);
    XcdBarrier bar; bar.bar = ctl + CW_BAR; bar.x = 0; bar.st = (volatile LAS unsigned*)X.misc;
    const bool multi = ((P.ph_hi & 255) - P.ph_lo) > 1;
    if (multi) bar = xcd_barrier_post(ctl + CW_BAR, (volatile LAS unsigned*)X.misc);
#ifndef PHMASK
#define PHMASK 0xFFFF
#endif
#define RUN(ph) (P.ph_lo <= (ph) && (ph) < (P.ph_hi & 255))
#define HAS(k) ((PHMASK >> (k)) & 1)
#define SEAM(ph) do { if (RUN(ph) && RUN((ph) + 1)) xcd_barrier(bar); } while (0)
    if (HAS(9) && RUN(0)) phase_prologue(P, X);
    SEAM(0);
#define FRESH() do { int _t = threadIdx.x; asm volatile("" : "+v"(_t)); X.tid = _t; X.lane = _t & 63; X.wave = __builtin_amdgcn_readfirstlane(_t >> 6); } while (0)
#pragma unroll 1
    for (int l = 0; l < DEPTH; ++l) {
        const int pb = 1 + 9 * l;
        FRESH(); if (HAS(0) && RUN(pb + 0)) phase_norm1(P, X, l);
        SEAM(pb + 0);
        FRESH(); if (HAS(1) && RUN(pb + 1)) { DenseSched S; S.init(P.ws + WS_ACT, P.ws + WS_WIN, M, PW, DM, X.G, X.bid); EpiStoreBf16 E{(bf16_t*)(P.ws + WS_PROJ), PW}; gemm8(X.L, DM, S, E); }
        SEAM(pb + 1);
        FRESH(); if (HAS(2) && RUN(pb + 2)) phase_postproj(P, X, l);
        SEAM(pb + 2);
        FRESH(); if (HAS(3) && RUN(pb + 3)) phase_mixers(P, X, l, (P.ph_hi >> 8) ? (P.ph_hi >> 8) : 7);
        SEAM(pb + 3);
        FRESH(); if (HAS(4) && RUN(pb + 4)) phase_ssdgate(P, X, l);
        SEAM(pb + 4);
        FRESH(); if (HAS(5) && RUN(pb + 5)) { DenseSched S; S.init(P.ws + WS_ACT, P.ws + WS_WOUT, M, DM, DM, X.G, X.bid);
            EpiResidual E{(float*)(P.ws + WS_HC), P.out, (const float*)(P.ws + WS_MOD) + (size_t)l * 17 * 6144}; gemm8(X.L, DM, S, E); }
        SEAM(pb + 5);
        FRESH(); if (HAS(6) && RUN(pb + 6)) phase_norm2_route(P, X, l);
        SEAM(pb + 6);
        FRESH(); if (HAS(7) && RUN(pb + 7)) { moe_tables(P, X, l);
            MoeSched<true> S{(const char*)(P.ws + WS_ACT), (const char*)(P.ws + WS_WGU), (const int*)(P.ws + WS_LIST), X.misc, DM, X.G, X.bid};
            EpiGateUp E{(bf16_t*)(P.ws + WS_HE)}; gemm8(X.L, DM, S, E); }
        SEAM(pb + 7);
        FRESH(); if (HAS(8) && RUN(pb + 8)) { moe_tables(P, X, l);
            MoeSched<false> S{(const char*)(P.ws + WS_HE), (const char*)(P.ws + WS_WD), nullptr, X.misc, 512, X.G, X.bid};
            EpiStoreBf16 E{(bf16_t*)(P.ws + WS_YS), DM}; gemm8(X.L, 512, S, E); }
        SEAM(pb + 8);
    }
    FRESH(); if (HAS(10) && RUN(37)) phase_final(P, X);
#undef RUN
#undef SEAM
}
}

#ifndef PROBE_SEL
#define PROBE_SEL 0
#endif
#ifndef MK_MODE
#define MK_MODE 1
#endif
extern "C" void kernel_launch(void* const* d_in, const int* in_sizes, int n_in, void* d_out, int out_size, void* d_ws, size_t ws_size, hipStream_t stream) {
    using namespace mk;
    static int grid = 0;
    if (grid == 0) {
        if (n_in != 28 || ws_size < WS_END) { fprintf(stderr, "kernel_launch: unexpected inputs (n_in %d, ws %zu < %zu)\n", n_in, ws_size, (size_t)WS_END); grid = -1; return; }
        int dev = 0, cus = 0, per_cu = 0;
        if (hipGetDevice(&dev) != hipSuccess || hipDeviceGetAttribute(&cus, hipDeviceAttributeMultiprocessorCount, dev) != hipSuccess) { grid = -1; return; }
        if (hipFuncSetAttribute((const void*)mk_fwd, hipFuncAttributeMaxDynamicSharedMemorySize, LDS_BYTES) != hipSuccess) { fprintf(stderr, "kernel_launch: hipFuncSetAttribute failed\n"); grid = -1; return; }
        if (hipOccupancyMaxActiveBlocksPerMultiprocessor(&per_cu, (const void*)mk_fwd, NTHR, LDS_BYTES) != hipSuccess || per_cu < 1) { fprintf(stderr, "kernel_launch: occupancy query says %d\n", per_cu); (void)hipGetLastError(); grid = -1; return; }
        grid = cus;
    }
    if (grid < 0) return;
    (void)hipMemsetAsync((char*)d_ws + WS_CTL, 0, CTL_BYTES, stream);
    Params p{};
    const float** pp = (const float**)&p;
    for (int i = 0; i < 28; ++i) pp[i] = (const float*)d_in[i];
    p.out = (float*)d_out; p.ws = (unsigned char*)d_ws;
#if MK_MODE == 1
    p.ph_lo = 0; p.ph_hi = N_PHASES;
    hipLaunchKernelGGL(mk_fwd, dim3(grid), dim3(NTHR), LDS_BYTES, stream, p);
#else
    for (int ph = 0; ph < N_PHASES; ++ph) { p.ph_lo = ph; p.ph_hi = ph + 1; hipLaunchKernelGGL(mk_fwd, dim3(grid), dim3(NTHR), LDS_BYTES, stream, p); }
#if MK_MODE == 2
    for (int r = 0; r < PROBE_REP; ++r) { p.ph_lo = PROBE_PH; p.ph_hi = (PROBE_PH + 1) | (PROBE_SEL << 8); hipLaunchKernelGGL(mk_fwd, dim3(grid), dim3(NTHR), LDS_BYTES, stream, p); }
#endif
#endif
}
```

```cpp
#include <hip/hip_runtime.h>
#include <cstdio>
#include <cstdint>

namespace mk {
#define LAS __attribute__((address_space(3)))
#define DI __device__ __forceinline__
typedef unsigned short bf16_t;
typedef short bf16x8 __attribute__((ext_vector_type(8)));
typedef short s16x4 __attribute__((ext_vector_type(4)));
typedef float f32x2 __attribute__((ext_vector_type(2)));
typedef float f32x4 __attribute__((ext_vector_type(4)));
typedef float f32x16 __attribute__((ext_vector_type(16)));
typedef unsigned u32x2 __attribute__((ext_vector_type(2)));
typedef unsigned u32x4 __attribute__((ext_vector_type(4)));
typedef __bf16 bf16x2_t __attribute__((ext_vector_type(2)));

constexpr int DM = 1024, NB = 16, SEQ = 2048, CTX = 256, T = SEQ + CTX, M = NB * T, DEPTH = 4;
constexpr int PW = 2560, INW = 2480;
constexpr int C_DAQ = 0, C_DAK = 256, C_DAV = 512, C_Z = 768, C_XBC = 1280, C_DT = 2048, C_CQ = 2064, C_CKV = 2320, C_KR = 2448;
constexpr float EPS = 1e-6f, LOG2E = 1.4426950408889634f;
constexpr float DA_QS = 0.17677669529663687f * LOG2E, MLA_QS = 0.10206207261596577f * LOG2E;
constexpr int NSLOT = 2 * M + 4096;
constexpr int NTHR = 512, NWAVE = 8;

constexpr size_t MiB = 1u << 20;
constexpr size_t WS_CTL = 0, CTL_BYTES = 1 * MiB;
constexpr size_t WS_MOD = 1 * MiB, WS_ROPE = 3 * MiB, WS_HC = 4 * MiB;
constexpr size_t WS_WIN = 20 * MiB, WS_WOUT = 25 * MiB, WS_WUQ = 27 * MiB, WS_WUKV = 27 * MiB + 512 * 1024, WS_WGU = 28 * MiB, WS_WD = 60 * MiB;
constexpr size_t WS_ACT = 76 * MiB, WS_PROJ = 148 * MiB;
constexpr size_t WS_MLAQ = 328 * MiB, WS_MLAK = 355 * MiB, WS_VTM = 382 * MiB, WS_VTD = 400 * MiB;
constexpr size_t WS_XBC = 418 * MiB, WS_DT = 472 * MiB, WS_YF = 475 * MiB, WS_YB = 511 * MiB, WS_TOK = 547 * MiB, WS_LIST = 548 * MiB, WS_END = 551 * MiB;
constexpr size_t WS_HE = WS_MLAQ, WS_YS = WS_PROJ;
static_assert((size_t)NSLOT * 512 * 2 <= WS_XBC - WS_MLAQ, "HE alias");
static_assert((size_t)NSLOT * 1024 * 2 <= WS_MLAQ - WS_PROJ, "YS alias");
constexpr int CW_BAR = 4096, CW_CNT = 8192;

constexpr int LDS_MISC = 131072, LDS_BYTES = 135168;

struct Params {
    const float *x, *c, *ctx, *c_ctx, *g_mix, *g_ffn, *w_mod, *b_mod, *w_in, *w_out, *da_lam, *da_g, *conv_w, *conv_b, *dt_bias, *a_log, *ssd_d, *ssd_g,
                *mq_g, *mkv_g, *w_uq, *w_ukv, *r_w, *r_b, *wg, *wu, *wd, *fin_g;
    float* out; unsigned char* ws; int ph_lo, ph_hi;
};

DI unsigned pk2(float lo, float hi) { f32x2 v = {lo, hi}; bf16x2_t b = __builtin_convertvector(v, bf16x2_t); return __builtin_bit_cast(unsigned, b); }
DI float bflo(unsigned w) { return __uint_as_float(w << 16); }
DI float bfhi(unsigned w) { return __uint_as_float(w & 0xffff0000u); }
DI float shx(float v, int o, int lane) { return __int_as_float(__builtin_amdgcn_ds_bpermute((lane ^ o) << 2, __float_as_int(v))); }
DI float shl(float v, int src) { return __int_as_float(__builtin_amdgcn_ds_bpermute(src << 2, __float_as_int(v))); }
DI int shli(int v, int src) { return __builtin_amdgcn_ds_bpermute(src << 2, v); }
DI float shup(float v, int o, int lane) { return __int_as_float(__builtin_amdgcn_ds_bpermute((lane - o) << 2, __float_as_int(v))); }
DI int shupi(int v, int o, int lane) { return __builtin_amdgcn_ds_bpermute((lane - o) << 2, v); }
DI float wave_sum(float v, int lane) {
#pragma unroll
    for (int o = 1; o < 64; o <<= 1) v += shx(v, o, lane);
    return v;
}
DI float silu(float x) { return x / (1.f + __expf(-x)); }
DI float fexp2(float x) { return __builtin_amdgcn_exp2f(x); }
#define LDS_WAIT() asm volatile("s_waitcnt lgkmcnt(0)" ::: "memory")
#define MFMA32(a, b, c) __builtin_amdgcn_mfma_f32_32x32x16_bf16((a), (b), (c), 0, 0, 0)
#define MFMA16(a, b, c) __builtin_amdgcn_mfma_f32_16x16x32_bf16((a), (b), (c), 0, 0, 0)
DI int crow(int reg, int h) { return (reg & 3) + 8 * (reg >> 2) + 4 * h; }

#define XB_TMO      128
#define XB_XCNT(j)  (256  + 64 * (j))
#define XB_XSUB(j)  (1280 + 64 * (j))
#define XB_XGEN(j)  (2304 + 64 * (j))
#define XB_TOP      3328
#define XB_TOPGEN   3392
#define XCD_BAR_WORDS 3456
#define XB_SPIN_CAP (1u << 22)
DI unsigned xb_ld(unsigned* p)              { return __hip_atomic_load(p, __ATOMIC_RELAXED, __HIP_MEMORY_SCOPE_AGENT); }
DI unsigned xb_add(unsigned* p, unsigned v) { return __hip_atomic_fetch_add(p, v, __ATOMIC_RELAXED, __HIP_MEMORY_SCOPE_AGENT); }
DI unsigned xb_xcc_id() { return (unsigned)__builtin_amdgcn_s_getreg((3 << 11) | 20) & 0xFu; }
#define XB_SPIN(cond, bar) do { unsigned _sp = 0; while (cond) { __builtin_amdgcn_s_sleep(1); \
    if ((++_sp & 255u) == 0u) { if (xb_ld(&(bar)[XB_TMO])) break; if (_sp > XB_SPIN_CAP) { atomicAdd(&(bar)[XB_TMO], 1u); break; } } } } while (0)
struct XcdBarrier { unsigned* bar; unsigned x; volatile LAS unsigned* st; };
DI XcdBarrier xcd_barrier_post(unsigned* bar, volatile LAS unsigned* st) {
    XcdBarrier b; b.bar = bar; b.x = xb_xcc_id(); b.st = st;
    if (threadIdx.x == 0) (void)xb_add(&bar[XB_XCNT(b.x)], 1u);
    return b;
}
DI void xcd_barrier_complete(unsigned* bar, unsigned x, unsigned& nloc, unsigned& nx) {
    const unsigned G = gridDim.x * gridDim.y * gridDim.z;
    unsigned sum, cnt, mine, sp = 0u;
    for (;;) {
        sum = 0u; cnt = 0u; mine = 0u;
#pragma unroll
        for (unsigned j = 0; j < 16; ++j) { const unsigned c = xb_ld(&bar[XB_XCNT(j)]); sum += c; cnt += (c > 0u) ? 1u : 0u; }
        mine = xb_ld(&bar[XB_XCNT(x)]);
        if (sum == G) break;
        __builtin_amdgcn_s_sleep(1);
        if ((++sp & 255u) == 0u) { if (xb_ld(&bar[XB_TMO])) break; if (sp > XB_SPIN_CAP) { atomicAdd(&bar[XB_TMO], 1u); break; } }
    }
    nloc = mine > 0u ? mine : 1u; nx = cnt > 0u ? cnt : 1u;
}
DI void xcd_barrier(const XcdBarrier& b, int tid) {
    asm volatile("s_waitcnt vmcnt(0)" ::: "memory");
    __syncthreads();
    if (tid == 0) {
        unsigned* bar = b.bar;
        __builtin_amdgcn_s_waitcnt(0);
        unsigned nloc = b.st[0], nx = b.st[1];
        if (nloc == 0u) { xcd_barrier_complete(bar, b.x, nloc, nx); b.st[0] = nloc; b.st[1] = nx; }
        const unsigned old = xb_add(&bar[XB_XSUB(b.x)], 1u);
        const unsigned gen = old / nloc;
        if (old + 1u == (gen + 1u) * nloc) {
            __builtin_amdgcn_fence(__ATOMIC_RELEASE, "agent");
            asm volatile("s_waitcnt vmcnt(0)" ::: "memory");
            const unsigned og = xb_add(&bar[XB_TOP], 1u);
            const unsigned tg = og / nx;
            if (og + 1u == (tg + 1u) * nx) xb_add(&bar[XB_TOPGEN], 1u);
            else XB_SPIN(xb_ld(&bar[XB_TOPGEN]) == tg, bar);
            __builtin_amdgcn_fence(__ATOMIC_ACQUIRE, "agent");
            xb_add(&bar[XB_XGEN(b.x)], 1u);
            asm volatile("s_waitcnt vmcnt(0)" ::: "memory");
        } else {
            XB_SPIN(xb_ld(&bar[XB_XGEN(b.x)]) == gen, bar);
            __builtin_amdgcn_fence(__ATOMIC_ACQUIRE, "agent");
            asm volatile("s_waitcnt vmcnt(0)" ::: "memory");
        }
    }
    __syncthreads();
}

constexpr int HTB = 128 * 64 * 2;
DI int lds_byte(int r, int c) { const int st = (r >> 4) * 2 + (c >> 5), rr = r & 15, cc = c & 31, ob = rr * 64 + cc * 2; return st * 1024 + (ob ^ (((ob >> 9) & 1) << 5)); }
DI void stage_rc(int b, int& R, int& C) { const int st = b / 1024, sb = b % 1024, swz = sb ^ (((sb >> 9) & 1) << 5); R = (st >> 1) * 16 + swz / 64; C = (st & 1) * 32 + (swz % 64) / 2; }
DI int perm32(int rho) { const int n = rho >> 4, i = rho & 15; return 8 * (i >> 2) + 4 * n + (i & 3); }

struct GUnit { const char* A; const char* B; int pm, pn, e, row0; };

template <class Epi, class Sched>
DI void gemm8(LAS unsigned char* lds, const int K, const Sched& S, const Epi& E) {
    int tid_ = threadIdx.x; asm volatile("" : "+v"(tid_));
    const int tid = tid_, wid = __builtin_amdgcn_readfirstlane(tid >> 6), lane = tid & 63, wr = wid >> 2, wc = wid & 3, fr = lane & 15, fq = lane >> 4;
    const int nt = K / 64;
    int R[2], C[2]; unsigned voffB[2];
#pragma unroll
    for (int i = 0; i < 2; ++i) { stage_rc(tid * 16 + i * 8192, R[i], C[i]); const int Rb = Epi::PERM ? ((R[i] & ~31) + perm32(R[i] & 31)) : R[i]; voffB[i] = (unsigned)(Rb * K + C[i]) * 2u; }
    const size_t kstep = 128;
    const size_t hstepB = (size_t)128 * K * 2;
    const unsigned ldsw = (unsigned)wid * 1024u;
    const int aoff = lds_byte(wr * 64 + fr, fq * 8), boff = lds_byte(wc * 32 + fr, fq * 8);
#define G8_SA(b, h) (((b) * 2 + (h)) * HTB)
#define G8_SB(b, h) ((4 + (b) * 2 + (h)) * HTB)
#define G8_STAGE(bufoff, gbase, voff) do { _Pragma("unroll") for (int _i = 0; _i < 2; ++_i) \
        __builtin_amdgcn_global_load_lds((const unsigned*)((const char*)(gbase) + (voff)[_i]), (LAS unsigned*)(lds + (bufoff) + ldsw + _i * 8192), 16, 0, 0); } while (0)
#define G8_LDA(dst, b, h) do { _Pragma("unroll") for (int m = 0; m < 4; ++m) _Pragma("unroll") for (int k = 0; k < 2; ++k) dst[m][k] = *(const LAS bf16x8*)(lds + G8_SA(b, h) + aoff + m * 2048 + k * 1024); } while (0)
#define G8_LDB(dst, b, h) do { _Pragma("unroll") for (int n = 0; n < 2; ++n) _Pragma("unroll") for (int k = 0; k < 2; ++k) dst[n][k] = *(const LAS bf16x8*)(lds + G8_SB(b, h) + boff + n * 2048 + k * 1024); } while (0)
#define G8_MMA(ai, bj, At, Bt) do { __builtin_amdgcn_s_setprio(1); _Pragma("unroll") for (int m = 0; m < 4; ++m) _Pragma("unroll") for (int n = 0; n < 2; ++n) _Pragma("unroll") for (int k = 0; k < 2; ++k) \
        acc[ai][bj][m][n] = __builtin_amdgcn_mfma_f32_16x16x32_bf16(Bt[n][k], At[m][k], acc[ai][bj][m][n], 0, 0, 0); __builtin_amdgcn_s_setprio(0); } while (0)
#define G8_WAIT_V(n) asm volatile("s_waitcnt vmcnt(" #n ")" ::: "memory")
#define G8_WAIT_L(n) asm volatile("s_waitcnt lgkmcnt(" #n ")" ::: "memory")
#define G8_BAR __builtin_amdgcn_s_barrier()
#define G8_SCHED __builtin_amdgcn_sched_barrier(0)
    GUnit cur, nxt; int ui = 0;
    if (!S.next(0, cur)) return;
    unsigned aoC[2][2], aoN[2][2];
    S.aoff(cur, R, C, aoC);
    if constexpr (Sched::UNIFORM_AOFF) {
#pragma unroll
        for (int h = 0; h < 2; ++h)
#pragma unroll
            for (int i = 0; i < 2; ++i) aoN[h][i] = aoC[h][i]; }
    f32x4 acc[2][2][4][2];
#pragma unroll
    for (int a = 0; a < 2; ++a)
#pragma unroll
        for (int b = 0; b < 2; ++b)
#pragma unroll
            for (int m = 0; m < 4; ++m)
#pragma unroll
                for (int n = 0; n < 2; ++n) acc[a][b][m][n] = (f32x4){0.f, 0.f, 0.f, 0.f};
    bf16x8 At[4][2], B0[2][2], B1[2][2];
    const char* cA = cur.A; const char* cB = cur.B;
    asm volatile("s_waitcnt vmcnt(0)" ::: "memory");
    G8_STAGE(G8_SB(0, 0), cB, voffB); G8_STAGE(G8_SA(0, 0), cA, aoC[0]); G8_STAGE(G8_SB(0, 1), cB + hstepB, voffB); G8_STAGE(G8_SA(0, 1), cA, aoC[1]);
    if (wr == 1) G8_BAR;
    G8_WAIT_V(4); G8_BAR;
    G8_STAGE(G8_SB(1, 0), cB + kstep, voffB); G8_STAGE(G8_SA(1, 0), cA + kstep, aoC[0]); G8_STAGE(G8_SB(1, 1), cB + hstepB + kstep, voffB);
    G8_WAIT_V(6); G8_BAR;
    for (;;) {
        const bool has_next = S.next(ui + 1, nxt);
        if constexpr (!Sched::UNIFORM_AOFF) {
        if (has_next) S.aoff(nxt, R, C, aoN);
        else {
#pragma unroll
            for (int h = 0; h < 2; ++h)
#pragma unroll
                for (int i = 0; i < 2; ++i) aoN[h][i] = aoC[h][i]; } }
        const char* nA = has_next ? nxt.A : cA; const char* nB = has_next ? nxt.B : cB;
        for (int t = 0; t < nt; t += 2) {
            const bool last = (t == nt - 2);
            const char* a1 = cA + (size_t)(t + 1) * kstep;
            const char* a2 = last ? nA : cA + (size_t)(t + 2) * kstep; const char* b2 = last ? nB : cB + (size_t)(t + 2) * kstep;
            const char* a3 = a2 + kstep; const char* b3 = b2 + kstep;
            unsigned ao2[2][2];
#pragma unroll
            for (int h = 0; h < 2; ++h)
#pragma unroll
                for (int i = 0; i < 2; ++i) ao2[h][i] = (!Sched::UNIFORM_AOFF && last) ? aoN[h][i] : aoC[h][i];
            G8_LDB(B0, 0, 0); G8_SCHED; G8_LDA(At, 0, 0); G8_STAGE(G8_SA(1, 1), a1, aoC[1]);
            G8_WAIT_L(8); G8_BAR; G8_WAIT_L(0); G8_MMA(0, 0, At, B0); G8_BAR; G8_SCHED;
            G8_LDB(B1, 0, 1); G8_STAGE(G8_SB(0, 0), b2, voffB);
            G8_BAR; G8_WAIT_L(0); G8_MMA(0, 1, At, B1); G8_BAR;
            G8_LDA(At, 0, 1); G8_STAGE(G8_SA(0, 0), a2, ao2[0]);
            G8_BAR; G8_WAIT_L(0); G8_MMA(1, 0, At, B0); G8_BAR; G8_SCHED;
            G8_STAGE(G8_SB(0, 1), b2 + hstepB, voffB);
            G8_WAIT_V(6); G8_BAR; G8_MMA(1, 1, At, B1); G8_BAR;
            G8_LDB(B0, 1, 0); G8_SCHED; G8_LDA(At, 1, 0); G8_STAGE(G8_SA(0, 1), a2, ao2[1]);
            G8_WAIT_L(8); G8_BAR; G8_WAIT_L(0); G8_MMA(0, 0, At, B0); G8_BAR; G8_SCHED;
            G8_LDB(B1, 1, 1); G8_STAGE(G8_SB(1, 0), b3, voffB);
            G8_BAR; G8_WAIT_L(0); G8_MMA(0, 1, At, B1); G8_BAR;
            G8_LDA(At, 1, 1); G8_STAGE(G8_SA(1, 0), a3, ao2[0]);
            G8_BAR; G8_WAIT_L(0); G8_MMA(1, 0, At, B0); G8_BAR; G8_SCHED;
            G8_STAGE(G8_SB(1, 1), b3 + hstepB, voffB);
            G8_WAIT_V(6); G8_BAR; G8_MMA(1, 1, At, B1); G8_BAR;
        }
        E(acc, cur, wr, wc, fr, fq);
        if (!has_next) break;
#pragma unroll
        for (int a = 0; a < 2; ++a)
#pragma unroll
            for (int b = 0; b < 2; ++b)
#pragma unroll
                for (int m = 0; m < 4; ++m)
#pragma unroll
                    for (int n = 0; n < 2; ++n) acc[a][b][m][n] = (f32x4){0.f, 0.f, 0.f, 0.f};
        cur = nxt; cA = nA; cB = nB; ++ui;
        if constexpr (!Sched::UNIFORM_AOFF) {
#pragma unroll
        for (int h = 0; h < 2; ++h)
#pragma unroll
            for (int i = 0; i < 2; ++i) aoC[h][i] = aoN[h][i]; }
    }
    G8_WAIT_V(0);
    if (wr == 0) G8_BAR;
    G8_BAR;
#undef G8_SA
#undef G8_SB
#undef G8_STAGE
#undef G8_LDA
#undef G8_LDB
#undef G8_MMA
#undef G8_WAIT_V
#undef G8_WAIT_L
#undef G8_BAR
#undef G8_SCHED
}

constexpr int NXCD = 8, WGM = 8;
struct DenseSched {
    static constexpr bool UNIFORM_AOFF = true;
    const char* A; const char* Bt; int K, nM, nN, nwg, G, c;
    DI void init(const void* A_, const void* Bt_, int Mrows, int N, int K_, int G_, int c_) { A = (const char*)A_; Bt = (const char*)Bt_; K = K_; nM = Mrows / 256; nN = N / 256; nwg = nM * nN; G = G_; c = c_; }
    DI bool next(int i, GUnit& u) const {
        const long L = (long)i * G + c; if (L >= nwg) return false;
        int wgid = (int)L; { const int q = nwg / NXCD, r = nwg % NXCD, xcd = wgid % NXCD, off = wgid / NXCD; wgid = (xcd < r ? xcd * (q + 1) : r * (q + 1) + (xcd - r) * q) + off; }
        const int nig = WGM * nN, gid = wgid / nig, fm = gid * WGM, gsz = (nM - fm) < WGM ? (nM - fm) : WGM;
        u.pm = fm + ((wgid % nig) % gsz); u.pn = (wgid % nig) / gsz; u.e = 0; u.row0 = u.pm * 256;
        u.A = A + (size_t)u.pm * 256 * K * 2; u.B = Bt + (size_t)u.pn * 256 * K * 2; return true;
    }
    DI void aoff(const GUnit&, const int (&R)[2], const int (&C)[2], unsigned (&off)[2][2]) const {
#pragma unroll
        for (int h = 0; h < 2; ++h)
#pragma unroll
            for (int i = 0; i < 2; ++i) off[h][i] = (unsigned)((h * 128 + R[i]) * K + C[i]) * 2u;
    }
};
template <bool GATHER>
struct MoeSched {
    static constexpr bool UNIFORM_AOFF = !GATHER;
    const char* A; const char* W; const int* list; volatile LAS int* misc; int K, G, c;
    DI bool next(int i, GUnit& u) const {
        const int L = i * G + c;
        const int RT = __builtin_amdgcn_readfirstlane(misc[32 + 16]);
        if (L >= RT * 4) return false;
        const int rt = L >> 2; u.pn = L & 3;
        int e = 0;
#pragma unroll
        for (int j = 1; j < 16; ++j) { const int tp = __builtin_amdgcn_readfirstlane(misc[32 + j]); if (tp <= rt) e = j; }
        const int tp = __builtin_amdgcn_readfirstlane(misc[32 + e]);
        u.e = e; u.pm = rt - tp; u.row0 = __builtin_amdgcn_readfirstlane(misc[64 + e]) + u.pm * 256;
        u.A = GATHER ? A : A + (size_t)u.row0 * K * 2;
        u.B = W + ((size_t)e * 1024 + (size_t)u.pn * 256) * K * 2;
        return true;
    }
    DI void aoff(const GUnit& u, const int (&R)[2], const int (&C)[2], unsigned (&off)[2][2]) const {
        if (GATHER) {
            const int cnt = __builtin_amdgcn_readfirstlane(misc[16 + u.e]);
#pragma unroll
            for (int h = 0; h < 2; ++h)
#pragma unroll
                for (int i = 0; i < 2; ++i) { const int idx = u.pm * 256 + h * 128 + R[i]; const int tok = (idx < cnt) ? list[(size_t)u.e * M + idx] : 0; off[h][i] = (unsigned)(tok * K + C[i]) * 2u; }
        } else {
#pragma unroll
            for (int h = 0; h < 2; ++h)
#pragma unroll
                for (int i = 0; i < 2; ++i) off[h][i] = (unsigned)((h * 128 + R[i]) * K + C[i]) * 2u;
        }
    }
};

struct EpiStoreBf16 {
    static constexpr bool PERM = true;
    bf16_t* O; int ldc;
    DI void operator()(const f32x4 (&acc)[2][2][4][2], const GUnit& u, int wr, int wc, int fr, int fq) const {
        const int row0 = u.row0 + wr * 64 + fr, col0 = u.pn * 256 + wc * 32 + 8 * fq;
#pragma unroll
        for (int ai = 0; ai < 2; ++ai)
#pragma unroll
            for (int m = 0; m < 4; ++m) { bf16_t* rowp = O + (size_t)(row0 + ai * 128 + m * 16) * ldc + col0;
#pragma unroll
                for (int bj = 0; bj < 2; ++bj) { const f32x4 v0 = acc[ai][bj][m][0], v1 = acc[ai][bj][m][1];
                    u32x4 w; w.x = pk2(v0[0], v0[1]); w.y = pk2(v0[2], v0[3]); w.z = pk2(v1[0], v1[1]); w.w = pk2(v1[2], v1[3]);
                    *(u32x4*)(rowp + bj * 128) = w; } }
    }
};
struct EpiGateUp {
    static constexpr bool PERM = true;
    bf16_t* O;
    DI void operator()(const f32x4 (&acc)[2][2][4][2], const GUnit& u, int wr, int wc, int fr, int fq) const {
        const int row0 = u.row0 + wr * 64 + fr, col0 = u.pn * 128 + wc * 32 + 8 * fq;
#pragma unroll
        for (int ai = 0; ai < 2; ++ai)
#pragma unroll
            for (int m = 0; m < 4; ++m) { bf16_t* rowp = O + (size_t)(row0 + ai * 128 + m * 16) * 512 + col0;
                float hv[8];
#pragma unroll
                for (int n = 0; n < 2; ++n)
#pragma unroll
                    for (int i = 0; i < 4; ++i) hv[n * 4 + i] = silu(acc[ai][0][m][n][i]) * acc[ai][1][m][n][i];
                u32x4 w; w.x = pk2(hv[0], hv[1]); w.y = pk2(hv[2], hv[3]); w.z = pk2(hv[4], hv[5]); w.w = pk2(hv[6], hv[7]);
                *(u32x4*)rowp = w; }
    }
};
struct EpiResidual {
    static constexpr bool PERM = false;
    float* hc; float* hx; const float* modl;
    DI void operator()(const f32x4 (&acc)[2][2][4][2], const GUnit& u, int wr, int wc, int fr, int fq) const {
        const int b = u.pm / 9, tt = u.pm % 9;
        float* base = (tt == 0) ? hc + (size_t)b * CTX * DM : hx + ((size_t)b * SEQ + (size_t)(tt - 1) * 256) * DM;
        const float* gate = modl + (size_t)((tt == 0) ? 16 : b) * 6144 + 2 * DM;
        const int row0 = wr * 64 + fr, col0 = u.pn * 256 + wc * 32 + 4 * fq;
#pragma unroll
        for (int ai = 0; ai < 2; ++ai)
#pragma unroll
            for (int m = 0; m < 4; ++m) { float* rowp = base + (size_t)(row0 + ai * 128 + m * 16) * DM + col0;
#pragma unroll
                for (int bj = 0; bj < 2; ++bj)
#pragma unroll
                    for (int n = 0; n < 2; ++n) { f32x4* p = (f32x4*)(rowp + bj * 128 + n * 16); const f32x4 gv = *(const f32x4*)(gate + col0 + bj * 128 + n * 16); *p = *p + gv * acc[ai][bj][m][n]; }
                asm volatile("" ::: "memory"); }
    }
};

struct Ctx {
    LAS unsigned char* L; volatile LAS int* misc; unsigned char* ws; int tid, lane, wave, G, bid;
};
DI float* hrow(const Params& P, int m) { const int b = m / T, t = m - b * T; return (t < CTX) ? (float*)(P.ws + WS_HC) + ((size_t)b * CTX + t) * DM : P.out + ((size_t)b * SEQ + (t - CTX)) * DM; }

DI void phase_prologue(const Params& P, Ctx& X) {
    float* MOD = (float*)(P.ws + WS_MOD);
    LAS float* tab = (LAS float*)(X.L + X.wave * 8704);
    for (int u = X.bid; u < 4 * 48; u += X.G) {
        const int l = u / 48, jc = u % 48;
        __syncthreads();
        for (int idx = X.lane; idx < 17 * 128; idx += 64) { const int r = idx >> 7, kk = idx & 127; const float* src = (r < 16) ? P.c + r * DM : P.c_ctx; tab[idx] = silu(src[X.wave * 128 + kk]); }
        __syncthreads();
        float a0[17], a1[17];
#pragma unroll
        for (int r = 0; r < 17; ++r) { a0[r] = 0.f; a1[r] = 0.f; }
        const float* wp = P.w_mod + ((size_t)l * DM + X.wave * 128) * 6144 + jc * 128 + 2 * X.lane;
#pragma unroll 4
        for (int kk = 0; kk < 128; ++kk) { const f32x2 w2 = *(const f32x2*)(wp + (size_t)kk * 6144);
#pragma unroll
            for (int r = 0; r < 17; ++r) { const float a = tab[r * 128 + kk]; a0[r] += a * w2.x; a1[r] += a * w2.y; } }
        __syncthreads();
#pragma unroll
        for (int r = 0; r < 17; ++r) { tab[r * 128 + 2 * X.lane] = a0[r]; tab[r * 128 + 2 * X.lane + 1] = a1[r]; }
        __syncthreads();
        for (int idx = X.tid; idx < 17 * 128; idx += NTHR) { const int r = idx >> 7, j = idx & 127; float s = P.b_mod[l * 6144 + jc * 128 + j];
#pragma unroll
            for (int w = 0; w < 8; ++w) s += ((LAS float*)(X.L + w * 8704))[idx];
            MOD[((size_t)l * 17 + r) * 6144 + jc * 128 + j] = s; }
    }
    __syncthreads();
    f32x2* rope = (f32x2*)(P.ws + WS_ROPE);
    for (int e = X.bid * NTHR + X.tid; e < SEQ * 16; e += X.G * NTHR) { const int p = e >> 4, d = e & 15; const int row = p >> 6, col = p & 63;
        const float inv = powf(10000.f, -(float)(d & 7) / 8.f); const float ang = (float)((d < 8) ? row : col) * inv; rope[e] = (f32x2){cosf(ang), sinf(ang)}; }
    u32x4* wz = (u32x4*)((bf16_t*)(P.ws + WS_WIN) + (size_t)2496 * DM);
    for (int e = X.bid * NTHR + X.tid; e < 64 * DM * 2 / 16; e += X.G * NTHR) wz[e] = (u32x4){0u, 0u, 0u, 0u};
}

DI void cvt_item(const float* W, int ldw, int N, int k0, int n0, bf16_t* WT, int K, int row0, const float* kscale, float mul, LAS float* scr, int lane) {
#pragma unroll 8
    for (int i = 0; i < 32; ++i) { const int kk = 2 * i + (lane >> 5), n = n0 + (lane & 31);
        float v = (n < N) ? W[(size_t)(k0 + kk) * ldw + n] : 0.f; if (kscale) v *= kscale[k0 + kk];
        scr[kk * 33 + (lane & 31)] = v * mul; }
    LDS_WAIT(); asm volatile("" ::: "memory");
    const int c = lane & 7;
#pragma unroll
    for (int j = 0; j < 4; ++j) { const int nn = (lane >> 3) + 8 * j; const LAS float* s = scr + (8 * c) * 33 + nn;
        u32x4 o; o.x = pk2(s[0 * 33], s[1 * 33]); o.y = pk2(s[2 * 33], s[3 * 33]); o.z = pk2(s[4 * 33], s[5 * 33]); o.w = pk2(s[6 * 33], s[7 * 33]);
        *(u32x4*)(WT + (size_t)(row0 + nn) * K + k0 + 8 * c) = o; }
    LDS_WAIT(); asm volatile("" ::: "memory");
}
DI void convert_weights(const Params& P, Ctx& X, int l) {
    LAS float* scr = (LAS float*)(X.L + X.wave * 8704);
    const int gw = X.bid * NWAVE + X.wave, NGW = X.G * NWAVE;
    constexpr int I_IN = 16 * 78, I_OUT = 16 * 32, I_UQ = 4 * 12, I_UKV = 2 * 16, I_E = 768, NIT = I_IN + I_OUT + I_UQ + I_UKV + 16 * I_E;
    for (int it = gw; it < NIT; it += NGW) {
        int r = it;
        if (r < I_IN) { cvt_item(P.w_in + (size_t)l * DM * INW, INW, INW, 64 * (r / 78), 32 * (r % 78), (bf16_t*)(P.ws + WS_WIN), DM, 32 * (r % 78), nullptr, 1.f, scr, X.lane); continue; } r -= I_IN;
        if (r < I_OUT) { cvt_item(P.w_out + (size_t)l * DM * DM, DM, DM, 64 * (r / 32), 32 * (r % 32), (bf16_t*)(P.ws + WS_WOUT), DM, 32 * (r % 32), nullptr, 1.f, scr, X.lane); continue; } r -= I_OUT;
        if (r < I_UQ) { cvt_item(P.w_uq + (size_t)l * 256 * 384, 384, 384, 64 * (r / 12), 32 * (r % 12), (bf16_t*)(P.ws + WS_WUQ), 256, 32 * (r % 12), P.mq_g + l * 256, MLA_QS, scr, X.lane); continue; } r -= I_UQ;
        if (r < I_UKV) { cvt_item(P.w_ukv + (size_t)l * 128 * 512, 512, 512, 64 * (r / 16), 32 * (r % 16), (bf16_t*)(P.ws + WS_WUKV), 128, 32 * (r % 16), P.mkv_g + l * 128, 1.f, scr, X.lane); continue; } r -= I_UKV;
        const int e = r / I_E; r -= e * I_E;
        if (r < 256) { const int kb = r / 16, nb = r % 16;
            cvt_item(P.wg + ((size_t)l * 16 + e) * DM * 512, 512, 512, 64 * kb, 32 * nb, (bf16_t*)(P.ws + WS_WGU) + (size_t)e * 1024 * DM, DM, 256 * (nb >> 2) + 32 * (nb & 3), nullptr, 1.f, scr, X.lane); continue; } r -= 256;
        if (r < 256) { const int kb = r / 16, nb = r % 16;
            cvt_item(P.wu + ((size_t)l * 16 + e) * DM * 512, 512, 512, 64 * kb, 32 * nb, (bf16_t*)(P.ws + WS_WGU) + (size_t)e * 1024 * DM, DM, 256 * (nb >> 2) + 128 + 32 * (nb & 3), nullptr, 1.f, scr, X.lane); continue; } r -= 256;
        { const int kb = r / 32, nb = r % 32;
            cvt_item(P.wd + ((size_t)l * 16 + e) * 512 * DM, DM, DM, 64 * kb, 32 * nb, (bf16_t*)(P.ws + WS_WD) + (size_t)e * 1024 * 512, 512, 32 * nb, nullptr, 1.f, scr, X.lane); }
    }
}

DI int slot_base_lane(const unsigned* cnt, int lane) {
    int c = (lane < 16) ? (int)cnt[lane] : 0;
    int tiles = (c + 255) >> 8;
    int incl = tiles;
#pragma unroll
    for (int o = 1; o < 16; o <<= 1) { const int v = shupi(incl, o, lane); if (lane >= o) incl += v; }
    return (incl - tiles) * 256;
}

constexpr int RPC = 18;
struct RowIn { f32x4 h[4]; u32x2 y0[4], y1[4]; float w0, w1; };
DI void row_issue(const Params& P, RowIn& R, int l, int m, int sbase, const u32x4 ti, int lane) {
    const int b = m / T, t = m - b * T;
    if (l == 0) {
        const float* src = (t < CTX) ? P.ctx + ((size_t)b * CTX + t) * DM : P.x + ((size_t)b * SEQ + (t - CTX)) * DM;
#pragma unroll
        for (int j = 0; j < 4; ++j) R.h[j] = *(const f32x4*)(src + 256 * j + 4 * lane);
        R.w0 = 0.f; R.w1 = 0.f;
    } else {
        const float* hp = hrow(P, m);
        const bf16_t* YS = (const bf16_t*)(P.ws + WS_YS);
        const int s0 = shli(sbase, (int)(ti.x & 15u)) + (int)(ti.x >> 4), s1 = shli(sbase, (int)(ti.y & 15u)) + (int)(ti.y >> 4);
        const bf16_t* y0 = YS + (size_t)s0 * DM; const bf16_t* y1 = YS + (size_t)s1 * DM;
#pragma unroll
        for (int j = 0; j < 4; ++j) { const int cidx = 256 * j + 4 * lane; R.h[j] = *(const f32x4*)(hp + cidx); R.y0[j] = *(const u32x2*)(y0 + cidx); R.y1[j] = *(const u32x2*)(y1 + cidx); }
        R.w0 = __uint_as_float(ti.z); R.w1 = __uint_as_float(ti.w);
    }
}
DI float row_combine(const RowIn& R, bool comb, const f32x4 (&gp)[4], f32x4 (&v)[4]) {
    float ss = 0.f;
#pragma unroll
    for (int j = 0; j < 4; ++j) {
        if (comb) { const u32x2 a = R.y0[j], bb = R.y1[j];
            f32x4 yv; yv[0] = R.w0 * bflo(a.x) + R.w1 * bflo(bb.x); yv[1] = R.w0 * bfhi(a.x) + R.w1 * bfhi(bb.x); yv[2] = R.w0 * bflo(a.y) + R.w1 * bflo(bb.y); yv[3] = R.w0 * bfhi(a.y) + R.w1 * bfhi(bb.y);
            v[j] = R.h[j] + gp[j] * yv; }
        else v[j] = R.h[j];
        ss += v[j][0] * v[j][0] + v[j][1] * v[j][1] + v[j][2] * v[j][2] + v[j][3] * v[j][3]; }
    return ss;
}
DI void phase_norm1(const Params& P, Ctx& X, int l) {
    convert_weights(P, X, l);
    const float* MOD = (const float*)(P.ws + WS_MOD);
    bf16_t* ACT = (bf16_t*)(P.ws + WS_ACT);
    const u32x4* TOK = (const u32x4*)(P.ws + WS_TOK);
    const unsigned* cnt = (const unsigned*)(P.ws + WS_CTL) + CW_CNT + (l > 0 ? (l - 1) * 16 : 0);
    const int sbase = (l > 0) ? slot_base_lane(cnt, X.lane) : 0;
    const int gw = X.bid * NWAVE + X.wave, NGW = X.G * NWAVE, lane = X.lane;
    const float* g = P.g_mix + l * DM;
    const u32x4 tz = {0u, 0u, 0u, 0u};
    for (int ck = gw; ck < M / RPC; ck += NGW) {
        const int m0 = ck * RPC, b = m0 / T, t0 = m0 - b * T;
        int cur_cls = -1; f32x4 gs[4], sh[4], gp[4];
        RowIn cur, nxt;
        row_issue(P, cur, l, m0, sbase, (l > 0) ? TOK[m0] : tz, lane);
        u32x4 tiN = (l > 0) ? TOK[m0 + 1] : tz;
        for (int r = 0; r < RPC; ++r) {
            const int m = m0 + r, t = t0 + r, cls = (t < CTX) ? 1 : 0;
            if (r + 1 < RPC) row_issue(P, nxt, l, m + 1, sbase, tiN, lane);
            if (l > 0 && r + 2 < RPC) tiN = TOK[m + 2];
            if (cls != cur_cls) { cur_cls = cls;
                const float* mrow = MOD + ((size_t)l * 17 + (cls ? 16 : b)) * 6144;
                const float* gprev = MOD + ((size_t)(l > 0 ? l - 1 : 0) * 17 + (cls ? 16 : b)) * 6144 + 5 * DM;
#pragma unroll
                for (int j = 0; j < 4; ++j) { const int cidx = 256 * j + 4 * lane;
                    gs[j] = *(const f32x4*)(g + cidx) * (*(const f32x4*)(mrow + DM + cidx) + 1.f); sh[j] = *(const f32x4*)(mrow + cidx); gp[j] = *(const f32x4*)(gprev + cidx); } }
            f32x4 v[4];
            const float ss = row_combine(cur, l > 0, gp, v);
            float* hp = hrow(P, m);
#pragma unroll
            for (int j = 0; j < 4; ++j) *(f32x4*)(hp + 256 * j + 4 * lane) = v[j];
            const float rstd = rsqrtf(wave_sum(ss, lane) * (1.f / DM) + EPS);
#pragma unroll
            for (int j = 0; j < 4; ++j) { const f32x4 uu = v[j] * rstd * gs[j] + sh[j];
                u32x2 o; o.x = pk2(uu[0], uu[1]); o.y = pk2(uu[2], uu[3]);
                *(u32x2*)(ACT + (size_t)m * DM + 256 * j + 4 * lane) = o; }
            cur = nxt;
        }
    }
}
DI void phase_final(const Params& P, Ctx& X) {
    constexpr int RPF = 16;
    const float* MOD = (const float*)(P.ws + WS_MOD);
    const u32x4* TOK = (const u32x4*)(P.ws + WS_TOK);
    const unsigned* cnt = (const unsigned*)(P.ws + WS_CTL) + CW_CNT + 3 * 16;
    const int sbase = slot_base_lane(cnt, X.lane);
    const int gw = X.bid * NWAVE + X.wave, NGW = X.G * NWAVE, lane = X.lane;
    f32x4 fg[4];
#pragma unroll
    for (int j = 0; j < 4; ++j) fg[j] = *(const f32x4*)(P.fin_g + 256 * j + 4 * lane);
    for (int ck = gw; ck < NB * SEQ / RPF; ck += NGW) {
        const int r0 = ck * RPF, b = r0 / SEQ, m0 = b * T + CTX + (r0 - b * SEQ);
        f32x4 gp[4];
#pragma unroll
        for (int j = 0; j < 4; ++j) gp[j] = *(const f32x4*)(MOD + ((size_t)3 * 17 + b) * 6144 + 5 * DM + 256 * j + 4 * lane);
        RowIn cur, nxt;
        row_issue(P, cur, 3, m0, sbase, TOK[m0], lane);
        u32x4 tiN = TOK[m0 + 1];
        for (int r = 0; r < RPF; ++r) {
            const int m = m0 + r;
            if (r + 1 < RPF) row_issue(P, nxt, 3, m + 1, sbase, tiN, lane);
            if (r + 2 < RPF) tiN = TOK[m + 2];
            f32x4 v[4];
            const float ss = row_combine(cur, true, gp, v);
            const float rstd = rsqrtf(wave_sum(ss, lane) * (1.f / DM) + EPS);
            float* hp = P.out + (size_t)(r0 + r) * DM;
#pragma unroll
            for (int j = 0; j < 4; ++j) *(f32x4*)(hp + 256 * j + 4 * lane) = v[j] * rstd * fg[j];
            cur = nxt;
        }
    }
}

DI void phase_postproj(const Params& P, Ctx& X, int l) {
    bf16_t* PROJ = (bf16_t*)(P.ws + WS_PROJ);
    const f32x2* rope = (const f32x2*)(P.ws + WS_ROPE);
    bf16_t* XBC = (bf16_t*)(P.ws + WS_XBC); float* DT = (float*)(P.ws + WS_DT);
    bf16_t* MLAQ = (bf16_t*)(P.ws + WS_MLAQ); bf16_t* MLAK = (bf16_t*)(P.ws + WS_MLAK);
    bf16_t* VTM = (bf16_t*)(P.ws + WS_VTM); bf16_t* VTD = (bf16_t*)(P.ws + WS_VTD);
    const bf16_t* WUQ = (const bf16_t*)(P.ws + WS_WUQ); const bf16_t* WUKV = (const bf16_t*)(P.ws + WS_WUKV);
    const int lane = X.lane, wave = X.wave;
    for (int u = X.bid; u < M / 144; u += X.G) {
        const int m0 = u * 144, b = m0 / T, t0 = m0 - b * T;
        __syncthreads();
        float cw[3][12], cb[12];
#pragma unroll
        for (int g3 = 0; g3 < 3; ++g3)
#pragma unroll
            for (int i = 0; i < 4; ++i) { const int ch = 256 * g3 + 4 * lane + i; cb[g3 * 4 + i] = P.conv_b[l * 768 + ch];
#pragma unroll
                for (int k = 0; k < 3; ++k) cw[k][g3 * 4 + i] = P.conv_w[((size_t)l * 3 + k) * 768 + ch]; }
        for (int rr = 0; rr < 18; ++rr) {
            const int t = t0 + wave * 18 + rr; const size_t m = (size_t)b * T + t;
            bf16_t* prow = PROJ + m * PW;
            { const int vv = lane >> 2, d0 = 4 * (lane & 3);
              bf16_t* p1 = prow + vv * 32 + d0;
              const u32x2 a = *(const u32x2*)p1, bq = *(const u32x2*)(p1 + 16);
              float x1[4] = {bflo(a.x), bfhi(a.x), bflo(a.y), bfhi(a.y)}, x2[4] = {bflo(bq.x), bfhi(bq.x), bflo(bq.y), bfhi(bq.y)};
              const float qs = (vv < 8) ? DA_QS : 1.f;
              float o1[4], o2[4];
              if (t >= CTX) { const f32x2* rp = rope + (size_t)(t - CTX) * 16 + d0;
#pragma unroll
                  for (int i = 0; i < 4; ++i) { const f32x2 cs = rp[i]; o1[i] = (x1[i] * cs.x - x2[i] * cs.y) * qs; o2[i] = (x2[i] * cs.x + x1[i] * cs.y) * qs; } }
              else {
#pragma unroll
                  for (int i = 0; i < 4; ++i) { o1[i] = x1[i] * qs; o2[i] = x2[i] * qs; } }
              u32x2 w1, w2; w1.x = pk2(o1[0], o1[1]); w1.y = pk2(o1[2], o1[3]); w2.x = pk2(o2[0], o2[1]); w2.y = pk2(o2[2], o2[3]);
              *(u32x2*)p1 = w1; *(u32x2*)(p1 + 16) = w2; }
            { const u32x2 vv = *(const u32x2*)(prow + C_DAV + 4 * lane);
              *(LAS u32x2*)(X.L + (size_t)(wave * 18 + rr) * 520 + lane * 8) = vv; }
            { const int lo = (t < CTX) ? 0 : CTX, hi = (t < CTX) ? CTX : T;
#pragma unroll
              for (int g3 = 0; g3 < 3; ++g3) { const int ch = 256 * g3 + 4 * lane;
                  const u32x2 c0 = *(const u32x2*)(prow + C_XBC + ch);
                  u32x2 cm = {0u, 0u}, cp = {0u, 0u};
                  if (t - 1 >= lo) cm = *(const u32x2*)(prow - PW + C_XBC + ch);
                  if (t + 1 < hi) cp = *(const u32x2*)(prow + PW + C_XBC + ch);
                  const float xm[4] = {bflo(cm.x), bfhi(cm.x), bflo(cm.y), bfhi(cm.y)}, x0[4] = {bflo(c0.x), bfhi(c0.x), bflo(c0.y), bfhi(c0.y)}, xp[4] = {bflo(cp.x), bfhi(cp.x), bflo(cp.y), bfhi(cp.y)};
                  float o[4];
#pragma unroll
                  for (int i = 0; i < 4; ++i) o[i] = silu(cb[g3 * 4 + i] + cw[0][g3 * 4 + i] * xm[i] + cw[1][g3 * 4 + i] * x0[i] + cw[2][g3 * 4 + i] * xp[i]);
                  u32x2 w; w.x = pk2(o[0], o[1]); w.y = pk2(o[2], o[3]);
                  *(u32x2*)(XBC + m * 768 + ch) = w; } }
            if (lane < 16) { const float v = __uint_as_float(((unsigned)prow[C_DT + lane]) << 16) + P.dt_bias[l * 16 + lane]; DT[m * 16 + lane] = (v > 20.f) ? v : log1pf(__expf(v)); }
            if (lane < 16) { const float x1 = __uint_as_float(((unsigned)prow[C_KR + lane]) << 16), x2 = __uint_as_float(((unsigned)prow[C_KR + 16 + lane]) << 16);
                float o1 = x1, o2 = x2;
                if (t >= CTX) { const f32x2 cs = rope[(size_t)(t - CTX) * 16 + lane]; o1 = x1 * cs.x - x2 * cs.y; o2 = x2 * cs.x + x1 * cs.y; }
                const bf16_t b1 = (bf16_t)(pk2(o1, 0.f) & 0xffffu), b2 = (bf16_t)(pk2(o2, 0.f) & 0xffffu);
#pragma unroll
                for (int h = 0; h < 4; ++h) { MLAK[(m * 4 + h) * 96 + 64 + lane] = b1; MLAK[(m * 4 + h) * 96 + 80 + lane] = b2; } }
        }
        __syncthreads();
        { const int vr = X.tid >> 1, th = X.tid & 1;
          bf16_t* dst = VTD + ((size_t)b * 256 + vr) * T + t0 + th * 72;
#pragma unroll 1
          for (int q8 = 0; q8 < 9; ++q8) { unsigned w[4];
#pragma unroll
              for (int i = 0; i < 4; ++i) { const int tt = th * 72 + q8 * 8 + 2 * i;
                  const unsigned lo = *(const LAS unsigned short*)(X.L + (size_t)tt * 520 + vr * 2), hi = *(const LAS unsigned short*)(X.L + (size_t)(tt + 1) * 520 + vr * 2);
                  w[i] = lo | (hi << 16); }
              *(u32x4*)(dst + q8 * 8) = (u32x4){w[0], w[1], w[2], w[3]}; } }
        { const int tk = lane & 15, q4 = lane >> 4;
          bf16x8 bw[3][8];
#pragma unroll
          for (int ct = 0; ct < 3; ++ct)
#pragma unroll
              for (int s = 0; s < 8; ++s) bw[ct][s] = *(const bf16x8*)(WUQ + (size_t)((3 * wave + ct) * 16 + tk) * 256 + 32 * s + 8 * q4);
          for (int rt = 0; rt < 9; ++rt) {
              const int t = t0 + rt * 16 + tk; const size_t m = (size_t)b * T + t;
              bf16x8 af[8]; float ss = 0.f;
#pragma unroll
              for (int s = 0; s < 8; ++s) { af[s] = *(const bf16x8*)(PROJ + m * PW + C_CQ + 32 * s + 8 * q4);
#pragma unroll
                  for (int j = 0; j < 8; ++j) { const float f = __uint_as_float(((unsigned)(unsigned short)af[s][j]) << 16); ss += f * f; } }
              ss += shx(ss, 16, lane); ss += shx(ss, 32, lane);
              const float rstd = rsqrtf(ss * (1.f / 256.f) + EPS);
              f32x4 acc[3];
#pragma unroll
              for (int ct = 0; ct < 3; ++ct) { acc[ct] = (f32x4){0.f, 0.f, 0.f, 0.f};
#pragma unroll
                  for (int s = 0; s < 8; ++s) acc[ct] = MFMA16(bw[ct][s], af[s], acc[ct]);
                  acc[ct] = acc[ct] * rstd; }
              if ((wave & 1) && t >= CTX) {
                  const f32x2* rp = rope + (size_t)(t - CTX) * 16 + 4 * q4;
#pragma unroll
                  for (int i = 0; i < 4; ++i) { const f32x2 cs = rp[i]; const float x1 = acc[1][i], x2 = acc[2][i]; acc[1][i] = x1 * cs.x - x2 * cs.y; acc[2][i] = x2 * cs.x + x1 * cs.y; } }
#pragma unroll
              for (int ct = 0; ct < 3; ++ct) { u32x2 w; w.x = pk2(acc[ct][0], acc[ct][1]); w.y = pk2(acc[ct][2], acc[ct][3]);
                  *(u32x2*)(MLAQ + m * 384 + (3 * wave + ct) * 16 + 4 * q4) = w; }
          }
        }
        { const int tk = lane & 15, q4 = lane >> 4, hh = wave >> 1;
          bf16x8 bw[4][4];
#pragma unroll
          for (int ct = 0; ct < 4; ++ct)
#pragma unroll
              for (int s = 0; s < 4; ++s) bw[ct][s] = *(const bf16x8*)(WUKV + (size_t)((4 * wave + ct) * 16 + tk) * 128 + 32 * s + 8 * q4);
          for (int rt = 0; rt < 9; ++rt) {
              const int t = t0 + rt * 16 + tk; const size_t m = (size_t)b * T + t;
              bf16x8 af[4]; float ss = 0.f;
#pragma unroll
              for (int s = 0; s < 4; ++s) { af[s] = *(const bf16x8*)(PROJ + m * PW + C_CKV + 32 * s + 8 * q4);
#pragma unroll
                  for (int j = 0; j < 8; ++j) { const float f = __uint_as_float(((unsigned)(unsigned short)af[s][j]) << 16); ss += f * f; } }
              ss += shx(ss, 16, lane); ss += shx(ss, 32, lane);
              const float rstd = rsqrtf(ss * (1.f / 128.f) + EPS);
              if ((wave & 1) == 0) {
#pragma unroll
                  for (int ct = 0; ct < 4; ++ct) { f32x4 acc = {0.f, 0.f, 0.f, 0.f};
#pragma unroll
                      for (int s = 0; s < 4; ++s) acc = MFMA16(bw[ct][s], af[s], acc);
                      acc = acc * rstd;
                      u32x2 w; w.x = pk2(acc[0], acc[1]); w.y = pk2(acc[2], acc[3]);
                      *(u32x2*)(MLAK + (m * 4 + hh) * 96 + ct * 16 + 4 * q4) = w; }
              } else {
                  float rs[4];
#pragma unroll
                  for (int i = 0; i < 4; ++i) rs[i] = shl(rstd, 4 * q4 + i);
#pragma unroll
                  for (int ct = 0; ct < 4; ++ct) { f32x4 acc = {0.f, 0.f, 0.f, 0.f};
#pragma unroll
                      for (int s = 0; s < 4; ++s) acc = MFMA16(af[s], bw[ct][s], acc);
                      u32x2 w; w.x = pk2(acc[0] * rs[0], acc[1] * rs[1]); w.y = pk2(acc[2] * rs[2], acc[3] * rs[3]);
                      *(u32x2*)(VTM + (((size_t)b * 4 + hh) * 64 + ct * 16 + tk) * T + t0 + rt * 16 + 4 * q4) = w; }
              }
          }
        }
    }
}

template <int KIND>
DI void attn_unit(const Params& P, Ctx& X, int l, int b, int h, int qt, float lam, float lam_init) {
    constexpr int DK = KIND ? 96 : 64, KROW = DK * 2 + 16, NS = KIND ? 6 : 2;
    constexpr int KBUF = 64 * KROW, VROW = 136, VBUF = 64 * VROW;
    constexpr int OFF_K = 0, OFF_V = 2 * KBUF, OFF_X = 36864;
    const bf16_t* PROJ = (const bf16_t*)(P.ws + WS_PROJ);
    const bf16_t* MLAQ = (const bf16_t*)(P.ws + WS_MLAQ); const bf16_t* MLAK = (const bf16_t*)(P.ws + WS_MLAK);
    const bf16_t* VT = (const bf16_t*)(P.ws + (KIND ? WS_VTM : WS_VTD)) + ((size_t)b * 4 + h) * 64 * T;
    bf16_t* ACT = (bf16_t*)(P.ws + WS_ACT);
    const int tid = X.tid, lane = X.lane, wave = X.wave, r = lane & 31, hh = lane >> 5;
    const int mmw = KIND ? 0 : (wave & 1), qg = KIND ? wave : (wave >> 1);
    const bool is_ctx = KIND ? (qt == 0) : (qt < 2);
    const int nk = is_ctx ? CTX : T, ntile = nk / 64;
    const size_t mrow = (size_t)b * T + qt * (KIND ? 256 : 128) + qg * 32 + r;
    bf16x8 qf[NS];
#pragma unroll
    for (int s = 0; s < NS; ++s)
        qf[s] = KIND ? *(const bf16x8*)(MLAQ + mrow * 384 + h * 96 + 16 * s + 8 * hh) : *(const bf16x8*)(PROJ + mrow * PW + C_DAQ + h * 64 + mmw * 32 + 16 * s + 8 * hh);
    const int kcol = mmw * 64 + 16 * hh;
    const int kkey = KIND ? (tid / 12) : (tid >> 3), kpc = KIND ? (tid % 12) : (tid & 7);
    const int kkey2 = (512 + tid) / 12, kpc2 = (512 + tid) % 12;
    const int vdv = tid >> 3, vpc = tid & 7;
    u32x4 kr0, kr1 = {0u, 0u, 0u, 0u}, vr0;
    auto gload = [&](int it) {
        const int key0 = it * 64;
        if (KIND) { kr0 = *(const u32x4*)(MLAK + (((size_t)b * T + key0 + kkey) * 4 + h) * 96 + kpc * 8);
                    if (tid < 256) kr1 = *(const u32x4*)(MLAK + (((size_t)b * T + key0 + kkey2) * 4 + h) * 96 + kpc2 * 8); }
        else kr0 = *(const u32x4*)(PROJ + ((size_t)b * T + key0 + kkey) * PW + C_DAK + h * 64 + kpc * 8);
        vr0 = *(const u32x4*)(VT + (size_t)vdv * T + key0 + vpc * 8);
    };
    auto lstore = [&](int buf) {
        *(LAS u32x4*)(X.L + OFF_K + buf * KBUF + kkey * KROW + kpc * 16) = kr0;
        if (KIND && tid < 256) *(LAS u32x4*)(X.L + OFF_K + buf * KBUF + kkey2 * KROW + kpc2 * 16) = kr1;
        LAS unsigned char* vp = X.L + OFF_V + buf * VBUF + vdv * VROW + vpc * 16;
        *(LAS u32x2*)vp = (u32x2){vr0.x, vr0.y}; *(LAS u32x2*)(vp + 8) = (u32x2){vr0.z, vr0.w};
    };
    f32x16 O[2]; float mrun = -1e30f, lsum = 0.f;
#pragma unroll
    for (int d = 0; d < 2; ++d)
#pragma unroll
        for (int i = 0; i < 16; ++i) O[d][i] = 0.f;
    __syncthreads();
    gload(0); lstore(0);
    __syncthreads();
    for (int it = 0; it < ntile; ++it) {
        const int buf = it & 1;
        if (it + 1 < ntile) gload(it + 1);
        const LAS unsigned char* Kb = X.L + OFF_K + buf * KBUF; const LAS unsigned char* Vb = X.L + OFF_V + buf * VBUF;
        f32x16 S0, S1;
#pragma unroll
        for (int i = 0; i < 16; ++i) { S0[i] = 0.f; S1[i] = 0.f; }
#pragma unroll
        for (int s = 0; s < NS; ++s) {
            const bf16x8 k0 = *(const LAS bf16x8*)(Kb + r * KROW + kcol + 32 * s);
            const bf16x8 k1 = *(const LAS bf16x8*)(Kb + (32 + r) * KROW + kcol + 32 * s);
            S0 = MFMA32(k0, qf[s], S0); S1 = MFMA32(k1, qf[s], S1);
        }
        float mx = S0[0];
#pragma unroll
        for (int i = 1; i < 16; ++i) mx = fmaxf(mx, S0[i]);
#pragma unroll
        for (int i = 0; i < 16; ++i) mx = fmaxf(mx, S1[i]);
        mx = fmaxf(mx, shx(mx, 32, lane));
        const float mnew = fmaxf(mrun, mx), alpha = fexp2(mrun - mnew);
        mrun = mnew;
        float ps = 0.f;
#pragma unroll
        for (int i = 0; i < 16; ++i) { S0[i] = fexp2(S0[i] - mnew); S1[i] = fexp2(S1[i] - mnew); ps += S0[i] + S1[i]; }
        lsum = lsum * alpha + ps;
#pragma unroll
        for (int d = 0; d < 2; ++d)
#pragma unroll
            for (int i = 0; i < 16; ++i) O[d][i] *= alpha;
        bf16x8 pf[2][2];
#pragma unroll
        for (int s = 0; s < 2; ++s) {
            u32x4 w0, w1;
            w0.x = pk2(S0[8 * s + 0], S0[8 * s + 1]); w0.y = pk2(S0[8 * s + 2], S0[8 * s + 3]); w0.z = pk2(S0[8 * s + 4], S0[8 * s + 5]); w0.w = pk2(S0[8 * s + 6], S0[8 * s + 7]);
            w1.x = pk2(S1[8 * s + 0], S1[8 * s + 1]); w1.y = pk2(S1[8 * s + 2], S1[8 * s + 3]); w1.z = pk2(S1[8 * s + 4], S1[8 * s + 5]); w1.w = pk2(S1[8 * s + 6], S1[8 * s + 7]);
            pf[0][s] = __builtin_bit_cast(bf16x8, w0); pf[1][s] = __builtin_bit_cast(bf16x8, w1);
        }
#pragma unroll
        for (int d = 0; d < 2; ++d)
#pragma unroll
            for (int kb = 0; kb < 2; ++kb)
#pragma unroll
                for (int s = 0; s < 2; ++s) {
                    const LAS unsigned char* vp = Vb + (32 * d + r) * VROW + (32 * kb + 16 * s + 4 * hh) * 2;
                    const s16x4 lo = *(const LAS s16x4*)vp, hi = *(const LAS s16x4*)(vp + 16);
                    const bf16x8 vf = __builtin_shufflevector(lo, hi, 0, 1, 2, 3, 4, 5, 6, 7);
                    O[d] = MFMA32(vf, pf[kb][s], O[d]);
                }
        if (it + 1 < ntile) lstore(buf ^ 1);
        __syncthreads();
    }
    const float inv = 1.f / (lsum + shx(lsum, 32, lane));
    if (KIND == 0) {
        LAS float* xb = (LAS float*)(X.L + OFF_X) + qg * 2048 + lane;
        if (mmw == 1) {
#pragma unroll
            for (int d = 0; d < 2; ++d)
#pragma unroll
                for (int i = 0; i < 16; ++i) xb[(d * 16 + i) * 64] = O[d][i] * inv;
        }
        __syncthreads();
        if (mmw == 0) {
            float ss = 0.f;
#pragma unroll
            for (int d = 0; d < 2; ++d)
#pragma unroll
                for (int i = 0; i < 16; ++i) { const float o = O[d][i] * inv - lam * xb[(d * 16 + i) * 64]; O[d][i] = o; ss += o * o; }
            ss += shx(ss, 32, lane);
            const float rstd = rsqrtf(ss * (1.f / 64.f) + EPS) * (1.f - lam_init);
#pragma unroll
            for (int d = 0; d < 2; ++d)
#pragma unroll
                for (int g4 = 0; g4 < 4; ++g4) { const int dv = 32 * d + 8 * g4 + 4 * hh; const f32x4 gg = *(const f32x4*)(P.da_g + l * 64 + dv);
                    u32x2 w; w.x = pk2(O[d][4 * g4] * rstd * gg[0], O[d][4 * g4 + 1] * rstd * gg[1]); w.y = pk2(O[d][4 * g4 + 2] * rstd * gg[2], O[d][4 * g4 + 3] * rstd * gg[3]);
                    *(u32x2*)(ACT + mrow * DM + h * 64 + dv) = w; }
        }
    } else {
#pragma unroll
        for (int d = 0; d < 2; ++d)
#pragma unroll
            for (int g4 = 0; g4 < 4; ++g4) { const int dv = 32 * d + 8 * g4 + 4 * hh;
                u32x2 w; w.x = pk2(O[d][4 * g4] * inv, O[d][4 * g4 + 1] * inv); w.y = pk2(O[d][4 * g4 + 2] * inv, O[d][4 * g4 + 3] * inv);
                *(u32x2*)(ACT + mrow * DM + 768 + h * 64 + dv) = w; }
    }
}

DI void ssd_unit(const Params& P, Ctx& X, int l, int b, int hd, int dir) {
    constexpr int OFF_BR = 0, OFF_CR = 18432, OFF_XT = 36864, OFF_XS = 53760, OFF_BT = 71168, OFF_SB = 88576, OFF_DA = 97792, OFF_AC = 98304, OFF_DTT = 98816;
    const bf16_t* XBC = (const bf16_t*)(P.ws + WS_XBC); const float* DT = (const float*)(P.ws + WS_DT);
    bf16_t* Y = (bf16_t*)(P.ws + (dir ? WS_YB : WS_YF));
    const int tid = X.tid, lane = X.lane, wave = X.wave, r = lane & 31, hh = lane >> 5, grp = hd >> 2;
    const float a = -__expf(P.a_log[l * 16 + dir * 8 + hd]);
    LAS unsigned char* L = X.L;
    LAS float* t_da = (LAS float*)(L + OFF_DA); LAS float* t_ac = (LAS float*)(L + OFF_AC); LAS float* t_dt = (LAS float*)(L + OFF_DTT);
    f32x4 Sacc[2] = {{0.f, 0.f, 0.f, 0.f}, {0.f, 0.f, 0.f, 0.f}};
    __syncthreads();
    for (int c = 0; c < 18; ++c) {
        const int seg0 = (c < 2) ? 0 : CTX, seg1 = (c < 2) ? CTX : T, cc = (c < 2) ? c : c - 2;
        const int tbase = dir ? (seg1 - 1 - 128 * cc) : (seg0 + 128 * cc), tstep = dir ? -1 : 1;
        const size_t rb = (size_t)b * T;
        if (tid < 128) { const float dtv = DT[(rb + tbase + tstep * tid) * 16 + dir * 8 + hd]; t_dt[tid] = dtv; t_da[tid] = dtv * a; }
        __syncthreads();
        if (wave == 0) { const float v0 = t_da[2 * lane], v1 = t_da[2 * lane + 1]; const float s = v0 + v1; float incl = s;
#pragma unroll
            for (int o = 1; o < 64; o <<= 1) { const float v = shup(incl, o, lane); if (lane >= o) incl += v; }
            const float ex = incl - s; t_ac[2 * lane] = ex + v0; t_ac[2 * lane + 1] = ex + v0 + v1; }
        __syncthreads();
        const float alast = t_ac[127];
        {
            const int tau = tid >> 2, q2 = tid & 3;
            const bf16_t* rowp = XBC + (rb + tbase + tstep * tau) * 768;
            const float wj = __expf(alast - t_ac[tau]) * t_dt[tau];
#pragma unroll
            for (int k = 0; k < 2; ++k) { const int pc = 2 * q2 + k;
                const u32x4 xv = *(const u32x4*)(rowp + hd * 64 + 8 * pc), bv = *(const u32x4*)(rowp + 512 + grp * 64 + 8 * pc), cv = *(const u32x4*)(rowp + 640 + grp * 64 + 8 * pc);
                *(LAS u32x4*)(L + OFF_BR + tau * 144 + pc * 16) = bv; *(LAS u32x4*)(L + OFF_CR + tau * 144 + pc * 16) = cv;
                const unsigned xw[4] = {xv.x, xv.y, xv.z, xv.w}, bw[4] = {bv.x, bv.y, bv.z, bv.w};
#pragma unroll
                for (int i = 0; i < 4; ++i) { const int p0 = 8 * pc + 2 * i;
                    *(LAS unsigned short*)(L + OFF_XT + p0 * 264 + tau * 2) = (unsigned short)(xw[i] & 0xffffu);
                    *(LAS unsigned short*)(L + OFF_XT + (p0 + 1) * 264 + tau * 2) = (unsigned short)(xw[i] >> 16);
                    const unsigned sc = pk2(bflo(xw[i]) * wj, bfhi(xw[i]) * wj);
                    *(LAS unsigned short*)(L + OFF_XS + p0 * 272 + tau * 2) = (unsigned short)(sc & 0xffffu);
                    *(LAS unsigned short*)(L + OFF_XS + (p0 + 1) * 272 + tau * 2) = (unsigned short)(sc >> 16);
                    *(LAS unsigned short*)(L + OFF_BT + p0 * 272 + tau * 2) = (unsigned short)(bw[i] & 0xffffu);
                    *(LAS unsigned short*)(L + OFF_BT + (p0 + 1) * 272 + tau * 2) = (unsigned short)(bw[i] >> 16); } }
#pragma unroll
            for (int k = 0; k < 2; ++k) { const int tl = 2 * wave + k, pt = tl >> 2, nt = tl & 3, n = 16 * nt + (lane & 15), p = 16 * pt + 4 * (lane >> 4);
#pragma unroll
                for (int i = 0; i < 4; ++i) *(LAS unsigned short*)(L + OFF_SB + (p + i) * 144 + n * 2) = (unsigned short)(pk2(Sacc[k][i], 0.f) & 0xffffu); }
        }
        __syncthreads();
        {
            const int ib = wave >> 1, pb = wave & 1, i_tok = 32 * ib + r;
            const float acum_i = t_ac[i_tok];
            bf16x8 cf[4];
#pragma unroll
            for (int s = 0; s < 4; ++s) cf[s] = *(const LAS bf16x8*)(L + OFF_CR + i_tok * 144 + (16 * s + 8 * hh) * 2);
            f32x16 accO, accD;
#pragma unroll
            for (int i = 0; i < 16; ++i) { accO[i] = 0.f; accD[i] = 0.f; }
#pragma unroll
            for (int s = 0; s < 4; ++s) { const bf16x8 sa = *(const LAS bf16x8*)(L + OFF_SB + (32 * pb + r) * 144 + (16 * s + 8 * hh) * 2); accO = MFMA32(sa, cf[s], accO); }
            for (int jb = 0; jb <= ib; ++jb) {
                f32x16 g;
#pragma unroll
                for (int i = 0; i < 16; ++i) g[i] = 0.f;
#pragma unroll
                for (int s = 0; s < 4; ++s) { const bf16x8 ba = *(const LAS bf16x8*)(L + OFF_BR + (32 * jb + r) * 144 + (16 * s + 8 * hh) * 2); g = MFMA32(ba, cf[s], g); }
#pragma unroll
                for (int g4 = 0; g4 < 4; ++g4) { const int j0 = 32 * jb + 8 * g4 + 4 * hh;
                    const f32x4 aj = *(const LAS f32x4*)(L + OFF_AC + j0 * 4), dj = *(const LAS f32x4*)(L + OFF_DTT + j0 * 4);
#pragma unroll
                    for (int i = 0; i < 4; ++i) { const float arg = fminf(acum_i - aj[i], 0.f); const float wv = __expf(arg) * dj[i] * g[4 * g4 + i]; g[4 * g4 + i] = (j0 + i <= i_tok) ? wv : 0.f; } }
#pragma unroll
                for (int s = 0; s < 2; ++s) {
                    u32x4 w; w.x = pk2(g[8 * s + 0], g[8 * s + 1]); w.y = pk2(g[8 * s + 2], g[8 * s + 3]); w.z = pk2(g[8 * s + 4], g[8 * s + 5]); w.w = pk2(g[8 * s + 6], g[8 * s + 7]);
                    const bf16x8 wf = __builtin_bit_cast(bf16x8, w);
                    const LAS unsigned char* xp = L + OFF_XT + (32 * pb + r) * 264 + (32 * jb + 16 * s + 4 * hh) * 2;
                    const s16x4 lo = *(const LAS s16x4*)xp, hi = *(const LAS s16x4*)(xp + 16);
                    const bf16x8 xf = __builtin_shufflevector(lo, hi, 0, 1, 2, 3, 4, 5, 6, 7);
                    accD = MFMA32(xf, wf, accD);
                }
            }
            const float ei = __expf(acum_i);
            bf16_t* yp = Y + (rb + tbase + tstep * i_tok) * 512 + hd * 64 + 32 * pb + 4 * hh;
#pragma unroll
            for (int g4 = 0; g4 < 4; ++g4) { u32x2 w; w.x = pk2(accD[4 * g4] + ei * accO[4 * g4], accD[4 * g4 + 1] + ei * accO[4 * g4 + 1]); w.y = pk2(accD[4 * g4 + 2] + ei * accO[4 * g4 + 2], accD[4 * g4 + 3] + ei * accO[4 * g4 + 3]);
                *(u32x2*)(yp + 8 * g4) = w; }
        }
        {
            const float dec = __expf(alast);
#pragma unroll
            for (int k = 0; k < 2; ++k) { const int tl = 2 * wave + k, pt = tl >> 2, nt = tl & 3;
                f32x4 acc = Sacc[k] * dec;
#pragma unroll
                for (int s = 0; s < 4; ++s) {
                    const bf16x8 xa = *(const LAS bf16x8*)(L + OFF_XS + (16 * pt + (lane & 15)) * 272 + (32 * s + 8 * (lane >> 4)) * 2);
                    const bf16x8 bb = *(const LAS bf16x8*)(L + OFF_BT + (16 * nt + (lane & 15)) * 272 + (32 * s + 8 * (lane >> 4)) * 2);
                    acc = MFMA16(xa, bb, acc); }
                Sacc[k] = acc; }
        }
        __syncthreads();
    }
}

DI void phase_mixers(const Params& P, Ctx& X, int l, int sel = 7) {
    const float lam_init = 0.8f - 0.6f * __expf(-0.3f * (float)l);
    float l01 = 0.f, l23 = 0.f;
    if (X.lane < 32) { const float* lv = P.da_lam + l * 128; l01 = lv[X.lane] * lv[32 + X.lane]; l23 = lv[64 + X.lane] * lv[96 + X.lane]; }
    const float lam = __expf(wave_sum(l01, X.lane)) - __expf(wave_sum(l23, X.lane)) + lam_init;
    if (sel & 1) for (int u = X.bid; u < NB * 8 * 2; u += X.G) ssd_unit(P, X, l, u >> 4, (u >> 1) & 7, u & 1);
    if (sel & 2) for (int u = X.bid; u < 1024; u += X.G) attn_unit<0>(P, X, l, u >> 6, (u >> 4) & 3, 2 + (u & 15), lam, lam_init);
    if (sel & 4) for (int u = X.bid; u < 512; u += X.G) attn_unit<1>(P, X, l, u >> 5, (u >> 3) & 3, 1 + (u & 7), lam, lam_init);
    for (int u = X.bid; u < 192; u += X.G) { if (u < 128) { if (sel & 2) attn_unit<0>(P, X, l, u >> 3, (u >> 1) & 3, u & 1, lam, lam_init); } else { if (sel & 4) attn_unit<1>(P, X, l, (u - 128) >> 2, u & 3, 0, lam, lam_init); } }
}

DI void phase_ssdgate(const Params& P, Ctx& X, int l) {
    const bf16_t* PROJ = (const bf16_t*)(P.ws + WS_PROJ); const bf16_t* XBC = (const bf16_t*)(P.ws + WS_XBC);
    const bf16_t* YF = (const bf16_t*)(P.ws + WS_YF); const bf16_t* YB = (const bf16_t*)(P.ws + WS_YB);
    bf16_t* ACT = (bf16_t*)(P.ws + WS_ACT);
    const int gw = X.bid * NWAVE + X.wave, NGW = X.G * NWAVE, c0 = 8 * X.lane;
    const float dsk = P.ssd_d[l * 8 + (X.lane >> 3)];
    const f32x4 g0 = *(const f32x4*)(P.ssd_g + l * 512 + c0), g1 = *(const f32x4*)(P.ssd_g + l * 512 + c0 + 4);
    for (int m = gw; m < M; m += NGW) {
        const u32x4 yf = *(const u32x4*)(YF + (size_t)m * 512 + c0), yb = *(const u32x4*)(YB + (size_t)m * 512 + c0), xv = *(const u32x4*)(XBC + (size_t)m * 768 + c0), zv = *(const u32x4*)(PROJ + (size_t)m * PW + C_Z + c0);
        const unsigned yfw[4] = {yf.x, yf.y, yf.z, yf.w}, ybw[4] = {yb.x, yb.y, yb.z, yb.w}, xw[4] = {xv.x, xv.y, xv.z, xv.w}, zw[4] = {zv.x, zv.y, zv.z, zv.w};
        float v[8]; float ss = 0.f;
#pragma unroll
        for (int i = 0; i < 4; ++i) {
            v[2 * i] = (bflo(yfw[i]) + bflo(ybw[i]) + dsk * bflo(xw[i])) * silu(bflo(zw[i]));
            v[2 * i + 1] = (bfhi(yfw[i]) + bfhi(ybw[i]) + dsk * bfhi(xw[i])) * silu(bfhi(zw[i]));
            ss += v[2 * i] * v[2 * i] + v[2 * i + 1] * v[2 * i + 1]; }
        const float rstd = rsqrtf(wave_sum(ss, X.lane) * (1.f / 512.f) + EPS);
        u32x4 w; w.x = pk2(v[0] * rstd * g0[0], v[1] * rstd * g0[1]); w.y = pk2(v[2] * rstd * g0[2], v[3] * rstd * g0[3]); w.z = pk2(v[4] * rstd * g1[0], v[5] * rstd * g1[1]); w.w = pk2(v[6] * rstd * g1[2], v[7] * rstd * g1[3]);
        *(u32x4*)(ACT + (size_t)m * DM + 256 + c0) = w;
    }
}

DI float reduce16(const float (&lg)[16], int lane) {
    float x8[8], x4[4], x2[2];
    const bool b3 = (lane & 8) != 0, b2 = (lane & 4) != 0, b1 = (lane & 2) != 0, b0 = (lane & 1) != 0;
#pragma unroll
    for (int i = 0; i < 8; ++i) { const float keep = b3 ? lg[i + 8] : lg[i], send = b3 ? lg[i] : lg[i + 8]; x8[i] = keep + shx(send, 8, lane); }
#pragma unroll
    for (int i = 0; i < 4; ++i) { const float keep = b2 ? x8[i + 4] : x8[i], send = b2 ? x8[i] : x8[i + 4]; x4[i] = keep + shx(send, 4, lane); }
#pragma unroll
    for (int i = 0; i < 2; ++i) { const float keep = b1 ? x4[i + 2] : x4[i], send = b1 ? x4[i] : x4[i + 2]; x2[i] = keep + shx(send, 2, lane); }
    const float keep = b0 ? x2[1] : x2[0], send = b0 ? x2[0] : x2[1];
    float x = keep + shx(send, 1, lane);
    x += shx(x, 16, lane); x += shx(x, 32, lane);
    return x;
}
DI void route_select(float x, float rbias, int lane, int& i1, int& i2, float& w1, float& w2) {
    const float aff = 1.f / (1.f + expf(-x)), sel = aff + rbias;
    const float q1 = shx(sel, 1, lane), q2 = shx(sel, 2, lane), q3 = shx(sel, 3, lane);
    const float hi1 = fmaxf(sel, q1), lo1 = fminf(sel, q1), hi2 = fmaxf(q2, q3), lo2 = fminf(q2, q3);
    const float gs = fmaxf(hi1, hi2) + fmaxf(fminf(hi1, hi2), fmaxf(lo1, lo2));
    const float g0 = shl(gs, 0), g1 = shl(gs, 4), g2 = shl(gs, 8), g3 = shl(gs, 12);
    int best = 0; float bs = g0;
    if (g1 > bs) { bs = g1; best = 1; }
    if (g2 > bs) { bs = g2; best = 2; }
    if (g3 > bs) { bs = g3; best = 3; }
    int j1 = 0, j2 = 0; float v1 = -1e30f, v2 = -1e30f, a1 = 0.f, a2 = 0.f;
#pragma unroll
    for (int j = 0; j < 4; ++j) { const float s = shl(sel, 4 * best + j), a = shl(aff, 4 * best + j);
        if (s > v1) { v2 = v1; j2 = j1; a2 = a1; v1 = s; j1 = j; a1 = a; } else if (s > v2) { v2 = s; j2 = j; a2 = a; } }
    i1 = 4 * best + j1; i2 = 4 * best + j2; w1 = a1 / (a1 + a2); w2 = a2 / (a1 + a2);
}
DI void phase_norm2_route(const Params& P, Ctx& X, int l) {
    const float* MOD = (const float*)(P.ws + WS_MOD);
    bf16_t* ACT = (bf16_t*)(P.ws + WS_ACT);
    u32x4* TOK = (u32x4*)(P.ws + WS_TOK); int* LIST = (int*)(P.ws + WS_LIST);
    unsigned* cnt = (unsigned*)(P.ws + WS_CTL) + CW_CNT + l * 16;
    const int lane = X.lane;
    constexpr int RPW = 36;
    LAS unsigned* lcnt = (LAS unsigned*)(X.L + 65536); LAS unsigned* lbase = lcnt + 16; LAS unsigned* ltab = lcnt + 64;
    __syncthreads();
    for (int k = X.tid; k < DM; k += NTHR) { const int j = k >> 8, ln = (k >> 2) & 63, i = k & 3, slot = (4 * j + i) * 64 + ln;
#pragma unroll
        for (int e4 = 0; e4 < 4; ++e4) *(LAS f32x4*)(X.L + ((size_t)e4 * 1024 + slot) * 16) = *(const f32x4*)(P.r_w + k * 16 + 4 * e4); }
    if (X.tid < 32) lcnt[X.tid] = 0u;
    __syncthreads();
    const float rbias = P.r_b[lane & 15];
    const int gw = X.bid * NWAVE + X.wave, NGW = X.G * NWAVE;
    const float* g = P.g_ffn + l * DM;
    int it = 0;
    for (int ck = gw; ck < M / RPC; ck += NGW, ++it) {
        const int m0 = ck * RPC, b = m0 / T, t0 = m0 - b * T;
        int cur_cls = -1; f32x4 gs[4], sh[4];
        f32x4 c0[4], n0[4];
        { const float* h0 = hrow(P, m0);
#pragma unroll
          for (int j = 0; j < 4; ++j) c0[j] = *(const f32x4*)(h0 + 256 * j + 4 * lane); }
#pragma unroll 1
        for (int r = 0; r < RPC; ++r) {
            const int m = m0 + r, t = t0 + r, cls = (t < CTX) ? 1 : 0;
            if (r + 1 < RPC) { const float* h0 = hrow(P, m + 1);
#pragma unroll
                for (int j = 0; j < 4; ++j) n0[j] = *(const f32x4*)(h0 + 256 * j + 4 * lane); }
            if (!(l == DEPTH - 1 && cls)) {
                if (cls != cur_cls) { cur_cls = cls;
                    const float* mrow = MOD + ((size_t)l * 17 + (cls ? 16 : b)) * 6144;
#pragma unroll
                    for (int j = 0; j < 4; ++j) { const int cidx = 256 * j + 4 * lane;
                        gs[j] = *(const f32x4*)(g + cidx) * (*(const f32x4*)(mrow + 4 * DM + cidx) + 1.f); sh[j] = *(const f32x4*)(mrow + 3 * DM + cidx); } }
                float s0 = 0.f;
#pragma unroll
                for (int j = 0; j < 4; ++j) s0 += c0[j][0] * c0[j][0] + c0[j][1] * c0[j][1] + c0[j][2] * c0[j][2] + c0[j][3] * c0[j][3];
                const float r0 = rsqrtf(wave_sum(s0, lane) * (1.f / DM) + EPS);
                float lg0[16];
#pragma unroll
                for (int e = 0; e < 16; ++e) lg0[e] = 0.f;
#pragma unroll
                for (int j = 0; j < 4; ++j) { const int cidx = 256 * j + 4 * lane;
                    const f32x4 u0 = c0[j] * r0 * gs[j] + sh[j];
                    u32x2 o; o.x = pk2(u0[0], u0[1]); o.y = pk2(u0[2], u0[3]); *(u32x2*)(ACT + (size_t)m * DM + cidx) = o;
#pragma unroll
                    for (int i = 0; i < 4; ++i) { const int slot = (4 * j + i) * 64 + lane;
#pragma unroll
                        for (int e4 = 0; e4 < 4; ++e4) { const f32x4 rw = *(const LAS f32x4*)(X.L + ((size_t)e4 * 1024 + slot) * 16);
                            lg0[4 * e4] += u0[i] * rw[0]; lg0[4 * e4 + 1] += u0[i] * rw[1]; lg0[4 * e4 + 2] += u0[i] * rw[2]; lg0[4 * e4 + 3] += u0[i] * rw[3]; } } }
                int a1, a2; float wa1, wa2;
                route_select(reduce16(lg0, lane), rbias, lane, a1, a2, wa1, wa2);
                if (lane == 0) {
                    LAS unsigned* rec = ltab + (X.wave * RPW + it * RPC + r) * 4;
                    const unsigned ra1 = __hip_atomic_fetch_add(lcnt + a1, 1u, __ATOMIC_RELAXED, __HIP_MEMORY_SCOPE_WORKGROUP), ra2 = __hip_atomic_fetch_add(lcnt + a2, 1u, __ATOMIC_RELAXED, __HIP_MEMORY_SCOPE_WORKGROUP);
                    rec[0] = (unsigned)a1 | (ra1 << 4); rec[1] = (unsigned)a2 | (ra2 << 4); rec[2] = __float_as_uint(wa1); rec[3] = __float_as_uint(wa2);
                }
            }
#pragma unroll
            for (int j = 0; j < 4; ++j) c0[j] = n0[j];
        }
    }
    __syncthreads();
    if (X.tid < 16) { const unsigned c = lcnt[X.tid]; lbase[X.tid] = c ? atomicAdd(&cnt[X.tid], c) : 0u; }
    __syncthreads();
    it = 0;
    for (int ck = gw; ck < M / RPC; ck += NGW, ++it) {
        const int m0 = ck * RPC, b = m0 / T, t0 = m0 - b * T;
        if (lane < RPC) { const int m = m0 + lane, t = t0 + lane;
            if (!(l == DEPTH - 1 && t < CTX)) {
                const LAS unsigned* rec = ltab + (X.wave * RPW + it * RPC + lane) * 4;
                const unsigned e1 = rec[0] & 15u, e2 = rec[1] & 15u, p1 = lbase[e1] + (rec[0] >> 4), p2 = lbase[e2] + (rec[1] >> 4);
                LIST[(size_t)e1 * M + p1] = m; LIST[(size_t)e2 * M + p2] = m;
                u32x4 ti; ti.x = e1 | (p1 << 4); ti.y = e2 | (p2 << 4); ti.z = rec[2]; ti.w = rec[3];
                TOK[m] = ti; } }
    }
}
DI void moe_tables(const Params& P, Ctx& X, int l) {
    __syncthreads();
    if (X.tid < 64) { const unsigned* cnt = (const unsigned*)(P.ws + WS_CTL) + CW_CNT + l * 16;
        const int c = (X.lane < 16) ? (int)__hip_atomic_load(cnt + (X.lane & 15), __ATOMIC_RELAXED, __HIP_MEMORY_SCOPE_AGENT) : 0;
        const int tiles = (c + 255) >> 8; int incl = tiles;
#pragma unroll
        for (int o = 1; o < 16; o <<= 1) { const int v = shupi(incl, o, X.lane); if (X.lane >= o) incl += v; }
        if (X.lane < 16) { X.misc[16 + X.lane] = c; X.misc[32 + X.lane] = incl - tiles; X.misc[64 + X.lane] = (incl - tiles) * 256; }
        if (X.lane == 15) X.misc[32 + 16] = incl; }
    __syncthreads();
}

constexpr int N_PHASES = 38;
__global__ void __launch_bounds__(NTHR, 2) mk_fwd(Params PK) {
    const Params& P0 = PK; const Params* kp = &PK;
    extern __shared__ __attribute__((aligned(16))) unsigned char lds_raw[];
    Ctx X;
    X.L = (LAS unsigned char*)lds_raw; X.misc = (volatile LAS int*)(X.L + LDS_MISC); X.ws = PK.ws;
    X.tid = threadIdx.x; X.lane = X.tid & 63; X.wave = __builtin_amdgcn_readfirstlane(X.tid >> 6); X.G = gridDim.x; X.bid = blockIdx.x;
    const int wave0 = X.wave;
    if (X.tid < 128) X.misc[X.tid] = 0;
    __syncthreads();
    unsigned* ctl = (unsigned*)(PK.ws + WS_CTL);
    XcdBarrier bar; bar.bar = ctl + CW_BAR; bar.x = 0; bar.st = (volatile LAS unsigned*)X.misc;
    const bool multi = ((PK.ph_hi & 255) - PK.ph_lo) > 1;
    if (multi) bar = xcd_barrier_post(ctl + CW_BAR, (volatile LAS unsigned*)X.misc);
#ifndef PHMASK
#define PHMASK 0xFFFF
#endif
#define RUN(ph) (PK.ph_lo <= (ph) && (ph) < (PK.ph_hi & 255))
#define HAS(k) ((PHMASK >> (k)) & 1)
#define SEAM(ph) do { if (RUN(ph) && RUN((ph) + 1)) { FRESH(); xcd_barrier(bar, X.tid); } } while (0)
#define FRESH() do { int _t = wave0 * 64 + (int)__builtin_amdgcn_mbcnt_hi(~0u, __builtin_amdgcn_mbcnt_lo(~0u, 0u)); asm volatile("" : "+v"(_t)); X.tid = _t; X.lane = _t & 63; X.wave = __builtin_amdgcn_readfirstlane(_t >> 6); \
        const __attribute__((address_space(4))) Params* _kp = (const __attribute__((address_space(4))) Params*)__builtin_amdgcn_kernarg_segment_ptr(); asm volatile("" : "+s"(_kp)); kp = (const Params*)_kp; X.ws = kp->ws; \
        int _b = blockIdx.x, _g = gridDim.x; asm volatile("" : "+s"(_b), "+s"(_g)); X.bid = _b; X.G = _g; } while (0)
#define P (*kp)
    if (HAS(9) && RUN(0)) phase_prologue(P, X);
    SEAM(0);
#pragma unroll 1
    for (int l = 0; l < DEPTH; ++l) {
        const int pb = 1 + 9 * l;
        FRESH(); if (HAS(0) && RUN(pb + 0)) phase_norm1(P, X, l);
        SEAM(pb + 0);
        FRESH(); if (HAS(1) && RUN(pb + 1)) { DenseSched S; S.init(P.ws + WS_ACT, P.ws + WS_WIN, M, PW, DM, X.G, X.bid); EpiStoreBf16 E{(bf16_t*)(P.ws + WS_PROJ), PW}; gemm8(X.L, DM, S, E); }
        SEAM(pb + 1);
        FRESH(); if (HAS(2) && RUN(pb + 2)) phase_postproj(P, X, l);
        SEAM(pb + 2);
        FRESH(); if (HAS(3) && RUN(pb + 3)) phase_mixers(P, X, l, (PK.ph_hi >> 8) ? (PK.ph_hi >> 8) : 7);
        SEAM(pb + 3);
        FRESH(); if (HAS(4) && RUN(pb + 4)) phase_ssdgate(P, X, l);
        SEAM(pb + 4);
        FRESH(); if (HAS(5) && RUN(pb + 5)) { DenseSched S; S.init(P.ws + WS_ACT, P.ws + WS_WOUT, M, DM, DM, X.G, X.bid);
            EpiResidual E{(float*)(P.ws + WS_HC), P.out, (const float*)(P.ws + WS_MOD) + (size_t)l * 17 * 6144}; gemm8(X.L, DM, S, E); }
        SEAM(pb + 5);
        FRESH(); if (HAS(6) && RUN(pb + 6)) phase_norm2_route(P, X, l);
        SEAM(pb + 6);
        FRESH(); if (HAS(7) && RUN(pb + 7)) { moe_tables(P, X, l);
            MoeSched<true> S{(const char*)(P.ws + WS_ACT), (const char*)(P.ws + WS_WGU), (const int*)(P.ws + WS_LIST), X.misc, DM, X.G, X.bid};
            EpiGateUp E{(bf16_t*)(P.ws + WS_HE)}; gemm8(X.L, DM, S, E); }
        SEAM(pb + 7);
        FRESH(); if (HAS(8) && RUN(pb + 8)) { moe_tables(P, X, l);
            MoeSched<false> S{(const char*)(P.ws + WS_HE), (const char*)(P.ws + WS_WD), nullptr, X.misc, 512, X.G, X.bid};
            EpiStoreBf16 E{(bf16_t*)(P.ws + WS_YS), DM}; gemm8(X.L, 512, S, E); }
        SEAM(pb + 8);
    }
    FRESH(); if (HAS(10) && RUN(37)) phase_final(P, X);
#undef P
#undef RUN
#undef SEAM
}
}

#ifndef PROBE_SEL
#define PROBE_SEL 0
#endif
#ifndef MK_MODE
#define MK_MODE 1
#endif
extern "C" void kernel_launch(void* const* d_in, const int* in_sizes, int n_in, void* d_out, int out_size, void* d_ws, size_t ws_size, hipStream_t stream) {
    using namespace mk;
    static int grid = 0;
    if (grid == 0) {
        if (n_in != 28 || ws_size < WS_END) { fprintf(stderr, "kernel_launch: unexpected inputs (n_in %d, ws %zu < %zu)\n", n_in, ws_size, (size_t)WS_END); grid = -1; return; }
        int dev = 0, cus = 0, per_cu = 0;
        if (hipGetDevice(&dev) != hipSuccess || hipDeviceGetAttribute(&cus, hipDeviceAttributeMultiprocessorCount, dev) != hipSuccess) { grid = -1; return; }
        if (hipFuncSetAttribute((const void*)mk_fwd, hipFuncAttributeMaxDynamicSharedMemorySize, LDS_BYTES) != hipSuccess) { fprintf(stderr, "kernel_launch: hipFuncSetAttribute failed\n"); grid = -1; return; }
        if (hipOccupancyMaxActiveBlocksPerMultiprocessor(&per_cu, (const void*)mk_fwd, NTHR, LDS_BYTES) != hipSuccess || per_cu < 1) { fprintf(stderr, "kernel_launch: occupancy query says %d\n", per_cu); (void)hipGetLastError(); grid = -1; return; }
        grid = cus;
    }
    if (grid < 0) return;
    (void)hipMemsetAsync((char*)d_ws + WS_CTL, 0, CTL_BYTES, stream);
    Params p{};
    const float** pp = (const float**)&p;
    for (int i = 0; i < 28; ++i) pp[i] = (const float*)d_in[i];
    p.out = (float*)d_out; p.ws = (unsigned char*)d_ws;
#if MK_MODE == 1
    p.ph_lo = 0; p.ph_hi = N_PHASES;
    hipLaunchKernelGGL(mk_fwd, dim3(grid), dim3(NTHR), LDS_BYTES, stream, p);
#else
    for (int ph = 0; ph < N_PHASES; ++ph) { p.ph_lo = ph; p.ph_hi = ph + 1; hipLaunchKernelGGL(mk_fwd, dim3(grid), dim3(NTHR), LDS_BYTES, stream, p);
#if MK_MODE == 3
        if (ph == PROBE_PH) for (int r = 0; r < PROBE_REP; ++r) hipLaunchKernelGGL(mk_fwd, dim3(grid), dim3(NTHR), LDS_BYTES, stream, p);
#endif
    }
#if MK_MODE == 2
    for (int r = 0; r < PROBE_REP; ++r) { p.ph_lo = PROBE_PH; p.ph_hi = (PROBE_PH + 1) | (PROBE_SEL << 8); hipLaunchKernelGGL(mk_fwd, dim3(grid), dim3(NTHR), LDS_BYTES, stream, p); }
#endif
#endif
}
```

```cpp
#include <hip/hip_runtime.h>
#include <cstdio>
#include <cstdint>

namespace mk {
#define LAS __attribute__((address_space(3)))
#define DI __device__ __forceinline__
typedef unsigned short bf16_t;
typedef short bf16x8 __attribute__((ext_vector_type(8)));
typedef short s16x4 __attribute__((ext_vector_type(4)));
typedef float f32x2 __attribute__((ext_vector_type(2)));
typedef float f32x4 __attribute__((ext_vector_type(4)));
typedef float f32x16 __attribute__((ext_vector_type(16)));
typedef unsigned u32x2 __attribute__((ext_vector_type(2)));
typedef unsigned u32x4 __attribute__((ext_vector_type(4)));
typedef __bf16 bf16x2_t __attribute__((ext_vector_type(2)));

constexpr int DM = 1024, NB = 16, SEQ = 2048, CTX = 256, T = SEQ + CTX, M = NB * T, DEPTH = 4;
constexpr int PW = 2560, INW = 2480;
constexpr int C_DAQ = 0, C_DAK = 256, C_DAV = 512, C_Z = 768, C_XBC = 1280, C_DT = 2048, C_CQ = 2064, C_CKV = 2320, C_KR = 2448;
constexpr float EPS = 1e-6f, LOG2E = 1.4426950408889634f;
constexpr float DA_QS = 0.17677669529663687f * LOG2E, MLA_QS = 0.10206207261596577f * LOG2E;
constexpr int NSLOT = 2 * M + 4096;
constexpr int NTHR = 512, NWAVE = 8;

constexpr size_t MiB = 1u << 20;
constexpr size_t WS_CTL = 0, CTL_BYTES = 1 * MiB;
constexpr size_t WS_MOD = 1 * MiB, WS_ROPE = 3 * MiB, WS_HC = 4 * MiB;
constexpr size_t WS_WIN = 20 * MiB, WS_WOUT = 25 * MiB, WS_WUQ = 27 * MiB, WS_WUKV = 27 * MiB + 512 * 1024, WS_WGU = 28 * MiB, WS_WD = 60 * MiB;
constexpr size_t WS_ACT = 76 * MiB, WS_PROJ = 148 * MiB;
constexpr size_t WS_MLAQ = 328 * MiB, WS_MLAK = 355 * MiB, WS_VTM = 382 * MiB, WS_VTD = 400 * MiB;
constexpr size_t WS_XBC = 418 * MiB, WS_DT = 472 * MiB, WS_YF = 475 * MiB, WS_YB = 511 * MiB, WS_TOK = 547 * MiB, WS_LIST = 548 * MiB, WS_END = 551 * MiB;
constexpr size_t WS_HE = WS_MLAQ, WS_YS = WS_PROJ;
static_assert((size_t)NSLOT * 512 * 2 <= WS_XBC - WS_MLAQ, "HE alias");
static_assert((size_t)NSLOT * 1024 * 2 <= WS_MLAQ - WS_PROJ, "YS alias");
constexpr int CW_BAR = 4096, CW_CNT = 8192;

constexpr int LDS_MISC = 131072, LDS_BYTES = 135168;

struct Params {
    const float *x, *c, *ctx, *c_ctx, *g_mix, *g_ffn, *w_mod, *b_mod, *w_in, *w_out, *da_lam, *da_g, *conv_w, *conv_b, *dt_bias, *a_log, *ssd_d, *ssd_g,
                *mq_g, *mkv_g, *w_uq, *w_ukv, *r_w, *r_b, *wg, *wu, *wd, *fin_g;
    float* out; unsigned char* ws; int ph_lo, ph_hi;
};

DI unsigned pk2(float lo, float hi) { f32x2 v = {lo, hi}; bf16x2_t b = __builtin_convertvector(v, bf16x2_t); return __builtin_bit_cast(unsigned, b); }
DI float bflo(unsigned w) { return __uint_as_float(w << 16); }
DI float bfhi(unsigned w) { return __uint_as_float(w & 0xffff0000u); }
DI float shx(float v, int o, int lane) { return __int_as_float(__builtin_amdgcn_ds_bpermute((lane ^ o) << 2, __float_as_int(v))); }
DI float shl(float v, int src) { return __int_as_float(__builtin_amdgcn_ds_bpermute(src << 2, __float_as_int(v))); }
DI int shli(int v, int src) { return __builtin_amdgcn_ds_bpermute(src << 2, v); }
DI float shup(float v, int o, int lane) { return __int_as_float(__builtin_amdgcn_ds_bpermute((lane - o) << 2, __float_as_int(v))); }
DI int shupi(int v, int o, int lane) { return __builtin_amdgcn_ds_bpermute((lane - o) << 2, v); }
DI float wave_sum(float v, int lane) {
#pragma unroll
    for (int o = 1; o < 64; o <<= 1) v += shx(v, o, lane);
    return v;
}
DI float silu(float x) { return x / (1.f + __expf(-x)); }
DI float fexp2(float x) { return __builtin_amdgcn_exp2f(x); }
#define LDS_WAIT() asm volatile("s_waitcnt lgkmcnt(0)" ::: "memory")
#define MFMA32(a, b, c) __builtin_amdgcn_mfma_f32_32x32x16_bf16((a), (b), (c), 0, 0, 0)
#define MFMA16(a, b, c) __builtin_amdgcn_mfma_f32_16x16x32_bf16((a), (b), (c), 0, 0, 0)
DI int crow(int reg, int h) { return (reg & 3) + 8 * (reg >> 2) + 4 * h; }

#define XB_TMO      128
#define XB_XCNT(j)  (256  + 64 * (j))
#define XB_XSUB(j)  (1280 + 64 * (j))
#define XB_XGEN(j)  (2304 + 64 * (j))
#define XB_TOP      3328
#define XB_TOPGEN   3392
#define XCD_BAR_WORDS 3456
#define XB_SPIN_CAP (1u << 22)
DI unsigned xb_ld(unsigned* p)              { return __hip_atomic_load(p, __ATOMIC_RELAXED, __HIP_MEMORY_SCOPE_AGENT); }
DI unsigned xb_add(unsigned* p, unsigned v) { return __hip_atomic_fetch_add(p, v, __ATOMIC_RELAXED, __HIP_MEMORY_SCOPE_AGENT); }
DI unsigned xb_xcc_id() { return (unsigned)__builtin_amdgcn_s_getreg((3 << 11) | 20) & 0xFu; }
#define XB_SPIN(cond, bar) do { unsigned _sp = 0; while (cond) { __builtin_amdgcn_s_sleep(1); \
    if ((++_sp & 255u) == 0u) { if (xb_ld(&(bar)[XB_TMO])) break; if (_sp > XB_SPIN_CAP) { atomicAdd(&(bar)[XB_TMO], 1u); break; } } } } while (0)
struct XcdBarrier { unsigned* bar; unsigned x; volatile LAS unsigned* st; };
DI XcdBarrier xcd_barrier_post(unsigned* bar, volatile LAS unsigned* st) {
    XcdBarrier b; b.bar = bar; b.x = xb_xcc_id(); b.st = st;
    if (threadIdx.x == 0) (void)xb_add(&bar[XB_XCNT(b.x)], 1u);
    return b;
}
DI void xcd_barrier_complete(unsigned* bar, unsigned x, unsigned& nloc, unsigned& nx) {
    const unsigned G = gridDim.x * gridDim.y * gridDim.z;
    unsigned sum, cnt, mine, sp = 0u;
    for (;;) {
        sum = 0u; cnt = 0u; mine = 0u;
#pragma unroll
        for (unsigned j = 0; j < 16; ++j) { const unsigned c = xb_ld(&bar[XB_XCNT(j)]); sum += c; cnt += (c > 0u) ? 1u : 0u; }
        mine = xb_ld(&bar[XB_XCNT(x)]);
        if (sum == G) break;
        __builtin_amdgcn_s_sleep(1);
        if ((++sp & 255u) == 0u) { if (xb_ld(&bar[XB_TMO])) break; if (sp > XB_SPIN_CAP) { atomicAdd(&bar[XB_TMO], 1u); break; } }
    }
    nloc = mine > 0u ? mine : 1u; nx = cnt > 0u ? cnt : 1u;
}
DI void xcd_barrier(const XcdBarrier& b, int tid) {
    asm volatile("s_waitcnt vmcnt(0)" ::: "memory");
    __syncthreads();
    if (tid == 0) {
        unsigned* bar = b.bar;
        __builtin_amdgcn_s_waitcnt(0);
        unsigned nloc = b.st[0], nx = b.st[1];
        if (nloc == 0u) { xcd_barrier_complete(bar, b.x, nloc, nx); b.st[0] = nloc; b.st[1] = nx; }
        const unsigned old = xb_add(&bar[XB_XSUB(b.x)], 1u);
        const unsigned gen = old / nloc;
        if (old + 1u == (gen + 1u) * nloc) {
            __builtin_amdgcn_fence(__ATOMIC_RELEASE, "agent");
            asm volatile("s_waitcnt vmcnt(0)" ::: "memory");
            const unsigned og = xb_add(&bar[XB_TOP], 1u);
            const unsigned tg = og / nx;
            if (og + 1u == (tg + 1u) * nx) xb_add(&bar[XB_TOPGEN], 1u);
            else XB_SPIN(xb_ld(&bar[XB_TOPGEN]) == tg, bar);
            __builtin_amdgcn_fence(__ATOMIC_ACQUIRE, "agent");
            xb_add(&bar[XB_XGEN(b.x)], 1u);
            asm volatile("s_waitcnt vmcnt(0)" ::: "memory");
        } else {
            XB_SPIN(xb_ld(&bar[XB_XGEN(b.x)]) == gen, bar);
            __builtin_amdgcn_fence(__ATOMIC_ACQUIRE, "agent");
            asm volatile("s_waitcnt vmcnt(0)" ::: "memory");
        }
    }
    __syncthreads();
}

constexpr int HTB = 128 * 64 * 2;
DI int lds_byte(int r, int c) { const int st = (r >> 4) * 2 + (c >> 5), rr = r & 15, cc = c & 31, ob = rr * 64 + cc * 2; return st * 1024 + (ob ^ (((ob >> 9) & 1) << 5)); }
DI void stage_rc(int b, int& R, int& C) { const int st = b / 1024, sb = b % 1024, swz = sb ^ (((sb >> 9) & 1) << 5); R = (st >> 1) * 16 + swz / 64; C = (st & 1) * 32 + (swz % 64) / 2; }
DI int perm32(int rho) { const int n = rho >> 4, i = rho & 15; return 8 * (i >> 2) + 4 * n + (i & 3); }

struct GUnit { const char* A; const char* B; int pm, pn, e, row0; };

template <class Epi, class Sched>
DI void gemm8(LAS unsigned char* lds, const int K, const Sched& S, const Epi& E) {
    int tid_ = threadIdx.x; asm volatile("" : "+v"(tid_));
    const int tid = tid_, wid = __builtin_amdgcn_readfirstlane(tid >> 6), lane = tid & 63, wr = wid >> 2, wc = wid & 3, fr = lane & 15, fq = lane >> 4;
    const int nt = K / 64;
    int R[2], C[2]; unsigned voffB[2];
#pragma unroll
    for (int i = 0; i < 2; ++i) { stage_rc(tid * 16 + i * 8192, R[i], C[i]); const int Rb = Epi::PERM ? ((R[i] & ~31) + perm32(R[i] & 31)) : R[i]; voffB[i] = (unsigned)(Rb * K + C[i]) * 2u; }
    const size_t kstep = 128;
    const size_t hstepB = (size_t)128 * K * 2;
    const unsigned ldsw = (unsigned)wid * 1024u;
    const int aoff = lds_byte(wr * 64 + fr, fq * 8), boff = lds_byte(wc * 32 + fr, fq * 8);
#define G8_SA(b, h) (((b) * 2 + (h)) * HTB)
#define G8_SB(b, h) ((4 + (b) * 2 + (h)) * HTB)
#define G8_STAGE(bufoff, gbase, voff) do { _Pragma("unroll") for (int _i = 0; _i < 2; ++_i) \
        __builtin_amdgcn_global_load_lds((const unsigned*)((const char*)(gbase) + (voff)[_i]), (LAS unsigned*)(lds + (bufoff) + ldsw + _i * 8192), 16, 0, 0); } while (0)
#define G8_LDA(dst, b, h) do { _Pragma("unroll") for (int m = 0; m < 4; ++m) _Pragma("unroll") for (int k = 0; k < 2; ++k) dst[m][k] = *(const LAS bf16x8*)(lds + G8_SA(b, h) + aoff + m * 2048 + k * 1024); } while (0)
#define G8_LDB(dst, b, h) do { _Pragma("unroll") for (int n = 0; n < 2; ++n) _Pragma("unroll") for (int k = 0; k < 2; ++k) dst[n][k] = *(const LAS bf16x8*)(lds + G8_SB(b, h) + boff + n * 2048 + k * 1024); } while (0)
#define G8_MMA(ai, bj, At, Bt) do { __builtin_amdgcn_s_setprio(1); _Pragma("unroll") for (int m = 0; m < 4; ++m) _Pragma("unroll") for (int n = 0; n < 2; ++n) _Pragma("unroll") for (int k = 0; k < 2; ++k) \
        acc[ai][bj][m][n] = __builtin_amdgcn_mfma_f32_16x16x32_bf16(Bt[n][k], At[m][k], acc[ai][bj][m][n], 0, 0, 0); __builtin_amdgcn_s_setprio(0); } while (0)
#define G8_WAIT_V(n) asm volatile("s_waitcnt vmcnt(" #n ")" ::: "memory")
#define G8_WAIT_L(n) asm volatile("s_waitcnt lgkmcnt(" #n ")" ::: "memory")
#define G8_BAR __builtin_amdgcn_s_barrier()
#define G8_SCHED __builtin_amdgcn_sched_barrier(0)
    GUnit cur, nxt; int ui = 0;
    if (!S.next(0, cur)) return;
    unsigned aoC[2][2], aoN[2][2];
    S.aoff(cur, R, C, aoC);
    if constexpr (Sched::UNIFORM_AOFF) {
#pragma unroll
        for (int h = 0; h < 2; ++h)
#pragma unroll
            for (int i = 0; i < 2; ++i) aoN[h][i] = aoC[h][i]; }
    f32x4 acc[2][2][4][2];
#pragma unroll
    for (int a = 0; a < 2; ++a)
#pragma unroll
        for (int b = 0; b < 2; ++b)
#pragma unroll
            for (int m = 0; m < 4; ++m)
#pragma unroll
                for (int n = 0; n < 2; ++n) acc[a][b][m][n] = (f32x4){0.f, 0.f, 0.f, 0.f};
    bf16x8 At[4][2], B0[2][2], B1[2][2];
    const char* cA = cur.A; const char* cB = cur.B;
    asm volatile("s_waitcnt vmcnt(0)" ::: "memory");
    G8_STAGE(G8_SB(0, 0), cB, voffB); G8_STAGE(G8_SA(0, 0), cA, aoC[0]); G8_STAGE(G8_SB(0, 1), cB + hstepB, voffB); G8_STAGE(G8_SA(0, 1), cA, aoC[1]);
    if (wr == 1) G8_BAR;
    G8_WAIT_V(4); G8_BAR;
    G8_STAGE(G8_SB(1, 0), cB + kstep, voffB); G8_STAGE(G8_SA(1, 0), cA + kstep, aoC[0]); G8_STAGE(G8_SB(1, 1), cB + hstepB + kstep, voffB);
    G8_WAIT_V(6); G8_BAR;
    for (;;) {
        const bool has_next = S.next(ui + 1, nxt);
        if constexpr (!Sched::UNIFORM_AOFF) {
        if (has_next) S.aoff(nxt, R, C, aoN);
        else {
#pragma unroll
            for (int h = 0; h < 2; ++h)
#pragma unroll
                for (int i = 0; i < 2; ++i) aoN[h][i] = aoC[h][i]; } }
        const char* nA = has_next ? nxt.A : cA; const char* nB = has_next ? nxt.B : cB;
        for (int t = 0; t < nt; t += 2) {
            const bool last = (t == nt - 2);
            const char* a1 = cA + (size_t)(t + 1) * kstep;
            const char* a2 = last ? nA : cA + (size_t)(t + 2) * kstep; const char* b2 = last ? nB : cB + (size_t)(t + 2) * kstep;
            const char* a3 = a2 + kstep; const char* b3 = b2 + kstep;
            unsigned ao2[2][2];
#pragma unroll
            for (int h = 0; h < 2; ++h)
#pragma unroll
                for (int i = 0; i < 2; ++i) ao2[h][i] = (!Sched::UNIFORM_AOFF && last) ? aoN[h][i] : aoC[h][i];
            G8_LDB(B0, 0, 0); G8_SCHED; G8_LDA(At, 0, 0); G8_STAGE(G8_SA(1, 1), a1, aoC[1]);
            G8_WAIT_L(8); G8_BAR; G8_WAIT_L(0); G8_MMA(0, 0, At, B0); G8_BAR; G8_SCHED;
            G8_LDB(B1, 0, 1); G8_STAGE(G8_SB(0, 0), b2, voffB);
            G8_BAR; G8_WAIT_L(0); G8_MMA(0, 1, At, B1); G8_BAR;
            G8_LDA(At, 0, 1); G8_STAGE(G8_SA(0, 0), a2, ao2[0]);
            G8_BAR; G8_WAIT_L(0); G8_MMA(1, 0, At, B0); G8_BAR; G8_SCHED;
            G8_STAGE(G8_SB(0, 1), b2 + hstepB, voffB);
            G8_WAIT_V(6); G8_BAR; G8_MMA(1, 1, At, B1); G8_BAR;
            G8_LDB(B0, 1, 0); G8_SCHED; G8_LDA(At, 1, 0); G8_STAGE(G8_SA(0, 1), a2, ao2[1]);
            G8_WAIT_L(8); G8_BAR; G8_WAIT_L(0); G8_MMA(0, 0, At, B0); G8_BAR; G8_SCHED;
            G8_LDB(B1, 1, 1); G8_STAGE(G8_SB(1, 0), b3, voffB);
            G8_BAR; G8_WAIT_L(0); G8_MMA(0, 1, At, B1); G8_BAR;
            G8_LDA(At, 1, 1); G8_STAGE(G8_SA(1, 0), a3, ao2[0]);
            G8_BAR; G8_WAIT_L(0); G8_MMA(1, 0, At, B0); G8_BAR; G8_SCHED;
            G8_STAGE(G8_SB(1, 1), b3 + hstepB, voffB);
            G8_WAIT_V(6); G8_BAR; G8_MMA(1, 1, At, B1); G8_BAR;
        }
        E(acc, cur, wr, wc, fr, fq);
        if (!has_next) break;
#pragma unroll
        for (int a = 0; a < 2; ++a)
#pragma unroll
            for (int b = 0; b < 2; ++b)
#pragma unroll
                for (int m = 0; m < 4; ++m)
#pragma unroll
                    for (int n = 0; n < 2; ++n) acc[a][b][m][n] = (f32x4){0.f, 0.f, 0.f, 0.f};
        cur = nxt; cA = nA; cB = nB; ++ui;
        if constexpr (!Sched::UNIFORM_AOFF) {
#pragma unroll
        for (int h = 0; h < 2; ++h)
#pragma unroll
            for (int i = 0; i < 2; ++i) aoC[h][i] = aoN[h][i]; }
    }
    G8_WAIT_V(0);
    if (wr == 0) G8_BAR;
    G8_BAR;
#undef G8_SA
#undef G8_SB
#undef G8_STAGE
#undef G8_LDA
#undef G8_LDB
#undef G8_MMA
#undef G8_WAIT_V
#undef G8_WAIT_L
#undef G8_BAR
#undef G8_SCHED
}

constexpr int NXCD = 8, WGM = 8;
struct DenseSched {
    static constexpr bool UNIFORM_AOFF = true;
    const char* A; const char* Bt; int K, nM, nN, nwg, G, c;
    DI void init(const void* A_, const void* Bt_, int Mrows, int N, int K_, int G_, int c_) { A = (const char*)A_; Bt = (const char*)Bt_; K = K_; nM = Mrows / 256; nN = N / 256; nwg = nM * nN; G = G_; c = c_; }
    DI bool next(int i, GUnit& u) const {
        const long L = (long)i * G + c; if (L >= nwg) return false;
        int wgid = (int)L; { const int q = nwg / NXCD, r = nwg % NXCD, xcd = wgid % NXCD, off = wgid / NXCD; wgid = (xcd < r ? xcd * (q + 1) : r * (q + 1) + (xcd - r) * q) + off; }
        const int nig = WGM * nN, gid = wgid / nig, fm = gid * WGM, gsz = (nM - fm) < WGM ? (nM - fm) : WGM;
        u.pm = fm + ((wgid % nig) % gsz); u.pn = (wgid % nig) / gsz; u.e = 0; u.row0 = u.pm * 256;
        u.A = A + (size_t)u.pm * 256 * K * 2; u.B = Bt + (size_t)u.pn * 256 * K * 2; return true;
    }
    DI void aoff(const GUnit&, const int (&R)[2], const int (&C)[2], unsigned (&off)[2][2]) const {
#pragma unroll
        for (int h = 0; h < 2; ++h)
#pragma unroll
            for (int i = 0; i < 2; ++i) off[h][i] = (unsigned)((h * 128 + R[i]) * K + C[i]) * 2u;
    }
};
template <bool GATHER>
struct MoeSched {
    static constexpr bool UNIFORM_AOFF = !GATHER;
    const char* A; const char* W; const int* list; volatile LAS int* misc; int K, G, c;
    DI bool next(int i, GUnit& u) const {
        const int L = i * G + c;
        const int RT = __builtin_amdgcn_readfirstlane(misc[32 + 16]);
        if (L >= RT * 4) return false;
        const int rt = L >> 2; u.pn = L & 3;
        int e = 0;
#pragma unroll
        for (int j = 1; j < 16; ++j) { const int tp = __builtin_amdgcn_readfirstlane(misc[32 + j]); if (tp <= rt) e = j; }
        const int tp = __builtin_amdgcn_readfirstlane(misc[32 + e]);
        u.e = e; u.pm = rt - tp; u.row0 = __builtin_amdgcn_readfirstlane(misc[64 + e]) + u.pm * 256;
        u.A = GATHER ? A : A + (size_t)u.row0 * K * 2;
        u.B = W + ((size_t)e * 1024 + (size_t)u.pn * 256) * K * 2;
        return true;
    }
    DI void aoff(const GUnit& u, const int (&R)[2], const int (&C)[2], unsigned (&off)[2][2]) const {
        if (GATHER) {
            const int cnt = __builtin_amdgcn_readfirstlane(misc[16 + u.e]);
#pragma unroll
            for (int h = 0; h < 2; ++h)
#pragma unroll
                for (int i = 0; i < 2; ++i) { const int idx = u.pm * 256 + h * 128 + R[i]; const int tok = (idx < cnt) ? list[(size_t)u.e * M + idx] : 0; off[h][i] = (unsigned)(tok * K + C[i]) * 2u; }
        } else {
#pragma unroll
            for (int h = 0; h < 2; ++h)
#pragma unroll
                for (int i = 0; i < 2; ++i) off[h][i] = (unsigned)((h * 128 + R[i]) * K + C[i]) * 2u;
        }
    }
};

struct EpiStoreBf16 {
    static constexpr bool PERM = true;
    bf16_t* O; int ldc;
    DI void operator()(const f32x4 (&acc)[2][2][4][2], const GUnit& u, int wr, int wc, int fr, int fq) const {
        const int row0 = u.row0 + wr * 64 + fr, col0 = u.pn * 256 + wc * 32 + 8 * fq;
#pragma unroll
        for (int ai = 0; ai < 2; ++ai)
#pragma unroll
            for (int m = 0; m < 4; ++m) { bf16_t* rowp = O + (size_t)(row0 + ai * 128 + m * 16) * ldc + col0;
#pragma unroll
                for (int bj = 0; bj < 2; ++bj) { const f32x4 v0 = acc[ai][bj][m][0], v1 = acc[ai][bj][m][1];
                    u32x4 w; w.x = pk2(v0[0], v0[1]); w.y = pk2(v0[2], v0[3]); w.z = pk2(v1[0], v1[1]); w.w = pk2(v1[2], v1[3]);
                    *(u32x4*)(rowp + bj * 128) = w; } }
    }
};
struct EpiGateUp {
    static constexpr bool PERM = true;
    bf16_t* O;
    DI void operator()(const f32x4 (&acc)[2][2][4][2], const GUnit& u, int wr, int wc, int fr, int fq) const {
        const int row0 = u.row0 + wr * 64 + fr, col0 = u.pn * 128 + wc * 32 + 8 * fq;
#pragma unroll
        for (int ai = 0; ai < 2; ++ai)
#pragma unroll
            for (int m = 0; m < 4; ++m) { bf16_t* rowp = O + (size_t)(row0 + ai * 128 + m * 16) * 512 + col0;
                float hv[8];
#pragma unroll
                for (int n = 0; n < 2; ++n)
#pragma unroll
                    for (int i = 0; i < 4; ++i) hv[n * 4 + i] = silu(acc[ai][0][m][n][i]) * acc[ai][1][m][n][i];
                u32x4 w; w.x = pk2(hv[0], hv[1]); w.y = pk2(hv[2], hv[3]); w.z = pk2(hv[4], hv[5]); w.w = pk2(hv[6], hv[7]);
                *(u32x4*)rowp = w; }
    }
};
struct EpiResidual {
    static constexpr bool PERM = false;
    float* hc; float* hx; const float* modl;
    DI void operator()(const f32x4 (&acc)[2][2][4][2], const GUnit& u, int wr, int wc, int fr, int fq) const {
        const int b = u.pm / 9, tt = u.pm % 9;
        float* base = (tt == 0) ? hc + (size_t)b * CTX * DM : hx + ((size_t)b * SEQ + (size_t)(tt - 1) * 256) * DM;
        const float* gate = modl + (size_t)((tt == 0) ? 16 : b) * 6144 + 2 * DM;
        const int row0 = wr * 64 + fr, col0 = u.pn * 256 + wc * 32 + 4 * fq;
#pragma unroll
        for (int ai = 0; ai < 2; ++ai)
#pragma unroll
            for (int m = 0; m < 4; ++m) { float* rowp = base + (size_t)(row0 + ai * 128 + m * 16) * DM + col0;
#pragma unroll
                for (int bj = 0; bj < 2; ++bj)
#pragma unroll
                    for (int n = 0; n < 2; ++n) { f32x4* p = (f32x4*)(rowp + bj * 128 + n * 16); const f32x4 gv = *(const f32x4*)(gate + col0 + bj * 128 + n * 16); *p = *p + gv * acc[ai][bj][m][n]; }
                asm volatile("" ::: "memory"); }
    }
};

struct Ctx {
    LAS unsigned char* L; volatile LAS int* misc; unsigned char* ws; int tid, lane, wave, G, bid;
};
DI float* hrow(const Params& P, int m) { const int b = m / T, t = m - b * T; return (t < CTX) ? (float*)(P.ws + WS_HC) + ((size_t)b * CTX + t) * DM : P.out + ((size_t)b * SEQ + (t - CTX)) * DM; }

DI void phase_prologue(const Params& P, Ctx& X) {
    float* MOD = (float*)(P.ws + WS_MOD);
    LAS float* tab = (LAS float*)(X.L + X.wave * 8704);
    for (int u = X.bid; u < 4 * 48; u += X.G) {
        const int l = u / 48, jc = u % 48;
        __syncthreads();
        for (int idx = X.lane; idx < 17 * 128; idx += 64) { const int r = idx >> 7, kk = idx & 127; const float* src = (r < 16) ? P.c + r * DM : P.c_ctx; tab[idx] = silu(src[X.wave * 128 + kk]); }
        __syncthreads();
        float a0[17], a1[17];
#pragma unroll
        for (int r = 0; r < 17; ++r) { a0[r] = 0.f; a1[r] = 0.f; }
        const float* wp = P.w_mod + ((size_t)l * DM + X.wave * 128) * 6144 + jc * 128 + 2 * X.lane;
#pragma unroll 4
        for (int kk = 0; kk < 128; ++kk) { const f32x2 w2 = *(const f32x2*)(wp + (size_t)kk * 6144);
#pragma unroll
            for (int r = 0; r < 17; ++r) { const float a = tab[r * 128 + kk]; a0[r] += a * w2.x; a1[r] += a * w2.y; } }
        __syncthreads();
#pragma unroll
        for (int r = 0; r < 17; ++r) { tab[r * 128 + 2 * X.lane] = a0[r]; tab[r * 128 + 2 * X.lane + 1] = a1[r]; }
        __syncthreads();
        for (int idx = X.tid; idx < 17 * 128; idx += NTHR) { const int r = idx >> 7, j = idx & 127; float s = P.b_mod[l * 6144 + jc * 128 + j];
#pragma unroll
            for (int w = 0; w < 8; ++w) s += ((LAS float*)(X.L + w * 8704))[idx];
            MOD[((size_t)l * 17 + r) * 6144 + jc * 128 + j] = s; }
    }
    __syncthreads();
    f32x2* rope = (f32x2*)(P.ws + WS_ROPE);
    for (int e = X.bid * NTHR + X.tid; e < SEQ * 16; e += X.G * NTHR) { const int p = e >> 4, d = e & 15; const int row = p >> 6, col = p & 63;
        const float inv = powf(10000.f, -(float)(d & 7) / 8.f); const float ang = (float)((d < 8) ? row : col) * inv; rope[e] = (f32x2){cosf(ang), sinf(ang)}; }
    u32x4* wz = (u32x4*)((bf16_t*)(P.ws + WS_WIN) + (size_t)2496 * DM);
    for (int e = X.bid * NTHR + X.tid; e < 64 * DM * 2 / 16; e += X.G * NTHR) wz[e] = (u32x4){0u, 0u, 0u, 0u};
}

DI void cvt_item(const float* W, int ldw, int N, int k0, int n0, bf16_t* WT, int K, int row0, const float* kscale, float mul, LAS float* scr, int lane) {
#pragma unroll 8
    for (int i = 0; i < 32; ++i) { const int kk = 2 * i + (lane >> 5), n = n0 + (lane & 31);
        float v = (n < N) ? W[(size_t)(k0 + kk) * ldw + n] : 0.f; if (kscale) v *= kscale[k0 + kk];
        scr[kk * 33 + (lane & 31)] = v * mul; }
    LDS_WAIT(); asm volatile("" ::: "memory");
    const int c = lane & 7;
#pragma unroll
    for (int j = 0; j < 4; ++j) { const int nn = (lane >> 3) + 8 * j; const LAS float* s = scr + (8 * c) * 33 + nn;
        u32x4 o; o.x = pk2(s[0 * 33], s[1 * 33]); o.y = pk2(s[2 * 33], s[3 * 33]); o.z = pk2(s[4 * 33], s[5 * 33]); o.w = pk2(s[6 * 33], s[7 * 33]);
        *(u32x4*)(WT + (size_t)(row0 + nn) * K + k0 + 8 * c) = o; }
    LDS_WAIT(); asm volatile("" ::: "memory");
}
DI void convert_weights(const Params& P, Ctx& X, int l) {
    LAS float* scr = (LAS float*)(X.L + X.wave * 8704);
    const int gw = X.bid * NWAVE + X.wave, NGW = X.G * NWAVE;
    constexpr int I_IN = 16 * 78, I_OUT = 16 * 32, I_UQ = 4 * 12, I_UKV = 2 * 16, I_E = 768, NIT = I_IN + I_OUT + I_UQ + I_UKV + 16 * I_E;
    for (int it = gw; it < NIT; it += NGW) {
        int r = it;
        if (r < I_IN) { cvt_item(P.w_in + (size_t)l * DM * INW, INW, INW, 64 * (r / 78), 32 * (r % 78), (bf16_t*)(P.ws + WS_WIN), DM, 32 * (r % 78), nullptr, 1.f, scr, X.lane); continue; } r -= I_IN;
        if (r < I_OUT) { cvt_item(P.w_out + (size_t)l * DM * DM, DM, DM, 64 * (r / 32), 32 * (r % 32), (bf16_t*)(P.ws + WS_WOUT), DM, 32 * (r % 32), nullptr, 1.f, scr, X.lane); continue; } r -= I_OUT;
        if (r < I_UQ) { cvt_item(P.w_uq + (size_t)l * 256 * 384, 384, 384, 64 * (r / 12), 32 * (r % 12), (bf16_t*)(P.ws + WS_WUQ), 256, 32 * (r % 12), P.mq_g + l * 256, MLA_QS, scr, X.lane); continue; } r -= I_UQ;
        if (r < I_UKV) { cvt_item(P.w_ukv + (size_t)l * 128 * 512, 512, 512, 64 * (r / 16), 32 * (r % 16), (bf16_t*)(P.ws + WS_WUKV), 128, 32 * (r % 16), P.mkv_g + l * 128, 1.f, scr, X.lane); continue; } r -= I_UKV;
        const int e = r / I_E; r -= e * I_E;
        if (r < 256) { const int kb = r / 16, nb = r % 16;
            cvt_item(P.wg + ((size_t)l * 16 + e) * DM * 512, 512, 512, 64 * kb, 32 * nb, (bf16_t*)(P.ws + WS_WGU) + (size_t)e * 1024 * DM, DM, 256 * (nb >> 2) + 32 * (nb & 3), nullptr, 1.f, scr, X.lane); continue; } r -= 256;
        if (r < 256) { const int kb = r / 16, nb = r % 16;
            cvt_item(P.wu + ((size_t)l * 16 + e) * DM * 512, 512, 512, 64 * kb, 32 * nb, (bf16_t*)(P.ws + WS_WGU) + (size_t)e * 1024 * DM, DM, 256 * (nb >> 2) + 128 + 32 * (nb & 3), nullptr, 1.f, scr, X.lane); continue; } r -= 256;
        { const int kb = r / 32, nb = r % 32;
            cvt_item(P.wd + ((size_t)l * 16 + e) * 512 * DM, DM, DM, 64 * kb, 32 * nb, (bf16_t*)(P.ws + WS_WD) + (size_t)e * 1024 * 512, 512, 32 * nb, nullptr, 1.f, scr, X.lane); }
    }
}

DI int slot_base_lane(const unsigned* cnt, int lane) {
    int c = (lane < 16) ? (int)cnt[lane] : 0;
    int tiles = (c + 255) >> 8;
    int incl = tiles;
#pragma unroll
    for (int o = 1; o < 16; o <<= 1) { const int v = shupi(incl, o, lane); if (lane >= o) incl += v; }
    return (incl - tiles) * 256;
}

constexpr int RPC = 18;
struct RowIn { f32x4 h[4]; u32x2 y0[4], y1[4]; float w0, w1; };
DI void row_issue(const Params& P, RowIn& R, int l, int m, int sbase, const u32x4 ti, int lane) {
    const int b = m / T, t = m - b * T;
    if (l == 0) {
        const float* src = (t < CTX) ? P.ctx + ((size_t)b * CTX + t) * DM : P.x + ((size_t)b * SEQ + (t - CTX)) * DM;
#pragma unroll
        for (int j = 0; j < 4; ++j) R.h[j] = *(const f32x4*)(src + 256 * j + 4 * lane);
        R.w0 = 0.f; R.w1 = 0.f;
    } else {
        const float* hp = hrow(P, m);
        const bf16_t* YS = (const bf16_t*)(P.ws + WS_YS);
        const int s0 = shli(sbase, (int)(ti.x & 15u)) + (int)(ti.x >> 4), s1 = shli(sbase, (int)(ti.y & 15u)) + (int)(ti.y >> 4);
        const bf16_t* y0 = YS + (size_t)s0 * DM; const bf16_t* y1 = YS + (size_t)s1 * DM;
#pragma unroll
        for (int j = 0; j < 4; ++j) { const int cidx = 256 * j + 4 * lane; R.h[j] = *(const f32x4*)(hp + cidx); R.y0[j] = *(const u32x2*)(y0 + cidx); R.y1[j] = *(const u32x2*)(y1 + cidx); }
        R.w0 = __uint_as_float(ti.z); R.w1 = __uint_as_float(ti.w);
    }
}
DI float row_combine(const RowIn& R, bool comb, const f32x4 (&gp)[4], f32x4 (&v)[4]) {
    float ss = 0.f;
#pragma unroll
    for (int j = 0; j < 4; ++j) {
        if (comb) { const u32x2 a = R.y0[j], bb = R.y1[j];
            f32x4 yv; yv[0] = R.w0 * bflo(a.x) + R.w1 * bflo(bb.x); yv[1] = R.w0 * bfhi(a.x) + R.w1 * bfhi(bb.x); yv[2] = R.w0 * bflo(a.y) + R.w1 * bflo(bb.y); yv[3] = R.w0 * bfhi(a.y) + R.w1 * bfhi(bb.y);
            v[j] = R.h[j] + gp[j] * yv; }
        else v[j] = R.h[j];
        ss += v[j][0] * v[j][0] + v[j][1] * v[j][1] + v[j][2] * v[j][2] + v[j][3] * v[j][3]; }
    return ss;
}
DI void phase_norm1(const Params& P, Ctx& X, int l) {
    convert_weights(P, X, l);
    const float* MOD = (const float*)(P.ws + WS_MOD);
    bf16_t* ACT = (bf16_t*)(P.ws + WS_ACT);
    const u32x4* TOK = (const u32x4*)(P.ws + WS_TOK);
    const unsigned* cnt = (const unsigned*)(P.ws + WS_CTL) + CW_CNT + (l > 0 ? (l - 1) * 16 : 0);
    const int sbase = (l > 0) ? slot_base_lane(cnt, X.lane) : 0;
    const int gw = X.bid * NWAVE + X.wave, NGW = X.G * NWAVE, lane = X.lane;
    const float* g = P.g_mix + l * DM;
    const u32x4 tz = {0u, 0u, 0u, 0u};
    for (int ck = gw; ck < M / RPC; ck += NGW) {
        const int m0 = ck * RPC, b = m0 / T, t0 = m0 - b * T;
        int cur_cls = -1; f32x4 gs[4], sh[4], gp[4];
        RowIn cur, nxt;
        row_issue(P, cur, l, m0, sbase, (l > 0) ? TOK[m0] : tz, lane);
        u32x4 tiN = (l > 0) ? TOK[m0 + 1] : tz;
        for (int r = 0; r < RPC; ++r) {
            const int m = m0 + r, t = t0 + r, cls = (t < CTX) ? 1 : 0;
            if (r + 1 < RPC) row_issue(P, nxt, l, m + 1, sbase, tiN, lane);
            if (l > 0 && r + 2 < RPC) tiN = TOK[m + 2];
            if (cls != cur_cls) { cur_cls = cls;
                const float* mrow = MOD + ((size_t)l * 17 + (cls ? 16 : b)) * 6144;
                const float* gprev = MOD + ((size_t)(l > 0 ? l - 1 : 0) * 17 + (cls ? 16 : b)) * 6144 + 5 * DM;
#pragma unroll
                for (int j = 0; j < 4; ++j) { const int cidx = 256 * j + 4 * lane;
                    gs[j] = *(const f32x4*)(g + cidx) * (*(const f32x4*)(mrow + DM + cidx) + 1.f); sh[j] = *(const f32x4*)(mrow + cidx); gp[j] = *(const f32x4*)(gprev + cidx); } }
            f32x4 v[4];
            const float ss = row_combine(cur, l > 0, gp, v);
            float* hp = hrow(P, m);
#pragma unroll
            for (int j = 0; j < 4; ++j) *(f32x4*)(hp + 256 * j + 4 * lane) = v[j];
            const float rstd = rsqrtf(wave_sum(ss, lane) * (1.f / DM) + EPS);
#pragma unroll
            for (int j = 0; j < 4; ++j) { const f32x4 uu = v[j] * rstd * gs[j] + sh[j];
                u32x2 o; o.x = pk2(uu[0], uu[1]); o.y = pk2(uu[2], uu[3]);
                *(u32x2*)(ACT + (size_t)m * DM + 256 * j + 4 * lane) = o; }
            cur = nxt;
        }
    }
}
DI void phase_final(const Params& P, Ctx& X) {
    constexpr int RPF = 16;
    const float* MOD = (const float*)(P.ws + WS_MOD);
    const u32x4* TOK = (const u32x4*)(P.ws + WS_TOK);
    const unsigned* cnt = (const unsigned*)(P.ws + WS_CTL) + CW_CNT + 3 * 16;
    const int sbase = slot_base_lane(cnt, X.lane);
    const int gw = X.bid * NWAVE + X.wave, NGW = X.G * NWAVE, lane = X.lane;
    f32x4 fg[4];
#pragma unroll
    for (int j = 0; j < 4; ++j) fg[j] = *(const f32x4*)(P.fin_g + 256 * j + 4 * lane);
    for (int ck = gw; ck < NB * SEQ / RPF; ck += NGW) {
        const int r0 = ck * RPF, b = r0 / SEQ, m0 = b * T + CTX + (r0 - b * SEQ);
        f32x4 gp[4];
#pragma unroll
        for (int j = 0; j < 4; ++j) gp[j] = *(const f32x4*)(MOD + ((size_t)3 * 17 + b) * 6144 + 5 * DM + 256 * j + 4 * lane);
        RowIn cur, nxt;
        row_issue(P, cur, 3, m0, sbase, TOK[m0], lane);
        u32x4 tiN = TOK[m0 + 1];
        for (int r = 0; r < RPF; ++r) {
            const int m = m0 + r;
            if (r + 1 < RPF) row_issue(P, nxt, 3, m + 1, sbase, tiN, lane);
            if (r + 2 < RPF) tiN = TOK[m + 2];
            f32x4 v[4];
            const float ss = row_combine(cur, true, gp, v);
            const float rstd = rsqrtf(wave_sum(ss, lane) * (1.f / DM) + EPS);
            float* hp = P.out + (size_t)(r0 + r) * DM;
#pragma unroll
            for (int j = 0; j < 4; ++j) *(f32x4*)(hp + 256 * j + 4 * lane) = v[j] * rstd * fg[j];
            cur = nxt;
        }
    }
}

DI void phase_postproj(const Params& P, Ctx& X, int l) {
    bf16_t* PROJ = (bf16_t*)(P.ws + WS_PROJ);
    const f32x2* rope = (const f32x2*)(P.ws + WS_ROPE);
    bf16_t* XBC = (bf16_t*)(P.ws + WS_XBC); float* DT = (float*)(P.ws + WS_DT);
    bf16_t* MLAQ = (bf16_t*)(P.ws + WS_MLAQ); bf16_t* MLAK = (bf16_t*)(P.ws + WS_MLAK);
    bf16_t* VTM = (bf16_t*)(P.ws + WS_VTM); bf16_t* VTD = (bf16_t*)(P.ws + WS_VTD);
    const bf16_t* WUQ = (const bf16_t*)(P.ws + WS_WUQ); const bf16_t* WUKV = (const bf16_t*)(P.ws + WS_WUKV);
    const int lane = X.lane, wave = X.wave;
    for (int u = X.bid; u < M / 144; u += X.G) {
        const int m0 = u * 144, b = m0 / T, t0 = m0 - b * T;
        __syncthreads();
        float cw[3][12], cb[12];
#pragma unroll
        for (int g3 = 0; g3 < 3; ++g3)
#pragma unroll
            for (int i = 0; i < 4; ++i) { const int ch = 256 * g3 + 4 * lane + i; cb[g3 * 4 + i] = P.conv_b[l * 768 + ch];
#pragma unroll
                for (int k = 0; k < 3; ++k) cw[k][g3 * 4 + i] = P.conv_w[((size_t)l * 3 + k) * 768 + ch]; }
        const int tw0 = t0 + wave * 18;
        const int vv = lane >> 2, d0 = 4 * (lane & 3);
        const float qs = (vv < 8) ? DA_QS : 1.f;
        struct RowRegs { u32x2 qa, qb, v; unsigned short dtr, k1, k2; };
        auto ld_row = [&](int t, RowRegs& R) { const bf16_t* prow = PROJ + ((size_t)b * T + t) * PW;
            R.qa = *(const u32x2*)(prow + vv * 32 + d0); R.qb = *(const u32x2*)(prow + vv * 32 + d0 + 16); R.v = *(const u32x2*)(prow + C_DAV + 4 * lane);
            R.dtr = prow[C_DT + (lane & 15)]; R.k1 = prow[C_KR + (lane & 15)]; R.k2 = prow[C_KR + 16 + (lane & 15)]; };
        auto ld_x = [&](int t, u32x2 (&xx)[3]) { const bool ok = (t >= 0 && t < T);
            const bf16_t* prow = PROJ + ((size_t)b * T + (ok ? t : 0)) * PW + C_XBC + 4 * lane;
#pragma unroll
            for (int g3 = 0; g3 < 3; ++g3) { xx[g3] = *(const u32x2*)(prow + 256 * g3); if (!ok) xx[g3] = (u32x2){0u, 0u}; } };
        RowRegs rc, rn; u32x2 xm[3], x0[3], xp[3], xq[3];
        ld_row(tw0, rc); ld_x(tw0 - 1, xm); ld_x(tw0, x0); ld_x(tw0 + 1, xp);
#pragma unroll 1
        for (int rr = 0; rr < 18; ++rr) {
            const int t = tw0 + rr; const size_t m = (size_t)b * T + t;
            if (rr + 1 < 18) ld_row(t + 1, rn);
            ld_x(t + 2, xq);
            bf16_t* prow = PROJ + m * PW;
            { const u32x2 a = rc.qa, bq = rc.qb;
              float x1[4] = {bflo(a.x), bfhi(a.x), bflo(a.y), bfhi(a.y)}, x2[4] = {bflo(bq.x), bfhi(bq.x), bflo(bq.y), bfhi(bq.y)};
              float o1[4], o2[4];
              if (t >= CTX) { const f32x2* rp = rope + (size_t)(t - CTX) * 16 + d0;
#pragma unroll
                  for (int i = 0; i < 4; ++i) { const f32x2 cs = rp[i]; o1[i] = (x1[i] * cs.x - x2[i] * cs.y) * qs; o2[i] = (x2[i] * cs.x + x1[i] * cs.y) * qs; } }
              else {
#pragma unroll
                  for (int i = 0; i < 4; ++i) { o1[i] = x1[i] * qs; o2[i] = x2[i] * qs; } }
              u32x2 w1, w2; w1.x = pk2(o1[0], o1[1]); w1.y = pk2(o1[2], o1[3]); w2.x = pk2(o2[0], o2[1]); w2.y = pk2(o2[2], o2[3]);
              bf16_t* p1 = prow + vv * 32 + d0;
              *(u32x2*)p1 = w1; *(u32x2*)(p1 + 16) = w2; }
            *(LAS u32x2*)(X.L + (size_t)(wave * 18 + rr) * 520 + lane * 8) = rc.v;
            { const int lo = (t < CTX) ? 0 : CTX, hi = (t < CTX) ? CTX : T;
              const bool hm = (t - 1 >= lo), hp = (t + 1 < hi);
#pragma unroll
              for (int g3 = 0; g3 < 3; ++g3) { const int ch = 256 * g3 + 4 * lane;
                  const u32x2 c0 = x0[g3]; u32x2 cm = xm[g3], cp = xp[g3];
                  if (!hm) cm = (u32x2){0u, 0u};
                  if (!hp) cp = (u32x2){0u, 0u};
                  const float xmv[4] = {bflo(cm.x), bfhi(cm.x), bflo(cm.y), bfhi(cm.y)}, x0v[4] = {bflo(c0.x), bfhi(c0.x), bflo(c0.y), bfhi(c0.y)}, xpv[4] = {bflo(cp.x), bfhi(cp.x), bflo(cp.y), bfhi(cp.y)};
                  float o[4];
#pragma unroll
                  for (int i = 0; i < 4; ++i) o[i] = silu(cb[g3 * 4 + i] + cw[0][g3 * 4 + i] * xmv[i] + cw[1][g3 * 4 + i] * x0v[i] + cw[2][g3 * 4 + i] * xpv[i]);
                  u32x2 w; w.x = pk2(o[0], o[1]); w.y = pk2(o[2], o[3]);
                  *(u32x2*)(XBC + m * 768 + ch) = w; } }
            if (lane < 16) { const float v = __uint_as_float(((unsigned)rc.dtr) << 16) + P.dt_bias[l * 16 + lane]; DT[m * 16 + lane] = (v > 20.f) ? v : log1pf(__expf(v)); }
            if (lane < 16) { const float x1 = __uint_as_float(((unsigned)rc.k1) << 16), x2 = __uint_as_float(((unsigned)rc.k2) << 16);
                float o1 = x1, o2 = x2;
                if (t >= CTX) { const f32x2 cs = rope[(size_t)(t - CTX) * 16 + lane]; o1 = x1 * cs.x - x2 * cs.y; o2 = x2 * cs.x + x1 * cs.y; }
                const bf16_t b1 = (bf16_t)(pk2(o1, 0.f) & 0xffffu), b2 = (bf16_t)(pk2(o2, 0.f) & 0xffffu);
#pragma unroll
                for (int h = 0; h < 4; ++h) { MLAK[(m * 4 + h) * 96 + 64 + lane] = b1; MLAK[(m * 4 + h) * 96 + 80 + lane] = b2; } }
            rc = rn;
#pragma unroll
            for (int g3 = 0; g3 < 3; ++g3) { xm[g3] = x0[g3]; x0[g3] = xp[g3]; xp[g3] = xq[g3]; }
        }
        __syncthreads();
        { const int vr = X.tid >> 1, th = X.tid & 1;
          bf16_t* dst = VTD + ((size_t)b * 256 + vr) * T + t0 + th * 72;
#pragma unroll 1
          for (int q8 = 0; q8 < 9; ++q8) { unsigned w[4];
#pragma unroll
              for (int i = 0; i < 4; ++i) { const int tt = th * 72 + q8 * 8 + 2 * i;
                  const unsigned lo = *(const LAS unsigned short*)(X.L + (size_t)tt * 520 + vr * 2), hi = *(const LAS unsigned short*)(X.L + (size_t)(tt + 1) * 520 + vr * 2);
                  w[i] = lo | (hi << 16); }
              *(u32x4*)(dst + q8 * 8) = (u32x4){w[0], w[1], w[2], w[3]}; } }
        { int lane_c = lane; asm volatile("" : "+v"(lane_c)); const int tk = lane_c & 15, q4 = lane_c >> 4;
#pragma unroll
          for (int pass = 0; pass < 2; ++pass) {
              constexpr int NCT_MAX = 2; const int nct = pass ? 2 : 1, ct0 = pass ? 1 : 0;
              bf16x8 bw[NCT_MAX][8];
#pragma unroll
              for (int ct = 0; ct < NCT_MAX; ++ct)
#pragma unroll
                  for (int s = 0; s < 8; ++s) if (ct < nct) bw[ct][s] = *(const bf16x8*)(WUQ + (size_t)((3 * wave + ct0 + ct) * 16 + tk) * 256 + 32 * s + 8 * q4);
              bf16x8 af[8], an[8];
#pragma unroll
              for (int s = 0; s < 8; ++s) af[s] = *(const bf16x8*)(PROJ + ((size_t)b * T + t0 + tk) * PW + C_CQ + 32 * s + 8 * q4);
#pragma unroll 1
              for (int rt = 0; rt < 9; ++rt) {
                  const int t = t0 + rt * 16 + tk; const size_t m = (size_t)b * T + t;
                  if (rt + 1 < 9) {
#pragma unroll
                      for (int s = 0; s < 8; ++s) an[s] = *(const bf16x8*)(PROJ + (m + 16) * PW + C_CQ + 32 * s + 8 * q4); }
                  float ss = 0.f;
#pragma unroll
                  for (int s = 0; s < 8; ++s)
#pragma unroll
                      for (int j = 0; j < 8; ++j) { const float f = __uint_as_float(((unsigned)(unsigned short)af[s][j]) << 16); ss += f * f; }
                  ss += shx(ss, 16, lane); ss += shx(ss, 32, lane);
                  const float rstd = rsqrtf(ss * (1.f / 256.f) + EPS);
                  f32x4 acc[NCT_MAX];
#pragma unroll
                  for (int ct = 0; ct < NCT_MAX; ++ct) if (ct < nct) { acc[ct] = (f32x4){0.f, 0.f, 0.f, 0.f};
#pragma unroll
                      for (int s = 0; s < 8; ++s) acc[ct] = MFMA16(bw[ct][s], af[s], acc[ct]);
                      acc[ct] = acc[ct] * rstd; }
                  if (pass && (wave & 1) && t >= CTX) {
                      const f32x2* rp = rope + (size_t)(t - CTX) * 16 + 4 * q4;
#pragma unroll
                      for (int i = 0; i < 4; ++i) { const f32x2 cs = rp[i]; const float x1 = acc[0][i], x2 = acc[1][i]; acc[0][i] = x1 * cs.x - x2 * cs.y; acc[1][i] = x2 * cs.x + x1 * cs.y; } }
#pragma unroll
                  for (int ct = 0; ct < NCT_MAX; ++ct) if (ct < nct) { u32x2 w; w.x = pk2(acc[ct][0], acc[ct][1]); w.y = pk2(acc[ct][2], acc[ct][3]);
                      *(u32x2*)(MLAQ + m * 384 + (3 * wave + ct0 + ct) * 16 + 4 * q4) = w; }
#pragma unroll
                  for (int s = 0; s < 8; ++s) af[s] = an[s];
              }
          }
        }
        { const int tk = lane & 15, q4 = lane >> 4, hh = wave >> 1;
          bf16x8 bw[4][4];
#pragma unroll
          for (int ct = 0; ct < 4; ++ct)
#pragma unroll
              for (int s = 0; s < 4; ++s) bw[ct][s] = *(const bf16x8*)(WUKV + (size_t)((4 * wave + ct) * 16 + tk) * 128 + 32 * s + 8 * q4);
          bf16x8 af[4], an[4];
#pragma unroll
          for (int s = 0; s < 4; ++s) af[s] = *(const bf16x8*)(PROJ + ((size_t)b * T + t0 + tk) * PW + C_CKV + 32 * s + 8 * q4);
#pragma unroll 1
          for (int rt = 0; rt < 9; ++rt) {
              const int t = t0 + rt * 16 + tk; const size_t m = (size_t)b * T + t;
              if (rt + 1 < 9) {
#pragma unroll
                  for (int s = 0; s < 4; ++s) an[s] = *(const bf16x8*)(PROJ + (m + 16) * PW + C_CKV + 32 * s + 8 * q4); }
              float ss = 0.f;
#pragma unroll
              for (int s = 0; s < 4; ++s)
#pragma unroll
                  for (int j = 0; j < 8; ++j) { const float f = __uint_as_float(((unsigned)(unsigned short)af[s][j]) << 16); ss += f * f; }
              ss += shx(ss, 16, lane); ss += shx(ss, 32, lane);
              const float rstd = rsqrtf(ss * (1.f / 128.f) + EPS);
              if ((wave & 1) == 0) {
#pragma unroll
                  for (int ct = 0; ct < 4; ++ct) { f32x4 acc = {0.f, 0.f, 0.f, 0.f};
#pragma unroll
                      for (int s = 0; s < 4; ++s) acc = MFMA16(bw[ct][s], af[s], acc);
                      acc = acc * rstd;
                      u32x2 w; w.x = pk2(acc[0], acc[1]); w.y = pk2(acc[2], acc[3]);
                      *(u32x2*)(MLAK + (m * 4 + hh) * 96 + ct * 16 + 4 * q4) = w; }
              } else {
                  float rs[4];
#pragma unroll
                  for (int i = 0; i < 4; ++i) rs[i] = shl(rstd, 4 * q4 + i);
#pragma unroll
                  for (int ct = 0; ct < 4; ++ct) { f32x4 acc = {0.f, 0.f, 0.f, 0.f};
#pragma unroll
                      for (int s = 0; s < 4; ++s) acc = MFMA16(af[s], bw[ct][s], acc);
                      u32x2 w; w.x = pk2(acc[0] * rs[0], acc[1] * rs[1]); w.y = pk2(acc[2] * rs[2], acc[3] * rs[3]);
                      *(u32x2*)(VTM + (((size_t)b * 4 + hh) * 64 + ct * 16 + tk) * T + t0 + rt * 16 + 4 * q4) = w; }
              }
#pragma unroll
              for (int s = 0; s < 4; ++s) af[s] = an[s];
          }
        }
    }
}

template <int KIND>
DI void attn_unit(const Params& P, Ctx& X, int l, int b, int h, int qt, float lam, float lam_init) {
    constexpr int DK = KIND ? 96 : 64, KROW = DK * 2 + 16, NS = KIND ? 6 : 2;
    constexpr int KBUF = 64 * KROW, VROW = 136, VBUF = 64 * VROW;
    constexpr int OFF_K = 0, OFF_V = 2 * KBUF, OFF_X = 36864;
    const bf16_t* PROJ = (const bf16_t*)(P.ws + WS_PROJ);
    const bf16_t* MLAQ = (const bf16_t*)(P.ws + WS_MLAQ); const bf16_t* MLAK = (const bf16_t*)(P.ws + WS_MLAK);
    const bf16_t* VT = (const bf16_t*)(P.ws + (KIND ? WS_VTM : WS_VTD)) + ((size_t)b * 4 + h) * 64 * T;
    bf16_t* ACT = (bf16_t*)(P.ws + WS_ACT);
    const int tid = X.tid, lane = X.lane, wave = X.wave, r = lane & 31, hh = lane >> 5;
    const int mmw = KIND ? 0 : (wave & 1), qg = KIND ? wave : (wave >> 1);
    const bool is_ctx = KIND ? (qt == 0) : (qt < 2);
    const int nk = is_ctx ? CTX : T, ntile = nk / 64;
    const size_t mrow = (size_t)b * T + qt * (KIND ? 256 : 128) + qg * 32 + r;
    bf16x8 qf[NS];
#pragma unroll
    for (int s = 0; s < NS; ++s)
        qf[s] = KIND ? *(const bf16x8*)(MLAQ + mrow * 384 + h * 96 + 16 * s + 8 * hh) : *(const bf16x8*)(PROJ + mrow * PW + C_DAQ + h * 64 + mmw * 32 + 16 * s + 8 * hh);
    const int kcol = mmw * 64 + 16 * hh;
    const int kkey = KIND ? (tid / 12) : (tid >> 3), kpc = KIND ? (tid % 12) : (tid & 7);
    const int kkey2 = (512 + tid) / 12, kpc2 = (512 + tid) % 12;
    const int vdv = tid >> 3, vpc = tid & 7;
    u32x4 kr0, kr1 = {0u, 0u, 0u, 0u}, vr0;
    auto gload = [&](int it) {
        const int key0 = it * 64;
        if (KIND) { kr0 = *(const u32x4*)(MLAK + (((size_t)b * T + key0 + kkey) * 4 + h) * 96 + kpc * 8);
                    if (tid < 256) kr1 = *(const u32x4*)(MLAK + (((size_t)b * T + key0 + kkey2) * 4 + h) * 96 + kpc2 * 8); }
        else kr0 = *(const u32x4*)(PROJ + ((size_t)b * T + key0 + kkey) * PW + C_DAK + h * 64 + kpc * 8);
        vr0 = *(const u32x4*)(VT + (size_t)vdv * T + key0 + vpc * 8);
    };
    auto lstore = [&](int buf) {
        *(LAS u32x4*)(X.L + OFF_K + buf * KBUF + kkey * KROW + kpc * 16) = kr0;
        if (KIND && tid < 256) *(LAS u32x4*)(X.L + OFF_K + buf * KBUF + kkey2 * KROW + kpc2 * 16) = kr1;
        LAS unsigned char* vp = X.L + OFF_V + buf * VBUF + vdv * VROW + vpc * 16;
        *(LAS u32x2*)vp = (u32x2){vr0.x, vr0.y}; *(LAS u32x2*)(vp + 8) = (u32x2){vr0.z, vr0.w};
    };
    f32x16 O[2]; float mrun = -1e30f, lsum = 0.f;
#pragma unroll
    for (int d = 0; d < 2; ++d)
#pragma unroll
        for (int i = 0; i < 16; ++i) O[d][i] = 0.f;
    __syncthreads();
    gload(0); lstore(0);
    __syncthreads();
    for (int it = 0; it < ntile; ++it) {
        const int buf = it & 1;
        if (it + 1 < ntile) gload(it + 1);
        const LAS unsigned char* Kb = X.L + OFF_K + buf * KBUF; const LAS unsigned char* Vb = X.L + OFF_V + buf * VBUF;
        f32x16 S0, S1;
#pragma unroll
        for (int i = 0; i < 16; ++i) { S0[i] = 0.f; S1[i] = 0.f; }
#pragma unroll
        for (int s = 0; s < NS; ++s) {
            const bf16x8 k0 = *(const LAS bf16x8*)(Kb + r * KROW + kcol + 32 * s);
            const bf16x8 k1 = *(const LAS bf16x8*)(Kb + (32 + r) * KROW + kcol + 32 * s);
            S0 = MFMA32(k0, qf[s], S0); S1 = MFMA32(k1, qf[s], S1);
        }
        float mx = S0[0];
#pragma unroll
        for (int i = 1; i < 16; ++i) mx = fmaxf(mx, S0[i]);
#pragma unroll
        for (int i = 0; i < 16; ++i) mx = fmaxf(mx, S1[i]);
        mx = fmaxf(mx, shx(mx, 32, lane));
        const float mnew = fmaxf(mrun, mx), alpha = fexp2(mrun - mnew);
        mrun = mnew;
        float ps = 0.f;
#pragma unroll
        for (int i = 0; i < 16; ++i) { S0[i] = fexp2(S0[i] - mnew); S1[i] = fexp2(S1[i] - mnew); ps += S0[i] + S1[i]; }
        lsum = lsum * alpha + ps;
#pragma unroll
        for (int d = 0; d < 2; ++d)
#pragma unroll
            for (int i = 0; i < 16; ++i) O[d][i] *= alpha;
        bf16x8 pf[2][2];
#pragma unroll
        for (int s = 0; s < 2; ++s) {
            u32x4 w0, w1;
            w0.x = pk2(S0[8 * s + 0], S0[8 * s + 1]); w0.y = pk2(S0[8 * s + 2], S0[8 * s + 3]); w0.z = pk2(S0[8 * s + 4], S0[8 * s + 5]); w0.w = pk2(S0[8 * s + 6], S0[8 * s + 7]);
            w1.x = pk2(S1[8 * s + 0], S1[8 * s + 1]); w1.y = pk2(S1[8 * s + 2], S1[8 * s + 3]); w1.z = pk2(S1[8 * s + 4], S1[8 * s + 5]); w1.w = pk2(S1[8 * s + 6], S1[8 * s + 7]);
            pf[0][s] = __builtin_bit_cast(bf16x8, w0); pf[1][s] = __builtin_bit_cast(bf16x8, w1);
        }
#pragma unroll
        for (int d = 0; d < 2; ++d)
#pragma unroll
            for (int kb = 0; kb < 2; ++kb)
#pragma unroll
                for (int s = 0; s < 2; ++s) {
                    const LAS unsigned char* vp = Vb + (32 * d + r) * VROW + (32 * kb + 16 * s + 4 * hh) * 2;
                    const s16x4 lo = *(const LAS s16x4*)vp, hi = *(const LAS s16x4*)(vp + 16);
                    const bf16x8 vf = __builtin_shufflevector(lo, hi, 0, 1, 2, 3, 4, 5, 6, 7);
                    O[d] = MFMA32(vf, pf[kb][s], O[d]);
                }
        if (it + 1 < ntile) lstore(buf ^ 1);
        __syncthreads();
    }
    const float inv = 1.f / (lsum + shx(lsum, 32, lane));
    if (KIND == 0) {
        LAS float* xb = (LAS float*)(X.L + OFF_X) + qg * 2048 + lane;
        if (mmw == 1) {
#pragma unroll
            for (int d = 0; d < 2; ++d)
#pragma unroll
                for (int i = 0; i < 16; ++i) xb[(d * 16 + i) * 64] = O[d][i] * inv;
        }
        __syncthreads();
        if (mmw == 0) {
            float ss = 0.f;
#pragma unroll
            for (int d = 0; d < 2; ++d)
#pragma unroll
                for (int i = 0; i < 16; ++i) { const float o = O[d][i] * inv - lam * xb[(d * 16 + i) * 64]; O[d][i] = o; ss += o * o; }
            ss += shx(ss, 32, lane);
            const float rstd = rsqrtf(ss * (1.f / 64.f) + EPS) * (1.f - lam_init);
#pragma unroll
            for (int d = 0; d < 2; ++d)
#pragma unroll
                for (int g4 = 0; g4 < 4; ++g4) { const int dv = 32 * d + 8 * g4 + 4 * hh; const f32x4 gg = *(const f32x4*)(P.da_g + l * 64 + dv);
                    u32x2 w; w.x = pk2(O[d][4 * g4] * rstd * gg[0], O[d][4 * g4 + 1] * rstd * gg[1]); w.y = pk2(O[d][4 * g4 + 2] * rstd * gg[2], O[d][4 * g4 + 3] * rstd * gg[3]);
                    *(u32x2*)(ACT + mrow * DM + h * 64 + dv) = w; }
        }
    } else {
#pragma unroll
        for (int d = 0; d < 2; ++d)
#pragma unroll
            for (int g4 = 0; g4 < 4; ++g4) { const int dv = 32 * d + 8 * g4 + 4 * hh;
                u32x2 w; w.x = pk2(O[d][4 * g4] * inv, O[d][4 * g4 + 1] * inv); w.y = pk2(O[d][4 * g4 + 2] * inv, O[d][4 * g4 + 3] * inv);
                *(u32x2*)(ACT + mrow * DM + 768 + h * 64 + dv) = w; }
    }
}

DI void ssd_unit(const Params& P, Ctx& X, int l, int b, int hd, int dir) {
    constexpr int OFF_BR = 0, OFF_CR = 18432, OFF_XT = 36864, OFF_XS = 53760, OFF_BT = 71168, OFF_SB = 88576, OFF_AC = 98304, OFF_DTT = 98816;
    const bf16_t* XBC = (const bf16_t*)(P.ws + WS_XBC); const float* DT = (const float*)(P.ws + WS_DT);
    bf16_t* Y = (bf16_t*)(P.ws + (dir ? WS_YB : WS_YF));
    const int tid = X.tid, lane = X.lane, wave = X.wave, r = lane & 31, hh = lane >> 5, grp = hd >> 2;
    const float a = -__expf(P.a_log[l * 16 + dir * 8 + hd]);
    LAS unsigned char* L = X.L;
    LAS float* t_ac = (LAS float*)(L + OFF_AC); LAS float* t_dt = (LAS float*)(L + OFF_DTT);
    f32x4 Sacc[2] = {{0.f, 0.f, 0.f, 0.f}, {0.f, 0.f, 0.f, 0.f}};
    const size_t rb = (size_t)b * T;
    const int tau = tid >> 2, q2 = tid & 3;
    u32x4 xr[2], br[2], cr[2]; float dt0, dt1;
    auto chunk_tok = [&](int c, int& tbase, int& tstep) { const int seg0 = (c < 2) ? 0 : CTX, seg1 = (c < 2) ? CTX : T, cc = (c < 2) ? c : c - 2;
        tbase = dir ? (seg1 - 1 - 128 * cc) : (seg0 + 128 * cc); tstep = dir ? -1 : 1; };
    auto issue = [&](int c) { int tbase, tstep; chunk_tok(c, tbase, tstep);
        const bf16_t* rowp = XBC + (rb + tbase + tstep * tau) * 768;
#pragma unroll
        for (int k = 0; k < 2; ++k) { const int pc = 2 * q2 + k; xr[k] = *(const u32x4*)(rowp + hd * 64 + 8 * pc); br[k] = *(const u32x4*)(rowp + 512 + grp * 64 + 8 * pc); cr[k] = *(const u32x4*)(rowp + 640 + grp * 64 + 8 * pc); }
        dt0 = DT[(rb + tbase + tstep * (2 * lane)) * 16 + dir * 8 + hd]; dt1 = DT[(rb + tbase + tstep * (2 * lane + 1)) * 16 + dir * 8 + hd]; };
    issue(0);
    __syncthreads();
    for (int c = 0; c < 18; ++c) {
        int tbase, tstep; chunk_tok(c, tbase, tstep);
        const float v0 = dt0 * a, v1 = dt1 * a, s2 = v0 + v1; float incl = s2;
#pragma unroll
        for (int o = 1; o < 64; o <<= 1) { const float v = shup(incl, o, lane); if (lane >= o) incl += v; }
        const float ac0 = incl - s2 + v0, ac1 = incl;
        const float alast = shl(incl, 63);
        if (wave == 0) { *(LAS f32x2*)(t_ac + 2 * lane) = (f32x2){ac0, ac1}; *(LAS f32x2*)(t_dt + 2 * lane) = (f32x2){dt0, dt1}; }
        {
            const int src = tau >> 1;
            const float a_e = shl(ac0, src), a_o = shl(ac1, src), d_e = shl(dt0, src), d_o = shl(dt1, src);
            const float wj = __expf(alast - ((tau & 1) ? a_o : a_e)) * ((tau & 1) ? d_o : d_e);
#pragma unroll
            for (int k = 0; k < 2; ++k) { const int pc = 2 * q2 + k;
                *(LAS u32x4*)(L + OFF_BR + tau * 144 + pc * 16) = br[k]; *(LAS u32x4*)(L + OFF_CR + tau * 144 + pc * 16) = cr[k];
                const unsigned xw[4] = {xr[k].x, xr[k].y, xr[k].z, xr[k].w}, bw[4] = {br[k].x, br[k].y, br[k].z, br[k].w};
#pragma unroll
                for (int i = 0; i < 4; ++i) { const int p0 = 8 * pc + 2 * i;
                    *(LAS unsigned short*)(L + OFF_XT + p0 * 264 + tau * 2) = (unsigned short)(xw[i] & 0xffffu);
                    *(LAS unsigned short*)(L + OFF_XT + (p0 + 1) * 264 + tau * 2) = (unsigned short)(xw[i] >> 16);
                    const unsigned sc = pk2(bflo(xw[i]) * wj, bfhi(xw[i]) * wj);
                    *(LAS unsigned short*)(L + OFF_XS + p0 * 272 + tau * 2) = (unsigned short)(sc & 0xffffu);
                    *(LAS unsigned short*)(L + OFF_XS + (p0 + 1) * 272 + tau * 2) = (unsigned short)(sc >> 16);
                    *(LAS unsigned short*)(L + OFF_BT + p0 * 272 + tau * 2) = (unsigned short)(bw[i] & 0xffffu);
                    *(LAS unsigned short*)(L + OFF_BT + (p0 + 1) * 272 + tau * 2) = (unsigned short)(bw[i] >> 16); } }
#pragma unroll
            for (int k = 0; k < 2; ++k) { const int tl = 2 * wave + k, pt = tl >> 2, nt = tl & 3, n = 16 * nt + (lane & 15), p = 16 * pt + 4 * (lane >> 4);
#pragma unroll
                for (int i = 0; i < 4; ++i) *(LAS unsigned short*)(L + OFF_SB + (p + i) * 144 + n * 2) = (unsigned short)(pk2(Sacc[k][i], 0.f) & 0xffffu); }
        }
        __syncthreads();
        if (c + 1 < 18) issue(c + 1);
        {
            const int ib = wave >> 1, pb = wave & 1, i_tok = 32 * ib + r;
            const float acum_i = t_ac[i_tok];
            bf16x8 cf[4];
#pragma unroll
            for (int s = 0; s < 4; ++s) cf[s] = *(const LAS bf16x8*)(L + OFF_CR + i_tok * 144 + (16 * s + 8 * hh) * 2);
            f32x16 accO, accD;
#pragma unroll
            for (int i = 0; i < 16; ++i) { accO[i] = 0.f; accD[i] = 0.f; }
#pragma unroll
            for (int s = 0; s < 4; ++s) { const bf16x8 sa = *(const LAS bf16x8*)(L + OFF_SB + (32 * pb + r) * 144 + (16 * s + 8 * hh) * 2); accO = MFMA32(sa, cf[s], accO); }
            for (int jb = 0; jb <= ib; ++jb) {
                f32x16 g;
#pragma unroll
                for (int i = 0; i < 16; ++i) g[i] = 0.f;
#pragma unroll
                for (int s = 0; s < 4; ++s) { const bf16x8 ba = *(const LAS bf16x8*)(L + OFF_BR + (32 * jb + r) * 144 + (16 * s + 8 * hh) * 2); g = MFMA32(ba, cf[s], g); }
#pragma unroll
                for (int g4 = 0; g4 < 4; ++g4) { const int j0 = 32 * jb + 8 * g4 + 4 * hh;
                    const f32x4 aj = *(const LAS f32x4*)(L + OFF_AC + j0 * 4), dj = *(const LAS f32x4*)(L + OFF_DTT + j0 * 4);
#pragma unroll
                    for (int i = 0; i < 4; ++i) { const float arg = fminf(acum_i - aj[i], 0.f); const float wv = __expf(arg) * dj[i] * g[4 * g4 + i]; g[4 * g4 + i] = (j0 + i <= i_tok) ? wv : 0.f; } }
#pragma unroll
                for (int s = 0; s < 2; ++s) {
                    u32x4 w; w.x = pk2(g[8 * s + 0], g[8 * s + 1]); w.y = pk2(g[8 * s + 2], g[8 * s + 3]); w.z = pk2(g[8 * s + 4], g[8 * s + 5]); w.w = pk2(g[8 * s + 6], g[8 * s + 7]);
                    const bf16x8 wf = __builtin_bit_cast(bf16x8, w);
                    const LAS unsigned char* xp = L + OFF_XT + (32 * pb + r) * 264 + (32 * jb + 16 * s + 4 * hh) * 2;
                    const s16x4 lo = *(const LAS s16x4*)xp, hi = *(const LAS s16x4*)(xp + 16);
                    const bf16x8 xf = __builtin_shufflevector(lo, hi, 0, 1, 2, 3, 4, 5, 6, 7);
                    accD = MFMA32(xf, wf, accD);
                }
            }
            const float ei = __expf(acum_i);
            bf16_t* yp = Y + (rb + tbase + tstep * i_tok) * 512 + hd * 64 + 32 * pb + 4 * hh;
#pragma unroll
            for (int g4 = 0; g4 < 4; ++g4) { u32x2 w; w.x = pk2(accD[4 * g4] + ei * accO[4 * g4], accD[4 * g4 + 1] + ei * accO[4 * g4 + 1]); w.y = pk2(accD[4 * g4 + 2] + ei * accO[4 * g4 + 2], accD[4 * g4 + 3] + ei * accO[4 * g4 + 3]);
                *(u32x2*)(yp + 8 * g4) = w; }
        }
        {
            const float dec = __expf(alast);
#pragma unroll
            for (int k = 0; k < 2; ++k) { const int tl = 2 * wave + k, pt = tl >> 2, nt = tl & 3;
                f32x4 acc = Sacc[k] * dec;
#pragma unroll
                for (int s = 0; s < 4; ++s) {
                    const bf16x8 xa = *(const LAS bf16x8*)(L + OFF_XS + (16 * pt + (lane & 15)) * 272 + (32 * s + 8 * (lane >> 4)) * 2);
                    const bf16x8 bb = *(const LAS bf16x8*)(L + OFF_BT + (16 * nt + (lane & 15)) * 272 + (32 * s + 8 * (lane >> 4)) * 2);
                    acc = MFMA16(xa, bb, acc); }
                Sacc[k] = acc; }
        }
        __syncthreads();
    }
}

DI void phase_mixers(const Params& P, Ctx& X, int l, int sel = 7) {
    const float lam_init = 0.8f - 0.6f * __expf(-0.3f * (float)l);
    float l01 = 0.f, l23 = 0.f;
    if (X.lane < 32) { const float* lv = P.da_lam + l * 128; l01 = lv[X.lane] * lv[32 + X.lane]; l23 = lv[64 + X.lane] * lv[96 + X.lane]; }
    const float lam = __expf(wave_sum(l01, X.lane)) - __expf(wave_sum(l23, X.lane)) + lam_init;
    if (sel & 1) for (int u = X.bid; u < NB * 8 * 2; u += X.G) ssd_unit(P, X, l, u >> 4, (u >> 1) & 7, u & 1);
    if (sel & 2) for (int u = X.bid; u < 1024; u += X.G) attn_unit<0>(P, X, l, u >> 6, (u >> 4) & 3, 2 + (u & 15), lam, lam_init);
    if (sel & 4) for (int u = X.bid; u < 512; u += X.G) attn_unit<1>(P, X, l, u >> 5, (u >> 3) & 3, 1 + (u & 7), lam, lam_init);
    for (int u = X.bid; u < 192; u += X.G) { if (u < 128) { if (sel & 2) attn_unit<0>(P, X, l, u >> 3, (u >> 1) & 3, u & 1, lam, lam_init); } else { if (sel & 4) attn_unit<1>(P, X, l, (u - 128) >> 2, u & 3, 0, lam, lam_init); } }
}

DI void phase_ssdgate(const Params& P, Ctx& X, int l) {
    const bf16_t* PROJ = (const bf16_t*)(P.ws + WS_PROJ); const bf16_t* XBC = (const bf16_t*)(P.ws + WS_XBC);
    const bf16_t* YF = (const bf16_t*)(P.ws + WS_YF); const bf16_t* YB = (const bf16_t*)(P.ws + WS_YB);
    bf16_t* ACT = (bf16_t*)(P.ws + WS_ACT);
    const int gw = X.bid * NWAVE + X.wave, NGW = X.G * NWAVE, c0 = 8 * X.lane;
    const float dsk = P.ssd_d[l * 8 + (X.lane >> 3)];
    const f32x4 g0 = *(const f32x4*)(P.ssd_g + l * 512 + c0), g1 = *(const f32x4*)(P.ssd_g + l * 512 + c0 + 4);
    for (int m = gw; m < M; m += NGW) {
        const u32x4 yf = *(const u32x4*)(YF + (size_t)m * 512 + c0), yb = *(const u32x4*)(YB + (size_t)m * 512 + c0), xv = *(const u32x4*)(XBC + (size_t)m * 768 + c0), zv = *(const u32x4*)(PROJ + (size_t)m * PW + C_Z + c0);
        const unsigned yfw[4] = {yf.x, yf.y, yf.z, yf.w}, ybw[4] = {yb.x, yb.y, yb.z, yb.w}, xw[4] = {xv.x, xv.y, xv.z, xv.w}, zw[4] = {zv.x, zv.y, zv.z, zv.w};
        float v[8]; float ss = 0.f;
#pragma unroll
        for (int i = 0; i < 4; ++i) {
            v[2 * i] = (bflo(yfw[i]) + bflo(ybw[i]) + dsk * bflo(xw[i])) * silu(bflo(zw[i]));
            v[2 * i + 1] = (bfhi(yfw[i]) + bfhi(ybw[i]) + dsk * bfhi(xw[i])) * silu(bfhi(zw[i]));
            ss += v[2 * i] * v[2 * i] + v[2 * i + 1] * v[2 * i + 1]; }
        const float rstd = rsqrtf(wave_sum(ss, X.lane) * (1.f / 512.f) + EPS);
        u32x4 w; w.x = pk2(v[0] * rstd * g0[0], v[1] * rstd * g0[1]); w.y = pk2(v[2] * rstd * g0[2], v[3] * rstd * g0[3]); w.z = pk2(v[4] * rstd * g1[0], v[5] * rstd * g1[1]); w.w = pk2(v[6] * rstd * g1[2], v[7] * rstd * g1[3]);
        *(u32x4*)(ACT + (size_t)m * DM + 256 + c0) = w;
    }
}

DI float reduce16(const float (&lg)[16], int lane) {
    float x8[8], x4[4], x2[2];
    const bool b3 = (lane & 8) != 0, b2 = (lane & 4) != 0, b1 = (lane & 2) != 0, b0 = (lane & 1) != 0;
#pragma unroll
    for (int i = 0; i < 8; ++i) { const float keep = b3 ? lg[i + 8] : lg[i], send = b3 ? lg[i] : lg[i + 8]; x8[i] = keep + shx(send, 8, lane); }
#pragma unroll
    for (int i = 0; i < 4; ++i) { const float keep = b2 ? x8[i + 4] : x8[i], send = b2 ? x8[i] : x8[i + 4]; x4[i] = keep + shx(send, 4, lane); }
#pragma unroll
    for (int i = 0; i < 2; ++i) { const float keep = b1 ? x4[i + 2] : x4[i], send = b1 ? x4[i] : x4[i + 2]; x2[i] = keep + shx(send, 2, lane); }
    const float keep = b0 ? x2[1] : x2[0], send = b0 ? x2[0] : x2[1];
    float x = keep + shx(send, 1, lane);
    x += shx(x, 16, lane); x += shx(x, 32, lane);
    return x;
}
DI void route_select(float x, float rbias, int lane, int& i1, int& i2, float& w1, float& w2) {
    const float aff = 1.f / (1.f + expf(-x)), sel = aff + rbias;
    const float q1 = shx(sel, 1, lane), q2 = shx(sel, 2, lane), q3 = shx(sel, 3, lane);
    const float hi1 = fmaxf(sel, q1), lo1 = fminf(sel, q1), hi2 = fmaxf(q2, q3), lo2 = fminf(q2, q3);
    const float gs = fmaxf(hi1, hi2) + fmaxf(fminf(hi1, hi2), fmaxf(lo1, lo2));
    const float g0 = shl(gs, 0), g1 = shl(gs, 4), g2 = shl(gs, 8), g3 = shl(gs, 12);
    int best = 0; float bs = g0;
    if (g1 > bs) { bs = g1; best = 1; }
    if (g2 > bs) { bs = g2; best = 2; }
    if (g3 > bs) { bs = g3; best = 3; }
    int j1 = 0, j2 = 0; float v1 = -1e30f, v2 = -1e30f, a1 = 0.f, a2 = 0.f;
#pragma unroll
    for (int j = 0; j < 4; ++j) { const float s = shl(sel, 4 * best + j), a = shl(aff, 4 * best + j);
        if (s > v1) { v2 = v1; j2 = j1; a2 = a1; v1 = s; j1 = j; a1 = a; } else if (s > v2) { v2 = s; j2 = j; a2 = a; } }
    i1 = 4 * best + j1; i2 = 4 * best + j2; w1 = a1 / (a1 + a2); w2 = a2 / (a1 + a2);
}
DI void phase_norm2_route(const Params& P, Ctx& X, int l) {
    const float* MOD = (const float*)(P.ws + WS_MOD);
    bf16_t* ACT = (bf16_t*)(P.ws + WS_ACT);
    u32x4* TOK = (u32x4*)(P.ws + WS_TOK); int* LIST = (int*)(P.ws + WS_LIST);
    unsigned* cnt = (unsigned*)(P.ws + WS_CTL) + CW_CNT + l * 16;
    const int lane = X.lane;
    constexpr int RPW = 36;
    LAS unsigned* lcnt = (LAS unsigned*)(X.L + 65536); LAS unsigned* lbase = lcnt + 16; LAS unsigned* ltab = lcnt + 64;
    __syncthreads();
    for (int k = X.tid; k < DM; k += NTHR) { const int j = k >> 8, ln = (k >> 2) & 63, i = k & 3, slot = (4 * j + i) * 64 + ln;
#pragma unroll
        for (int e4 = 0; e4 < 4; ++e4) *(LAS f32x4*)(X.L + ((size_t)e4 * 1024 + slot) * 16) = *(const f32x4*)(P.r_w + k * 16 + 4 * e4); }
    if (X.tid < 32) lcnt[X.tid] = 0u;
    __syncthreads();
    const float rbias = P.r_b[lane & 15];
    const int gw = X.bid * NWAVE + X.wave, NGW = X.G * NWAVE;
    const float* g = P.g_ffn + l * DM;
    int it = 0;
    for (int ck = gw; ck < M / RPC; ck += NGW, ++it) {
        const int m0 = ck * RPC, b = m0 / T, t0 = m0 - b * T;
        int cur_cls = -1; f32x4 gs[4], sh[4];
        f32x4 c0[4], n0[4];
        { const float* h0 = hrow(P, m0);
#pragma unroll
          for (int j = 0; j < 4; ++j) c0[j] = *(const f32x4*)(h0 + 256 * j + 4 * lane); }
#pragma unroll 1
        for (int r = 0; r < RPC; ++r) {
            const int m = m0 + r, t = t0 + r, cls = (t < CTX) ? 1 : 0;
            if (r + 1 < RPC) { const float* h0 = hrow(P, m + 1);
#pragma unroll
                for (int j = 0; j < 4; ++j) n0[j] = *(const f32x4*)(h0 + 256 * j + 4 * lane); }
            if (!(l == DEPTH - 1 && cls)) {
                if (cls != cur_cls) { cur_cls = cls;
                    const float* mrow = MOD + ((size_t)l * 17 + (cls ? 16 : b)) * 6144;
#pragma unroll
                    for (int j = 0; j < 4; ++j) { const int cidx = 256 * j + 4 * lane;
                        gs[j] = *(const f32x4*)(g + cidx) * (*(const f32x4*)(mrow + 4 * DM + cidx) + 1.f); sh[j] = *(const f32x4*)(mrow + 3 * DM + cidx); } }
                float s0 = 0.f;
#pragma unroll
                for (int j = 0; j < 4; ++j) s0 += c0[j][0] * c0[j][0] + c0[j][1] * c0[j][1] + c0[j][2] * c0[j][2] + c0[j][3] * c0[j][3];
                const float r0 = rsqrtf(wave_sum(s0, lane) * (1.f / DM) + EPS);
                float lg0[16];
#pragma unroll
                for (int e = 0; e < 16; ++e) lg0[e] = 0.f;
#pragma unroll
                for (int j = 0; j < 4; ++j) { const int cidx = 256 * j + 4 * lane;
                    const f32x4 u0 = c0[j] * r0 * gs[j] + sh[j];
                    u32x2 o; o.x = pk2(u0[0], u0[1]); o.y = pk2(u0[2], u0[3]); *(u32x2*)(ACT + (size_t)m * DM + cidx) = o;
#pragma unroll
                    for (int i = 0; i < 4; ++i) { const int slot = (4 * j + i) * 64 + lane;
#pragma unroll
                        for (int e4 = 0; e4 < 4; ++e4) { const f32x4 rw = *(const LAS f32x4*)(X.L + ((size_t)e4 * 1024 + slot) * 16);
                            lg0[4 * e4] += u0[i] * rw[0]; lg0[4 * e4 + 1] += u0[i] * rw[1]; lg0[4 * e4 + 2] += u0[i] * rw[2]; lg0[4 * e4 + 3] += u0[i] * rw[3]; } } }
                int a1, a2; float wa1, wa2;
                route_select(reduce16(lg0, lane), rbias, lane, a1, a2, wa1, wa2);
                if (lane == 0) {
                    LAS unsigned* rec = ltab + (X.wave * RPW + it * RPC + r) * 4;
                    const unsigned ra1 = __hip_atomic_fetch_add(lcnt + a1, 1u, __ATOMIC_RELAXED, __HIP_MEMORY_SCOPE_WORKGROUP), ra2 = __hip_atomic_fetch_add(lcnt + a2, 1u, __ATOMIC_RELAXED, __HIP_MEMORY_SCOPE_WORKGROUP);
                    rec[0] = (unsigned)a1 | (ra1 << 4); rec[1] = (unsigned)a2 | (ra2 << 4); rec[2] = __float_as_uint(wa1); rec[3] = __float_as_uint(wa2);
                }
            }
#pragma unroll
            for (int j = 0; j < 4; ++j) c0[j] = n0[j];
        }
    }
    __syncthreads();
    if (X.tid < 16) { const unsigned c = lcnt[X.tid]; lbase[X.tid] = c ? atomicAdd(&cnt[X.tid], c) : 0u; }
    __syncthreads();
    it = 0;
    for (int ck = gw; ck < M / RPC; ck += NGW, ++it) {
        const int m0 = ck * RPC, b = m0 / T, t0 = m0 - b * T;
        if (lane < RPC) { const int m = m0 + lane, t = t0 + lane;
            if (!(l == DEPTH - 1 && t < CTX)) {
                const LAS unsigned* rec = ltab + (X.wave * RPW + it * RPC + lane) * 4;
                const unsigned e1 = rec[0] & 15u, e2 = rec[1] & 15u, p1 = lbase[e1] + (rec[0] >> 4), p2 = lbase[e2] + (rec[1] >> 4);
                LIST[(size_t)e1 * M + p1] = m; LIST[(size_t)e2 * M + p2] = m;
                u32x4 ti; ti.x = e1 | (p1 << 4); ti.y = e2 | (p2 << 4); ti.z = rec[2]; ti.w = rec[3];
                TOK[m] = ti; } }
    }
}
DI void moe_tables(const Params& P, Ctx& X, int l) {
    __syncthreads();
    if (X.tid < 64) { const unsigned* cnt = (const unsigned*)(P.ws + WS_CTL) + CW_CNT + l * 16;
        const int c = (X.lane < 16) ? (int)__hip_atomic_load(cnt + (X.lane & 15), __ATOMIC_RELAXED, __HIP_MEMORY_SCOPE_AGENT) : 0;
        const int tiles = (c + 255) >> 8; int incl = tiles;
#pragma unroll
        for (int o = 1; o < 16; o <<= 1) { const int v = shupi(incl, o, X.lane); if (X.lane >= o) incl += v; }
        if (X.lane < 16) { X.misc[16 + X.lane] = c; X.misc[32 + X.lane] = incl - tiles; X.misc[64 + X.lane] = (incl - tiles) * 256; }
        if (X.lane == 15) X.misc[32 + 16] = incl; }
    __syncthreads();
}

constexpr int N_PHASES = 38;
__global__ void __launch_bounds__(NTHR, 2) mk_fwd(Params PK) {
    const Params& P0 = PK; const Params* kp = &PK;
    extern __shared__ __attribute__((aligned(16))) unsigned char lds_raw[];
    Ctx X;
    X.L = (LAS unsigned char*)lds_raw; X.misc = (volatile LAS int*)(X.L + LDS_MISC); X.ws = PK.ws;
    X.tid = threadIdx.x; X.lane = X.tid & 63; X.wave = __builtin_amdgcn_readfirstlane(X.tid >> 6); X.G = gridDim.x; X.bid = blockIdx.x;
    const int wave0 = X.wave;
    if (X.tid < 128) X.misc[X.tid] = 0;
    __syncthreads();
    unsigned* ctl = (unsigned*)(PK.ws + WS_CTL);
    XcdBarrier bar; bar.bar = ctl + CW_BAR; bar.x = 0; bar.st = (volatile LAS unsigned*)X.misc;
    const bool multi = ((PK.ph_hi & 255) - PK.ph_lo) > 1;
    if (multi) bar = xcd_barrier_post(ctl + CW_BAR, (volatile LAS unsigned*)X.misc);
#ifndef PHMASK
#define PHMASK 0xFFFF
#endif
#define RUN(ph) (PK.ph_lo <= (ph) && (ph) < (PK.ph_hi & 255))
#define HAS(k) ((PHMASK >> (k)) & 1)
#define SEAM(ph) do { if (RUN(ph) && RUN((ph) + 1)) { FRESH(); xcd_barrier(bar, X.tid); } } while (0)
#define FRESH() do { int _t = wave0 * 64 + (int)__builtin_amdgcn_mbcnt_hi(~0u, __builtin_amdgcn_mbcnt_lo(~0u, 0u)); asm volatile("" : "+v"(_t)); X.tid = _t; X.lane = _t & 63; X.wave = __builtin_amdgcn_readfirstlane(_t >> 6); \
        const __attribute__((address_space(4))) Params* _kp = (const __attribute__((address_space(4))) Params*)__builtin_amdgcn_kernarg_segment_ptr(); asm volatile("" : "+s"(_kp)); kp = (const Params*)_kp; X.ws = kp->ws; \
        int _b = blockIdx.x, _g = gridDim.x; asm volatile("" : "+s"(_b), "+s"(_g)); X.bid = _b; X.G = _g; } while (0)
#define P (*kp)
    if (HAS(9) && RUN(0)) phase_prologue(P, X);
    SEAM(0);
#pragma unroll 1
    for (int l = 0; l < DEPTH; ++l) {
        const int pb = 1 + 9 * l;
        FRESH(); if (HAS(0) && RUN(pb + 0)) phase_norm1(P, X, l);
        SEAM(pb + 0);
        FRESH(); if (HAS(1) && RUN(pb + 1)) { DenseSched S; S.init(P.ws + WS_ACT, P.ws + WS_WIN, M, PW, DM, X.G, X.bid); EpiStoreBf16 E{(bf16_t*)(P.ws + WS_PROJ), PW}; gemm8(X.L, DM, S, E); }
        SEAM(pb + 1);
        FRESH(); if (HAS(2) && RUN(pb + 2)) phase_postproj(P, X, l);
        SEAM(pb + 2);
        FRESH(); if (HAS(3) && RUN(pb + 3)) phase_mixers(P, X, l, (PK.ph_hi >> 8) ? (PK.ph_hi >> 8) : 7);
        SEAM(pb + 3);
        FRESH(); if (HAS(4) && RUN(pb + 4)) phase_ssdgate(P, X, l);
        SEAM(pb + 4);
        FRESH(); if (HAS(5) && RUN(pb + 5)) { DenseSched S; S.init(P.ws + WS_ACT, P.ws + WS_WOUT, M, DM, DM, X.G, X.bid);
            EpiResidual E{(float*)(P.ws + WS_HC), P.out, (const float*)(P.ws + WS_MOD) + (size_t)l * 17 * 6144}; gemm8(X.L, DM, S, E); }
        SEAM(pb + 5);
        FRESH(); if (HAS(6) && RUN(pb + 6)) phase_norm2_route(P, X, l);
        SEAM(pb + 6);
        FRESH(); if (HAS(7) && RUN(pb + 7)) { moe_tables(P, X, l);
            MoeSched<true> S{(const char*)(P.ws + WS_ACT), (const char*)(P.ws + WS_WGU), (const int*)(P.ws + WS_LIST), X.misc, DM, X.G, X.bid};
            EpiGateUp E{(bf16_t*)(P.ws + WS_HE)}; gemm8(X.L, DM, S, E); }
        SEAM(pb + 7);
        FRESH(); if (HAS(8) && RUN(pb + 8)) { moe_tables(P, X, l);
            MoeSched<false> S{(const char*)(P.ws + WS_HE), (const char*)(P.ws + WS_WD), nullptr, X.misc, 512, X.G, X.bid};
            EpiStoreBf16 E{(bf16_t*)(P.ws + WS_YS), DM}; gemm8(X.L, 512, S, E); }
        SEAM(pb + 8);
    }
    FRESH(); if (HAS(10) && RUN(37)) phase_final(P, X);
#undef P
#undef RUN
#undef SEAM
}
}

#ifndef PROBE_SEL
#define PROBE_SEL 0
#endif
#ifndef MK_MODE
#define MK_MODE 1
#endif
extern "C" void kernel_launch(void* const* d_in, const int* in_sizes, int n_in, void* d_out, int out_size, void* d_ws, size_t ws_size, hipStream_t stream) {
    using namespace mk;
    static int grid = 0;
    if (grid == 0) {
        if (n_in != 28 || ws_size < WS_END) { fprintf(stderr, "kernel_launch: unexpected inputs (n_in %d, ws %zu < %zu)\n", n_in, ws_size, (size_t)WS_END); grid = -1; return; }
        int dev = 0, cus = 0, per_cu = 0;
        if (hipGetDevice(&dev) != hipSuccess || hipDeviceGetAttribute(&cus, hipDeviceAttributeMultiprocessorCount, dev) != hipSuccess) { grid = -1; return; }
        if (hipFuncSetAttribute((const void*)mk_fwd, hipFuncAttributeMaxDynamicSharedMemorySize, LDS_BYTES) != hipSuccess) { fprintf(stderr, "kernel_launch: hipFuncSetAttribute failed\n"); grid = -1; return; }
        if (hipOccupancyMaxActiveBlocksPerMultiprocessor(&per_cu, (const void*)mk_fwd, NTHR, LDS_BYTES) != hipSuccess || per_cu < 1) { fprintf(stderr, "kernel_launch: occupancy query says %d\n", per_cu); (void)hipGetLastError(); grid = -1; return; }
        grid = cus;
    }
    if (grid < 0) return;
    (void)hipMemsetAsync((char*)d_ws + WS_CTL, 0, CTL_BYTES, stream);
    Params p{};
    const float** pp = (const float**)&p;
    for (int i = 0; i < 28; ++i) pp[i] = (const float*)d_in[i];
    p.out = (float*)d_out; p.ws = (unsigned char*)d_ws;
#if MK_MODE == 1
    p.ph_lo = 0; p.ph_hi = N_PHASES;
    hipLaunchKernelGGL(mk_fwd, dim3(grid), dim3(NTHR), LDS_BYTES, stream, p);
#else
    for (int ph = 0; ph < N_PHASES; ++ph) { p.ph_lo = ph; p.ph_hi = ph + 1; hipLaunchKernelGGL(mk_fwd, dim3(grid), dim3(NTHR), LDS_BYTES, stream, p);
#if MK_MODE == 3
        if (ph == PROBE_PH) for (int r = 0; r < PROBE_REP; ++r) hipLaunchKernelGGL(mk_fwd, dim3(grid), dim3(NTHR), LDS_BYTES, stream, p);
#endif
    }
#if MK_MODE == 2
    for (int r = 0; r < PROBE_REP; ++r) { p.ph_lo = PROBE_PH; p.ph_hi = (PROBE_PH + 1) | (PROBE_SEL << 8); hipLaunchKernelGGL(mk_fwd, dim3(grid), dim3(NTHR), LDS_BYTES, stream, p); }
#endif
#endif
}
```

```cpp
#include <hip/hip_runtime.h>
#include <cstdio>
#include <cstdint>

namespace mk {
#define LAS __attribute__((address_space(3)))
#define DI __device__ __forceinline__
typedef unsigned short bf16_t;
typedef short bf16x8 __attribute__((ext_vector_type(8)));
typedef short s16x4 __attribute__((ext_vector_type(4)));
typedef float f32x2 __attribute__((ext_vector_type(2)));
typedef float f32x4 __attribute__((ext_vector_type(4)));
typedef float f32x16 __attribute__((ext_vector_type(16)));
typedef unsigned u32x2 __attribute__((ext_vector_type(2)));
typedef unsigned u32x4 __attribute__((ext_vector_type(4)));
typedef __bf16 bf16x2_t __attribute__((ext_vector_type(2)));

constexpr int DM = 1024, NB = 16, SEQ = 2048, CTX = 256, T = SEQ + CTX, M = NB * T, DEPTH = 4;
constexpr int PW = 2560, INW = 2480;
constexpr int C_DAQ = 0, C_DAK = 256, C_DAV = 512, C_Z = 768, C_XBC = 1280, C_DT = 2048, C_CQ = 2064, C_CKV = 2320, C_KR = 2448;
constexpr float EPS = 1e-6f, LOG2E = 1.4426950408889634f;
constexpr float DA_QS = 0.17677669529663687f * LOG2E, MLA_QS = 0.10206207261596577f * LOG2E;
constexpr int NSLOT = 2 * M + 4096;
constexpr int NTHR = 512, NWAVE = 8;

constexpr size_t MiB = 1u << 20;
constexpr size_t WS_CTL = 0, CTL_BYTES = 1 * MiB;
constexpr size_t WS_MOD = 1 * MiB, WS_ROPE = 3 * MiB, WS_HC = 4 * MiB;
constexpr size_t WS_WIN = 20 * MiB, WS_WOUT = 25 * MiB, WS_WUQ = 27 * MiB, WS_WUKV = 27 * MiB + 512 * 1024, WS_WGU = 28 * MiB, WS_WD = 60 * MiB;
constexpr size_t WS_ACT = 76 * MiB, WS_PROJ = 148 * MiB;
constexpr size_t WS_MLAQ = 328 * MiB, WS_MLAK = 355 * MiB, WS_VTM = 382 * MiB, WS_VTD = 400 * MiB;
constexpr size_t WS_XBC = 418 * MiB, WS_DT = 472 * MiB, WS_YF = 475 * MiB, WS_YB = 511 * MiB, WS_TOK = 547 * MiB, WS_LIST = 548 * MiB, WS_END = 551 * MiB;
constexpr size_t WS_HE = WS_MLAQ, WS_YS = WS_PROJ;
static_assert((size_t)NSLOT * 512 * 2 <= WS_XBC - WS_MLAQ, "HE alias");
static_assert((size_t)NSLOT * 1024 * 2 <= WS_MLAQ - WS_PROJ, "YS alias");
constexpr int CW_BAR = 4096, CW_CNT = 8192;

constexpr int LDS_MISC = 131072, LDS_BYTES = 135168;

struct Params {
    const float *x, *c, *ctx, *c_ctx, *g_mix, *g_ffn, *w_mod, *b_mod, *w_in, *w_out, *da_lam, *da_g, *conv_w, *conv_b, *dt_bias, *a_log, *ssd_d, *ssd_g,
                *mq_g, *mkv_g, *w_uq, *w_ukv, *r_w, *r_b, *wg, *wu, *wd, *fin_g;
    float* out; unsigned char* ws; int ph_lo, ph_hi;
};

DI unsigned pk2(float lo, float hi) { f32x2 v = {lo, hi}; bf16x2_t b = __builtin_convertvector(v, bf16x2_t); return __builtin_bit_cast(unsigned, b); }
DI float bflo(unsigned w) { return __uint_as_float(w << 16); }
DI float bfhi(unsigned w) { return __uint_as_float(w & 0xffff0000u); }
DI float shx(float v, int o, int lane) { return __int_as_float(__builtin_amdgcn_ds_bpermute((lane ^ o) << 2, __float_as_int(v))); }
DI float shl(float v, int src) { return __int_as_float(__builtin_amdgcn_ds_bpermute(src << 2, __float_as_int(v))); }
DI int shli(int v, int src) { return __builtin_amdgcn_ds_bpermute(src << 2, v); }
DI float shup(float v, int o, int lane) { return __int_as_float(__builtin_amdgcn_ds_bpermute((lane - o) << 2, __float_as_int(v))); }
DI int shupi(int v, int o, int lane) { return __builtin_amdgcn_ds_bpermute((lane - o) << 2, v); }
DI float wave_sum(float v, int lane) {
#pragma unroll
    for (int o = 1; o < 64; o <<= 1) v += shx(v, o, lane);
    return v;
}
DI float silu(float x) { return x / (1.f + __expf(-x)); }
DI float fexp2(float x) { return __builtin_amdgcn_exp2f(x); }
#define LDS_WAIT() asm volatile("s_waitcnt lgkmcnt(0)" ::: "memory")
#define MFMA32(a, b, c) __builtin_amdgcn_mfma_f32_32x32x16_bf16((a), (b), (c), 0, 0, 0)
#define MFMA16(a, b, c) __builtin_amdgcn_mfma_f32_16x16x32_bf16((a), (b), (c), 0, 0, 0)
DI int crow(int reg, int h) { return (reg & 3) + 8 * (reg >> 2) + 4 * h; }

#define XB_TMO      128
#define XB_XCNT(j)  (256  + 64 * (j))
#define XB_XSUB(j)  (1280 + 64 * (j))
#define XB_XGEN(j)  (2304 + 64 * (j))
#define XB_TOP      3328
#define XB_TOPGEN   3392
#define XCD_BAR_WORDS 3456
#define XB_SPIN_CAP (1u << 22)
DI unsigned xb_ld(unsigned* p)              { return __hip_atomic_load(p, __ATOMIC_RELAXED, __HIP_MEMORY_SCOPE_AGENT); }
DI unsigned xb_add(unsigned* p, unsigned v) { return __hip_atomic_fetch_add(p, v, __ATOMIC_RELAXED, __HIP_MEMORY_SCOPE_AGENT); }
DI unsigned xb_xcc_id() { return (unsigned)__builtin_amdgcn_s_getreg((3 << 11) | 20) & 0xFu; }
#define XB_SPIN(cond, bar) do { unsigned _sp = 0; while (cond) { __builtin_amdgcn_s_sleep(1); \
    if ((++_sp & 255u) == 0u) { if (xb_ld(&(bar)[XB_TMO])) break; if (_sp > XB_SPIN_CAP) { atomicAdd(&(bar)[XB_TMO], 1u); break; } } } } while (0)
struct XcdBarrier { unsigned* bar; unsigned x; volatile LAS unsigned* st; };
DI XcdBarrier xcd_barrier_post(unsigned* bar, volatile LAS unsigned* st) {
    XcdBarrier b; b.bar = bar; b.x = xb_xcc_id(); b.st = st;
    if (threadIdx.x == 0) (void)xb_add(&bar[XB_XCNT(b.x)], 1u);
    return b;
}
DI void xcd_barrier_complete(unsigned* bar, unsigned x, unsigned& nloc, unsigned& nx) {
    const unsigned G = gridDim.x * gridDim.y * gridDim.z;
    unsigned sum, cnt, mine, sp = 0u;
    for (;;) {
        sum = 0u; cnt = 0u; mine = 0u;
#pragma unroll
        for (unsigned j = 0; j < 16; ++j) { const unsigned c = xb_ld(&bar[XB_XCNT(j)]); sum += c; cnt += (c > 0u) ? 1u : 0u; }
        mine = xb_ld(&bar[XB_XCNT(x)]);
        if (sum == G) break;
        __builtin_amdgcn_s_sleep(1);
        if ((++sp & 255u) == 0u) { if (xb_ld(&bar[XB_TMO])) break; if (sp > XB_SPIN_CAP) { atomicAdd(&bar[XB_TMO], 1u); break; } }
    }
    nloc = mine > 0u ? mine : 1u; nx = cnt > 0u ? cnt : 1u;
}
DI void xcd_barrier(const XcdBarrier& b, int tid) {
    asm volatile("s_waitcnt vmcnt(0)" ::: "memory");
    __syncthreads();
    if (tid == 0) {
        unsigned* bar = b.bar;
        __builtin_amdgcn_s_waitcnt(0);
        unsigned nloc = b.st[0], nx = b.st[1];
        if (nloc == 0u) { xcd_barrier_complete(bar, b.x, nloc, nx); b.st[0] = nloc; b.st[1] = nx; }
        const unsigned old = xb_add(&bar[XB_XSUB(b.x)], 1u);
        const unsigned gen = old / nloc;
        if (old + 1u == (gen + 1u) * nloc) {
            __builtin_amdgcn_fence(__ATOMIC_RELEASE, "agent");
            asm volatile("s_waitcnt vmcnt(0)" ::: "memory");
            const unsigned og = xb_add(&bar[XB_TOP], 1u);
            const unsigned tg = og / nx;
            if (og + 1u == (tg + 1u) * nx) xb_add(&bar[XB_TOPGEN], 1u);
            else XB_SPIN(xb_ld(&bar[XB_TOPGEN]) == tg, bar);
            __builtin_amdgcn_fence(__ATOMIC_ACQUIRE, "agent");
            xb_add(&bar[XB_XGEN(b.x)], 1u);
            asm volatile("s_waitcnt vmcnt(0)" ::: "memory");
        } else {
            XB_SPIN(xb_ld(&bar[XB_XGEN(b.x)]) == gen, bar);
            __builtin_amdgcn_fence(__ATOMIC_ACQUIRE, "agent");
            asm volatile("s_waitcnt vmcnt(0)" ::: "memory");
        }
    }
    __syncthreads();
}

constexpr int HTB = 128 * 64 * 2;
DI int lds_byte(int r, int c) { const int st = (r >> 4) * 2 + (c >> 5), rr = r & 15, cc = c & 31, ob = rr * 64 + cc * 2; return st * 1024 + (ob ^ (((ob >> 9) & 1) << 5)); }
DI void stage_rc(int b, int& R, int& C) { const int st = b / 1024, sb = b % 1024, swz = sb ^ (((sb >> 9) & 1) << 5); R = (st >> 1) * 16 + swz / 64; C = (st & 1) * 32 + (swz % 64) / 2; }
DI int perm32(int rho) { const int n = rho >> 4, i = rho & 15; return 8 * (i >> 2) + 4 * n + (i & 3); }

struct GUnit { const char* A; const char* B; int pm, pn, e, row0; };

template <class Epi, class Sched>
DI void gemm8(LAS unsigned char* lds, const int K, const Sched& S, const Epi& E) {
    int tid_ = threadIdx.x; asm volatile("" : "+v"(tid_));
    const int tid = tid_, wid = __builtin_amdgcn_readfirstlane(tid >> 6), lane = tid & 63, wr = wid >> 2, wc = wid & 3, fr = lane & 15, fq = lane >> 4;
    const int nt = K / 64;
    int R[2], C[2]; unsigned voffB[2];
#pragma unroll
    for (int i = 0; i < 2; ++i) { stage_rc(tid * 16 + i * 8192, R[i], C[i]); const int Rb = Epi::PERM ? ((R[i] & ~31) + perm32(R[i] & 31)) : R[i]; voffB[i] = (unsigned)(Rb * K + C[i]) * 2u; }
    const size_t kstep = 128;
    const size_t hstepB = (size_t)128 * K * 2;
    const unsigned ldsw = (unsigned)wid * 1024u;
    const int aoff = lds_byte(wr * 64 + fr, fq * 8), boff = lds_byte(wc * 32 + fr, fq * 8);
#define G8_SA(b, h) (((b) * 2 + (h)) * HTB)
#define G8_SB(b, h) ((4 + (b) * 2 + (h)) * HTB)
#define G8_STAGE(bufoff, gbase, voff) do { _Pragma("unroll") for (int _i = 0; _i < 2; ++_i) \
        __builtin_amdgcn_global_load_lds((const unsigned*)((const char*)(gbase) + (voff)[_i]), (LAS unsigned*)(lds + (bufoff) + ldsw + _i * 8192), 16, 0, 0); } while (0)
#define G8_LDA(dst, b, h) do { _Pragma("unroll") for (int m = 0; m < 4; ++m) _Pragma("unroll") for (int k = 0; k < 2; ++k) dst[m][k] = *(const LAS bf16x8*)(lds + G8_SA(b, h) + aoff + m * 2048 + k * 1024); } while (0)
#define G8_LDB(dst, b, h) do { _Pragma("unroll") for (int n = 0; n < 2; ++n) _Pragma("unroll") for (int k = 0; k < 2; ++k) dst[n][k] = *(const LAS bf16x8*)(lds + G8_SB(b, h) + boff + n * 2048 + k * 1024); } while (0)
#define G8_MMA(ai, bj, At, Bt) do { __builtin_amdgcn_s_setprio(1); _Pragma("unroll") for (int m = 0; m < 4; ++m) _Pragma("unroll") for (int n = 0; n < 2; ++n) _Pragma("unroll") for (int k = 0; k < 2; ++k) \
        acc[ai][bj][m][n] = __builtin_amdgcn_mfma_f32_16x16x32_bf16(Bt[n][k], At[m][k], acc[ai][bj][m][n], 0, 0, 0); __builtin_amdgcn_s_setprio(0); } while (0)
#define G8_WAIT_V(n) asm volatile("s_waitcnt vmcnt(" #n ")" ::: "memory")
#define G8_WAIT_L(n) asm volatile("s_waitcnt lgkmcnt(" #n ")" ::: "memory")
#define G8_BAR __builtin_amdgcn_s_barrier()
#define G8_SCHED __builtin_amdgcn_sched_barrier(0)
    GUnit cur, nxt; int ui = 0;
    if (!S.next(0, cur)) return;
    unsigned aoC[2][2], aoN[2][2];
    S.aoff(cur, R, C, aoC);
    if constexpr (Sched::UNIFORM_AOFF) {
#pragma unroll
        for (int h = 0; h < 2; ++h)
#pragma unroll
            for (int i = 0; i < 2; ++i) aoN[h][i] = aoC[h][i]; }
    f32x4 acc[2][2][4][2];
#pragma unroll
    for (int a = 0; a < 2; ++a)
#pragma unroll
        for (int b = 0; b < 2; ++b)
#pragma unroll
            for (int m = 0; m < 4; ++m)
#pragma unroll
                for (int n = 0; n < 2; ++n) acc[a][b][m][n] = (f32x4){0.f, 0.f, 0.f, 0.f};
    bf16x8 At[4][2], B0[2][2], B1[2][2];
    const char* cA = cur.A; const char* cB = cur.B;
    asm volatile("s_waitcnt vmcnt(0)" ::: "memory");
    G8_STAGE(G8_SB(0, 0), cB, voffB); G8_STAGE(G8_SA(0, 0), cA, aoC[0]); G8_STAGE(G8_SB(0, 1), cB + hstepB, voffB); G8_STAGE(G8_SA(0, 1), cA, aoC[1]);
    if (wr == 1) G8_BAR;
    G8_WAIT_V(4); G8_BAR;
    G8_STAGE(G8_SB(1, 0), cB + kstep, voffB); G8_STAGE(G8_SA(1, 0), cA + kstep, aoC[0]); G8_STAGE(G8_SB(1, 1), cB + hstepB + kstep, voffB);
    G8_WAIT_V(6); G8_BAR;
    for (;;) {
        const bool has_next = S.next(ui + 1, nxt);
        if constexpr (!Sched::UNIFORM_AOFF) {
        if (has_next) S.aoff(nxt, R, C, aoN);
        else {
#pragma unroll
            for (int h = 0; h < 2; ++h)
#pragma unroll
                for (int i = 0; i < 2; ++i) aoN[h][i] = aoC[h][i]; } }
        const char* nA = has_next ? nxt.A : cA; const char* nB = has_next ? nxt.B : cB;
        for (int t = 0; t < nt; t += 2) {
            const bool last = (t == nt - 2);
            const char* a1 = cA + (size_t)(t + 1) * kstep;
            const char* a2 = last ? nA : cA + (size_t)(t + 2) * kstep; const char* b2 = last ? nB : cB + (size_t)(t + 2) * kstep;
            const char* a3 = a2 + kstep; const char* b3 = b2 + kstep;
            unsigned ao2[2][2];
#pragma unroll
            for (int h = 0; h < 2; ++h)
#pragma unroll
                for (int i = 0; i < 2; ++i) ao2[h][i] = (!Sched::UNIFORM_AOFF && last) ? aoN[h][i] : aoC[h][i];
            G8_LDB(B0, 0, 0); G8_SCHED; G8_LDA(At, 0, 0); G8_STAGE(G8_SA(1, 1), a1, aoC[1]);
            G8_WAIT_L(8); G8_BAR; G8_WAIT_L(0); G8_MMA(0, 0, At, B0); G8_BAR; G8_SCHED;
            G8_LDB(B1, 0, 1); G8_STAGE(G8_SB(0, 0), b2, voffB);
            G8_BAR; G8_WAIT_L(0); G8_MMA(0, 1, At, B1); G8_BAR;
            G8_LDA(At, 0, 1); G8_STAGE(G8_SA(0, 0), a2, ao2[0]);
            G8_BAR; G8_WAIT_L(0); G8_MMA(1, 0, At, B0); G8_BAR; G8_SCHED;
            G8_STAGE(G8_SB(0, 1), b2 + hstepB, voffB);
            G8_WAIT_V(6); G8_BAR; G8_MMA(1, 1, At, B1); G8_BAR;
            G8_LDB(B0, 1, 0); G8_SCHED; G8_LDA(At, 1, 0); G8_STAGE(G8_SA(0, 1), a2, ao2[1]);
            G8_WAIT_L(8); G8_BAR; G8_WAIT_L(0); G8_MMA(0, 0, At, B0); G8_BAR; G8_SCHED;
            G8_LDB(B1, 1, 1); G8_STAGE(G8_SB(1, 0), b3, voffB);
            G8_BAR; G8_WAIT_L(0); G8_MMA(0, 1, At, B1); G8_BAR;
            G8_LDA(At, 1, 1); G8_STAGE(G8_SA(1, 0), a3, ao2[0]);
            G8_BAR; G8_WAIT_L(0); G8_MMA(1, 0, At, B0); G8_BAR; G8_SCHED;
            G8_STAGE(G8_SB(1, 1), b3 + hstepB, voffB);
            G8_WAIT_V(6); G8_BAR; G8_MMA(1, 1, At, B1); G8_BAR;
        }
        E(acc, cur, wr, wc, fr, fq);
        if (!has_next) break;
#pragma unroll
        for (int a = 0; a < 2; ++a)
#pragma unroll
            for (int b = 0; b < 2; ++b)
#pragma unroll
                for (int m = 0; m < 4; ++m)
#pragma unroll
                    for (int n = 0; n < 2; ++n) acc[a][b][m][n] = (f32x4){0.f, 0.f, 0.f, 0.f};
        cur = nxt; cA = nA; cB = nB; ++ui;
        if constexpr (!Sched::UNIFORM_AOFF) {
#pragma unroll
        for (int h = 0; h < 2; ++h)
#pragma unroll
            for (int i = 0; i < 2; ++i) aoC[h][i] = aoN[h][i]; }
    }
    G8_WAIT_V(0);
    if (wr == 0) G8_BAR;
    G8_BAR;
#undef G8_SA
#undef G8_SB
#undef G8_STAGE
#undef G8_LDA
#undef G8_LDB
#undef G8_MMA
#undef G8_WAIT_V
#undef G8_WAIT_L
#undef G8_BAR
#undef G8_SCHED
}

constexpr int NXCD = 8, WGM = 8;
struct DenseSched {
    static constexpr bool UNIFORM_AOFF = true;
    const char* A; const char* Bt; int K, nM, nN, nwg, G, c;
    DI void init(const void* A_, const void* Bt_, int Mrows, int N, int K_, int G_, int c_) { A = (const char*)A_; Bt = (const char*)Bt_; K = K_; nM = Mrows / 256; nN = N / 256; nwg = nM * nN; G = G_; c = c_; }
    DI bool next(int i, GUnit& u) const {
        const long L = (long)i * G + c; if (L >= nwg) return false;
        int wgid = (int)L; { const int q = nwg / NXCD, r = nwg % NXCD, xcd = wgid % NXCD, off = wgid / NXCD; wgid = (xcd < r ? xcd * (q + 1) : r * (q + 1) + (xcd - r) * q) + off; }
        const int nig = WGM * nN, gid = wgid / nig, fm = gid * WGM, gsz = (nM - fm) < WGM ? (nM - fm) : WGM;
        u.pm = fm + ((wgid % nig) % gsz); u.pn = (wgid % nig) / gsz; u.e = 0; u.row0 = u.pm * 256;
        u.A = A + (size_t)u.pm * 256 * K * 2; u.B = Bt + (size_t)u.pn * 256 * K * 2; return true;
    }
    DI void aoff(const GUnit&, const int (&R)[2], const int (&C)[2], unsigned (&off)[2][2]) const {
#pragma unroll
        for (int h = 0; h < 2; ++h)
#pragma unroll
            for (int i = 0; i < 2; ++i) off[h][i] = (unsigned)((h * 128 + R[i]) * K + C[i]) * 2u;
    }
};
template <bool GATHER>
struct MoeSched {
    static constexpr bool UNIFORM_AOFF = !GATHER;
    const char* A; const char* W; const int* list; volatile LAS int* misc; int K, G, c;
    DI bool next(int i, GUnit& u) const {
        const int L = i * G + c;
        const int RT = __builtin_amdgcn_readfirstlane(misc[32 + 16]);
        if (L >= RT * 4) return false;
        const int rt = L >> 2; u.pn = L & 3;
        int e = 0;
#pragma unroll
        for (int j = 1; j < 16; ++j) { const int tp = __builtin_amdgcn_readfirstlane(misc[32 + j]); if (tp <= rt) e = j; }
        const int tp = __builtin_amdgcn_readfirstlane(misc[32 + e]);
        u.e = e; u.pm = rt - tp; u.row0 = __builtin_amdgcn_readfirstlane(misc[64 + e]) + u.pm * 256;
        u.A = GATHER ? A : A + (size_t)u.row0 * K * 2;
        u.B = W + ((size_t)e * 1024 + (size_t)u.pn * 256) * K * 2;
        return true;
    }
    DI void aoff(const GUnit& u, const int (&R)[2], const int (&C)[2], unsigned (&off)[2][2]) const {
        if (GATHER) {
            const int cnt = __builtin_amdgcn_readfirstlane(misc[16 + u.e]);
#pragma unroll
            for (int h = 0; h < 2; ++h)
#pragma unroll
                for (int i = 0; i < 2; ++i) { const int idx = u.pm * 256 + h * 128 + R[i]; const int tok = (idx < cnt) ? list[(size_t)u.e * M + idx] : 0; off[h][i] = (unsigned)(tok * K + C[i]) * 2u; }
        } else {
#pragma unroll
            for (int h = 0; h < 2; ++h)
#pragma unroll
                for (int i = 0; i < 2; ++i) off[h][i] = (unsigned)((h * 128 + R[i]) * K + C[i]) * 2u;
        }
    }
};

struct EpiStoreBf16 {
    static constexpr bool PERM = true;
    bf16_t* O; int ldc;
    DI void operator()(const f32x4 (&acc)[2][2][4][2], const GUnit& u, int wr, int wc, int fr, int fq) const {
        const int row0 = u.row0 + wr * 64 + fr, col0 = u.pn * 256 + wc * 32 + 8 * fq;
#pragma unroll
        for (int ai = 0; ai < 2; ++ai)
#pragma unroll
            for (int m = 0; m < 4; ++m) { bf16_t* rowp = O + (size_t)(row0 + ai * 128 + m * 16) * ldc + col0;
#pragma unroll
                for (int bj = 0; bj < 2; ++bj) { const f32x4 v0 = acc[ai][bj][m][0], v1 = acc[ai][bj][m][1];
                    u32x4 w; w.x = pk2(v0[0], v0[1]); w.y = pk2(v0[2], v0[3]); w.z = pk2(v1[0], v1[1]); w.w = pk2(v1[2], v1[3]);
                    *(u32x4*)(rowp + bj * 128) = w; } }
    }
};
struct EpiGateUp {
    static constexpr bool PERM = true;
    bf16_t* O;
    DI void operator()(const f32x4 (&acc)[2][2][4][2], const GUnit& u, int wr, int wc, int fr, int fq) const {
        const int row0 = u.row0 + wr * 64 + fr, col0 = u.pn * 128 + wc * 32 + 8 * fq;
#pragma unroll
        for (int ai = 0; ai < 2; ++ai)
#pragma unroll
            for (int m = 0; m < 4; ++m) { bf16_t* rowp = O + (size_t)(row0 + ai * 128 + m * 16) * 512 + col0;
                float hv[8];
#pragma unroll
                for (int n = 0; n < 2; ++n)
#pragma unroll
                    for (int i = 0; i < 4; ++i) hv[n * 4 + i] = silu(acc[ai][0][m][n][i]) * acc[ai][1][m][n][i];
                u32x4 w; w.x = pk2(hv[0], hv[1]); w.y = pk2(hv[2], hv[3]); w.z = pk2(hv[4], hv[5]); w.w = pk2(hv[6], hv[7]);
                *(u32x4*)rowp = w; }
    }
};
struct EpiResidual {
    static constexpr bool PERM = false;
    float* hc; float* hx; const float* modl;
    DI void operator()(const f32x4 (&acc)[2][2][4][2], const GUnit& u, int wr, int wc, int fr, int fq) const {
        const int b = u.pm / 9, tt = u.pm % 9;
        float* base = (tt == 0) ? hc + (size_t)b * CTX * DM : hx + ((size_t)b * SEQ + (size_t)(tt - 1) * 256) * DM;
        const float* gate = modl + (size_t)((tt == 0) ? 16 : b) * 6144 + 2 * DM;
        const int row0 = wr * 64 + fr, col0 = u.pn * 256 + wc * 32 + 4 * fq;
#pragma unroll
        for (int ai = 0; ai < 2; ++ai)
#pragma unroll
            for (int m = 0; m < 4; ++m) { float* rowp = base + (size_t)(row0 + ai * 128 + m * 16) * DM + col0;
#pragma unroll
                for (int bj = 0; bj < 2; ++bj)
#pragma unroll
                    for (int n = 0; n < 2; ++n) { f32x4* p = (f32x4*)(rowp + bj * 128 + n * 16); const f32x4 gv = *(const f32x4*)(gate + col0 + bj * 128 + n * 16); *p = *p + gv * acc[ai][bj][m][n]; }
                asm volatile("" ::: "memory"); }
    }
};

struct Ctx {
    LAS unsigned char* L; volatile LAS int* misc; unsigned char* ws; int tid, lane, wave, G, bid;
};
DI float* hrow(const Params& P, int m) { const int b = m / T, t = m - b * T; return (t < CTX) ? (float*)(P.ws + WS_HC) + ((size_t)b * CTX + t) * DM : P.out + ((size_t)b * SEQ + (t - CTX)) * DM; }

DI void phase_prologue(const Params& P, Ctx& X) {
    float* MOD = (float*)(P.ws + WS_MOD);
    LAS float* tab = (LAS float*)(X.L + X.wave * 8704);
    for (int u = X.bid; u < 4 * 48; u += X.G) {
        const int l = u / 48, jc = u % 48;
        __syncthreads();
        for (int idx = X.lane; idx < 17 * 128; idx += 64) { const int r = idx >> 7, kk = idx & 127; const float* src = (r < 16) ? P.c + r * DM : P.c_ctx; tab[idx] = silu(src[X.wave * 128 + kk]); }
        __syncthreads();
        float a0[17], a1[17];
#pragma unroll
        for (int r = 0; r < 17; ++r) { a0[r] = 0.f; a1[r] = 0.f; }
        const float* wp = P.w_mod + ((size_t)l * DM + X.wave * 128) * 6144 + jc * 128 + 2 * X.lane;
#pragma unroll 4
        for (int kk = 0; kk < 128; ++kk) { const f32x2 w2 = *(const f32x2*)(wp + (size_t)kk * 6144);
#pragma unroll
            for (int r = 0; r < 17; ++r) { const float a = tab[r * 128 + kk]; a0[r] += a * w2.x; a1[r] += a * w2.y; } }
        __syncthreads();
#pragma unroll
        for (int r = 0; r < 17; ++r) { tab[r * 128 + 2 * X.lane] = a0[r]; tab[r * 128 + 2 * X.lane + 1] = a1[r]; }
        __syncthreads();
        for (int idx = X.tid; idx < 17 * 128; idx += NTHR) { const int r = idx >> 7, j = idx & 127; float s = P.b_mod[l * 6144 + jc * 128 + j];
#pragma unroll
            for (int w = 0; w < 8; ++w) s += ((LAS float*)(X.L + w * 8704))[idx];
            MOD[((size_t)l * 17 + r) * 6144 + jc * 128 + j] = s; }
    }
    __syncthreads();
    f32x2* rope = (f32x2*)(P.ws + WS_ROPE);
    for (int e = X.bid * NTHR + X.tid; e < SEQ * 16; e += X.G * NTHR) { const int p = e >> 4, d = e & 15; const int row = p >> 6, col = p & 63;
        const float inv = powf(10000.f, -(float)(d & 7) / 8.f); const float ang = (float)((d < 8) ? row : col) * inv; rope[e] = (f32x2){cosf(ang), sinf(ang)}; }
    u32x4* wz = (u32x4*)((bf16_t*)(P.ws + WS_WIN) + (size_t)2496 * DM);
    for (int e = X.bid * NTHR + X.tid; e < 64 * DM * 2 / 16; e += X.G * NTHR) wz[e] = (u32x4){0u, 0u, 0u, 0u};
}

DI void cvt_item(const float* W, int ldw, int N, int k0, int n0, bf16_t* WT, int K, int row0, const float* kscale, float mul, LAS float* scr, int lane) {
#pragma unroll 8
    for (int i = 0; i < 32; ++i) { const int kk = 2 * i + (lane >> 5), n = n0 + (lane & 31);
        float v = (n < N) ? W[(size_t)(k0 + kk) * ldw + n] : 0.f; if (kscale) v *= kscale[k0 + kk];
        scr[kk * 33 + (lane & 31)] = v * mul; }
    LDS_WAIT(); asm volatile("" ::: "memory");
    const int c = lane & 7;
#pragma unroll
    for (int j = 0; j < 4; ++j) { const int nn = (lane >> 3) + 8 * j; const LAS float* s = scr + (8 * c) * 33 + nn;
        u32x4 o; o.x = pk2(s[0 * 33], s[1 * 33]); o.y = pk2(s[2 * 33], s[3 * 33]); o.z = pk2(s[4 * 33], s[5 * 33]); o.w = pk2(s[6 * 33], s[7 * 33]);
        *(u32x4*)(WT + (size_t)(row0 + nn) * K + k0 + 8 * c) = o; }
    LDS_WAIT(); asm volatile("" ::: "memory");
}
DI void convert_weights(const Params& P, Ctx& X, int l) {
    LAS float* scr = (LAS float*)(X.L + X.wave * 8704);
    const int gw = X.bid * NWAVE + X.wave, NGW = X.G * NWAVE;
    constexpr int I_IN = 16 * 78, I_OUT = 16 * 32, I_UQ = 4 * 12, I_UKV = 2 * 16, I_E = 768, NIT = I_IN + I_OUT + I_UQ + I_UKV + 16 * I_E;
    for (int it = gw; it < NIT; it += NGW) {
        int r = it;
        if (r < I_IN) { cvt_item(P.w_in + (size_t)l * DM * INW, INW, INW, 64 * (r / 78), 32 * (r % 78), (bf16_t*)(P.ws + WS_WIN), DM, 32 * (r % 78), nullptr, 1.f, scr, X.lane); continue; } r -= I_IN;
        if (r < I_OUT) { cvt_item(P.w_out + (size_t)l * DM * DM, DM, DM, 64 * (r / 32), 32 * (r % 32), (bf16_t*)(P.ws + WS_WOUT), DM, 32 * (r % 32), nullptr, 1.f, scr, X.lane); continue; } r -= I_OUT;
        if (r < I_UQ) { cvt_item(P.w_uq + (size_t)l * 256 * 384, 384, 384, 64 * (r / 12), 32 * (r % 12), (bf16_t*)(P.ws + WS_WUQ), 256, 32 * (r % 12), P.mq_g + l * 256, MLA_QS, scr, X.lane); continue; } r -= I_UQ;
        if (r < I_UKV) { cvt_item(P.w_ukv + (size_t)l * 128 * 512, 512, 512, 64 * (r / 16), 32 * (r % 16), (bf16_t*)(P.ws + WS_WUKV), 128, 32 * (r % 16), P.mkv_g + l * 128, 1.f, scr, X.lane); continue; } r -= I_UKV;
        const int e = r / I_E; r -= e * I_E;
        if (r < 256) { const int kb = r / 16, nb = r % 16;
            cvt_item(P.wg + ((size_t)l * 16 + e) * DM * 512, 512, 512, 64 * kb, 32 * nb, (bf16_t*)(P.ws + WS_WGU) + (size_t)e * 1024 * DM, DM, 256 * (nb >> 2) + 32 * (nb & 3), nullptr, 1.f, scr, X.lane); continue; } r -= 256;
        if (r < 256) { const int kb = r / 16, nb = r % 16;
            cvt_item(P.wu + ((size_t)l * 16 + e) * DM * 512, 512, 512, 64 * kb, 32 * nb, (bf16_t*)(P.ws + WS_WGU) + (size_t)e * 1024 * DM, DM, 256 * (nb >> 2) + 128 + 32 * (nb & 3), nullptr, 1.f, scr, X.lane); continue; } r -= 256;
        { const int kb = r / 32, nb = r % 32;
            cvt_item(P.wd + ((size_t)l * 16 + e) * 512 * DM, DM, DM, 64 * kb, 32 * nb, (bf16_t*)(P.ws + WS_WD) + (size_t)e * 1024 * 512, 512, 32 * nb, nullptr, 1.f, scr, X.lane); }
    }
}

DI int slot_base_lane(const unsigned* cnt, int lane) {
    int c = (lane < 16) ? (int)cnt[lane] : 0;
    int tiles = (c + 255) >> 8;
    int incl = tiles;
#pragma unroll
    for (int o = 1; o < 16; o <<= 1) { const int v = shupi(incl, o, lane); if (lane >= o) incl += v; }
    return (incl - tiles) * 256;
}

constexpr int RPC = 18;
struct RowIn { f32x4 h[4]; u32x2 y0[4], y1[4]; float w0, w1; };
DI void row_issue(const Params& P, RowIn& R, int l, int m, int sbase, const u32x4 ti, int lane) {
    const int b = m / T, t = m - b * T;
    if (l == 0) {
        const float* src = (t < CTX) ? P.ctx + ((size_t)b * CTX + t) * DM : P.x + ((size_t)b * SEQ + (t - CTX)) * DM;
#pragma unroll
        for (int j = 0; j < 4; ++j) R.h[j] = *(const f32x4*)(src + 256 * j + 4 * lane);
        R.w0 = 0.f; R.w1 = 0.f;
    } else {
        const float* hp = hrow(P, m);
        const bf16_t* YS = (const bf16_t*)(P.ws + WS_YS);
        const int s0 = shli(sbase, (int)(ti.x & 15u)) + (int)(ti.x >> 4), s1 = shli(sbase, (int)(ti.y & 15u)) + (int)(ti.y >> 4);
        const bf16_t* y0 = YS + (size_t)s0 * DM; const bf16_t* y1 = YS + (size_t)s1 * DM;
#pragma unroll
        for (int j = 0; j < 4; ++j) { const int cidx = 256 * j + 4 * lane; R.h[j] = *(const f32x4*)(hp + cidx); R.y0[j] = *(const u32x2*)(y0 + cidx); R.y1[j] = *(const u32x2*)(y1 + cidx); }
        R.w0 = __uint_as_float(ti.z); R.w1 = __uint_as_float(ti.w);
    }
}
DI float row_combine(const RowIn& R, bool comb, const f32x4 (&gp)[4], f32x4 (&v)[4]) {
    float ss = 0.f;
#pragma unroll
    for (int j = 0; j < 4; ++j) {
        if (comb) { const u32x2 a = R.y0[j], bb = R.y1[j];
            f32x4 yv; yv[0] = R.w0 * bflo(a.x) + R.w1 * bflo(bb.x); yv[1] = R.w0 * bfhi(a.x) + R.w1 * bfhi(bb.x); yv[2] = R.w0 * bflo(a.y) + R.w1 * bflo(bb.y); yv[3] = R.w0 * bfhi(a.y) + R.w1 * bfhi(bb.y);
            v[j] = R.h[j] + gp[j] * yv; }
        else v[j] = R.h[j];
        ss += v[j][0] * v[j][0] + v[j][1] * v[j][1] + v[j][2] * v[j][2] + v[j][3] * v[j][3]; }
    return ss;
}
DI void phase_norm1(const Params& P, Ctx& X, int l) {
    convert_weights(P, X, l);
    const float* MOD = (const float*)(P.ws + WS_MOD);
    bf16_t* ACT = (bf16_t*)(P.ws + WS_ACT);
    const u32x4* TOK = (const u32x4*)(P.ws + WS_TOK);
    const unsigned* cnt = (const unsigned*)(P.ws + WS_CTL) + CW_CNT + (l > 0 ? (l - 1) * 16 : 0);
    const int sbase = (l > 0) ? slot_base_lane(cnt, X.lane) : 0;
    const int gw = X.bid * NWAVE + X.wave, NGW = X.G * NWAVE, lane = X.lane;
    const float* g = P.g_mix + l * DM;
    const u32x4 tz = {0u, 0u, 0u, 0u};
    for (int ck = gw; ck < M / RPC; ck += NGW) {
        const int m0 = ck * RPC, b = m0 / T, t0 = m0 - b * T;
        int cur_cls = -1; f32x4 gs[4], sh[4], gp[4];
        RowIn cur, nxt;
        row_issue(P, cur, l, m0, sbase, (l > 0) ? TOK[m0] : tz, lane);
        u32x4 tiN = (l > 0) ? TOK[m0 + 1] : tz;
        for (int r = 0; r < RPC; ++r) {
            const int m = m0 + r, t = t0 + r, cls = (t < CTX) ? 1 : 0;
            if (r + 1 < RPC) row_issue(P, nxt, l, m + 1, sbase, tiN, lane);
            if (l > 0 && r + 2 < RPC) tiN = TOK[m + 2];
            if (cls != cur_cls) { cur_cls = cls;
                const float* mrow = MOD + ((size_t)l * 17 + (cls ? 16 : b)) * 6144;
                const float* gprev = MOD + ((size_t)(l > 0 ? l - 1 : 0) * 17 + (cls ? 16 : b)) * 6144 + 5 * DM;
#pragma unroll
                for (int j = 0; j < 4; ++j) { const int cidx = 256 * j + 4 * lane;
                    gs[j] = *(const f32x4*)(g + cidx) * (*(const f32x4*)(mrow + DM + cidx) + 1.f); sh[j] = *(const f32x4*)(mrow + cidx); gp[j] = *(const f32x4*)(gprev + cidx); } }
            f32x4 v[4];
            const float ss = row_combine(cur, l > 0, gp, v);
            float* hp = hrow(P, m);
#pragma unroll
            for (int j = 0; j < 4; ++j) *(f32x4*)(hp + 256 * j + 4 * lane) = v[j];
            const float rstd = rsqrtf(wave_sum(ss, lane) * (1.f / DM) + EPS);
#pragma unroll
            for (int j = 0; j < 4; ++j) { const f32x4 uu = v[j] * rstd * gs[j] + sh[j];
                u32x2 o; o.x = pk2(uu[0], uu[1]); o.y = pk2(uu[2], uu[3]);
                *(u32x2*)(ACT + (size_t)m * DM + 256 * j + 4 * lane) = o; }
            cur = nxt;
        }
    }
}
DI void phase_final(const Params& P, Ctx& X) {
    constexpr int RPF = 16;
    const float* MOD = (const float*)(P.ws + WS_MOD);
    const u32x4* TOK = (const u32x4*)(P.ws + WS_TOK);
    const unsigned* cnt = (const unsigned*)(P.ws + WS_CTL) + CW_CNT + 3 * 16;
    const int sbase = slot_base_lane(cnt, X.lane);
    const int gw = X.bid * NWAVE + X.wave, NGW = X.G * NWAVE, lane = X.lane;
    f32x4 fg[4];
#pragma unroll
    for (int j = 0; j < 4; ++j) fg[j] = *(const f32x4*)(P.fin_g + 256 * j + 4 * lane);
    for (int ck = gw; ck < NB * SEQ / RPF; ck += NGW) {
        const int r0 = ck * RPF, b = r0 / SEQ, m0 = b * T + CTX + (r0 - b * SEQ);
        f32x4 gp[4];
#pragma unroll
        for (int j = 0; j < 4; ++j) gp[j] = *(const f32x4*)(MOD + ((size_t)3 * 17 + b) * 6144 + 5 * DM + 256 * j + 4 * lane);
        RowIn cur, nxt;
        row_issue(P, cur, 3, m0, sbase, TOK[m0], lane);
        u32x4 tiN = TOK[m0 + 1];
        for (int r = 0; r < RPF; ++r) {
            const int m = m0 + r;
            if (r + 1 < RPF) row_issue(P, nxt, 3, m + 1, sbase, tiN, lane);
            if (r + 2 < RPF) tiN = TOK[m + 2];
            f32x4 v[4];
            const float ss = row_combine(cur, true, gp, v);
            const float rstd = rsqrtf(wave_sum(ss, lane) * (1.f / DM) + EPS);
            float* hp = P.out + (size_t)(r0 + r) * DM;
#pragma unroll
            for (int j = 0; j < 4; ++j) *(f32x4*)(hp + 256 * j + 4 * lane) = v[j] * rstd * fg[j];
            cur = nxt;
        }
    }
}

DI void phase_postproj(const Params& P, Ctx& X, int l, int sel = 15) {
    bf16_t* PROJ = (bf16_t*)(P.ws + WS_PROJ);
    const f32x2* rope = (const f32x2*)(P.ws + WS_ROPE);
    bf16_t* XBC = (bf16_t*)(P.ws + WS_XBC); float* DT = (float*)(P.ws + WS_DT);
    bf16_t* MLAQ = (bf16_t*)(P.ws + WS_MLAQ); bf16_t* MLAK = (bf16_t*)(P.ws + WS_MLAK);
    bf16_t* VTM = (bf16_t*)(P.ws + WS_VTM); bf16_t* VTD = (bf16_t*)(P.ws + WS_VTD);
    const bf16_t* WUQ = (const bf16_t*)(P.ws + WS_WUQ); const bf16_t* WUKV = (const bf16_t*)(P.ws + WS_WUKV);
    const int lane = X.lane, wave = X.wave;
    for (int u = X.bid; u < M / 144; u += X.G) {
        const int m0 = u * 144, b = m0 / T, t0 = m0 - b * T;
        __syncthreads();
        float cw[3][12], cb[12];
#pragma unroll
        for (int g3 = 0; g3 < 3; ++g3)
#pragma unroll
            for (int i = 0; i < 4; ++i) { const int ch = 256 * g3 + 4 * lane + i; cb[g3 * 4 + i] = P.conv_b[l * 768 + ch];
#pragma unroll
                for (int k = 0; k < 3; ++k) cw[k][g3 * 4 + i] = P.conv_w[((size_t)l * 3 + k) * 768 + ch]; }
        const int tw0 = t0 + wave * 18;
        const int vv = lane >> 2, d0 = 4 * (lane & 3);
        const float qs = (vv < 8) ? DA_QS : 1.f;
        struct RowRegs { u32x2 qa, qb, v; unsigned short dtr, k1, k2; };
        auto ld_row = [&](int t, RowRegs& R) { const bf16_t* prow = PROJ + ((size_t)b * T + t) * PW;
            R.qa = *(const u32x2*)(prow + vv * 32 + d0); R.qb = *(const u32x2*)(prow + vv * 32 + d0 + 16); R.v = *(const u32x2*)(prow + C_DAV + 4 * lane);
            R.dtr = prow[C_DT + (lane & 15)]; R.k1 = prow[C_KR + (lane & 15)]; R.k2 = prow[C_KR + 16 + (lane & 15)]; };
        auto ld_x = [&](int t, u32x2 (&xx)[3]) { const bool ok = (t >= 0 && t < T);
            const bf16_t* prow = PROJ + ((size_t)b * T + (ok ? t : 0)) * PW + C_XBC + 4 * lane;
#pragma unroll
            for (int g3 = 0; g3 < 3; ++g3) { xx[g3] = *(const u32x2*)(prow + 256 * g3); if (!ok) xx[g3] = (u32x2){0u, 0u}; } };
        RowRegs rc, rn; u32x2 xm[3], x0[3], xp[3], xq[3];
        ld_row(tw0, rc); ld_x(tw0 - 1, xm); ld_x(tw0, x0); ld_x(tw0 + 1, xp);
#pragma unroll 1
        for (int rr = 0; rr < ((sel & 1) ? 18 : 0); ++rr) {
            const int t = tw0 + rr; const size_t m = (size_t)b * T + t;
            if (rr + 1 < 18) ld_row(t + 1, rn);
            ld_x(t + 2, xq);
            bf16_t* prow = PROJ + m * PW;
            { const u32x2 a = rc.qa, bq = rc.qb;
              float x1[4] = {bflo(a.x), bfhi(a.x), bflo(a.y), bfhi(a.y)}, x2[4] = {bflo(bq.x), bfhi(bq.x), bflo(bq.y), bfhi(bq.y)};
              float o1[4], o2[4];
              if (t >= CTX) { const f32x2* rp = rope + (size_t)(t - CTX) * 16 + d0;
#pragma unroll
                  for (int i = 0; i < 4; ++i) { const f32x2 cs = rp[i]; o1[i] = (x1[i] * cs.x - x2[i] * cs.y) * qs; o2[i] = (x2[i] * cs.x + x1[i] * cs.y) * qs; } }
              else {
#pragma unroll
                  for (int i = 0; i < 4; ++i) { o1[i] = x1[i] * qs; o2[i] = x2[i] * qs; } }
              u32x2 w1, w2; w1.x = pk2(o1[0], o1[1]); w1.y = pk2(o1[2], o1[3]); w2.x = pk2(o2[0], o2[1]); w2.y = pk2(o2[2], o2[3]);
              bf16_t* p1 = prow + vv * 32 + d0;
              *(u32x2*)p1 = w1; *(u32x2*)(p1 + 16) = w2; }
            *(LAS u32x2*)(X.L + (size_t)(wave * 18 + rr) * 520 + lane * 8) = rc.v;
            { const int lo = (t < CTX) ? 0 : CTX, hi = (t < CTX) ? CTX : T;
              const bool hm = (t - 1 >= lo), hp = (t + 1 < hi);
#pragma unroll
              for (int g3 = 0; g3 < 3; ++g3) { const int ch = 256 * g3 + 4 * lane;
                  const u32x2 c0 = x0[g3]; u32x2 cm = xm[g3], cp = xp[g3];
                  if (!hm) cm = (u32x2){0u, 0u};
                  if (!hp) cp = (u32x2){0u, 0u};
                  const float xmv[4] = {bflo(cm.x), bfhi(cm.x), bflo(cm.y), bfhi(cm.y)}, x0v[4] = {bflo(c0.x), bfhi(c0.x), bflo(c0.y), bfhi(c0.y)}, xpv[4] = {bflo(cp.x), bfhi(cp.x), bflo(cp.y), bfhi(cp.y)};
                  float o[4];
#pragma unroll
                  for (int i = 0; i < 4; ++i) o[i] = silu(cb[g3 * 4 + i] + cw[0][g3 * 4 + i] * xmv[i] + cw[1][g3 * 4 + i] * x0v[i] + cw[2][g3 * 4 + i] * xpv[i]);
                  u32x2 w; w.x = pk2(o[0], o[1]); w.y = pk2(o[2], o[3]);
                  *(u32x2*)(XBC + m * 768 + ch) = w; } }
            if (lane < 16) { const float v = __uint_as_float(((unsigned)rc.dtr) << 16) + P.dt_bias[l * 16 + lane]; DT[m * 16 + lane] = (v > 20.f) ? v : log1pf(__expf(v)); }
            if (lane < 16) { const float x1 = __uint_as_float(((unsigned)rc.k1) << 16), x2 = __uint_as_float(((unsigned)rc.k2) << 16);
                float o1 = x1, o2 = x2;
                if (t >= CTX) { const f32x2 cs = rope[(size_t)(t - CTX) * 16 + lane]; o1 = x1 * cs.x - x2 * cs.y; o2 = x2 * cs.x + x1 * cs.y; }
                const bf16_t b1 = (bf16_t)(pk2(o1, 0.f) & 0xffffu), b2 = (bf16_t)(pk2(o2, 0.f) & 0xffffu);
#pragma unroll
                for (int h = 0; h < 4; ++h) { MLAK[(m * 4 + h) * 96 + 64 + lane] = b1; MLAK[(m * 4 + h) * 96 + 80 + lane] = b2; } }
            rc = rn;
#pragma unroll
            for (int g3 = 0; g3 < 3; ++g3) { xm[g3] = x0[g3]; x0[g3] = xp[g3]; xp[g3] = xq[g3]; }
        }
        __syncthreads();
        if (sel & 2) { const int vr = X.tid >> 1, th = X.tid & 1;
          bf16_t* dst = VTD + ((size_t)b * 256 + vr) * T + t0 + th * 72;
#pragma unroll 1
          for (int q8 = 0; q8 < 9; ++q8) { unsigned w[4];
#pragma unroll
              for (int i = 0; i < 4; ++i) { const int tt = th * 72 + q8 * 8 + 2 * i;
                  const unsigned lo = *(const LAS unsigned short*)(X.L + (size_t)tt * 520 + vr * 2), hi = *(const LAS unsigned short*)(X.L + (size_t)(tt + 1) * 520 + vr * 2);
                  w[i] = lo | (hi << 16); }
              *(u32x4*)(dst + q8 * 8) = (u32x4){w[0], w[1], w[2], w[3]}; } }
        if (sel & 4) { int lane_c = lane; asm volatile("" : "+v"(lane_c)); const int tk = lane_c & 15, q4 = lane_c >> 4;
#pragma unroll
          for (int pass = 0; pass < 2; ++pass) {
              constexpr int NCT_MAX = 2; const int nct = pass ? 2 : 1, ct0 = pass ? 1 : 0;
              bf16x8 bw[NCT_MAX][8];
#pragma unroll
              for (int ct = 0; ct < NCT_MAX; ++ct)
#pragma unroll
                  for (int s = 0; s < 8; ++s) if (ct < nct) bw[ct][s] = *(const bf16x8*)(WUQ + (size_t)((3 * wave + ct0 + ct) * 16 + tk) * 256 + 32 * s + 8 * q4);
              bf16x8 af[8], an[8];
#pragma unroll
              for (int s = 0; s < 8; ++s) af[s] = *(const bf16x8*)(PROJ + ((size_t)b * T + t0 + tk) * PW + C_CQ + 32 * s + 8 * q4);
#pragma unroll 1
              for (int rt = 0; rt < 9; ++rt) {
                  const int t = t0 + rt * 16 + tk; const size_t m = (size_t)b * T + t;
                  if (rt + 1 < 9) {
#pragma unroll
                      for (int s = 0; s < 8; ++s) an[s] = *(const bf16x8*)(PROJ + (m + 16) * PW + C_CQ + 32 * s + 8 * q4); }
                  float ss = 0.f;
#pragma unroll
                  for (int s = 0; s < 8; ++s)
#pragma unroll
                      for (int j = 0; j < 8; ++j) { const float f = __uint_as_float(((unsigned)(unsigned short)af[s][j]) << 16); ss += f * f; }
                  ss += shx(ss, 16, lane); ss += shx(ss, 32, lane);
                  const float rstd = rsqrtf(ss * (1.f / 256.f) + EPS);
                  f32x4 acc[NCT_MAX];
#pragma unroll
                  for (int ct = 0; ct < NCT_MAX; ++ct) if (ct < nct) { acc[ct] = (f32x4){0.f, 0.f, 0.f, 0.f};
#pragma unroll
                      for (int s = 0; s < 8; ++s) acc[ct] = MFMA16(bw[ct][s], af[s], acc[ct]);
                      acc[ct] = acc[ct] * rstd; }
                  if (pass && (wave & 1) && t >= CTX) {
                      const f32x2* rp = rope + (size_t)(t - CTX) * 16 + 4 * q4;
#pragma unroll
                      for (int i = 0; i < 4; ++i) { const f32x2 cs = rp[i]; const float x1 = acc[0][i], x2 = acc[1][i]; acc[0][i] = x1 * cs.x - x2 * cs.y; acc[1][i] = x2 * cs.x + x1 * cs.y; } }
#pragma unroll
                  for (int ct = 0; ct < NCT_MAX; ++ct) if (ct < nct) { u32x2 w; w.x = pk2(acc[ct][0], acc[ct][1]); w.y = pk2(acc[ct][2], acc[ct][3]);
                      *(u32x2*)(MLAQ + m * 384 + (3 * wave + ct0 + ct) * 16 + 4 * q4) = w; }
#pragma unroll
                  for (int s = 0; s < 8; ++s) af[s] = an[s];
              }
          }
        }
        if (sel & 8) { const int tk = lane & 15, q4 = lane >> 4, hh = wave >> 1;
          bf16x8 bw[4][4];
#pragma unroll
          for (int ct = 0; ct < 4; ++ct)
#pragma unroll
              for (int s = 0; s < 4; ++s) bw[ct][s] = *(const bf16x8*)(WUKV + (size_t)((4 * wave + ct) * 16 + tk) * 128 + 32 * s + 8 * q4);
          bf16x8 af[4], an[4];
#pragma unroll
          for (int s = 0; s < 4; ++s) af[s] = *(const bf16x8*)(PROJ + ((size_t)b * T + t0 + tk) * PW + C_CKV + 32 * s + 8 * q4);
#pragma unroll 1
          for (int rt = 0; rt < 9; ++rt) {
              const int t = t0 + rt * 16 + tk; const size_t m = (size_t)b * T + t;
              if (rt + 1 < 9) {
#pragma unroll
                  for (int s = 0; s < 4; ++s) an[s] = *(const bf16x8*)(PROJ + (m + 16) * PW + C_CKV + 32 * s + 8 * q4); }
              float ss = 0.f;
#pragma unroll
              for (int s = 0; s < 4; ++s)
#pragma unroll
                  for (int j = 0; j < 8; ++j) { const float f = __uint_as_float(((unsigned)(unsigned short)af[s][j]) << 16); ss += f * f; }
              ss += shx(ss, 16, lane); ss += shx(ss, 32, lane);
              const float rstd = rsqrtf(ss * (1.f / 128.f) + EPS);
              if ((wave & 1) == 0) {
#pragma unroll
                  for (int ct = 0; ct < 4; ++ct) { f32x4 acc = {0.f, 0.f, 0.f, 0.f};
#pragma unroll
                      for (int s = 0; s < 4; ++s) acc = MFMA16(bw[ct][s], af[s], acc);
                      acc = acc * rstd;
                      u32x2 w; w.x = pk2(acc[0], acc[1]); w.y = pk2(acc[2], acc[3]);
                      *(u32x2*)(MLAK + (m * 4 + hh) * 96 + ct * 16 + 4 * q4) = w; }
              } else {
                  float rs[4];
#pragma unroll
                  for (int i = 0; i < 4; ++i) rs[i] = shl(rstd, 4 * q4 + i);
#pragma unroll
                  for (int ct = 0; ct < 4; ++ct) { f32x4 acc = {0.f, 0.f, 0.f, 0.f};
#pragma unroll
                      for (int s = 0; s < 4; ++s) acc = MFMA16(af[s], bw[ct][s], acc);
                      u32x2 w; w.x = pk2(acc[0] * rs[0], acc[1] * rs[1]); w.y = pk2(acc[2] * rs[2], acc[3] * rs[3]);
                      *(u32x2*)(VTM + (((size_t)b * 4 + hh) * 64 + ct * 16 + tk) * T + t0 + rt * 16 + 4 * q4) = w; }
              }
#pragma unroll
              for (int s = 0; s < 4; ++s) af[s] = an[s];
          }
        }
    }
}

template <int KIND>
DI void attn_unit(const Params& P, Ctx& X, int l, int b, int h, int qt, float lam, float lam_init) {
    constexpr int DK = KIND ? 96 : 64, KROW = DK * 2 + 16, NS = KIND ? 6 : 2;
    constexpr int KBUF = 64 * KROW, VROW = 136, VBUF = 64 * VROW;
    constexpr int OFF_K = 0, OFF_V = 2 * KBUF, OFF_X = 36864;
    const bf16_t* PROJ = (const bf16_t*)(P.ws + WS_PROJ);
    const bf16_t* MLAQ = (const bf16_t*)(P.ws + WS_MLAQ); const bf16_t* MLAK = (const bf16_t*)(P.ws + WS_MLAK);
    const bf16_t* VT = (const bf16_t*)(P.ws + (KIND ? WS_VTM : WS_VTD)) + ((size_t)b * 4 + h) * 64 * T;
    bf16_t* ACT = (bf16_t*)(P.ws + WS_ACT);
    const int tid = X.tid, lane = X.lane, wave = X.wave, r = lane & 31, hh = lane >> 5;
    const int mmw = KIND ? 0 : (wave & 1), qg = KIND ? wave : (wave >> 1);
    const bool is_ctx = KIND ? (qt == 0) : (qt < 2);
    const int nk = is_ctx ? CTX : T, ntile = nk / 64;
    const size_t mrow = (size_t)b * T + qt * (KIND ? 256 : 128) + qg * 32 + r;
    bf16x8 qf[NS];
#pragma unroll
    for (int s = 0; s < NS; ++s)
        qf[s] = KIND ? *(const bf16x8*)(MLAQ + mrow * 384 + h * 96 + 16 * s + 8 * hh) : *(const bf16x8*)(PROJ + mrow * PW + C_DAQ + h * 64 + mmw * 32 + 16 * s + 8 * hh);
    const int kcol = mmw * 64 + 16 * hh;
    const int kkey = KIND ? (tid / 12) : (tid >> 3), kpc = KIND ? (tid % 12) : (tid & 7);
    const int kkey2 = (512 + tid) / 12, kpc2 = (512 + tid) % 12;
    const int vdv = tid >> 3, vpc = tid & 7;
    u32x4 kr0, kr1 = {0u, 0u, 0u, 0u}, vr0;
    auto gload = [&](int it) {
        const int key0 = it * 64;
        if (KIND) { kr0 = *(const u32x4*)(MLAK + (((size_t)b * T + key0 + kkey) * 4 + h) * 96 + kpc * 8);
                    if (tid < 256) kr1 = *(const u32x4*)(MLAK + (((size_t)b * T + key0 + kkey2) * 4 + h) * 96 + kpc2 * 8); }
        else kr0 = *(const u32x4*)(PROJ + ((size_t)b * T + key0 + kkey) * PW + C_DAK + h * 64 + kpc * 8);
        vr0 = *(const u32x4*)(VT + (size_t)vdv * T + key0 + vpc * 8);
    };
    auto lstore = [&](int buf) {
        *(LAS u32x4*)(X.L + OFF_K + buf * KBUF + kkey * KROW + kpc * 16) = kr0;
        if (KIND && tid < 256) *(LAS u32x4*)(X.L + OFF_K + buf * KBUF + kkey2 * KROW + kpc2 * 16) = kr1;
        LAS unsigned char* vp = X.L + OFF_V + buf * VBUF + vdv * VROW + vpc * 16;
        *(LAS u32x2*)vp = (u32x2){vr0.x, vr0.y}; *(LAS u32x2*)(vp + 8) = (u32x2){vr0.z, vr0.w};
    };
    f32x16 O[2]; float mrun = -1e30f, lsum = 0.f;
#pragma unroll
    for (int d = 0; d < 2; ++d)
#pragma unroll
        for (int i = 0; i < 16; ++i) O[d][i] = 0.f;
    __syncthreads();
    gload(0); lstore(0);
    __syncthreads();
    for (int it = 0; it < ntile; ++it) {
        const int buf = it & 1;
        if (it + 1 < ntile) gload(it + 1);
        const LAS unsigned char* Kb = X.L + OFF_K + buf * KBUF; const LAS unsigned char* Vb = X.L + OFF_V + buf * VBUF;
        f32x16 S0, S1;
#pragma unroll
        for (int i = 0; i < 16; ++i) { S0[i] = 0.f; S1[i] = 0.f; }
#pragma unroll
        for (int s = 0; s < NS; ++s) {
            const bf16x8 k0 = *(const LAS bf16x8*)(Kb + r * KROW + kcol + 32 * s);
            const bf16x8 k1 = *(const LAS bf16x8*)(Kb + (32 + r) * KROW + kcol + 32 * s);
            S0 = MFMA32(k0, qf[s], S0); S1 = MFMA32(k1, qf[s], S1);
        }
        float mx = S0[0];
#pragma unroll
        for (int i = 1; i < 16; ++i) mx = fmaxf(mx, S0[i]);
#pragma unroll
        for (int i = 0; i < 16; ++i) mx = fmaxf(mx, S1[i]);
        mx = fmaxf(mx, shx(mx, 32, lane));
        const float mnew = fmaxf(mrun, mx), alpha = fexp2(mrun - mnew);
        mrun = mnew;
        float ps = 0.f;
#pragma unroll
        for (int i = 0; i < 16; ++i) { S0[i] = fexp2(S0[i] - mnew); S1[i] = fexp2(S1[i] - mnew); ps += S0[i] + S1[i]; }
        lsum = lsum * alpha + ps;
#pragma unroll
        for (int d = 0; d < 2; ++d)
#pragma unroll
            for (int i = 0; i < 16; ++i) O[d][i] *= alpha;
        bf16x8 pf[2][2];
#pragma unroll
        for (int s = 0; s < 2; ++s) {
            u32x4 w0, w1;
            w0.x = pk2(S0[8 * s + 0], S0[8 * s + 1]); w0.y = pk2(S0[8 * s + 2], S0[8 * s + 3]); w0.z = pk2(S0[8 * s + 4], S0[8 * s + 5]); w0.w = pk2(S0[8 * s + 6], S0[8 * s + 7]);
            w1.x = pk2(S1[8 * s + 0], S1[8 * s + 1]); w1.y = pk2(S1[8 * s + 2], S1[8 * s + 3]); w1.z = pk2(S1[8 * s + 4], S1[8 * s + 5]); w1.w = pk2(S1[8 * s + 6], S1[8 * s + 7]);
            pf[0][s] = __builtin_bit_cast(bf16x8, w0); pf[1][s] = __builtin_bit_cast(bf16x8, w1);
        }
#pragma unroll
        for (int d = 0; d < 2; ++d)
#pragma unroll
            for (int kb = 0; kb < 2; ++kb)
#pragma unroll
                for (int s = 0; s < 2; ++s) {
                    const LAS unsigned char* vp = Vb + (32 * d + r) * VROW + (32 * kb + 16 * s + 4 * hh) * 2;
                    const s16x4 lo = *(const LAS s16x4*)vp, hi = *(const LAS s16x4*)(vp + 16);
                    const bf16x8 vf = __builtin_shufflevector(lo, hi, 0, 1, 2, 3, 4, 5, 6, 7);
                    O[d] = MFMA32(vf, pf[kb][s], O[d]);
                }
        if (it + 1 < ntile) lstore(buf ^ 1);
        __syncthreads();
    }
    const float inv = 1.f / (lsum + shx(lsum, 32, lane));
    if (KIND == 0) {
        LAS float* xb = (LAS float*)(X.L + OFF_X) + qg * 2048 + lane;
        if (mmw == 1) {
#pragma unroll
            for (int d = 0; d < 2; ++d)
#pragma unroll
                for (int i = 0; i < 16; ++i) xb[(d * 16 + i) * 64] = O[d][i] * inv;
        }
        __syncthreads();
        if (mmw == 0) {
            float ss = 0.f;
#pragma unroll
            for (int d = 0; d < 2; ++d)
#pragma unroll
                for (int i = 0; i < 16; ++i) { const float o = O[d][i] * inv - lam * xb[(d * 16 + i) * 64]; O[d][i] = o; ss += o * o; }
            ss += shx(ss, 32, lane);
            const float rstd = rsqrtf(ss * (1.f / 64.f) + EPS) * (1.f - lam_init);
#pragma unroll
            for (int d = 0; d < 2; ++d)
#pragma unroll
                for (int g4 = 0; g4 < 4; ++g4) { const int dv = 32 * d + 8 * g4 + 4 * hh; const f32x4 gg = *(const f32x4*)(P.da_g + l * 64 + dv);
                    u32x2 w; w.x = pk2(O[d][4 * g4] * rstd * gg[0], O[d][4 * g4 + 1] * rstd * gg[1]); w.y = pk2(O[d][4 * g4 + 2] * rstd * gg[2], O[d][4 * g4 + 3] * rstd * gg[3]);
                    *(u32x2*)(ACT + mrow * DM + h * 64 + dv) = w; }
        }
    } else {
#pragma unroll
        for (int d = 0; d < 2; ++d)
#pragma unroll
            for (int g4 = 0; g4 < 4; ++g4) { const int dv = 32 * d + 8 * g4 + 4 * hh;
                u32x2 w; w.x = pk2(O[d][4 * g4] * inv, O[d][4 * g4 + 1] * inv); w.y = pk2(O[d][4 * g4 + 2] * inv, O[d][4 * g4 + 3] * inv);
                *(u32x2*)(ACT + mrow * DM + 768 + h * 64 + dv) = w; }
    }
}

DI void ssd_unit(const Params& P, Ctx& X, int l, int b, int hd, int dir) {
    constexpr int OFF_BR = 0, OFF_CR = 18432, OFF_XT = 36864, OFF_XS = 53760, OFF_BT = 71168, OFF_SB = 88576, OFF_AC = 98304, OFF_DTT = 98816;
    const bf16_t* XBC = (const bf16_t*)(P.ws + WS_XBC); const float* DT = (const float*)(P.ws + WS_DT);
    bf16_t* Y = (bf16_t*)(P.ws + (dir ? WS_YB : WS_YF));
    const int tid = X.tid, lane = X.lane, wave = X.wave, r = lane & 31, hh = lane >> 5, grp = hd >> 2;
    const float a = -__expf(P.a_log[l * 16 + dir * 8 + hd]);
    LAS unsigned char* L = X.L;
    LAS float* t_ac = (LAS float*)(L + OFF_AC); LAS float* t_dt = (LAS float*)(L + OFF_DTT);
    f32x4 Sacc[2] = {{0.f, 0.f, 0.f, 0.f}, {0.f, 0.f, 0.f, 0.f}};
    const size_t rb = (size_t)b * T;
    const int tau = tid >> 2, q2 = tid & 3;
    const int tq = tid & 31, pg = tid >> 5;
    u32x4 br[2], cr[2]; u32x2 xt[4], bt[4]; float dt0, dt1;
    auto chunk_tok = [&](int c, int& tbase, int& tstep) { const int seg0 = (c < 2) ? 0 : CTX, seg1 = (c < 2) ? CTX : T, cc = (c < 2) ? c : c - 2;
        tbase = dir ? (seg1 - 1 - 128 * cc) : (seg0 + 128 * cc); tstep = dir ? -1 : 1; };
    auto issue = [&](int c) { int tbase, tstep; chunk_tok(c, tbase, tstep);
        const bf16_t* rowp = XBC + (rb + tbase + tstep * tau) * 768;
#pragma unroll
        for (int k = 0; k < 2; ++k) { const int pc = 2 * q2 + k; br[k] = *(const u32x4*)(rowp + 512 + grp * 64 + 8 * pc); cr[k] = *(const u32x4*)(rowp + 640 + grp * 64 + 8 * pc); }
#pragma unroll
        for (int i = 0; i < 4; ++i) { const bf16_t* rp = XBC + (rb + tbase + tstep * (4 * tq + i)) * 768; xt[i] = *(const u32x2*)(rp + hd * 64 + 4 * pg); bt[i] = *(const u32x2*)(rp + 512 + grp * 64 + 4 * pg); }
        dt0 = DT[(rb + tbase + tstep * (2 * lane)) * 16 + dir * 8 + hd]; dt1 = DT[(rb + tbase + tstep * (2 * lane + 1)) * 16 + dir * 8 + hd]; };
    issue(0);
    __syncthreads();
    for (int c = 0; c < 18; ++c) {
        int tbase, tstep; chunk_tok(c, tbase, tstep);
        const float v0 = dt0 * a, v1 = dt1 * a, s2 = v0 + v1; float incl = s2;
#pragma unroll
        for (int o = 1; o < 64; o <<= 1) { const float v = shup(incl, o, lane); if (lane >= o) incl += v; }
        const float ac0 = incl - s2 + v0, ac1 = incl;
        const float alast = shl(incl, 63);
        if (wave == 0) { *(LAS f32x2*)(t_ac + 2 * lane) = (f32x2){ac0, ac1}; *(LAS f32x2*)(t_dt + 2 * lane) = (f32x2){dt0, dt1}; }
        {
#pragma unroll
            for (int k = 0; k < 2; ++k) { const int pc = 2 * q2 + k;
                *(LAS u32x4*)(L + OFF_BR + tau * 144 + pc * 16) = br[k]; *(LAS u32x4*)(L + OFF_CR + tau * 144 + pc * 16) = cr[k]; }
            float wj[4];
#pragma unroll
            for (int i = 0; i < 4; ++i) { const int tk = 4 * tq + i, src = tk >> 1;
                const float a_t = (i & 1) ? shl(ac1, src) : shl(ac0, src), d_t = (i & 1) ? shl(dt1, src) : shl(dt0, src);
                wj[i] = __expf(alast - a_t) * d_t; }
            float xe[4][4]; unsigned short be[4][4];
#pragma unroll
            for (int i = 0; i < 4; ++i) { xe[i][0] = bflo(xt[i].x); xe[i][1] = bfhi(xt[i].x); xe[i][2] = bflo(xt[i].y); xe[i][3] = bfhi(xt[i].y);
                be[i][0] = (unsigned short)(bt[i].x & 0xffffu); be[i][1] = (unsigned short)(bt[i].x >> 16); be[i][2] = (unsigned short)(bt[i].y & 0xffffu); be[i][3] = (unsigned short)(bt[i].y >> 16); }
#pragma unroll
            for (int f = 0; f < 4; ++f) { const int p = 4 * pg + f;
                u32x2 w; w.x = pk2(xe[0][f], xe[1][f]); w.y = pk2(xe[2][f], xe[3][f]);
                *(LAS u32x2*)(L + OFF_XT + p * 264 + tq * 8) = w;
                w.x = pk2(xe[0][f] * wj[0], xe[1][f] * wj[1]); w.y = pk2(xe[2][f] * wj[2], xe[3][f] * wj[3]);
                *(LAS u32x2*)(L + OFF_XS + p * 272 + tq * 8) = w;
                w.x = (unsigned)be[0][f] | ((unsigned)be[1][f] << 16); w.y = (unsigned)be[2][f] | ((unsigned)be[3][f] << 16);
                *(LAS u32x2*)(L + OFF_BT + p * 272 + tq * 8) = w; }
#pragma unroll
            for (int k = 0; k < 2; ++k) { const int tl = 2 * wave + k, pt = tl >> 2, nt = tl & 3, n = 16 * nt + (lane & 15), p = 16 * pt + 4 * (lane >> 4);
#pragma unroll
                for (int i = 0; i < 4; ++i) *(LAS unsigned short*)(L + OFF_SB + (p + i) * 144 + n * 2) = (unsigned short)(pk2(Sacc[k][i], 0.f) & 0xffffu); }
        }
        __syncthreads();
        if (c + 1 < 18) issue(c + 1);
        {
            const int ib = wave >> 1, pb = wave & 1, i_tok = 32 * ib + r;
            const float acum_i = t_ac[i_tok];
            bf16x8 cf[4];
#pragma unroll
            for (int s = 0; s < 4; ++s) cf[s] = *(const LAS bf16x8*)(L + OFF_CR + i_tok * 144 + (16 * s + 8 * hh) * 2);
            f32x16 accO, accD;
#pragma unroll
            for (int i = 0; i < 16; ++i) { accO[i] = 0.f; accD[i] = 0.f; }
#pragma unroll
            for (int s = 0; s < 4; ++s) { const bf16x8 sa = *(const LAS bf16x8*)(L + OFF_SB + (32 * pb + r) * 144 + (16 * s + 8 * hh) * 2); accO = MFMA32(sa, cf[s], accO); }
            for (int jb = 0; jb <= ib; ++jb) {
                f32x16 g;
#pragma unroll
                for (int i = 0; i < 16; ++i) g[i] = 0.f;
#pragma unroll
                for (int s = 0; s < 4; ++s) { const bf16x8 ba = *(const LAS bf16x8*)(L + OFF_BR + (32 * jb + r) * 144 + (16 * s + 8 * hh) * 2); g = MFMA32(ba, cf[s], g); }
#pragma unroll
                for (int g4 = 0; g4 < 4; ++g4) { const int j0 = 32 * jb + 8 * g4 + 4 * hh;
                    const f32x4 aj = *(const LAS f32x4*)(L + OFF_AC + j0 * 4), dj = *(const LAS f32x4*)(L + OFF_DTT + j0 * 4);
#pragma unroll
                    for (int i = 0; i < 4; ++i) { const float arg = fminf(acum_i - aj[i], 0.f); const float wv = __expf(arg) * dj[i] * g[4 * g4 + i]; g[4 * g4 + i] = (j0 + i <= i_tok) ? wv : 0.f; } }
#pragma unroll
                for (int s = 0; s < 2; ++s) {
                    u32x4 w; w.x = pk2(g[8 * s + 0], g[8 * s + 1]); w.y = pk2(g[8 * s + 2], g[8 * s + 3]); w.z = pk2(g[8 * s + 4], g[8 * s + 5]); w.w = pk2(g[8 * s + 6], g[8 * s + 7]);
                    const bf16x8 wf = __builtin_bit_cast(bf16x8, w);
                    const LAS unsigned char* xp = L + OFF_XT + (32 * pb + r) * 264 + (32 * jb + 16 * s + 4 * hh) * 2;
                    const s16x4 lo = *(const LAS s16x4*)xp, hi = *(const LAS s16x4*)(xp + 16);
                    const bf16x8 xf = __builtin_shufflevector(lo, hi, 0, 1, 2, 3, 4, 5, 6, 7);
                    accD = MFMA32(xf, wf, accD);
                }
            }
            const float ei = __expf(acum_i);
            bf16_t* yp = Y + (rb + tbase + tstep * i_tok) * 512 + hd * 64 + 32 * pb + 4 * hh;
#pragma unroll
            for (int g4 = 0; g4 < 4; ++g4) { u32x2 w; w.x = pk2(accD[4 * g4] + ei * accO[4 * g4], accD[4 * g4 + 1] + ei * accO[4 * g4 + 1]); w.y = pk2(accD[4 * g4 + 2] + ei * accO[4 * g4 + 2], accD[4 * g4 + 3] + ei * accO[4 * g4 + 3]);
                *(u32x2*)(yp + 8 * g4) = w; }
        }
        {
            const float dec = __expf(alast);
#pragma unroll
            for (int k = 0; k < 2; ++k) { const int tl = 2 * wave + k, pt = tl >> 2, nt = tl & 3;
                f32x4 acc = Sacc[k] * dec;
#pragma unroll
                for (int s = 0; s < 4; ++s) {
                    const bf16x8 xa = *(const LAS bf16x8*)(L + OFF_XS + (16 * pt + (lane & 15)) * 272 + (32 * s + 8 * (lane >> 4)) * 2);
                    const bf16x8 bb = *(const LAS bf16x8*)(L + OFF_BT + (16 * nt + (lane & 15)) * 272 + (32 * s + 8 * (lane >> 4)) * 2);
                    acc = MFMA16(xa, bb, acc); }
                Sacc[k] = acc; }
        }
        __syncthreads();
    }
}

DI void phase_mixers(const Params& P, Ctx& X, int l, int sel = 7) {
    const float lam_init = 0.8f - 0.6f * __expf(-0.3f * (float)l);
    float l01 = 0.f, l23 = 0.f;
    if (X.lane < 32) { const float* lv = P.da_lam + l * 128; l01 = lv[X.lane] * lv[32 + X.lane]; l23 = lv[64 + X.lane] * lv[96 + X.lane]; }
    const float lam = __expf(wave_sum(l01, X.lane)) - __expf(wave_sum(l23, X.lane)) + lam_init;
    if (sel & 1) for (int u = X.bid; u < NB * 8 * 2; u += X.G) ssd_unit(P, X, l, u >> 4, (u >> 1) & 7, u & 1);
    if (sel & 2) for (int u = X.bid; u < 1024; u += X.G) attn_unit<0>(P, X, l, u >> 6, (u >> 4) & 3, 2 + (u & 15), lam, lam_init);
    if (sel & 4) for (int u = X.bid; u < 512; u += X.G) attn_unit<1>(P, X, l, u >> 5, (u >> 3) & 3, 1 + (u & 7), lam, lam_init);
    for (int u = X.bid; u < 192; u += X.G) { if (u < 128) { if (sel & 2) attn_unit<0>(P, X, l, u >> 3, (u >> 1) & 3, u & 1, lam, lam_init); } else { if (sel & 4) attn_unit<1>(P, X, l, (u - 128) >> 2, u & 3, 0, lam, lam_init); } }
}

DI void phase_ssdgate(const Params& P, Ctx& X, int l) {
    const bf16_t* PROJ = (const bf16_t*)(P.ws + WS_PROJ); const bf16_t* XBC = (const bf16_t*)(P.ws + WS_XBC);
    const bf16_t* YF = (const bf16_t*)(P.ws + WS_YF); const bf16_t* YB = (const bf16_t*)(P.ws + WS_YB);
    bf16_t* ACT = (bf16_t*)(P.ws + WS_ACT);
    const int gw = X.bid * NWAVE + X.wave, NGW = X.G * NWAVE, c0 = 8 * X.lane;
    const float dsk = P.ssd_d[l * 8 + (X.lane >> 3)];
    const f32x4 g0 = *(const f32x4*)(P.ssd_g + l * 512 + c0), g1 = *(const f32x4*)(P.ssd_g + l * 512 + c0 + 4);
    for (int m = gw; m < M; m += NGW) {
        const u32x4 yf = *(const u32x4*)(YF + (size_t)m * 512 + c0), yb = *(const u32x4*)(YB + (size_t)m * 512 + c0), xv = *(const u32x4*)(XBC + (size_t)m * 768 + c0), zv = *(const u32x4*)(PROJ + (size_t)m * PW + C_Z + c0);
        const unsigned yfw[4] = {yf.x, yf.y, yf.z, yf.w}, ybw[4] = {yb.x, yb.y, yb.z, yb.w}, xw[4] = {xv.x, xv.y, xv.z, xv.w}, zw[4] = {zv.x, zv.y, zv.z, zv.w};
        float v[8]; float ss = 0.f;
#pragma unroll
        for (int i = 0; i < 4; ++i) {
            v[2 * i] = (bflo(yfw[i]) + bflo(ybw[i]) + dsk * bflo(xw[i])) * silu(bflo(zw[i]));
            v[2 * i + 1] = (bfhi(yfw[i]) + bfhi(ybw[i]) + dsk * bfhi(xw[i])) * silu(bfhi(zw[i]));
            ss += v[2 * i] * v[2 * i] + v[2 * i + 1] * v[2 * i + 1]; }
        const float rstd = rsqrtf(wave_sum(ss, X.lane) * (1.f / 512.f) + EPS);
        u32x4 w; w.x = pk2(v[0] * rstd * g0[0], v[1] * rstd * g0[1]); w.y = pk2(v[2] * rstd * g0[2], v[3] * rstd * g0[3]); w.z = pk2(v[4] * rstd * g1[0], v[5] * rstd * g1[1]); w.w = pk2(v[6] * rstd * g1[2], v[7] * rstd * g1[3]);
        *(u32x4*)(ACT + (size_t)m * DM + 256 + c0) = w;
    }
}

DI float reduce16(const float (&lg)[16], int lane) {
    float x8[8], x4[4], x2[2];
    const bool b3 = (lane & 8) != 0, b2 = (lane & 4) != 0, b1 = (lane & 2) != 0, b0 = (lane & 1) != 0;
#pragma unroll
    for (int i = 0; i < 8; ++i) { const float keep = b3 ? lg[i + 8] : lg[i], send = b3 ? lg[i] : lg[i + 8]; x8[i] = keep + shx(send, 8, lane); }
#pragma unroll
    for (int i = 0; i < 4; ++i) { const float keep = b2 ? x8[i + 4] : x8[i], send = b2 ? x8[i] : x8[i + 4]; x4[i] = keep + shx(send, 4, lane); }
#pragma unroll
    for (int i = 0; i < 2; ++i) { const float keep = b1 ? x4[i + 2] : x4[i], send = b1 ? x4[i] : x4[i + 2]; x2[i] = keep + shx(send, 2, lane); }
    const float keep = b0 ? x2[1] : x2[0], send = b0 ? x2[0] : x2[1];
    float x = keep + shx(send, 1, lane);
    x += shx(x, 16, lane); x += shx(x, 32, lane);
    return x;
}
DI void route_select(float x, float rbias, int lane, int& i1, int& i2, float& w1, float& w2) {
    const float aff = 1.f / (1.f + expf(-x)), sel = aff + rbias;
    const float q1 = shx(sel, 1, lane), q2 = shx(sel, 2, lane), q3 = shx(sel, 3, lane);
    const float hi1 = fmaxf(sel, q1), lo1 = fminf(sel, q1), hi2 = fmaxf(q2, q3), lo2 = fminf(q2, q3);
    const float gs = fmaxf(hi1, hi2) + fmaxf(fminf(hi1, hi2), fmaxf(lo1, lo2));
    const float g0 = shl(gs, 0), g1 = shl(gs, 4), g2 = shl(gs, 8), g3 = shl(gs, 12);
    int best = 0; float bs = g0;
    if (g1 > bs) { bs = g1; best = 1; }
    if (g2 > bs) { bs = g2; best = 2; }
    if (g3 > bs) { bs = g3; best = 3; }
    int j1 = 0, j2 = 0; float v1 = -1e30f, v2 = -1e30f, a1 = 0.f, a2 = 0.f;
#pragma unroll
    for (int j = 0; j < 4; ++j) { const float s = shl(sel, 4 * best + j), a = shl(aff, 4 * best + j);
        if (s > v1) { v2 = v1; j2 = j1; a2 = a1; v1 = s; j1 = j; a1 = a; } else if (s > v2) { v2 = s; j2 = j; a2 = a; } }
    i1 = 4 * best + j1; i2 = 4 * best + j2; w1 = a1 / (a1 + a2); w2 = a2 / (a1 + a2);
}
DI void phase_norm2_route(const Params& P, Ctx& X, int l) {
    const float* MOD = (const float*)(P.ws + WS_MOD);
    bf16_t* ACT = (bf16_t*)(P.ws + WS_ACT);
    u32x4* TOK = (u32x4*)(P.ws + WS_TOK); int* LIST = (int*)(P.ws + WS_LIST);
    unsigned* cnt = (unsigned*)(P.ws + WS_CTL) + CW_CNT + l * 16;
    const int lane = X.lane;
    constexpr int RPW = 36;
    LAS unsigned* lcnt = (LAS unsigned*)(X.L + 65536); LAS unsigned* lbase = lcnt + 16; LAS unsigned* ltab = lcnt + 64;
    __syncthreads();
    for (int k = X.tid; k < DM; k += NTHR) { const int j = k >> 8, ln = (k >> 2) & 63, i = k & 3, slot = (4 * j + i) * 64 + ln;
#pragma unroll
        for (int e4 = 0; e4 < 4; ++e4) *(LAS f32x4*)(X.L + ((size_t)e4 * 1024 + slot) * 16) = *(const f32x4*)(P.r_w + k * 16 + 4 * e4); }
    if (X.tid < 32) lcnt[X.tid] = 0u;
    __syncthreads();
    const float rbias = P.r_b[lane & 15];
    const int gw = X.bid * NWAVE + X.wave, NGW = X.G * NWAVE;
    const float* g = P.g_ffn + l * DM;
    int it = 0;
    for (int ck = gw; ck < M / RPC; ck += NGW, ++it) {
        const int m0 = ck * RPC, b = m0 / T, t0 = m0 - b * T;
        int cur_cls = -1; f32x4 gs[4], sh[4];
        f32x4 c0[4], n0[4];
        { const float* h0 = hrow(P, m0);
#pragma unroll
          for (int j = 0; j < 4; ++j) c0[j] = *(const f32x4*)(h0 + 256 * j + 4 * lane); }
#pragma unroll 1
        for (int r = 0; r < RPC; ++r) {
            const int m = m0 + r, t = t0 + r, cls = (t < CTX) ? 1 : 0;
            if (r + 1 < RPC) { const float* h0 = hrow(P, m + 1);
#pragma unroll
                for (int j = 0; j < 4; ++j) n0[j] = *(const f32x4*)(h0 + 256 * j + 4 * lane); }
            if (!(l == DEPTH - 1 && cls)) {
                if (cls != cur_cls) { cur_cls = cls;
                    const float* mrow = MOD + ((size_t)l * 17 + (cls ? 16 : b)) * 6144;
#pragma unroll
                    for (int j = 0; j < 4; ++j) { const int cidx = 256 * j + 4 * lane;
                        gs[j] = *(const f32x4*)(g + cidx) * (*(const f32x4*)(mrow + 4 * DM + cidx) + 1.f); sh[j] = *(const f32x4*)(mrow + 3 * DM + cidx); } }
                float s0 = 0.f;
#pragma unroll
                for (int j = 0; j < 4; ++j) s0 += c0[j][0] * c0[j][0] + c0[j][1] * c0[j][1] + c0[j][2] * c0[j][2] + c0[j][3] * c0[j][3];
                const float r0 = rsqrtf(wave_sum(s0, lane) * (1.f / DM) + EPS);
                float lg0[16];
#pragma unroll
                for (int e = 0; e < 16; ++e) lg0[e] = 0.f;
#pragma unroll
                for (int j = 0; j < 4; ++j) { const int cidx = 256 * j + 4 * lane;
                    const f32x4 u0 = c0[j] * r0 * gs[j] + sh[j];
                    u32x2 o; o.x = pk2(u0[0], u0[1]); o.y = pk2(u0[2], u0[3]); *(u32x2*)(ACT + (size_t)m * DM + cidx) = o;
#pragma unroll
                    for (int i = 0; i < 4; ++i) { const int slot = (4 * j + i) * 64 + lane;
#pragma unroll
                        for (int e4 = 0; e4 < 4; ++e4) { const f32x4 rw = *(const LAS f32x4*)(X.L + ((size_t)e4 * 1024 + slot) * 16);
                            lg0[4 * e4] += u0[i] * rw[0]; lg0[4 * e4 + 1] += u0[i] * rw[1]; lg0[4 * e4 + 2] += u0[i] * rw[2]; lg0[4 * e4 + 3] += u0[i] * rw[3]; } } }
                int a1, a2; float wa1, wa2;
                route_select(reduce16(lg0, lane), rbias, lane, a1, a2, wa1, wa2);
                if (lane == 0) {
                    LAS unsigned* rec = ltab + (X.wave * RPW + it * RPC + r) * 4;
                    const unsigned ra1 = __hip_atomic_fetch_add(lcnt + a1, 1u, __ATOMIC_RELAXED, __HIP_MEMORY_SCOPE_WORKGROUP), ra2 = __hip_atomic_fetch_add(lcnt + a2, 1u, __ATOMIC_RELAXED, __HIP_MEMORY_SCOPE_WORKGROUP);
                    rec[0] = (unsigned)a1 | (ra1 << 4); rec[1] = (unsigned)a2 | (ra2 << 4); rec[2] = __float_as_uint(wa1); rec[3] = __float_as_uint(wa2);
                }
            }
#pragma unroll
            for (int j = 0; j < 4; ++j) c0[j] = n0[j];
        }
    }
    __syncthreads();
    if (X.tid < 16) { const unsigned c = lcnt[X.tid]; lbase[X.tid] = c ? atomicAdd(&cnt[X.tid], c) : 0u; }
    __syncthreads();
    it = 0;
    for (int ck = gw; ck < M / RPC; ck += NGW, ++it) {
        const int m0 = ck * RPC, b = m0 / T, t0 = m0 - b * T;
        if (lane < RPC) { const int m = m0 + lane, t = t0 + lane;
            if (!(l == DEPTH - 1 && t < CTX)) {
                const LAS unsigned* rec = ltab + (X.wave * RPW + it * RPC + lane) * 4;
                const unsigned e1 = rec[0] & 15u, e2 = rec[1] & 15u, p1 = lbase[e1] + (rec[0] >> 4), p2 = lbase[e2] + (rec[1] >> 4);
                LIST[(size_t)e1 * M + p1] = m; LIST[(size_t)e2 * M + p2] = m;
                u32x4 ti; ti.x = e1 | (p1 << 4); ti.y = e2 | (p2 << 4); ti.z = rec[2]; ti.w = rec[3];
                TOK[m] = ti; } }
    }
}
DI void moe_tables(const Params& P, Ctx& X, int l) {
    __syncthreads();
    if (X.tid < 64) { const unsigned* cnt = (const unsigned*)(P.ws + WS_CTL) + CW_CNT + l * 16;
        const int c = (X.lane < 16) ? (int)__hip_atomic_load(cnt + (X.lane & 15), __ATOMIC_RELAXED, __HIP_MEMORY_SCOPE_AGENT) : 0;
        const int tiles = (c + 255) >> 8; int incl = tiles;
#pragma unroll
        for (int o = 1; o < 16; o <<= 1) { const int v = shupi(incl, o, X.lane); if (X.lane >= o) incl += v; }
        if (X.lane < 16) { X.misc[16 + X.lane] = c; X.misc[32 + X.lane] = incl - tiles; X.misc[64 + X.lane] = (incl - tiles) * 256; }
        if (X.lane == 15) X.misc[32 + 16] = incl; }
    __syncthreads();
}

constexpr int N_PHASES = 38;
__global__ void __launch_bounds__(NTHR, 2) mk_fwd(Params PK) {
    const Params& P0 = PK; const Params* kp = &PK;
    extern __shared__ __attribute__((aligned(16))) unsigned char lds_raw[];
    Ctx X;
    X.L = (LAS unsigned char*)lds_raw; X.misc = (volatile LAS int*)(X.L + LDS_MISC); X.ws = PK.ws;
    X.tid = threadIdx.x; X.lane = X.tid & 63; X.wave = __builtin_amdgcn_readfirstlane(X.tid >> 6); X.G = gridDim.x; X.bid = blockIdx.x;
    const int wave0 = X.wave;
    if (X.tid < 128) X.misc[X.tid] = 0;
    __syncthreads();
    unsigned* ctl = (unsigned*)(PK.ws + WS_CTL);
    XcdBarrier bar; bar.bar = ctl + CW_BAR; bar.x = 0; bar.st = (volatile LAS unsigned*)X.misc;
    const bool multi = ((PK.ph_hi & 255) - PK.ph_lo) > 1;
    if (multi) bar = xcd_barrier_post(ctl + CW_BAR, (volatile LAS unsigned*)X.misc);
#ifndef PHMASK
#define PHMASK 0xFFFF
#endif
#define RUN(ph) (PK.ph_lo <= (ph) && (ph) < (PK.ph_hi & 255))
#define HAS(k) ((PHMASK >> (k)) & 1)
#define SEAM(ph) do { if (RUN(ph) && RUN((ph) + 1)) { FRESH(); xcd_barrier(bar, X.tid); } } while (0)
#define FRESH() do { int _t = wave0 * 64 + (int)__builtin_amdgcn_mbcnt_hi(~0u, __builtin_amdgcn_mbcnt_lo(~0u, 0u)); asm volatile("" : "+v"(_t)); X.tid = _t; X.lane = _t & 63; X.wave = __builtin_amdgcn_readfirstlane(_t >> 6); \
        const __attribute__((address_space(4))) Params* _kp = (const __attribute__((address_space(4))) Params*)__builtin_amdgcn_kernarg_segment_ptr(); asm volatile("" : "+s"(_kp)); kp = (const Params*)_kp; X.ws = kp->ws; \
        int _b = blockIdx.x, _g = gridDim.x; asm volatile("" : "+s"(_b), "+s"(_g)); X.bid = _b; X.G = _g; } while (0)
#define P (*kp)
    if (HAS(9) && RUN(0)) phase_prologue(P, X);
    SEAM(0);
#pragma unroll 1
    for (int l = 0; l < DEPTH; ++l) {
        const int pb = 1 + 9 * l;
        FRESH(); if (HAS(0) && RUN(pb + 0)) phase_norm1(P, X, l);
        SEAM(pb + 0);
        FRESH(); if (HAS(1) && RUN(pb + 1)) { DenseSched S; S.init(P.ws + WS_ACT, P.ws + WS_WIN, M, PW, DM, X.G, X.bid); EpiStoreBf16 E{(bf16_t*)(P.ws + WS_PROJ), PW}; gemm8(X.L, DM, S, E); }
        SEAM(pb + 1);
        FRESH(); if (HAS(2) && RUN(pb + 2)) phase_postproj(P, X, l, (PK.ph_hi >> 8) ? (PK.ph_hi >> 8) : 15);
        SEAM(pb + 2);
        FRESH(); if (HAS(3) && RUN(pb + 3)) phase_mixers(P, X, l, (PK.ph_hi >> 8) ? (PK.ph_hi >> 8) : 7);
        SEAM(pb + 3);
        FRESH(); if (HAS(4) && RUN(pb + 4)) phase_ssdgate(P, X, l);
        SEAM(pb + 4);
        FRESH(); if (HAS(5) && RUN(pb + 5)) { DenseSched S; S.init(P.ws + WS_ACT, P.ws + WS_WOUT, M, DM, DM, X.G, X.bid);
            EpiResidual E{(float*)(P.ws + WS_HC), P.out, (const float*)(P.ws + WS_MOD) + (size_t)l * 17 * 6144}; gemm8(X.L, DM, S, E); }
        SEAM(pb + 5);
        FRESH(); if (HAS(6) && RUN(pb + 6)) phase_norm2_route(P, X, l);
        SEAM(pb + 6);
        FRESH(); if (HAS(7) && RUN(pb + 7)) { moe_tables(P, X, l);
            MoeSched<true> S{(const char*)(P.ws + WS_ACT), (const char*)(P.ws + WS_WGU), (const int*)(P.ws + WS_LIST), X.misc, DM, X.G, X.bid};
            EpiGateUp E{(bf16_t*)(P.ws + WS_HE)}; gemm8(X.L, DM, S, E); }
        SEAM(pb + 7);
        FRESH(); if (HAS(8) && RUN(pb + 8)) { moe_tables(P, X, l);
            MoeSched<false> S{(const char*)(P.ws + WS_HE), (const char*)(P.ws + WS_WD), nullptr, X.misc, 512, X.G, X.bid};
            EpiStoreBf16 E{(bf16_t*)(P.ws + WS_YS), DM}; gemm8(X.L, 512, S, E); }
        SEAM(pb + 8);
    }
    FRESH(); if (HAS(10) && RUN(37)) phase_final(P, X);
#undef P
#undef RUN
#undef SEAM
}
}

#ifndef PROBE_SEL
#define PROBE_SEL 0
#endif
#ifndef MK_MODE
#define MK_MODE 1
#endif
extern "C" void kernel_launch(void* const* d_in, const int* in_sizes, int n_in, void* d_out, int out_size, void* d_ws, size_t ws_size, hipStream_t stream) {
    using namespace mk;
    static int grid = 0;
    if (grid == 0) {
        if (n_in != 28 || ws_size < WS_END) { fprintf(stderr, "kernel_launch: unexpected inputs (n_in %d, ws %zu < %zu)\n", n_in, ws_size, (size_t)WS_END); grid = -1; return; }
        int dev = 0, cus = 0, per_cu = 0;
        if (hipGetDevice(&dev) != hipSuccess || hipDeviceGetAttribute(&cus, hipDeviceAttributeMultiprocessorCount, dev) != hipSuccess) { grid = -1; return; }
        if (hipFuncSetAttribute((const void*)mk_fwd, hipFuncAttributeMaxDynamicSharedMemorySize, LDS_BYTES) != hipSuccess) { fprintf(stderr, "kernel_launch: hipFuncSetAttribute failed\n"); grid = -1; return; }
        if (hipOccupancyMaxActiveBlocksPerMultiprocessor(&per_cu, (const void*)mk_fwd, NTHR, LDS_BYTES) != hipSuccess || per_cu < 1) { fprintf(stderr, "kernel_launch: occupancy query says %d\n", per_cu); (void)hipGetLastError(); grid = -1; return; }
        grid = cus;
    }
    if (grid < 0) return;
    (void)hipMemsetAsync((char*)d_ws + WS_CTL, 0, CTL_BYTES, stream);
    Params p{};
    const float** pp = (const float**)&p;
    for (int i = 0; i < 28; ++i) pp[i] = (const float*)d_in[i];
    p.out = (float*)d_out; p.ws = (unsigned char*)d_ws;
#if MK_MODE == 1
    p.ph_lo = 0; p.ph_hi = N_PHASES;
    hipLaunchKernelGGL(mk_fwd, dim3(grid), dim3(NTHR), LDS_BYTES, stream, p);
#else
    for (int ph = 0; ph < N_PHASES; ++ph) { p.ph_lo = ph; p.ph_hi = ph + 1; hipLaunchKernelGGL(mk_fwd, dim3(grid), dim3(NTHR), LDS_BYTES, stream, p);
#if MK_MODE == 3
        if (ph == PROBE_PH) for (int r = 0; r < PROBE_REP; ++r) hipLaunchKernelGGL(mk_fwd, dim3(grid), dim3(NTHR), LDS_BYTES, stream, p);
#endif
    }
#if MK_MODE == 2
    for (int r = 0; r < PROBE_REP; ++r) { p.ph_lo = PROBE_PH; p.ph_hi = (PROBE_PH + 1) | (PROBE_SEL << 8); hipLaunchKernelGGL(mk_fwd, dim3(grid), dim3(NTHR), LDS_BYTES, stream, p); }
#endif
#endif
}
```

```cpp
#include <hip/hip_runtime.h>
#include <cstdio>
#include <cstdint>

namespace mk {
#define LAS __attribute__((address_space(3)))
#define DI __device__ __forceinline__
typedef unsigned short bf16_t;
typedef short bf16x8 __attribute__((ext_vector_type(8)));
typedef short s16x4 __attribute__((ext_vector_type(4)));
typedef float f32x2 __attribute__((ext_vector_type(2)));
typedef float f32x4 __attribute__((ext_vector_type(4)));
typedef float f32x16 __attribute__((ext_vector_type(16)));
typedef unsigned u32x2 __attribute__((ext_vector_type(2)));
typedef unsigned u32x4 __attribute__((ext_vector_type(4)));
typedef __bf16 bf16x2_t __attribute__((ext_vector_type(2)));

constexpr int DM = 1024, NB = 16, SEQ = 2048, CTX = 256, T = SEQ + CTX, M = NB * T, DEPTH = 4;
constexpr int PW = 2560, INW = 2480;
constexpr int C_DAQ = 0, C_DAK = 256, C_DAV = 512, C_Z = 768, C_XBC = 1280, C_DT = 2048, C_CQ = 2064, C_CKV = 2320, C_KR = 2448;
constexpr float EPS = 1e-6f, LOG2E = 1.4426950408889634f;
constexpr float DA_QS = 0.17677669529663687f * LOG2E, MLA_QS = 0.10206207261596577f * LOG2E;
constexpr int NSLOT = 2 * M + 4096;
constexpr int NTHR = 512, NWAVE = 8;

constexpr size_t MiB = 1u << 20;
constexpr size_t WS_CTL = 0, CTL_BYTES = 1 * MiB;
constexpr size_t WS_MOD = 1 * MiB, WS_ROPE = 3 * MiB, WS_HC = 4 * MiB;
constexpr size_t WS_WIN = 20 * MiB, WS_WOUT = 25 * MiB, WS_WUQ = 27 * MiB, WS_WUKV = 27 * MiB + 512 * 1024, WS_WGU = 28 * MiB, WS_WD = 60 * MiB;
constexpr size_t WS_ACT = 76 * MiB, WS_PROJ = 148 * MiB;
constexpr size_t WS_MLAQ = 328 * MiB, WS_MLAK = 355 * MiB, WS_VTM = 382 * MiB, WS_VTD = 400 * MiB;
constexpr size_t WS_XBC = 418 * MiB, WS_DT = 472 * MiB, WS_YF = 475 * MiB, WS_YB = 511 * MiB, WS_TOK = 547 * MiB, WS_LIST = 548 * MiB, WS_END = 551 * MiB;
constexpr size_t WS_HE = WS_MLAQ, WS_YS = WS_PROJ;
static_assert((size_t)NSLOT * 512 * 2 <= WS_XBC - WS_MLAQ, "HE alias");
static_assert((size_t)NSLOT * 1024 * 2 <= WS_MLAQ - WS_PROJ, "YS alias");
constexpr int CW_BAR = 4096, CW_CNT = 8192;

constexpr int LDS_MISC = 131072, LDS_BYTES = 135168;

struct Params {
    const float *x, *c, *ctx, *c_ctx, *g_mix, *g_ffn, *w_mod, *b_mod, *w_in, *w_out, *da_lam, *da_g, *conv_w, *conv_b, *dt_bias, *a_log, *ssd_d, *ssd_g,
                *mq_g, *mkv_g, *w_uq, *w_ukv, *r_w, *r_b, *wg, *wu, *wd, *fin_g;
    float* out; unsigned char* ws; int ph_lo, ph_hi;
};

DI unsigned pk2(float lo, float hi) { f32x2 v = {lo, hi}; bf16x2_t b = __builtin_convertvector(v, bf16x2_t); return __builtin_bit_cast(unsigned, b); }
DI float bflo(unsigned w) { return __uint_as_float(w << 16); }
DI float bfhi(unsigned w) { return __uint_as_float(w & 0xffff0000u); }
DI float shx(float v, int o, int lane) { return __int_as_float(__builtin_amdgcn_ds_bpermute((lane ^ o) << 2, __float_as_int(v))); }
DI float shl(float v, int src) { return __int_as_float(__builtin_amdgcn_ds_bpermute(src << 2, __float_as_int(v))); }
DI int shli(int v, int src) { return __builtin_amdgcn_ds_bpermute(src << 2, v); }
DI float shup(float v, int o, int lane) { return __int_as_float(__builtin_amdgcn_ds_bpermute((lane - o) << 2, __float_as_int(v))); }
DI int shupi(int v, int o, int lane) { return __builtin_amdgcn_ds_bpermute((lane - o) << 2, v); }
DI float wave_sum(float v, int lane) {
#pragma unroll
    for (int o = 1; o < 64; o <<= 1) v += shx(v, o, lane);
    return v;
}
DI float silu(float x) { return x * __builtin_amdgcn_rcpf(1.f + __expf(-x)); }
DI float fexp2(float x) { return __builtin_amdgcn_exp2f(x); }
#define LDS_WAIT() asm volatile("s_waitcnt lgkmcnt(0)" ::: "memory")
#define MFMA32(a, b, c) __builtin_amdgcn_mfma_f32_32x32x16_bf16((a), (b), (c), 0, 0, 0)
#define MFMA16(a, b, c) __builtin_amdgcn_mfma_f32_16x16x32_bf16((a), (b), (c), 0, 0, 0)
DI int crow(int reg, int h) { return (reg & 3) + 8 * (reg >> 2) + 4 * h; }

#define XB_TMO      128
#define XB_XCNT(j)  (256  + 64 * (j))
#define XB_XSUB(j)  (1280 + 64 * (j))
#define XB_XGEN(j)  (2304 + 64 * (j))
#define XB_TOP      3328
#define XB_TOPGEN   3392
#define XCD_BAR_WORDS 3456
#define XB_SPIN_CAP (1u << 22)
DI unsigned xb_ld(unsigned* p)              { return __hip_atomic_load(p, __ATOMIC_RELAXED, __HIP_MEMORY_SCOPE_AGENT); }
DI unsigned xb_add(unsigned* p, unsigned v) { return __hip_atomic_fetch_add(p, v, __ATOMIC_RELAXED, __HIP_MEMORY_SCOPE_AGENT); }
DI unsigned xb_xcc_id() { return (unsigned)__builtin_amdgcn_s_getreg((3 << 11) | 20) & 0xFu; }
#define XB_SPIN(cond, bar) do { unsigned _sp = 0; while (cond) { __builtin_amdgcn_s_sleep(1); \
    if ((++_sp & 255u) == 0u) { if (xb_ld(&(bar)[XB_TMO])) break; if (_sp > XB_SPIN_CAP) { atomicAdd(&(bar)[XB_TMO], 1u); break; } } } } while (0)
struct XcdBarrier { unsigned* bar; unsigned x; volatile LAS unsigned* st; };
DI XcdBarrier xcd_barrier_post(unsigned* bar, volatile LAS unsigned* st) {
    XcdBarrier b; b.bar = bar; b.x = xb_xcc_id(); b.st = st;
    if (threadIdx.x == 0) (void)xb_add(&bar[XB_XCNT(b.x)], 1u);
    return b;
}
DI void xcd_barrier_complete(unsigned* bar, unsigned x, unsigned& nloc, unsigned& nx) {
    const unsigned G = gridDim.x * gridDim.y * gridDim.z;
    unsigned sum, cnt, mine, sp = 0u;
    for (;;) {
        sum = 0u; cnt = 0u; mine = 0u;
#pragma unroll
        for (unsigned j = 0; j < 16; ++j) { const unsigned c = xb_ld(&bar[XB_XCNT(j)]); sum += c; cnt += (c > 0u) ? 1u : 0u; }
        mine = xb_ld(&bar[XB_XCNT(x)]);
        if (sum == G) break;
        __builtin_amdgcn_s_sleep(1);
        if ((++sp & 255u) == 0u) { if (xb_ld(&bar[XB_TMO])) break; if (sp > XB_SPIN_CAP) { atomicAdd(&bar[XB_TMO], 1u); break; } }
    }
    nloc = mine > 0u ? mine : 1u; nx = cnt > 0u ? cnt : 1u;
}
DI void xcd_barrier(const XcdBarrier& b, int tid) {
    asm volatile("s_waitcnt vmcnt(0)" ::: "memory");
    __syncthreads();
    if (tid == 0) {
        unsigned* bar = b.bar;
        __builtin_amdgcn_s_waitcnt(0);
        unsigned nloc = b.st[0], nx = b.st[1];
        if (nloc == 0u) { xcd_barrier_complete(bar, b.x, nloc, nx); b.st[0] = nloc; b.st[1] = nx; }
        const unsigned old = xb_add(&bar[XB_XSUB(b.x)], 1u);
        const unsigned gen = old / nloc;
        if (old + 1u == (gen + 1u) * nloc) {
            __builtin_amdgcn_fence(__ATOMIC_RELEASE, "agent");
            asm volatile("s_waitcnt vmcnt(0)" ::: "memory");
            const unsigned og = xb_add(&bar[XB_TOP], 1u);
            const unsigned tg = og / nx;
            if (og + 1u == (tg + 1u) * nx) xb_add(&bar[XB_TOPGEN], 1u);
            else XB_SPIN(xb_ld(&bar[XB_TOPGEN]) == tg, bar);
            __builtin_amdgcn_fence(__ATOMIC_ACQUIRE, "agent");
            xb_add(&bar[XB_XGEN(b.x)], 1u);
            asm volatile("s_waitcnt vmcnt(0)" ::: "memory");
        } else {
            XB_SPIN(xb_ld(&bar[XB_XGEN(b.x)]) == gen, bar);
            __builtin_amdgcn_fence(__ATOMIC_ACQUIRE, "agent");
            asm volatile("s_waitcnt vmcnt(0)" ::: "memory");
        }
    }
    __syncthreads();
}

constexpr int HTB = 128 * 64 * 2;
DI int lds_byte(int r, int c) { const int st = (r >> 4) * 2 + (c >> 5), rr = r & 15, cc = c & 31, ob = rr * 64 + cc * 2; return st * 1024 + (ob ^ (((ob >> 9) & 1) << 5)); }
DI void stage_rc(int b, int& R, int& C) { const int st = b / 1024, sb = b % 1024, swz = sb ^ (((sb >> 9) & 1) << 5); R = (st >> 1) * 16 + swz / 64; C = (st & 1) * 32 + (swz % 64) / 2; }
DI int perm32(int rho) { const int n = rho >> 4, i = rho & 15; return 8 * (i >> 2) + 4 * n + (i & 3); }

struct GUnit { const char* A; const char* B; int pm, pn, e, row0; };

template <class Epi, class Sched>
DI void gemm8(LAS unsigned char* lds, const int K, const Sched& S, const Epi& E) {
    int tid_ = threadIdx.x; asm volatile("" : "+v"(tid_));
    const int tid = tid_, wid = __builtin_amdgcn_readfirstlane(tid >> 6), lane = tid & 63, wr = wid >> 2, wc = wid & 3, fr = lane & 15, fq = lane >> 4;
    const int nt = K / 64;
    int R[2], C[2]; unsigned voffB[2];
#pragma unroll
    for (int i = 0; i < 2; ++i) { stage_rc(tid * 16 + i * 8192, R[i], C[i]); const int Rb = Epi::PERM ? ((R[i] & ~31) + perm32(R[i] & 31)) : R[i]; voffB[i] = (unsigned)(Rb * K + C[i]) * 2u; }
    const size_t kstep = 128;
    const size_t hstepB = (size_t)128 * K * 2;
    const unsigned ldsw = (unsigned)wid * 1024u;
    const int aoff = lds_byte(wr * 64 + fr, fq * 8), boff = lds_byte(wc * 32 + fr, fq * 8);
#define G8_SA(b, h) (((b) * 2 + (h)) * HTB)
#define G8_SB(b, h) ((4 + (b) * 2 + (h)) * HTB)
#define G8_STAGE(bufoff, gbase, voff) do { _Pragma("unroll") for (int _i = 0; _i < 2; ++_i) \
        __builtin_amdgcn_global_load_lds((const unsigned*)((const char*)(gbase) + (voff)[_i]), (LAS unsigned*)(lds + (bufoff) + ldsw + _i * 8192), 16, 0, 0); } while (0)
#define G8_LDA(dst, b, h) do { _Pragma("unroll") for (int m = 0; m < 4; ++m) _Pragma("unroll") for (int k = 0; k < 2; ++k) dst[m][k] = *(const LAS bf16x8*)(lds + G8_SA(b, h) + aoff + m * 2048 + k * 1024); } while (0)
#define G8_LDB(dst, b, h) do { _Pragma("unroll") for (int n = 0; n < 2; ++n) _Pragma("unroll") for (int k = 0; k < 2; ++k) dst[n][k] = *(const LAS bf16x8*)(lds + G8_SB(b, h) + boff + n * 2048 + k * 1024); } while (0)
#define G8_MMA(ai, bj, At, Bt) do { __builtin_amdgcn_s_setprio(1); _Pragma("unroll") for (int m = 0; m < 4; ++m) _Pragma("unroll") for (int n = 0; n < 2; ++n) _Pragma("unroll") for (int k = 0; k < 2; ++k) \
        acc[ai][bj][m][n] = __builtin_amdgcn_mfma_f32_16x16x32_bf16(Bt[n][k], At[m][k], acc[ai][bj][m][n], 0, 0, 0); __builtin_amdgcn_s_setprio(0); } while (0)
#define G8_WAIT_V(n) asm volatile("s_waitcnt vmcnt(" #n ")" ::: "memory")
#define G8_WAIT_L(n) asm volatile("s_waitcnt lgkmcnt(" #n ")" ::: "memory")
#define G8_BAR __builtin_amdgcn_s_barrier()
#define G8_SCHED __builtin_amdgcn_sched_barrier(0)
    GUnit cur, nxt; int ui = 0;
    if (!S.next(0, cur)) return;
    unsigned aoC[2][2], aoN[2][2];
    S.aoff(cur, R, C, aoC);
    if constexpr (Sched::UNIFORM_AOFF) {
#pragma unroll
        for (int h = 0; h < 2; ++h)
#pragma unroll
            for (int i = 0; i < 2; ++i) aoN[h][i] = aoC[h][i]; }
    f32x4 acc[2][2][4][2];
#pragma unroll
    for (int a = 0; a < 2; ++a)
#pragma unroll
        for (int b = 0; b < 2; ++b)
#pragma unroll
            for (int m = 0; m < 4; ++m)
#pragma unroll
                for (int n = 0; n < 2; ++n) acc[a][b][m][n] = (f32x4){0.f, 0.f, 0.f, 0.f};
    bf16x8 At[4][2], B0[2][2], B1[2][2];
    const char* cA = cur.A; const char* cB = cur.B;
    asm volatile("s_waitcnt vmcnt(0)" ::: "memory");
    G8_STAGE(G8_SB(0, 0), cB, voffB); G8_STAGE(G8_SA(0, 0), cA, aoC[0]); G8_STAGE(G8_SB(0, 1), cB + hstepB, voffB); G8_STAGE(G8_SA(0, 1), cA, aoC[1]);
    if (wr == 1) G8_BAR;
    G8_WAIT_V(4); G8_BAR;
    G8_STAGE(G8_SB(1, 0), cB + kstep, voffB); G8_STAGE(G8_SA(1, 0), cA + kstep, aoC[0]); G8_STAGE(G8_SB(1, 1), cB + hstepB + kstep, voffB);
    G8_WAIT_V(6); G8_BAR;
    for (;;) {
        const bool has_next = S.next(ui + 1, nxt);
        if constexpr (!Sched::UNIFORM_AOFF) {
        if (has_next) S.aoff(nxt, R, C, aoN);
        else {
#pragma unroll
            for (int h = 0; h < 2; ++h)
#pragma unroll
                for (int i = 0; i < 2; ++i) aoN[h][i] = aoC[h][i]; } }
        const char* nA = has_next ? nxt.A : cA; const char* nB = has_next ? nxt.B : cB;
        for (int t = 0; t < nt; t += 2) {
            const bool last = (t == nt - 2);
            const char* a1 = cA + (size_t)(t + 1) * kstep;
            const char* a2 = last ? nA : cA + (size_t)(t + 2) * kstep; const char* b2 = last ? nB : cB + (size_t)(t + 2) * kstep;
            const char* a3 = a2 + kstep; const char* b3 = b2 + kstep;
            unsigned ao2[2][2];
#pragma unroll
            for (int h = 0; h < 2; ++h)
#pragma unroll
                for (int i = 0; i < 2; ++i) ao2[h][i] = (!Sched::UNIFORM_AOFF && last) ? aoN[h][i] : aoC[h][i];
            G8_LDB(B0, 0, 0); G8_SCHED; G8_LDA(At, 0, 0); G8_STAGE(G8_SA(1, 1), a1, aoC[1]);
            G8_WAIT_L(8); G8_BAR; G8_WAIT_L(0); G8_MMA(0, 0, At, B0); G8_BAR; G8_SCHED;
            G8_LDB(B1, 0, 1); G8_STAGE(G8_SB(0, 0), b2, voffB);
            G8_BAR; G8_WAIT_L(0); G8_MMA(0, 1, At, B1); G8_BAR;
            G8_LDA(At, 0, 1); G8_STAGE(G8_SA(0, 0), a2, ao2[0]);
            G8_BAR; G8_WAIT_L(0); G8_MMA(1, 0, At, B0); G8_BAR; G8_SCHED;
            G8_STAGE(G8_SB(0, 1), b2 + hstepB, voffB);
            G8_WAIT_V(6); G8_BAR; G8_MMA(1, 1, At, B1); G8_BAR;
            G8_LDB(B0, 1, 0); G8_SCHED; G8_LDA(At, 1, 0); G8_STAGE(G8_SA(0, 1), a2, ao2[1]);
            G8_WAIT_L(8); G8_BAR; G8_WAIT_L(0); G8_MMA(0, 0, At, B0); G8_BAR; G8_SCHED;
            G8_LDB(B1, 1, 1); G8_STAGE(G8_SB(1, 0), b3, voffB);
            G8_BAR; G8_WAIT_L(0); G8_MMA(0, 1, At, B1); G8_BAR;
            G8_LDA(At, 1, 1); G8_STAGE(G8_SA(1, 0), a3, ao2[0]);
            G8_BAR; G8_WAIT_L(0); G8_MMA(1, 0, At, B0); G8_BAR; G8_SCHED;
            G8_STAGE(G8_SB(1, 1), b3 + hstepB, voffB);
            G8_WAIT_V(6); G8_BAR; G8_MMA(1, 1, At, B1); G8_BAR;
        }
        E(acc, cur, wr, wc, fr, fq);
        if (!has_next) break;
#pragma unroll
        for (int a = 0; a < 2; ++a)
#pragma unroll
            for (int b = 0; b < 2; ++b)
#pragma unroll
                for (int m = 0; m < 4; ++m)
#pragma unroll
                    for (int n = 0; n < 2; ++n) acc[a][b][m][n] = (f32x4){0.f, 0.f, 0.f, 0.f};
        cur = nxt; cA = nA; cB = nB; ++ui;
        if constexpr (!Sched::UNIFORM_AOFF) {
#pragma unroll
        for (int h = 0; h < 2; ++h)
#pragma unroll
            for (int i = 0; i < 2; ++i) aoC[h][i] = aoN[h][i]; }
    }
    G8_WAIT_V(0);
    if (wr == 0) G8_BAR;
    G8_BAR;
#undef G8_SA
#undef G8_SB
#undef G8_STAGE
#undef G8_LDA
#undef G8_LDB
#undef G8_MMA
#undef G8_WAIT_V
#undef G8_WAIT_L
#undef G8_BAR
#undef G8_SCHED
}

constexpr int NXCD = 8, WGM = 8;
struct DenseSched {
    static constexpr bool UNIFORM_AOFF = true;
    const char* A; const char* Bt; int K, nM, nN, nwg, G, c;
    DI void init(const void* A_, const void* Bt_, int Mrows, int N, int K_, int G_, int c_) { A = (const char*)A_; Bt = (const char*)Bt_; K = K_; nM = Mrows / 256; nN = N / 256; nwg = nM * nN; G = G_; c = c_; }
    DI bool next(int i, GUnit& u) const {
        const long L = (long)i * G + c; if (L >= nwg) return false;
        int wgid = (int)L; { const int q = nwg / NXCD, r = nwg % NXCD, xcd = wgid % NXCD, off = wgid / NXCD; wgid = (xcd < r ? xcd * (q + 1) : r * (q + 1) + (xcd - r) * q) + off; }
        const int nig = WGM * nN, gid = wgid / nig, fm = gid * WGM, gsz = (nM - fm) < WGM ? (nM - fm) : WGM;
        u.pm = fm + ((wgid % nig) % gsz); u.pn = (wgid % nig) / gsz; u.e = 0; u.row0 = u.pm * 256;
        u.A = A + (size_t)u.pm * 256 * K * 2; u.B = Bt + (size_t)u.pn * 256 * K * 2; return true;
    }
    DI void aoff(const GUnit&, const int (&R)[2], const int (&C)[2], unsigned (&off)[2][2]) const {
#pragma unroll
        for (int h = 0; h < 2; ++h)
#pragma unroll
            for (int i = 0; i < 2; ++i) off[h][i] = (unsigned)((h * 128 + R[i]) * K + C[i]) * 2u;
    }
};
template <bool GATHER>
struct MoeSched {
    static constexpr bool UNIFORM_AOFF = !GATHER;
    const char* A; const char* W; const int* list; volatile LAS int* misc; int K, G, c;
    DI bool next(int i, GUnit& u) const {
        const int L = i * G + c;
        const int RT = __builtin_amdgcn_readfirstlane(misc[32 + 16]);
        if (L >= RT * 4) return false;
        const int rt = L >> 2; u.pn = L & 3;
        int e = 0;
#pragma unroll
        for (int j = 1; j < 16; ++j) { const int tp = __builtin_amdgcn_readfirstlane(misc[32 + j]); if (tp <= rt) e = j; }
        const int tp = __builtin_amdgcn_readfirstlane(misc[32 + e]);
        u.e = e; u.pm = rt - tp; u.row0 = __builtin_amdgcn_readfirstlane(misc[64 + e]) + u.pm * 256;
        u.A = GATHER ? A : A + (size_t)u.row0 * K * 2;
        u.B = W + ((size_t)e * 1024 + (size_t)u.pn * 256) * K * 2;
        return true;
    }
    DI void aoff(const GUnit& u, const int (&R)[2], const int (&C)[2], unsigned (&off)[2][2]) const {
        if (GATHER) {
            const int cnt = __builtin_amdgcn_readfirstlane(misc[16 + u.e]);
#pragma unroll
            for (int h = 0; h < 2; ++h)
#pragma unroll
                for (int i = 0; i < 2; ++i) { const int idx = u.pm * 256 + h * 128 + R[i]; const int tok = (idx < cnt) ? list[(size_t)u.e * M + idx] : 0; off[h][i] = (unsigned)(tok * K + C[i]) * 2u; }
        } else {
#pragma unroll
            for (int h = 0; h < 2; ++h)
#pragma unroll
                for (int i = 0; i < 2; ++i) off[h][i] = (unsigned)((h * 128 + R[i]) * K + C[i]) * 2u;
        }
    }
};

struct EpiStoreBf16 {
    static constexpr bool PERM = true;
    bf16_t* O; int ldc;
    DI void operator()(const f32x4 (&acc)[2][2][4][2], const GUnit& u, int wr, int wc, int fr, int fq) const {
        const int row0 = u.row0 + wr * 64 + fr, col0 = u.pn * 256 + wc * 32 + 8 * fq;
#pragma unroll
        for (int ai = 0; ai < 2; ++ai)
#pragma unroll
            for (int m = 0; m < 4; ++m) { bf16_t* rowp = O + (size_t)(row0 + ai * 128 + m * 16) * ldc + col0;
#pragma unroll
                for (int bj = 0; bj < 2; ++bj) { const f32x4 v0 = acc[ai][bj][m][0], v1 = acc[ai][bj][m][1];
                    u32x4 w; w.x = pk2(v0[0], v0[1]); w.y = pk2(v0[2], v0[3]); w.z = pk2(v1[0], v1[1]); w.w = pk2(v1[2], v1[3]);
                    *(u32x4*)(rowp + bj * 128) = w; } }
    }
};
struct EpiGateUp {
    static constexpr bool PERM = true;
    bf16_t* O;
    DI void operator()(const f32x4 (&acc)[2][2][4][2], const GUnit& u, int wr, int wc, int fr, int fq) const {
        const int row0 = u.row0 + wr * 64 + fr, col0 = u.pn * 128 + wc * 32 + 8 * fq;
#pragma unroll
        for (int ai = 0; ai < 2; ++ai)
#pragma unroll
            for (int m = 0; m < 4; ++m) { bf16_t* rowp = O + (size_t)(row0 + ai * 128 + m * 16) * 512 + col0;
                float hv[8];
#pragma unroll
                for (int n = 0; n < 2; ++n)
#pragma unroll
                    for (int i = 0; i < 4; ++i) hv[n * 4 + i] = silu(acc[ai][0][m][n][i]) * acc[ai][1][m][n][i];
                u32x4 w; w.x = pk2(hv[0], hv[1]); w.y = pk2(hv[2], hv[3]); w.z = pk2(hv[4], hv[5]); w.w = pk2(hv[6], hv[7]);
                *(u32x4*)rowp = w; }
    }
};
struct EpiResidual {
    static constexpr bool PERM = false;
    float* hc; float* hx; const float* modl;
    DI void operator()(const f32x4 (&acc)[2][2][4][2], const GUnit& u, int wr, int wc, int fr, int fq) const {
        const int b = u.pm / 9, tt = u.pm % 9;
        float* base = (tt == 0) ? hc + (size_t)b * CTX * DM : hx + ((size_t)b * SEQ + (size_t)(tt - 1) * 256) * DM;
        const float* gate = modl + (size_t)((tt == 0) ? 16 : b) * 6144 + 2 * DM;
        const int row0 = wr * 64 + fr, col0 = u.pn * 256 + wc * 32 + 4 * fq;
#pragma unroll
        for (int ai = 0; ai < 2; ++ai)
#pragma unroll
            for (int m = 0; m < 4; ++m) { float* rowp = base + (size_t)(row0 + ai * 128 + m * 16) * DM + col0;
#pragma unroll
                for (int bj = 0; bj < 2; ++bj)
#pragma unroll
                    for (int n = 0; n < 2; ++n) { f32x4* p = (f32x4*)(rowp + bj * 128 + n * 16); const f32x4 gv = *(const f32x4*)(gate + col0 + bj * 128 + n * 16); *p = *p + gv * acc[ai][bj][m][n]; }
                asm volatile("" ::: "memory"); }
    }
};

struct Ctx {
    LAS unsigned char* L; volatile LAS int* misc; unsigned char* ws; int tid, lane, wave, G, bid;
};
DI float* hrow(const Params& P, int m) { const int b = m / T, t = m - b * T; return (t < CTX) ? (float*)(P.ws + WS_HC) + ((size_t)b * CTX + t) * DM : P.out + ((size_t)b * SEQ + (t - CTX)) * DM; }

DI void phase_prologue(const Params& P, Ctx& X) {
    float* MOD = (float*)(P.ws + WS_MOD);
    LAS float* tab = (LAS float*)(X.L + X.wave * 8704);
    for (int u = X.bid; u < 4 * 48; u += X.G) {
        const int l = u / 48, jc = u % 48;
        __syncthreads();
        for (int idx = X.lane; idx < 17 * 128; idx += 64) { const int r = idx >> 7, kk = idx & 127; const float* src = (r < 16) ? P.c + r * DM : P.c_ctx; tab[idx] = silu(src[X.wave * 128 + kk]); }
        __syncthreads();
        float a0[17], a1[17];
#pragma unroll
        for (int r = 0; r < 17; ++r) { a0[r] = 0.f; a1[r] = 0.f; }
        const float* wp = P.w_mod + ((size_t)l * DM + X.wave * 128) * 6144 + jc * 128 + 2 * X.lane;
#pragma unroll 4
        for (int kk = 0; kk < 128; ++kk) { const f32x2 w2 = *(const f32x2*)(wp + (size_t)kk * 6144);
#pragma unroll
            for (int r = 0; r < 17; ++r) { const float a = tab[r * 128 + kk]; a0[r] += a * w2.x; a1[r] += a * w2.y; } }
        __syncthreads();
#pragma unroll
        for (int r = 0; r < 17; ++r) { tab[r * 128 + 2 * X.lane] = a0[r]; tab[r * 128 + 2 * X.lane + 1] = a1[r]; }
        __syncthreads();
        for (int idx = X.tid; idx < 17 * 128; idx += NTHR) { const int r = idx >> 7, j = idx & 127; float s = P.b_mod[l * 6144 + jc * 128 + j];
#pragma unroll
            for (int w = 0; w < 8; ++w) s += ((LAS float*)(X.L + w * 8704))[idx];
            MOD[((size_t)l * 17 + r) * 6144 + jc * 128 + j] = s; }
    }
    __syncthreads();
    f32x2* rope = (f32x2*)(P.ws + WS_ROPE);
    for (int e = X.bid * NTHR + X.tid; e < SEQ * 16; e += X.G * NTHR) { const int p = e >> 4, d = e & 15; const int row = p >> 6, col = p & 63;
        const float inv = powf(10000.f, -(float)(d & 7) / 8.f); const float ang = (float)((d < 8) ? row : col) * inv; rope[e] = (f32x2){cosf(ang), sinf(ang)}; }
    u32x4* wz = (u32x4*)((bf16_t*)(P.ws + WS_WIN) + (size_t)2496 * DM);
    for (int e = X.bid * NTHR + X.tid; e < 64 * DM * 2 / 16; e += X.G * NTHR) wz[e] = (u32x4){0u, 0u, 0u, 0u};
}

DI void cvt_item(const float* W, int ldw, int N, int k0, int n0, bf16_t* WT, int K, int row0, const float* kscale, float mul, LAS float* scr, int lane) {
    const int cq = 4 * (lane & 7), kr = lane >> 3;
#pragma unroll
    for (int i = 0; i < 8; ++i) { const int kk = 8 * i + kr, n = n0 + cq;
        f32x4 v = (n < N) ? *(const f32x4*)(W + (size_t)(k0 + kk) * ldw + n) : (f32x4){0.f, 0.f, 0.f, 0.f};
        const float sc = (kscale ? kscale[k0 + kk] : 1.f) * mul;
        scr[kk * 33 + cq] = v[0] * sc; scr[kk * 33 + cq + 1] = v[1] * sc; scr[kk * 33 + cq + 2] = v[2] * sc; scr[kk * 33 + cq + 3] = v[3] * sc; }
    LDS_WAIT(); asm volatile("" ::: "memory");
    const int c = lane & 7;
#pragma unroll
    for (int j = 0; j < 4; ++j) { const int nn = (lane >> 3) + 8 * j; const LAS float* s = scr + (8 * c) * 33 + nn;
        u32x4 o; o.x = pk2(s[0 * 33], s[1 * 33]); o.y = pk2(s[2 * 33], s[3 * 33]); o.z = pk2(s[4 * 33], s[5 * 33]); o.w = pk2(s[6 * 33], s[7 * 33]);
        *(u32x4*)(WT + (size_t)(row0 + nn) * K + k0 + 8 * c) = o; }
    LDS_WAIT(); asm volatile("" ::: "memory");
}
DI void convert_weights(const Params& P, Ctx& X, int l) {
    LAS float* scr = (LAS float*)(X.L + X.wave * 8704);
    const int gw = X.bid * NWAVE + X.wave, NGW = X.G * NWAVE;
    constexpr int I_IN = 16 * 78, I_OUT = 16 * 32, I_UQ = 4 * 12, I_UKV = 2 * 16, I_E = 768, NIT = I_IN + I_OUT + I_UQ + I_UKV + 16 * I_E;
    for (int it = gw; it < NIT; it += NGW) {
        int r = it;
        if (r < I_IN) { cvt_item(P.w_in + (size_t)l * DM * INW, INW, INW, 64 * (r / 78), 32 * (r % 78), (bf16_t*)(P.ws + WS_WIN), DM, 32 * (r % 78), nullptr, 1.f, scr, X.lane); continue; } r -= I_IN;
        if (r < I_OUT) { cvt_item(P.w_out + (size_t)l * DM * DM, DM, DM, 64 * (r / 32), 32 * (r % 32), (bf16_t*)(P.ws + WS_WOUT), DM, 32 * (r % 32), nullptr, 1.f, scr, X.lane); continue; } r -= I_OUT;
        if (r < I_UQ) { cvt_item(P.w_uq + (size_t)l * 256 * 384, 384, 384, 64 * (r / 12), 32 * (r % 12), (bf16_t*)(P.ws + WS_WUQ), 256, 32 * (r % 12), P.mq_g + l * 256, MLA_QS, scr, X.lane); continue; } r -= I_UQ;
        if (r < I_UKV) { cvt_item(P.w_ukv + (size_t)l * 128 * 512, 512, 512, 64 * (r / 16), 32 * (r % 16), (bf16_t*)(P.ws + WS_WUKV), 128, 32 * (r % 16), P.mkv_g + l * 128, 1.f, scr, X.lane); continue; } r -= I_UKV;
        const int e = r / I_E; r -= e * I_E;
        if (r < 256) { const int kb = r / 16, nb = r % 16;
            cvt_item(P.wg + ((size_t)l * 16 + e) * DM * 512, 512, 512, 64 * kb, 32 * nb, (bf16_t*)(P.ws + WS_WGU) + (size_t)e * 1024 * DM, DM, 256 * (nb >> 2) + 32 * (nb & 3), nullptr, 1.f, scr, X.lane); continue; } r -= 256;
        if (r < 256) { const int kb = r / 16, nb = r % 16;
            cvt_item(P.wu + ((size_t)l * 16 + e) * DM * 512, 512, 512, 64 * kb, 32 * nb, (bf16_t*)(P.ws + WS_WGU) + (size_t)e * 1024 * DM, DM, 256 * (nb >> 2) + 128 + 32 * (nb & 3), nullptr, 1.f, scr, X.lane); continue; } r -= 256;
        { const int kb = r / 32, nb = r % 32;
            cvt_item(P.wd + ((size_t)l * 16 + e) * 512 * DM, DM, DM, 64 * kb, 32 * nb, (bf16_t*)(P.ws + WS_WD) + (size_t)e * 1024 * 512, 512, 32 * nb, nullptr, 1.f, scr, X.lane); }
    }
}

DI int slot_base_lane(const unsigned* cnt, int lane) {
    int c = (lane < 16) ? (int)cnt[lane] : 0;
    int tiles = (c + 255) >> 8;
    int incl = tiles;
#pragma unroll
    for (int o = 1; o < 16; o <<= 1) { const int v = shupi(incl, o, lane); if (lane >= o) incl += v; }
    return (incl - tiles) * 256;
}

constexpr int RPC = 18;
struct RowIn { f32x4 h[4]; u32x2 y0[4], y1[4]; float w0, w1; };
DI void row_issue(const Params& P, RowIn& R, int l, int m, int sbase, const u32x4 ti, int lane) {
    const int b = m / T, t = m - b * T;
    if (l == 0) {
        const float* src = (t < CTX) ? P.ctx + ((size_t)b * CTX + t) * DM : P.x + ((size_t)b * SEQ + (t - CTX)) * DM;
#pragma unroll
        for (int j = 0; j < 4; ++j) R.h[j] = *(const f32x4*)(src + 256 * j + 4 * lane);
        R.w0 = 0.f; R.w1 = 0.f;
    } else {
        const float* hp = hrow(P, m);
        const bf16_t* YS = (const bf16_t*)(P.ws + WS_YS);
        const int s0 = shli(sbase, (int)(ti.x & 15u)) + (int)(ti.x >> 4), s1 = shli(sbase, (int)(ti.y & 15u)) + (int)(ti.y >> 4);
        const bf16_t* y0 = YS + (size_t)s0 * DM; const bf16_t* y1 = YS + (size_t)s1 * DM;
#pragma unroll
        for (int j = 0; j < 4; ++j) { const int cidx = 256 * j + 4 * lane; R.h[j] = *(const f32x4*)(hp + cidx); R.y0[j] = *(const u32x2*)(y0 + cidx); R.y1[j] = *(const u32x2*)(y1 + cidx); }
        R.w0 = __uint_as_float(ti.z); R.w1 = __uint_as_float(ti.w);
    }
}
DI float row_combine(const RowIn& R, bool comb, const f32x4 (&gp)[4], f32x4 (&v)[4]) {
    float ss = 0.f;
#pragma unroll
    for (int j = 0; j < 4; ++j) {
        if (comb) { const u32x2 a = R.y0[j], bb = R.y1[j];
            f32x4 yv; yv[0] = R.w0 * bflo(a.x) + R.w1 * bflo(bb.x); yv[1] = R.w0 * bfhi(a.x) + R.w1 * bfhi(bb.x); yv[2] = R.w0 * bflo(a.y) + R.w1 * bflo(bb.y); yv[3] = R.w0 * bfhi(a.y) + R.w1 * bfhi(bb.y);
            v[j] = R.h[j] + gp[j] * yv; }
        else v[j] = R.h[j];
        ss += v[j][0] * v[j][0] + v[j][1] * v[j][1] + v[j][2] * v[j][2] + v[j][3] * v[j][3]; }
    return ss;
}
DI void phase_norm1(const Params& P, Ctx& X, int l) {
    convert_weights(P, X, l);
    const float* MOD = (const float*)(P.ws + WS_MOD);
    bf16_t* ACT = (bf16_t*)(P.ws + WS_ACT);
    const u32x4* TOK = (const u32x4*)(P.ws + WS_TOK);
    const unsigned* cnt = (const unsigned*)(P.ws + WS_CTL) + CW_CNT + (l > 0 ? (l - 1) * 16 : 0);
    const int sbase = (l > 0) ? slot_base_lane(cnt, X.lane) : 0;
    const int gw = X.bid * NWAVE + X.wave, NGW = X.G * NWAVE, lane = X.lane;
    const float* g = P.g_mix + l * DM;
    const u32x4 tz = {0u, 0u, 0u, 0u};
    for (int ck = gw; ck < M / RPC; ck += NGW) {
        const int m0 = ck * RPC, b = m0 / T, t0 = m0 - b * T;
        int cur_cls = -1; f32x4 gs[4], sh[4], gp[4];
        RowIn cur, nxt;
        row_issue(P, cur, l, m0, sbase, (l > 0) ? TOK[m0] : tz, lane);
        u32x4 tiN = (l > 0) ? TOK[m0 + 1] : tz;
        for (int r = 0; r < RPC; ++r) {
            const int m = m0 + r, t = t0 + r, cls = (t < CTX) ? 1 : 0;
            if (r + 1 < RPC) row_issue(P, nxt, l, m + 1, sbase, tiN, lane);
            if (l > 0 && r + 2 < RPC) tiN = TOK[m + 2];
            if (cls != cur_cls) { cur_cls = cls;
                const float* mrow = MOD + ((size_t)l * 17 + (cls ? 16 : b)) * 6144;
                const float* gprev = MOD + ((size_t)(l > 0 ? l - 1 : 0) * 17 + (cls ? 16 : b)) * 6144 + 5 * DM;
#pragma unroll
                for (int j = 0; j < 4; ++j) { const int cidx = 256 * j + 4 * lane;
                    gs[j] = *(const f32x4*)(g + cidx) * (*(const f32x4*)(mrow + DM + cidx) + 1.f); sh[j] = *(const f32x4*)(mrow + cidx); gp[j] = *(const f32x4*)(gprev + cidx); } }
            f32x4 v[4];
            const float ss = row_combine(cur, l > 0, gp, v);
            float* hp = hrow(P, m);
#pragma unroll
            for (int j = 0; j < 4; ++j) *(f32x4*)(hp + 256 * j + 4 * lane) = v[j];
            const float rstd = rsqrtf(wave_sum(ss, lane) * (1.f / DM) + EPS);
#pragma unroll
            for (int j = 0; j < 4; ++j) { const f32x4 uu = v[j] * rstd * gs[j] + sh[j];
                u32x2 o; o.x = pk2(uu[0], uu[1]); o.y = pk2(uu[2], uu[3]);
                *(u32x2*)(ACT + (size_t)m * DM + 256 * j + 4 * lane) = o; }
            cur = nxt;
        }
    }
}
DI void phase_final(const Params& P, Ctx& X) {
    constexpr int RPF = 16;
    const float* MOD = (const float*)(P.ws + WS_MOD);
    const u32x4* TOK = (const u32x4*)(P.ws + WS_TOK);
    const unsigned* cnt = (const unsigned*)(P.ws + WS_CTL) + CW_CNT + 3 * 16;
    const int sbase = slot_base_lane(cnt, X.lane);
    const int gw = X.bid * NWAVE + X.wave, NGW = X.G * NWAVE, lane = X.lane;
    f32x4 fg[4];
#pragma unroll
    for (int j = 0; j < 4; ++j) fg[j] = *(const f32x4*)(P.fin_g + 256 * j + 4 * lane);
    for (int ck = gw; ck < NB * SEQ / RPF; ck += NGW) {
        const int r0 = ck * RPF, b = r0 / SEQ, m0 = b * T + CTX + (r0 - b * SEQ);
        f32x4 gp[4];
#pragma unroll
        for (int j = 0; j < 4; ++j) gp[j] = *(const f32x4*)(MOD + ((size_t)3 * 17 + b) * 6144 + 5 * DM + 256 * j + 4 * lane);
        RowIn cur, nxt;
        row_issue(P, cur, 3, m0, sbase, TOK[m0], lane);
        u32x4 tiN = TOK[m0 + 1];
        for (int r = 0; r < RPF; ++r) {
            const int m = m0 + r;
            if (r + 1 < RPF) row_issue(P, nxt, 3, m + 1, sbase, tiN, lane);
            if (r + 2 < RPF) tiN = TOK[m + 2];
            f32x4 v[4];
            const float ss = row_combine(cur, true, gp, v);
            const float rstd = rsqrtf(wave_sum(ss, lane) * (1.f / DM) + EPS);
            float* hp = P.out + (size_t)(r0 + r) * DM;
#pragma unroll
            for (int j = 0; j < 4; ++j) *(f32x4*)(hp + 256 * j + 4 * lane) = v[j] * rstd * fg[j];
            cur = nxt;
        }
    }
}

DI void phase_postproj(const Params& P, Ctx& X, int l, int sel = 15) {
    bf16_t* PROJ = (bf16_t*)(P.ws + WS_PROJ);
    const f32x2* rope = (const f32x2*)(P.ws + WS_ROPE);
    bf16_t* XBC = (bf16_t*)(P.ws + WS_XBC); float* DT = (float*)(P.ws + WS_DT);
    bf16_t* MLAQ = (bf16_t*)(P.ws + WS_MLAQ); bf16_t* MLAK = (bf16_t*)(P.ws + WS_MLAK);
    bf16_t* VTM = (bf16_t*)(P.ws + WS_VTM); bf16_t* VTD = (bf16_t*)(P.ws + WS_VTD);
    const bf16_t* WUQ = (const bf16_t*)(P.ws + WS_WUQ); const bf16_t* WUKV = (const bf16_t*)(P.ws + WS_WUKV);
    const int lane = X.lane, wave = X.wave;
    for (int u = X.bid; u < M / 144; u += X.G) {
        const int m0 = u * 144, b = m0 / T, t0 = m0 - b * T;
        __syncthreads();
        float cw[3][12], cb[12];
#pragma unroll
        for (int g3 = 0; g3 < 3; ++g3)
#pragma unroll
            for (int i = 0; i < 4; ++i) { const int ch = 256 * g3 + 4 * lane + i; cb[g3 * 4 + i] = P.conv_b[l * 768 + ch];
#pragma unroll
                for (int k = 0; k < 3; ++k) cw[k][g3 * 4 + i] = P.conv_w[((size_t)l * 3 + k) * 768 + ch]; }
        const int tw0 = t0 + wave * 18;
        const int vv = lane >> 2, d0 = 4 * (lane & 3);
        const float qs = (vv < 8) ? DA_QS : 1.f;
        struct RowRegs { u32x2 qa, qb, v, cq; unsigned ckv; unsigned short dtr, k1, k2; };
        LAS float* rs_q = (LAS float*)(X.L + 76800); LAS float* rs_kv = rs_q + 144;
        auto ld_row = [&](int t, RowRegs& R) { const bf16_t* prow = PROJ + ((size_t)b * T + t) * PW;
            R.qa = *(const u32x2*)(prow + vv * 32 + d0); R.qb = *(const u32x2*)(prow + vv * 32 + d0 + 16); R.v = *(const u32x2*)(prow + C_DAV + 4 * lane);
            R.dtr = prow[C_DT + (lane & 15)]; R.k1 = prow[C_KR + (lane & 15)]; R.k2 = prow[C_KR + 16 + (lane & 15)];
            R.cq = *(const u32x2*)(prow + C_CQ + 4 * lane); R.ckv = *(const unsigned*)(prow + C_CKV + 2 * lane); };
        auto ld_x = [&](int t, u32x2 (&xx)[3]) { const bool ok = (t >= 0 && t < T);
            const bf16_t* prow = PROJ + ((size_t)b * T + (ok ? t : 0)) * PW + C_XBC + 4 * lane;
#pragma unroll
            for (int g3 = 0; g3 < 3; ++g3) { xx[g3] = *(const u32x2*)(prow + 256 * g3); if (!ok) xx[g3] = (u32x2){0u, 0u}; } };
        RowRegs rc, rn; u32x2 xm[3], x0[3], xp[3], xq[3];
        ld_row(tw0, rc); ld_x(tw0 - 1, xm); ld_x(tw0, x0); ld_x(tw0 + 1, xp);
#pragma unroll 1
        for (int rr = 0; rr < ((sel & 1) ? 18 : 0); ++rr) {
            const int t = tw0 + rr; const size_t m = (size_t)b * T + t;
            if (rr + 1 < 18) ld_row(t + 1, rn);
            ld_x(t + 2, xq);
            bf16_t* prow = PROJ + m * PW;
            { const u32x2 a = rc.qa, bq = rc.qb;
              float x1[4] = {bflo(a.x), bfhi(a.x), bflo(a.y), bfhi(a.y)}, x2[4] = {bflo(bq.x), bfhi(bq.x), bflo(bq.y), bfhi(bq.y)};
              float o1[4], o2[4];
              if (t >= CTX) { const f32x2* rp = rope + (size_t)(t - CTX) * 16 + d0;
#pragma unroll
                  for (int i = 0; i < 4; ++i) { const f32x2 cs = rp[i]; o1[i] = (x1[i] * cs.x - x2[i] * cs.y) * qs; o2[i] = (x2[i] * cs.x + x1[i] * cs.y) * qs; } }
              else {
#pragma unroll
                  for (int i = 0; i < 4; ++i) { o1[i] = x1[i] * qs; o2[i] = x2[i] * qs; } }
              u32x2 w1, w2; w1.x = pk2(o1[0], o1[1]); w1.y = pk2(o1[2], o1[3]); w2.x = pk2(o2[0], o2[1]); w2.y = pk2(o2[2], o2[3]);
              bf16_t* p1 = prow + vv * 32 + d0;
              *(u32x2*)p1 = w1; *(u32x2*)(p1 + 16) = w2; }
            *(LAS u32x2*)(X.L + (size_t)(wave * 18 + rr) * 520 + lane * 8) = rc.v;
            { const float c0 = bflo(rc.cq.x), c1 = bfhi(rc.cq.x), c2 = bflo(rc.cq.y), c3 = bfhi(rc.cq.y), k0 = bflo(rc.ckv), k1 = bfhi(rc.ckv);
              const float sq = wave_sum(c0 * c0 + c1 * c1 + c2 * c2 + c3 * c3, lane), sk = wave_sum(k0 * k0 + k1 * k1, lane);
              if (lane == 0) { rs_q[wave * 18 + rr] = rsqrtf(sq * (1.f / 256.f) + EPS); rs_kv[wave * 18 + rr] = rsqrtf(sk * (1.f / 128.f) + EPS); } }
            { const int lo = (t < CTX) ? 0 : CTX, hi = (t < CTX) ? CTX : T;
              const bool hm = (t - 1 >= lo), hp = (t + 1 < hi);
#pragma unroll
              for (int g3 = 0; g3 < 3; ++g3) { const int ch = 256 * g3 + 4 * lane;
                  const u32x2 c0 = x0[g3]; u32x2 cm = xm[g3], cp = xp[g3];
                  if (!hm) cm = (u32x2){0u, 0u};
                  if (!hp) cp = (u32x2){0u, 0u};
                  const float xmv[4] = {bflo(cm.x), bfhi(cm.x), bflo(cm.y), bfhi(cm.y)}, x0v[4] = {bflo(c0.x), bfhi(c0.x), bflo(c0.y), bfhi(c0.y)}, xpv[4] = {bflo(cp.x), bfhi(cp.x), bflo(cp.y), bfhi(cp.y)};
                  float o[4];
#pragma unroll
                  for (int i = 0; i < 4; ++i) o[i] = silu(cb[g3 * 4 + i] + cw[0][g3 * 4 + i] * xmv[i] + cw[1][g3 * 4 + i] * x0v[i] + cw[2][g3 * 4 + i] * xpv[i]);
                  u32x2 w; w.x = pk2(o[0], o[1]); w.y = pk2(o[2], o[3]);
                  *(u32x2*)(XBC + m * 768 + ch) = w; } }
            if (lane < 16) { const float v = __uint_as_float(((unsigned)rc.dtr) << 16) + P.dt_bias[l * 16 + lane]; DT[m * 16 + lane] = (v > 20.f) ? v : log1pf(__expf(v)); }
            if (lane < 16) { const float x1 = __uint_as_float(((unsigned)rc.k1) << 16), x2 = __uint_as_float(((unsigned)rc.k2) << 16);
                float o1 = x1, o2 = x2;
                if (t >= CTX) { const f32x2 cs = rope[(size_t)(t - CTX) * 16 + lane]; o1 = x1 * cs.x - x2 * cs.y; o2 = x2 * cs.x + x1 * cs.y; }
                const bf16_t b1 = (bf16_t)(pk2(o1, 0.f) & 0xffffu), b2 = (bf16_t)(pk2(o2, 0.f) & 0xffffu);
#pragma unroll
                for (int h = 0; h < 4; ++h) { MLAK[(m * 4 + h) * 96 + 64 + lane] = b1; MLAK[(m * 4 + h) * 96 + 80 + lane] = b2; } }
            rc = rn;
#pragma unroll
            for (int g3 = 0; g3 < 3; ++g3) { xm[g3] = x0[g3]; x0[g3] = xp[g3]; xp[g3] = xq[g3]; }
        }
        __syncthreads();
        if (sel & 2) { const int vr = X.tid >> 1, th = X.tid & 1;
          bf16_t* dst = VTD + ((size_t)b * 256 + vr) * T + t0 + th * 72;
#pragma unroll 1
          for (int q8 = 0; q8 < 9; ++q8) { unsigned w[4];
#pragma unroll
              for (int i = 0; i < 4; ++i) { const int tt = th * 72 + q8 * 8 + 2 * i;
                  const unsigned lo = *(const LAS unsigned short*)(X.L + (size_t)tt * 520 + vr * 2), hi = *(const LAS unsigned short*)(X.L + (size_t)(tt + 1) * 520 + vr * 2);
                  w[i] = lo | (hi << 16); }
              *(u32x4*)(dst + q8 * 8) = (u32x4){w[0], w[1], w[2], w[3]}; } }
        if (sel & 4) { int lane_c = lane; asm volatile("" : "+v"(lane_c)); const int tk = lane_c & 15, q4 = lane_c >> 4;
#pragma unroll
          for (int pass = 0; pass < 2; ++pass) {
              constexpr int NCT_MAX = 2; const int nct = pass ? 2 : 1, ct0 = pass ? 1 : 0;
              bf16x8 bw[NCT_MAX][8];
#pragma unroll
              for (int ct = 0; ct < NCT_MAX; ++ct)
#pragma unroll
                  for (int s = 0; s < 8; ++s) if (ct < nct) bw[ct][s] = *(const bf16x8*)(WUQ + (size_t)((3 * wave + ct0 + ct) * 16 + tk) * 256 + 32 * s + 8 * q4);
              bf16x8 af[8], an[8];
#pragma unroll
              for (int s = 0; s < 8; ++s) af[s] = *(const bf16x8*)(PROJ + ((size_t)b * T + t0 + tk) * PW + C_CQ + 32 * s + 8 * q4);
#pragma unroll 1
              for (int rt = 0; rt < 9; ++rt) {
                  const int t = t0 + rt * 16 + tk; const size_t m = (size_t)b * T + t;
                  if (rt + 1 < 9) {
#pragma unroll
                      for (int s = 0; s < 8; ++s) an[s] = *(const bf16x8*)(PROJ + (m + 16) * PW + C_CQ + 32 * s + 8 * q4); }
                  const float rstd = ((LAS float*)(X.L + 76800))[rt * 16 + tk];
                  f32x4 acc[NCT_MAX];
#pragma unroll
                  for (int ct = 0; ct < NCT_MAX; ++ct) if (ct < nct) { acc[ct] = (f32x4){0.f, 0.f, 0.f, 0.f};
#pragma unroll
                      for (int s = 0; s < 8; ++s) acc[ct] = MFMA16(bw[ct][s], af[s], acc[ct]);
                      acc[ct] = acc[ct] * rstd; }
                  if (pass && (wave & 1) && t >= CTX) {
                      const f32x2* rp = rope + (size_t)(t - CTX) * 16 + 4 * q4;
#pragma unroll
                      for (int i = 0; i < 4; ++i) { const f32x2 cs = rp[i]; const float x1 = acc[0][i], x2 = acc[1][i]; acc[0][i] = x1 * cs.x - x2 * cs.y; acc[1][i] = x2 * cs.x + x1 * cs.y; } }
#pragma unroll
                  for (int ct = 0; ct < NCT_MAX; ++ct) if (ct < nct) { u32x2 w; w.x = pk2(acc[ct][0], acc[ct][1]); w.y = pk2(acc[ct][2], acc[ct][3]);
                      *(u32x2*)(MLAQ + m * 384 + (3 * wave + ct0 + ct) * 16 + 4 * q4) = w; }
#pragma unroll
                  for (int s = 0; s < 8; ++s) af[s] = an[s];
              }
          }
        }
        if (sel & 8) { const int tk = lane & 15, q4 = lane >> 4, hh = wave >> 1;
          bf16x8 bw[4][4];
#pragma unroll
          for (int ct = 0; ct < 4; ++ct)
#pragma unroll
              for (int s = 0; s < 4; ++s) bw[ct][s] = *(const bf16x8*)(WUKV + (size_t)((4 * wave + ct) * 16 + tk) * 128 + 32 * s + 8 * q4);
          bf16x8 af[4], an[4];
#pragma unroll
          for (int s = 0; s < 4; ++s) af[s] = *(const bf16x8*)(PROJ + ((size_t)b * T + t0 + tk) * PW + C_CKV + 32 * s + 8 * q4);
#pragma unroll 1
          for (int rt = 0; rt < 9; ++rt) {
              const int t = t0 + rt * 16 + tk; const size_t m = (size_t)b * T + t;
              if (rt + 1 < 9) {
#pragma unroll
                  for (int s = 0; s < 4; ++s) an[s] = *(const bf16x8*)(PROJ + (m + 16) * PW + C_CKV + 32 * s + 8 * q4); }
              const LAS float* rs_kv = (const LAS float*)(X.L + 76800) + 144;
              const float rstd = rs_kv[rt * 16 + tk];
              if ((wave & 1) == 0) {
#pragma unroll
                  for (int ct = 0; ct < 4; ++ct) { f32x4 acc = {0.f, 0.f, 0.f, 0.f};
#pragma unroll
                      for (int s = 0; s < 4; ++s) acc = MFMA16(bw[ct][s], af[s], acc);
                      acc = acc * rstd;
                      u32x2 w; w.x = pk2(acc[0], acc[1]); w.y = pk2(acc[2], acc[3]);
                      *(u32x2*)(MLAK + (m * 4 + hh) * 96 + ct * 16 + 4 * q4) = w; }
              } else {
                  const f32x4 rs = *(const LAS f32x4*)(rs_kv + rt * 16 + 4 * q4);
#pragma unroll
                  for (int ct = 0; ct < 4; ++ct) { f32x4 acc = {0.f, 0.f, 0.f, 0.f};
#pragma unroll
                      for (int s = 0; s < 4; ++s) acc = MFMA16(af[s], bw[ct][s], acc);
                      u32x2 w; w.x = pk2(acc[0] * rs[0], acc[1] * rs[1]); w.y = pk2(acc[2] * rs[2], acc[3] * rs[3]);
                      *(u32x2*)(VTM + (((size_t)b * 4 + hh) * 64 + ct * 16 + tk) * T + t0 + rt * 16 + 4 * q4) = w; }
              }
#pragma unroll
              for (int s = 0; s < 4; ++s) af[s] = an[s];
          }
        }
    }
}

template <int KIND>
DI void attn_unit(const Params& P, Ctx& X, int l, int b, int h, int qt, float lam, float lam_init) {
    constexpr int DK = KIND ? 96 : 64, KROW = DK * 2 + 16, NS = KIND ? 6 : 2;
    constexpr int KBUF = 64 * KROW, VROW = 136, VBUF = 64 * VROW;
    constexpr int OFF_K = 0, OFF_V = 2 * KBUF, OFF_X = 36864;
    const bf16_t* PROJ = (const bf16_t*)(P.ws + WS_PROJ);
    const bf16_t* MLAQ = (const bf16_t*)(P.ws + WS_MLAQ); const bf16_t* MLAK = (const bf16_t*)(P.ws + WS_MLAK);
    const bf16_t* VT = (const bf16_t*)(P.ws + (KIND ? WS_VTM : WS_VTD)) + ((size_t)b * 4 + h) * 64 * T;
    bf16_t* ACT = (bf16_t*)(P.ws + WS_ACT);
    const int tid = X.tid, lane = X.lane, wave = X.wave, r = lane & 31, hh = lane >> 5;
    const int mmw = KIND ? 0 : (wave & 1), qg = KIND ? wave : (wave >> 1);
    const bool is_ctx = KIND ? (qt == 0) : (qt < 2);
    const int nk = is_ctx ? CTX : T, ntile = nk / 64;
    const size_t mrow = (size_t)b * T + qt * (KIND ? 256 : 128) + qg * 32 + r;
    bf16x8 qf[NS];
#pragma unroll
    for (int s = 0; s < NS; ++s)
        qf[s] = KIND ? *(const bf16x8*)(MLAQ + mrow * 384 + h * 96 + 16 * s + 8 * hh) : *(const bf16x8*)(PROJ + mrow * PW + C_DAQ + h * 64 + mmw * 32 + 16 * s + 8 * hh);
    const int kcol = mmw * 64 + 16 * hh;
    const int kkey = KIND ? (tid / 12) : (tid >> 3), kpc = KIND ? (tid % 12) : (tid & 7);
    const int kkey2 = (512 + tid) / 12, kpc2 = (512 + tid) % 12;
    const int vdv = tid >> 3, vpc = tid & 7;
    u32x4 kr0, kr1 = {0u, 0u, 0u, 0u}, vr0;
    auto gload = [&](int it) {
        const int key0 = it * 64;
        if (KIND) { kr0 = *(const u32x4*)(MLAK + (((size_t)b * T + key0 + kkey) * 4 + h) * 96 + kpc * 8);
                    if (tid < 256) kr1 = *(const u32x4*)(MLAK + (((size_t)b * T + key0 + kkey2) * 4 + h) * 96 + kpc2 * 8); }
        else kr0 = *(const u32x4*)(PROJ + ((size_t)b * T + key0 + kkey) * PW + C_DAK + h * 64 + kpc * 8);
        vr0 = *(const u32x4*)(VT + (size_t)vdv * T + key0 + vpc * 8);
    };
    auto lstore = [&](int buf) {
        *(LAS u32x4*)(X.L + OFF_K + buf * KBUF + kkey * KROW + kpc * 16) = kr0;
        if (KIND && tid < 256) *(LAS u32x4*)(X.L + OFF_K + buf * KBUF + kkey2 * KROW + kpc2 * 16) = kr1;
        LAS unsigned char* vp = X.L + OFF_V + buf * VBUF + vdv * VROW + vpc * 16;
        *(LAS u32x2*)vp = (u32x2){vr0.x, vr0.y}; *(LAS u32x2*)(vp + 8) = (u32x2){vr0.z, vr0.w};
    };
    f32x16 O[2]; float mrun = -1e30f, lsum = 0.f;
#pragma unroll
    for (int d = 0; d < 2; ++d)
#pragma unroll
        for (int i = 0; i < 16; ++i) O[d][i] = 0.f;
    __syncthreads();
    gload(0); lstore(0);
    __syncthreads();
    for (int it = 0; it < ntile; ++it) {
        const int buf = it & 1;
        if (it + 1 < ntile) gload(it + 1);
        const LAS unsigned char* Kb = X.L + OFF_K + buf * KBUF; const LAS unsigned char* Vb = X.L + OFF_V + buf * VBUF;
        f32x16 S0, S1;
#pragma unroll
        for (int i = 0; i < 16; ++i) { S0[i] = 0.f; S1[i] = 0.f; }
#pragma unroll
        for (int s = 0; s < NS; ++s) {
            const bf16x8 k0 = *(const LAS bf16x8*)(Kb + r * KROW + kcol + 32 * s);
            const bf16x8 k1 = *(const LAS bf16x8*)(Kb + (32 + r) * KROW + kcol + 32 * s);
            S0 = MFMA32(k0, qf[s], S0); S1 = MFMA32(k1, qf[s], S1);
        }
        float mx = S0[0];
#pragma unroll
        for (int i = 1; i < 16; ++i) mx = fmaxf(mx, S0[i]);
#pragma unroll
        for (int i = 0; i < 16; ++i) mx = fmaxf(mx, S1[i]);
        mx = fmaxf(mx, shx(mx, 32, lane));
        const float mnew = fmaxf(mrun, mx), alpha = fexp2(mrun - mnew);
        mrun = mnew;
        float ps = 0.f;
#pragma unroll
        for (int i = 0; i < 16; ++i) { S0[i] = fexp2(S0[i] - mnew); S1[i] = fexp2(S1[i] - mnew); ps += S0[i] + S1[i]; }
        lsum = lsum * alpha + ps;
#pragma unroll
        for (int d = 0; d < 2; ++d)
#pragma unroll
            for (int i = 0; i < 16; ++i) O[d][i] *= alpha;
        bf16x8 pf[2][2];
#pragma unroll
        for (int s = 0; s < 2; ++s) {
            u32x4 w0, w1;
            w0.x = pk2(S0[8 * s + 0], S0[8 * s + 1]); w0.y = pk2(S0[8 * s + 2], S0[8 * s + 3]); w0.z = pk2(S0[8 * s + 4], S0[8 * s + 5]); w0.w = pk2(S0[8 * s + 6], S0[8 * s + 7]);
            w1.x = pk2(S1[8 * s + 0], S1[8 * s + 1]); w1.y = pk2(S1[8 * s + 2], S1[8 * s + 3]); w1.z = pk2(S1[8 * s + 4], S1[8 * s + 5]); w1.w = pk2(S1[8 * s + 6], S1[8 * s + 7]);
            pf[0][s] = __builtin_bit_cast(bf16x8, w0); pf[1][s] = __builtin_bit_cast(bf16x8, w1);
        }
#pragma unroll
        for (int d = 0; d < 2; ++d)
#pragma unroll
            for (int kb = 0; kb < 2; ++kb)
#pragma unroll
                for (int s = 0; s < 2; ++s) {
                    const LAS unsigned char* vp = Vb + (32 * d + r) * VROW + (32 * kb + 16 * s + 4 * hh) * 2;
                    const s16x4 lo = *(const LAS s16x4*)vp, hi = *(const LAS s16x4*)(vp + 16);
                    const bf16x8 vf = __builtin_shufflevector(lo, hi, 0, 1, 2, 3, 4, 5, 6, 7);
                    O[d] = MFMA32(vf, pf[kb][s], O[d]);
                }
        if (it + 1 < ntile) lstore(buf ^ 1);
        __syncthreads();
    }
    const float inv = 1.f / (lsum + shx(lsum, 32, lane));
    if (KIND == 0) {
        LAS float* xb = (LAS float*)(X.L + OFF_X) + qg * 2048 + lane;
        if (mmw == 1) {
#pragma unroll
            for (int d = 0; d < 2; ++d)
#pragma unroll
                for (int i = 0; i < 16; ++i) xb[(d * 16 + i) * 64] = O[d][i] * inv;
        }
        __syncthreads();
        if (mmw == 0) {
            float ss = 0.f;
#pragma unroll
            for (int d = 0; d < 2; ++d)
#pragma unroll
                for (int i = 0; i < 16; ++i) { const float o = O[d][i] * inv - lam * xb[(d * 16 + i) * 64]; O[d][i] = o; ss += o * o; }
            ss += shx(ss, 32, lane);
            const float rstd = rsqrtf(ss * (1.f / 64.f) + EPS) * (1.f - lam_init);
#pragma unroll
            for (int d = 0; d < 2; ++d)
#pragma unroll
                for (int g4 = 0; g4 < 4; ++g4) { const int dv = 32 * d + 8 * g4 + 4 * hh; const f32x4 gg = *(const f32x4*)(P.da_g + l * 64 + dv);
                    u32x2 w; w.x = pk2(O[d][4 * g4] * rstd * gg[0], O[d][4 * g4 + 1] * rstd * gg[1]); w.y = pk2(O[d][4 * g4 + 2] * rstd * gg[2], O[d][4 * g4 + 3] * rstd * gg[3]);
                    *(u32x2*)(ACT + mrow * DM + h * 64 + dv) = w; }
        }
    } else {
#pragma unroll
        for (int d = 0; d < 2; ++d)
#pragma unroll
            for (int g4 = 0; g4 < 4; ++g4) { const int dv = 32 * d + 8 * g4 + 4 * hh;
                u32x2 w; w.x = pk2(O[d][4 * g4] * inv, O[d][4 * g4 + 1] * inv); w.y = pk2(O[d][4 * g4 + 2] * inv, O[d][4 * g4 + 3] * inv);
                *(u32x2*)(ACT + mrow * DM + 768 + h * 64 + dv) = w; }
    }
}

DI void ssd_unit(const Params& P, Ctx& X, int l, int b, int hd, int dir) {
    constexpr int OFF_BR = 0, OFF_CR = 18432, OFF_XT = 36864, OFF_XS = 53760, OFF_BT = 71168, OFF_SB = 88576, OFF_AC = 98304, OFF_DTT = 98816;
    const bf16_t* XBC = (const bf16_t*)(P.ws + WS_XBC); const float* DT = (const float*)(P.ws + WS_DT);
    bf16_t* Y = (bf16_t*)(P.ws + (dir ? WS_YB : WS_YF));
    const int tid = X.tid, lane = X.lane, wave = X.wave, r = lane & 31, hh = lane >> 5, grp = hd >> 2;
    const float a = -__expf(P.a_log[l * 16 + dir * 8 + hd]);
    LAS unsigned char* L = X.L;
    LAS float* t_ac = (LAS float*)(L + OFF_AC); LAS float* t_dt = (LAS float*)(L + OFF_DTT);
    f32x4 Sacc[2] = {{0.f, 0.f, 0.f, 0.f}, {0.f, 0.f, 0.f, 0.f}};
    const size_t rb = (size_t)b * T;
    const int tau = tid >> 2, q2 = tid & 3;
    const int tq = tid & 31, pg = tid >> 5;
    u32x4 br[2], cr[2]; u32x2 xt[4], bt[4]; float dt0, dt1;
    auto chunk_tok = [&](int c, int& tbase, int& tstep) { const int seg0 = (c < 2) ? 0 : CTX, seg1 = (c < 2) ? CTX : T, cc = (c < 2) ? c : c - 2;
        tbase = dir ? (seg1 - 1 - 128 * cc) : (seg0 + 128 * cc); tstep = dir ? -1 : 1; };
    auto issue = [&](int c) { int tbase, tstep; chunk_tok(c, tbase, tstep);
        const bf16_t* rowp = XBC + (rb + tbase + tstep * tau) * 768;
#pragma unroll
        for (int k = 0; k < 2; ++k) { const int pc = 2 * q2 + k; br[k] = *(const u32x4*)(rowp + 512 + grp * 64 + 8 * pc); cr[k] = *(const u32x4*)(rowp + 640 + grp * 64 + 8 * pc); }
#pragma unroll
        for (int i = 0; i < 4; ++i) { const bf16_t* rp = XBC + (rb + tbase + tstep * (4 * tq + i)) * 768; xt[i] = *(const u32x2*)(rp + hd * 64 + 4 * pg); bt[i] = *(const u32x2*)(rp + 512 + grp * 64 + 4 * pg); }
        dt0 = DT[(rb + tbase + tstep * (2 * lane)) * 16 + dir * 8 + hd]; dt1 = DT[(rb + tbase + tstep * (2 * lane + 1)) * 16 + dir * 8 + hd]; };
    issue(0);
    __syncthreads();
    for (int c = 0; c < 18; ++c) {
        int tbase, tstep; chunk_tok(c, tbase, tstep);
        const float v0 = dt0 * a, v1 = dt1 * a, s2 = v0 + v1; float incl = s2;
#pragma unroll
        for (int o = 1; o < 64; o <<= 1) { const float v = shup(incl, o, lane); if (lane >= o) incl += v; }
        const float ac0 = incl - s2 + v0, ac1 = incl;
        const float alast = shl(incl, 63);
        if (wave == 0) { *(LAS f32x2*)(t_ac + 2 * lane) = (f32x2){ac0, ac1}; *(LAS f32x2*)(t_dt + 2 * lane) = (f32x2){dt0, dt1}; }
        {
#pragma unroll
            for (int k = 0; k < 2; ++k) { const int pc = 2 * q2 + k;
                *(LAS u32x4*)(L + OFF_BR + tau * 144 + pc * 16) = br[k]; *(LAS u32x4*)(L + OFF_CR + tau * 144 + pc * 16) = cr[k]; }
            float wj[4];
#pragma unroll
            for (int i = 0; i < 4; ++i) { const int tk = 4 * tq + i, src = tk >> 1;
                const float a_t = (i & 1) ? shl(ac1, src) : shl(ac0, src), d_t = (i & 1) ? shl(dt1, src) : shl(dt0, src);
                wj[i] = __expf(alast - a_t) * d_t; }
            float xe[4][4]; unsigned short be[4][4];
#pragma unroll
            for (int i = 0; i < 4; ++i) { xe[i][0] = bflo(xt[i].x); xe[i][1] = bfhi(xt[i].x); xe[i][2] = bflo(xt[i].y); xe[i][3] = bfhi(xt[i].y);
                be[i][0] = (unsigned short)(bt[i].x & 0xffffu); be[i][1] = (unsigned short)(bt[i].x >> 16); be[i][2] = (unsigned short)(bt[i].y & 0xffffu); be[i][3] = (unsigned short)(bt[i].y >> 16); }
#pragma unroll
            for (int f = 0; f < 4; ++f) { const int p = 4 * pg + f;
                u32x2 w; w.x = pk2(xe[0][f], xe[1][f]); w.y = pk2(xe[2][f], xe[3][f]);
                *(LAS u32x2*)(L + OFF_XT + p * 264 + tq * 8) = w;
                w.x = pk2(xe[0][f] * wj[0], xe[1][f] * wj[1]); w.y = pk2(xe[2][f] * wj[2], xe[3][f] * wj[3]);
                *(LAS u32x2*)(L + OFF_XS + p * 272 + tq * 8) = w;
                w.x = (unsigned)be[0][f] | ((unsigned)be[1][f] << 16); w.y = (unsigned)be[2][f] | ((unsigned)be[3][f] << 16);
                *(LAS u32x2*)(L + OFF_BT + p * 272 + tq * 8) = w; }
#pragma unroll
            for (int k = 0; k < 2; ++k) { const int tl = 2 * wave + k, pt = tl >> 2, nt = tl & 3, n = 16 * nt + (lane & 15), p = 16 * pt + 4 * (lane >> 4);
#pragma unroll
                for (int i = 0; i < 4; ++i) *(LAS unsigned short*)(L + OFF_SB + (p + i) * 144 + n * 2) = (unsigned short)(pk2(Sacc[k][i], 0.f) & 0xffffu); }
        }
        __syncthreads();
        if (c + 1 < 18) issue(c + 1);
        {
            const int ib = wave >> 1, pb = wave & 1, i_tok = 32 * ib + r;
            const float acum_i = t_ac[i_tok];
            bf16x8 cf[4];
#pragma unroll
            for (int s = 0; s < 4; ++s) cf[s] = *(const LAS bf16x8*)(L + OFF_CR + i_tok * 144 + (16 * s + 8 * hh) * 2);
            f32x16 accO, accD;
#pragma unroll
            for (int i = 0; i < 16; ++i) { accO[i] = 0.f; accD[i] = 0.f; }
#pragma unroll
            for (int s = 0; s < 4; ++s) { const bf16x8 sa = *(const LAS bf16x8*)(L + OFF_SB + (32 * pb + r) * 144 + (16 * s + 8 * hh) * 2); accO = MFMA32(sa, cf[s], accO); }
            for (int jb = 0; jb <= ib; ++jb) {
                f32x16 g;
#pragma unroll
                for (int i = 0; i < 16; ++i) g[i] = 0.f;
#pragma unroll
                for (int s = 0; s < 4; ++s) { const bf16x8 ba = *(const LAS bf16x8*)(L + OFF_BR + (32 * jb + r) * 144 + (16 * s + 8 * hh) * 2); g = MFMA32(ba, cf[s], g); }
#pragma unroll
                for (int g4 = 0; g4 < 4; ++g4) { const int j0 = 32 * jb + 8 * g4 + 4 * hh;
                    const f32x4 aj = *(const LAS f32x4*)(L + OFF_AC + j0 * 4), dj = *(const LAS f32x4*)(L + OFF_DTT + j0 * 4);
#pragma unroll
                    for (int i = 0; i < 4; ++i) { const float arg = fminf(acum_i - aj[i], 0.f); const float wv = __expf(arg) * dj[i] * g[4 * g4 + i]; g[4 * g4 + i] = (j0 + i <= i_tok) ? wv : 0.f; } }
#pragma unroll
                for (int s = 0; s < 2; ++s) {
                    u32x4 w; w.x = pk2(g[8 * s + 0], g[8 * s + 1]); w.y = pk2(g[8 * s + 2], g[8 * s + 3]); w.z = pk2(g[8 * s + 4], g[8 * s + 5]); w.w = pk2(g[8 * s + 6], g[8 * s + 7]);
                    const bf16x8 wf = __builtin_bit_cast(bf16x8, w);
                    const LAS unsigned char* xp = L + OFF_XT + (32 * pb + r) * 264 + (32 * jb + 16 * s + 4 * hh) * 2;
                    const s16x4 lo = *(const LAS s16x4*)xp, hi = *(const LAS s16x4*)(xp + 16);
                    const bf16x8 xf = __builtin_shufflevector(lo, hi, 0, 1, 2, 3, 4, 5, 6, 7);
                    accD = MFMA32(xf, wf, accD);
                }
            }
            const float ei = __expf(acum_i);
            bf16_t* yp = Y + (rb + tbase + tstep * i_tok) * 512 + hd * 64 + 32 * pb + 4 * hh;
#pragma unroll
            for (int g4 = 0; g4 < 4; ++g4) { u32x2 w; w.x = pk2(accD[4 * g4] + ei * accO[4 * g4], accD[4 * g4 + 1] + ei * accO[4 * g4 + 1]); w.y = pk2(accD[4 * g4 + 2] + ei * accO[4 * g4 + 2], accD[4 * g4 + 3] + ei * accO[4 * g4 + 3]);
                *(u32x2*)(yp + 8 * g4) = w; }
        }
        {
            const float dec = __expf(alast);
#pragma unroll
            for (int k = 0; k < 2; ++k) { const int tl = 2 * wave + k, pt = tl >> 2, nt = tl & 3;
                f32x4 acc = Sacc[k] * dec;
#pragma unroll
                for (int s = 0; s < 4; ++s) {
                    const bf16x8 xa = *(const LAS bf16x8*)(L + OFF_XS + (16 * pt + (lane & 15)) * 272 + (32 * s + 8 * (lane >> 4)) * 2);
                    const bf16x8 bb = *(const LAS bf16x8*)(L + OFF_BT + (16 * nt + (lane & 15)) * 272 + (32 * s + 8 * (lane >> 4)) * 2);
                    acc = MFMA16(xa, bb, acc); }
                Sacc[k] = acc; }
        }
        __syncthreads();
    }
}

DI void phase_mixers(const Params& P, Ctx& X, int l, int sel = 7) {
    const float lam_init = 0.8f - 0.6f * __expf(-0.3f * (float)l);
    float l01 = 0.f, l23 = 0.f;
    if (X.lane < 32) { const float* lv = P.da_lam + l * 128; l01 = lv[X.lane] * lv[32 + X.lane]; l23 = lv[64 + X.lane] * lv[96 + X.lane]; }
    const float lam = __expf(wave_sum(l01, X.lane)) - __expf(wave_sum(l23, X.lane)) + lam_init;
    if (sel & 1) for (int u = X.bid; u < NB * 8 * 2; u += X.G) ssd_unit(P, X, l, u >> 4, (u >> 1) & 7, u & 1);
    if (sel & 2) for (int u = X.bid; u < 1024; u += X.G) attn_unit<0>(P, X, l, u >> 6, (u >> 4) & 3, 2 + (u & 15), lam, lam_init);
    if (sel & 4) for (int u = X.bid; u < 512; u += X.G) attn_unit<1>(P, X, l, u >> 5, (u >> 3) & 3, 1 + (u & 7), lam, lam_init);
    for (int u = X.bid; u < 192; u += X.G) { if (u < 128) { if (sel & 2) attn_unit<0>(P, X, l, u >> 3, (u >> 1) & 3, u & 1, lam, lam_init); } else { if (sel & 4) attn_unit<1>(P, X, l, (u - 128) >> 2, u & 3, 0, lam, lam_init); } }
}

DI void phase_ssdgate(const Params& P, Ctx& X, int l) {
    const bf16_t* PROJ = (const bf16_t*)(P.ws + WS_PROJ); const bf16_t* XBC = (const bf16_t*)(P.ws + WS_XBC);
    const bf16_t* YF = (const bf16_t*)(P.ws + WS_YF); const bf16_t* YB = (const bf16_t*)(P.ws + WS_YB);
    bf16_t* ACT = (bf16_t*)(P.ws + WS_ACT);
    const int gw = X.bid * NWAVE + X.wave, NGW = X.G * NWAVE, c0 = 8 * X.lane;
    const float dsk = P.ssd_d[l * 8 + (X.lane >> 3)];
    const f32x4 g0 = *(const f32x4*)(P.ssd_g + l * 512 + c0), g1 = *(const f32x4*)(P.ssd_g + l * 512 + c0 + 4);
    for (int m = gw; m < M; m += NGW) {
        const u32x4 yf = *(const u32x4*)(YF + (size_t)m * 512 + c0), yb = *(const u32x4*)(YB + (size_t)m * 512 + c0), xv = *(const u32x4*)(XBC + (size_t)m * 768 + c0), zv = *(const u32x4*)(PROJ + (size_t)m * PW + C_Z + c0);
        const unsigned yfw[4] = {yf.x, yf.y, yf.z, yf.w}, ybw[4] = {yb.x, yb.y, yb.z, yb.w}, xw[4] = {xv.x, xv.y, xv.z, xv.w}, zw[4] = {zv.x, zv.y, zv.z, zv.w};
        float v[8]; float ss = 0.f;
#pragma unroll
        for (int i = 0; i < 4; ++i) {
            v[2 * i] = (bflo(yfw[i]) + bflo(ybw[i]) + dsk * bflo(xw[i])) * silu(bflo(zw[i]));
            v[2 * i + 1] = (bfhi(yfw[i]) + bfhi(ybw[i]) + dsk * bfhi(xw[i])) * silu(bfhi(zw[i]));
            ss += v[2 * i] * v[2 * i] + v[2 * i + 1] * v[2 * i + 1]; }
        const float rstd = rsqrtf(wave_sum(ss, X.lane) * (1.f / 512.f) + EPS);
        u32x4 w; w.x = pk2(v[0] * rstd * g0[0], v[1] * rstd * g0[1]); w.y = pk2(v[2] * rstd * g0[2], v[3] * rstd * g0[3]); w.z = pk2(v[4] * rstd * g1[0], v[5] * rstd * g1[1]); w.w = pk2(v[6] * rstd * g1[2], v[7] * rstd * g1[3]);
        *(u32x4*)(ACT + (size_t)m * DM + 256 + c0) = w;
    }
}

DI float reduce16(const float (&lg)[16], int lane) {
    float x8[8], x4[4], x2[2];
    const bool b3 = (lane & 8) != 0, b2 = (lane & 4) != 0, b1 = (lane & 2) != 0, b0 = (lane & 1) != 0;
#pragma unroll
    for (int i = 0; i < 8; ++i) { const float keep = b3 ? lg[i + 8] : lg[i], send = b3 ? lg[i] : lg[i + 8]; x8[i] = keep + shx(send, 8, lane); }
#pragma unroll
    for (int i = 0; i < 4; ++i) { const float keep = b2 ? x8[i + 4] : x8[i], send = b2 ? x8[i] : x8[i + 4]; x4[i] = keep + shx(send, 4, lane); }
#pragma unroll
    for (int i = 0; i < 2; ++i) { const float keep = b1 ? x4[i + 2] : x4[i], send = b1 ? x4[i] : x4[i + 2]; x2[i] = keep + shx(send, 2, lane); }
    const float keep = b0 ? x2[1] : x2[0], send = b0 ? x2[0] : x2[1];
    float x = keep + shx(send, 1, lane);
    x += shx(x, 16, lane); x += shx(x, 32, lane);
    return x;
}
DI void route_select(float x, float rbias, int lane, int& i1, int& i2, float& w1, float& w2) {
    const float aff = 1.f / (1.f + expf(-x)), sel = aff + rbias;
    const float q1 = shx(sel, 1, lane), q2 = shx(sel, 2, lane), q3 = shx(sel, 3, lane);
    const float hi1 = fmaxf(sel, q1), lo1 = fminf(sel, q1), hi2 = fmaxf(q2, q3), lo2 = fminf(q2, q3);
    const float gs = fmaxf(hi1, hi2) + fmaxf(fminf(hi1, hi2), fmaxf(lo1, lo2));
    const float g0 = shl(gs, 0), g1 = shl(gs, 4), g2 = shl(gs, 8), g3 = shl(gs, 12);
    int best = 0; float bs = g0;
    if (g1 > bs) { bs = g1; best = 1; }
    if (g2 > bs) { bs = g2; best = 2; }
    if (g3 > bs) { bs = g3; best = 3; }
    int j1 = 0, j2 = 0; float v1 = -1e30f, v2 = -1e30f, a1 = 0.f, a2 = 0.f;
#pragma unroll
    for (int j = 0; j < 4; ++j) { const float s = shl(sel, 4 * best + j), a = shl(aff, 4 * best + j);
        if (s > v1) { v2 = v1; j2 = j1; a2 = a1; v1 = s; j1 = j; a1 = a; } else if (s > v2) { v2 = s; j2 = j; a2 = a; } }
    i1 = 4 * best + j1; i2 = 4 * best + j2; w1 = a1 / (a1 + a2); w2 = a2 / (a1 + a2);
}
DI void phase_norm2_route(const Params& P, Ctx& X, int l) {
    const float* MOD = (const float*)(P.ws + WS_MOD);
    bf16_t* ACT = (bf16_t*)(P.ws + WS_ACT);
    u32x4* TOK = (u32x4*)(P.ws + WS_TOK); int* LIST = (int*)(P.ws + WS_LIST);
    unsigned* cnt = (unsigned*)(P.ws + WS_CTL) + CW_CNT + l * 16;
    const int lane = X.lane;
    constexpr int RPW = 36;
    LAS unsigned* lcnt = (LAS unsigned*)(X.L + 65536); LAS unsigned* lbase = lcnt + 16; LAS unsigned* ltab = lcnt + 64;
    __syncthreads();
    for (int k = X.tid; k < DM; k += NTHR) { const int j = k >> 8, ln = (k >> 2) & 63, i = k & 3, slot = (4 * j + i) * 64 + ln;
#pragma unroll
        for (int e4 = 0; e4 < 4; ++e4) *(LAS f32x4*)(X.L + ((size_t)e4 * 1024 + slot) * 16) = *(const f32x4*)(P.r_w + k * 16 + 4 * e4); }
    if (X.tid < 32) lcnt[X.tid] = 0u;
    __syncthreads();
    const float rbias = P.r_b[lane & 15];
    const int gw = X.bid * NWAVE + X.wave, NGW = X.G * NWAVE;
    const float* g = P.g_ffn + l * DM;
    int it = 0;
    for (int ck = gw; ck < M / RPC; ck += NGW, ++it) {
        const int m0 = ck * RPC, b = m0 / T, t0 = m0 - b * T;
        int cur_cls = -1; f32x4 gs[4], sh[4];
        f32x4 c0[4], n0[4];
        { const float* h0 = hrow(P, m0);
#pragma unroll
          for (int j = 0; j < 4; ++j) c0[j] = *(const f32x4*)(h0 + 256 * j + 4 * lane); }
#pragma unroll 1
        for (int r = 0; r < RPC; ++r) {
            const int m = m0 + r, t = t0 + r, cls = (t < CTX) ? 1 : 0;
            if (r + 1 < RPC) { const float* h0 = hrow(P, m + 1);
#pragma unroll
                for (int j = 0; j < 4; ++j) n0[j] = *(const f32x4*)(h0 + 256 * j + 4 * lane); }
            if (!(l == DEPTH - 1 && cls)) {
                if (cls != cur_cls) { cur_cls = cls;
                    const float* mrow = MOD + ((size_t)l * 17 + (cls ? 16 : b)) * 6144;
#pragma unroll
                    for (int j = 0; j < 4; ++j) { const int cidx = 256 * j + 4 * lane;
                        gs[j] = *(const f32x4*)(g + cidx) * (*(const f32x4*)(mrow + 4 * DM + cidx) + 1.f); sh[j] = *(const f32x4*)(mrow + 3 * DM + cidx); } }
                float s0 = 0.f;
#pragma unroll
                for (int j = 0; j < 4; ++j) s0 += c0[j][0] * c0[j][0] + c0[j][1] * c0[j][1] + c0[j][2] * c0[j][2] + c0[j][3] * c0[j][3];
                const float r0 = rsqrtf(wave_sum(s0, lane) * (1.f / DM) + EPS);
                float lg0[16];
#pragma unroll
                for (int e = 0; e < 16; ++e) lg0[e] = 0.f;
#pragma unroll
                for (int j = 0; j < 4; ++j) { const int cidx = 256 * j + 4 * lane;
                    const f32x4 u0 = c0[j] * r0 * gs[j] + sh[j];
                    u32x2 o; o.x = pk2(u0[0], u0[1]); o.y = pk2(u0[2], u0[3]); *(u32x2*)(ACT + (size_t)m * DM + cidx) = o;
#pragma unroll
                    for (int i = 0; i < 4; ++i) { const int slot = (4 * j + i) * 64 + lane;
#pragma unroll
                        for (int e4 = 0; e4 < 4; ++e4) { const f32x4 rw = *(const LAS f32x4*)(X.L + ((size_t)e4 * 1024 + slot) * 16);
                            lg0[4 * e4] += u0[i] * rw[0]; lg0[4 * e4 + 1] += u0[i] * rw[1]; lg0[4 * e4 + 2] += u0[i] * rw[2]; lg0[4 * e4 + 3] += u0[i] * rw[3]; } } }
                int a1, a2; float wa1, wa2;
                route_select(reduce16(lg0, lane), rbias, lane, a1, a2, wa1, wa2);
                if (lane == 0) {
                    LAS unsigned* rec = ltab + (X.wave * RPW + it * RPC + r) * 4;
                    const unsigned ra1 = __hip_atomic_fetch_add(lcnt + a1, 1u, __ATOMIC_RELAXED, __HIP_MEMORY_SCOPE_WORKGROUP), ra2 = __hip_atomic_fetch_add(lcnt + a2, 1u, __ATOMIC_RELAXED, __HIP_MEMORY_SCOPE_WORKGROUP);
                    rec[0] = (unsigned)a1 | (ra1 << 4); rec[1] = (unsigned)a2 | (ra2 << 4); rec[2] = __float_as_uint(wa1); rec[3] = __float_as_uint(wa2);
                }
            }
#pragma unroll
            for (int j = 0; j < 4; ++j) c0[j] = n0[j];
        }
    }
    __syncthreads();
    if (X.tid < 16) { const unsigned c = lcnt[X.tid]; lbase[X.tid] = c ? atomicAdd(&cnt[X.tid], c) : 0u; }
    __syncthreads();
    it = 0;
    for (int ck = gw; ck < M / RPC; ck += NGW, ++it) {
        const int m0 = ck * RPC, b = m0 / T, t0 = m0 - b * T;
        if (lane < RPC) { const int m = m0 + lane, t = t0 + lane;
            if (!(l == DEPTH - 1 && t < CTX)) {
                const LAS unsigned* rec = ltab + (X.wave * RPW + it * RPC + lane) * 4;
                const unsigned e1 = rec[0] & 15u, e2 = rec[1] & 15u, p1 = lbase[e1] + (rec[0] >> 4), p2 = lbase[e2] + (rec[1] >> 4);
                LIST[(size_t)e1 * M + p1] = m; LIST[(size_t)e2 * M + p2] = m;
                u32x4 ti; ti.x = e1 | (p1 << 4); ti.y = e2 | (p2 << 4); ti.z = rec[2]; ti.w = rec[3];
                TOK[m] = ti; } }
    }
}
DI void moe_tables(const Params& P, Ctx& X, int l) {
    __syncthreads();
    if (X.tid < 64) { const unsigned* cnt = (const unsigned*)(P.ws + WS_CTL) + CW_CNT + l * 16;
        const int c = (X.lane < 16) ? (int)__hip_atomic_load(cnt + (X.lane & 15), __ATOMIC_RELAXED, __HIP_MEMORY_SCOPE_AGENT) : 0;
        const int tiles = (c + 255) >> 8; int incl = tiles;
#pragma unroll
        for (int o = 1; o < 16; o <<= 1) { const int v = shupi(incl, o, X.lane); if (X.lane >= o) incl += v; }
        if (X.lane < 16) { X.misc[16 + X.lane] = c; X.misc[32 + X.lane] = incl - tiles; X.misc[64 + X.lane] = (incl - tiles) * 256; }
        if (X.lane == 15) X.misc[32 + 16] = incl; }
    __syncthreads();
}

constexpr int N_PHASES = 38;
__global__ void __launch_bounds__(NTHR, 2) mk_fwd(Params PK) {
    const Params& P0 = PK; const Params* kp = &PK;
    extern __shared__ __attribute__((aligned(16))) unsigned char lds_raw[];
    Ctx X;
    X.L = (LAS unsigned char*)lds_raw; X.misc = (volatile LAS int*)(X.L + LDS_MISC); X.ws = PK.ws;
    X.tid = threadIdx.x; X.lane = X.tid & 63; X.wave = __builtin_amdgcn_readfirstlane(X.tid >> 6); X.G = gridDim.x; X.bid = blockIdx.x;
    const int wave0 = X.wave;
    if (X.tid < 128) X.misc[X.tid] = 0;
    __syncthreads();
    unsigned* ctl = (unsigned*)(PK.ws + WS_CTL);
    XcdBarrier bar; bar.bar = ctl + CW_BAR; bar.x = 0; bar.st = (volatile LAS unsigned*)X.misc;
    const bool multi = ((PK.ph_hi & 255) - PK.ph_lo) > 1;
    if (multi) bar = xcd_barrier_post(ctl + CW_BAR, (volatile LAS unsigned*)X.misc);
#ifndef PHMASK
#define PHMASK 0xFFFF
#endif
#define RUN(ph) (PK.ph_lo <= (ph) && (ph) < (PK.ph_hi & 255))
#define HAS(k) ((PHMASK >> (k)) & 1)
#define SEAM(ph) do { if (RUN(ph) && RUN((ph) + 1)) { FRESH(); xcd_barrier(bar, X.tid); } } while (0)
#define FRESH() do { int _t = wave0 * 64 + (int)__builtin_amdgcn_mbcnt_hi(~0u, __builtin_amdgcn_mbcnt_lo(~0u, 0u)); asm volatile("" : "+v"(_t)); X.tid = _t; X.lane = _t & 63; X.wave = __builtin_amdgcn_readfirstlane(_t >> 6); \
        const __attribute__((address_space(4))) Params* _kp = (const __attribute__((address_space(4))) Params*)__builtin_amdgcn_kernarg_segment_ptr(); asm volatile("" : "+s"(_kp)); kp = (const Params*)_kp; X.ws = kp->ws; \
        int _b = blockIdx.x, _g = gridDim.x; asm volatile("" : "+s"(_b), "+s"(_g)); X.bid = _b; X.G = _g; } while (0)
#define P (*kp)
    if (HAS(9) && RUN(0)) phase_prologue(P, X);
    SEAM(0);
#pragma unroll 1
    for (int l = 0; l < DEPTH; ++l) {
        const int pb = 1 + 9 * l;
        FRESH(); if (HAS(0) && RUN(pb + 0)) phase_norm1(P, X, l);
        SEAM(pb + 0);
        FRESH(); if (HAS(1) && RUN(pb + 1)) { DenseSched S; S.init(P.ws + WS_ACT, P.ws + WS_WIN, M, PW, DM, X.G, X.bid); EpiStoreBf16 E{(bf16_t*)(P.ws + WS_PROJ), PW}; gemm8(X.L, DM, S, E); }
        SEAM(pb + 1);
        FRESH(); if (HAS(2) && RUN(pb + 2)) phase_postproj(P, X, l, (PK.ph_hi >> 8) ? (PK.ph_hi >> 8) : 15);
        SEAM(pb + 2);
        FRESH(); if (HAS(3) && RUN(pb + 3)) phase_mixers(P, X, l, (PK.ph_hi >> 8) ? (PK.ph_hi >> 8) : 7);
        SEAM(pb + 3);
        FRESH(); if (HAS(4) && RUN(pb + 4)) phase_ssdgate(P, X, l);
        SEAM(pb + 4);
        FRESH(); if (HAS(5) && RUN(pb + 5)) { DenseSched S; S.init(P.ws + WS_ACT, P.ws + WS_WOUT, M, DM, DM, X.G, X.bid);
            EpiResidual E{(float*)(P.ws + WS_HC), P.out, (const float*)(P.ws + WS_MOD) + (size_t)l * 17 * 6144}; gemm8(X.L, DM, S, E); }
        SEAM(pb + 5);
        FRESH(); if (HAS(6) && RUN(pb + 6)) phase_norm2_route(P, X, l);
        SEAM(pb + 6);
        FRESH(); if (HAS(7) && RUN(pb + 7)) { moe_tables(P, X, l);
            MoeSched<true> S{(const char*)(P.ws + WS_ACT), (const char*)(P.ws + WS_WGU), (const int*)(P.ws + WS_LIST), X.misc, DM, X.G, X.bid};
            EpiGateUp E{(bf16_t*)(P.ws + WS_HE)}; gemm8(X.L, DM, S, E); }
        SEAM(pb + 7);
        FRESH(); if (HAS(8) && RUN(pb + 8)) { moe_tables(P, X, l);
            MoeSched<false> S{(const char*)(P.ws + WS_HE), (const char*)(P.ws + WS_WD), nullptr, X.misc, 512, X.G, X.bid};
            EpiStoreBf16 E{(bf16_t*)(P.ws + WS_YS), DM}; gemm8(X.L, 512, S, E); }
        SEAM(pb + 8);
    }
    FRESH(); if (HAS(10) && RUN(37)) phase_final(P, X);
#undef P
#undef RUN
#undef SEAM
}
}

#ifndef PROBE_SEL
#define PROBE_SEL 0
#endif
#ifndef MK_MODE
#define MK_MODE 1
#endif
extern "C" void kernel_launch(void* const* d_in, const int* in_sizes, int n_in, void* d_out, int out_size, void* d_ws, size_t ws_size, hipStream_t stream) {
    using namespace mk;
    static int grid = 0;
    if (grid == 0) {
        if (n_in != 28 || ws_size < WS_END) { fprintf(stderr, "kernel_launch: unexpected inputs (n_in %d, ws %zu < %zu)\n", n_in, ws_size, (size_t)WS_END); grid = -1; return; }
        int dev = 0, cus = 0, per_cu = 0;
        if (hipGetDevice(&dev) != hipSuccess || hipDeviceGetAttribute(&cus, hipDeviceAttributeMultiprocessorCount, dev) != hipSuccess) { grid = -1; return; }
        if (hipFuncSetAttribute((const void*)mk_fwd, hipFuncAttributeMaxDynamicSharedMemorySize, LDS_BYTES) != hipSuccess) { fprintf(stderr, "kernel_launch: hipFuncSetAttribute failed\n"); grid = -1; return; }
        if (hipOccupancyMaxActiveBlocksPerMultiprocessor(&per_cu, (const void*)mk_fwd, NTHR, LDS_BYTES) != hipSuccess || per_cu < 1) { fprintf(stderr, "kernel_launch: occupancy query says %d\n", per_cu); (void)hipGetLastError(); grid = -1; return; }
        grid = cus;
    }
    if (grid < 0) return;
    (void)hipMemsetAsync((char*)d_ws + WS_CTL, 0, CTL_BYTES, stream);
    Params p{};
    const float** pp = (const float**)&p;
    for (int i = 0; i < 28; ++i) pp[i] = (const float*)d_in[i];
    p.out = (float*)d_out; p.ws = (unsigned char*)d_ws;
#if MK_MODE == 1
    p.ph_lo = 0; p.ph_hi = N_PHASES;
    hipLaunchKernelGGL(mk_fwd, dim3(grid), dim3(NTHR), LDS_BYTES, stream, p);
#else
    for (int ph = 0; ph < N_PHASES; ++ph) { p.ph_lo = ph; p.ph_hi = ph + 1; hipLaunchKernelGGL(mk_fwd, dim3(grid), dim3(NTHR), LDS_BYTES, stream, p);
#if MK_MODE == 3
        if (ph == PROBE_PH) for (int r = 0; r < PROBE_REP; ++r) hipLaunchKernelGGL(mk_fwd, dim3(grid), dim3(NTHR), LDS_BYTES, stream, p);
#endif
    }
#if MK_MODE == 2
    p.out = (float*)((unsigned char*)d_ws + WS_PROJ);
    for (int r = 0; r < PROBE_REP; ++r) { p.ph_lo = PROBE_PH; p.ph_hi = (PROBE_PH + 1) | (PROBE_SEL << 8); hipLaunchKernelGGL(mk_fwd, dim3(grid), dim3(NTHR), LDS_BYTES, stream, p); }
#endif
#endif
}
```

```cpp
#include <hip/hip_runtime.h>
#include <cstdio>
#include <cstdint>

namespace mk {
#if defined(MK_MODE) && MK_MODE == 4
#define MIX_STAMP(c) do { if (X.tid == 0) { const unsigned long long _n = __builtin_amdgcn_s_memrealtime(); const unsigned long long _p = ((unsigned long long)(unsigned)X.misc[94] << 32) | (unsigned)X.misc[95]; X.misc[96 + (c)] += (int)(unsigned)(_n - _p); X.misc[94] = (int)(unsigned)(_n >> 32); X.misc[95] = (int)(unsigned)_n; } } while (0)
#endif
#define LAS __attribute__((address_space(3)))
#define DI __device__ __forceinline__
typedef unsigned short bf16_t;
typedef short bf16x8 __attribute__((ext_vector_type(8)));
typedef short s16x4 __attribute__((ext_vector_type(4)));
typedef float f32x2 __attribute__((ext_vector_type(2)));
typedef float f32x4 __attribute__((ext_vector_type(4)));
typedef float f32x16 __attribute__((ext_vector_type(16)));
typedef unsigned u32x2 __attribute__((ext_vector_type(2)));
typedef unsigned u32x4 __attribute__((ext_vector_type(4)));
typedef __bf16 bf16x2_t __attribute__((ext_vector_type(2)));
typedef short v4i16_t __attribute__((ext_vector_type(4)));

constexpr int DM = 1024, NB = 16, SEQ = 2048, CTX = 256, T = SEQ + CTX, M = NB * T, DEPTH = 4;
constexpr int PW = 2560, INW = 2480;
constexpr int C_DAQ = 0, C_DAK = 256, C_DAV = 512, C_Z = 768, C_XBC = 1280, C_DT = 2048, C_CQ = 2064, C_CKV = 2320, C_KR = 2448;
constexpr float EPS = 1e-6f, LOG2E = 1.4426950408889634f;
constexpr float DA_QS = 0.17677669529663687f * LOG2E, MLA_QS = 0.10206207261596577f * LOG2E;
constexpr int NSLOT = 2 * M + 4096;
constexpr int NTHR = 512, NWAVE = 8;

constexpr size_t MiB = 1u << 20;
constexpr size_t WS_CTL = 0, CTL_BYTES = 1 * MiB;
constexpr size_t WS_MOD = 1 * MiB, WS_ROPE = 3 * MiB, WS_HC = 4 * MiB;
constexpr size_t WS_WIN = 20 * MiB, WS_WOUT = 25 * MiB, WS_WUQ = 27 * MiB, WS_WUKV = 27 * MiB + 512 * 1024, WS_WGU = 28 * MiB, WS_WD = 60 * MiB;
constexpr size_t WS_ACT = 76 * MiB, WS_PROJ = 148 * MiB;
constexpr size_t WS_MLAQ = 328 * MiB, WS_MLAK = 355 * MiB, WS_VTM = 382 * MiB, WS_VTD = 400 * MiB;
constexpr size_t WS_XBC = 418 * MiB, WS_DT = 472 * MiB, WS_YF = 475 * MiB, WS_YB = 511 * MiB, WS_TOK = 547 * MiB, WS_LIST = 548 * MiB, WS_H = 551 * MiB, WS_END = 623 * MiB;
constexpr size_t WS_HE = WS_MLAQ, WS_YS = WS_PROJ, WS_MIX = WS_PROJ;
static_assert((size_t)NSLOT * 512 * 2 <= WS_XBC - WS_MLAQ, "HE alias");
static_assert((size_t)NSLOT * 1024 * 2 <= WS_MLAQ - WS_PROJ, "YS alias");
constexpr int CW_BAR = 4096, CW_CNT = 8192;

constexpr int LDS_MISC = 131072, LDS_IDX = LDS_MISC + 1024, MOE_MAXU = 8, LDS_BYTES = LDS_IDX + MOE_MAXU * 1024;

struct Params {
    const float *x, *c, *ctx, *c_ctx, *g_mix, *g_ffn, *w_mod, *b_mod, *w_in, *w_out, *da_lam, *da_g, *conv_w, *conv_b, *dt_bias, *a_log, *ssd_d, *ssd_g,
                *mq_g, *mkv_g, *w_uq, *w_ukv, *r_w, *r_b, *wg, *wu, *wd, *fin_g;
    float* out; unsigned char* ws; int ph_lo, ph_hi;
};

DI unsigned pk2(float lo, float hi) { f32x2 v = {lo, hi}; bf16x2_t b = __builtin_convertvector(v, bf16x2_t); return __builtin_bit_cast(unsigned, b); }
DI float bflo(unsigned w) { return __uint_as_float(w << 16); }
DI float bfhi(unsigned w) { return __uint_as_float(w & 0xffff0000u); }
DI float shx(float v, int o, int lane) { return __int_as_float(__builtin_amdgcn_ds_bpermute((lane ^ o) << 2, __float_as_int(v))); }
DI float shl(float v, int src) { return __int_as_float(__builtin_amdgcn_ds_bpermute(src << 2, __float_as_int(v))); }
DI int shli(int v, int src) { return __builtin_amdgcn_ds_bpermute(src << 2, v); }
DI float shup(float v, int o, int lane) { return __int_as_float(__builtin_amdgcn_ds_bpermute((lane - o) << 2, __float_as_int(v))); }
DI int shupi(int v, int o, int lane) { return __builtin_amdgcn_ds_bpermute((lane - o) << 2, v); }
DI float wave_sum(float v, int lane) {
#pragma unroll
    for (int o = 1; o < 64; o <<= 1) v += shx(v, o, lane);
    return v;
}
DI float silu(float x) { return x * __builtin_amdgcn_rcpf(1.f + __expf(-x)); }
DI float fexp2(float x) { return __builtin_amdgcn_exp2f(x); }
DI float max3f(float a, float b, float c) { return __builtin_fmaxf(__builtin_fmaxf(a, b), c); }
#define LDS_WAIT() asm volatile("s_waitcnt lgkmcnt(0)" ::: "memory")
#define MFMA32(a, b, c) __builtin_amdgcn_mfma_f32_32x32x16_bf16((a), (b), (c), 0, 0, 0)
#define MFMA16(a, b, c) __builtin_amdgcn_mfma_f32_16x16x32_bf16((a), (b), (c), 0, 0, 0)
DI int crow(int reg, int h) { return (reg & 3) + 8 * (reg >> 2) + 4 * h; }

#define XB_TMO      128
#define XB_XCNT(j)  (256  + 64 * (j))
#define XB_XSUB(j)  (1280 + 64 * (j))
#define XB_XGEN(j)  (2304 + 64 * (j))
#define XB_TOP      3328
#define XB_TOPGEN   3392
#define XCD_BAR_WORDS 3456
#define XB_SPIN_CAP (1u << 22)
DI unsigned xb_ld(unsigned* p)              { return __hip_atomic_load(p, __ATOMIC_RELAXED, __HIP_MEMORY_SCOPE_AGENT); }
DI unsigned xb_add(unsigned* p, unsigned v) { return __hip_atomic_fetch_add(p, v, __ATOMIC_RELAXED, __HIP_MEMORY_SCOPE_AGENT); }
DI unsigned xb_xcc_id() { return (unsigned)__builtin_amdgcn_s_getreg((3 << 11) | 20) & 0xFu; }
#define XB_SPIN(cond, bar) do { unsigned _sp = 0; while (cond) { __builtin_amdgcn_s_sleep(1); \
    if ((++_sp & 255u) == 0u) { if (xb_ld(&(bar)[XB_TMO])) break; if (_sp > XB_SPIN_CAP) { atomicAdd(&(bar)[XB_TMO], 1u); break; } } } } while (0)
struct XcdBarrier { unsigned* bar; unsigned x; volatile LAS unsigned* st; };
DI XcdBarrier xcd_barrier_post(unsigned* bar, volatile LAS unsigned* st) {
    XcdBarrier b; b.bar = bar; b.x = xb_xcc_id(); b.st = st;
    if (threadIdx.x == 0) (void)xb_add(&bar[XB_XCNT(b.x)], 1u);
    return b;
}
DI void xcd_barrier_complete(unsigned* bar, unsigned x, unsigned& nloc, unsigned& nx) {
    const unsigned G = gridDim.x * gridDim.y * gridDim.z;
    unsigned sum, cnt, mine, sp = 0u;
    for (;;) {
        sum = 0u; cnt = 0u; mine = 0u;
#pragma unroll
        for (unsigned j = 0; j < 16; ++j) { const unsigned c = xb_ld(&bar[XB_XCNT(j)]); sum += c; cnt += (c > 0u) ? 1u : 0u; }
        mine = xb_ld(&bar[XB_XCNT(x)]);
        if (sum == G) break;
        __builtin_amdgcn_s_sleep(1);
        if ((++sp & 255u) == 0u) { if (xb_ld(&bar[XB_TMO])) break; if (sp > XB_SPIN_CAP) { atomicAdd(&bar[XB_TMO], 1u); break; } }
    }
    nloc = mine > 0u ? mine : 1u; nx = cnt > 0u ? cnt : 1u;
}
DI void xcd_barrier(const XcdBarrier& b, int tid) {
    asm volatile("s_waitcnt vmcnt(0)" ::: "memory");
    __syncthreads();
    if (tid == 0) {
        unsigned* bar = b.bar;
        __builtin_amdgcn_s_waitcnt(0);
        unsigned nloc = b.st[0], nx = b.st[1];
        if (nloc == 0u) { xcd_barrier_complete(bar, b.x, nloc, nx); b.st[0] = nloc; b.st[1] = nx; }
        const unsigned old = xb_add(&bar[XB_XSUB(b.x)], 1u);
        const unsigned gen = old / nloc;
        if (old + 1u == (gen + 1u) * nloc) {
            __builtin_amdgcn_fence(__ATOMIC_RELEASE, "agent");
            asm volatile("s_waitcnt vmcnt(0)" ::: "memory");
            const unsigned og = xb_add(&bar[XB_TOP], 1u);
            const unsigned tg = og / nx;
            if (og + 1u == (tg + 1u) * nx) xb_add(&bar[XB_TOPGEN], 1u);
            else XB_SPIN(xb_ld(&bar[XB_TOPGEN]) == tg, bar);
            __builtin_amdgcn_fence(__ATOMIC_ACQUIRE, "agent");
            xb_add(&bar[XB_XGEN(b.x)], 1u);
            asm volatile("s_waitcnt vmcnt(0)" ::: "memory");
        } else {
            XB_SPIN(xb_ld(&bar[XB_XGEN(b.x)]) == gen, bar);
            __builtin_amdgcn_fence(__ATOMIC_ACQUIRE, "agent");
            asm volatile("s_waitcnt vmcnt(0)" ::: "memory");
        }
    }
    __syncthreads();
}

constexpr int HTB = 128 * 64 * 2;
DI int lds_byte(int r, int c) { const int st = (r >> 4) * 2 + (c >> 5), rr = r & 15, cc = c & 31, ob = rr * 64 + cc * 2; return st * 1024 + (ob ^ (((ob >> 9) & 1) << 5)); }
DI void stage_rc(int b, int& R, int& C) { const int st = b / 1024, sb = b % 1024, swz = sb ^ (((sb >> 9) & 1) << 5); R = (st >> 1) * 16 + swz / 64; C = (st & 1) * 32 + (swz % 64) / 2; }
DI int perm32(int rho) { const int n = rho >> 4, i = rho & 15; return 8 * (i >> 2) + 4 * n + (i & 3); }

struct GUnit { const char* A; const char* B; int pm, pn, e, row0, ord; };

template <class Epi, class Sched>
DI void gemm8(LAS unsigned char* lds, const int K, const Sched& S, const Epi& E, int tid_in) {
    int tid_ = tid_in; asm volatile("" : "+v"(tid_));
    const int tid = tid_, wid = __builtin_amdgcn_readfirstlane(tid >> 6), lane = tid & 63, wr = wid >> 2, wc = wid & 3, fr = lane & 15, fq = lane >> 4;
    const int nt = K / 64;
    int R[2], C[2]; unsigned voffB[2];
#pragma unroll
    for (int i = 0; i < 2; ++i) { stage_rc(tid * 16 + i * 8192, R[i], C[i]); const int Rb = Epi::PERM ? ((R[i] & ~31) + perm32(R[i] & 31)) : R[i]; voffB[i] = (unsigned)(Rb * K + C[i]) * 2u; }
    const size_t kstep = 128;
    const size_t hstepB = (size_t)128 * K * 2;
    const unsigned ldsw = (unsigned)wid * 1024u;
    const int aoff = lds_byte(wr * 64 + fr, fq * 8), boff = lds_byte(wc * 32 + fr, fq * 8);
#define G8_SA(b, h) (((b) * 2 + (h)) * HTB)
#define G8_SB(b, h) ((4 + (b) * 2 + (h)) * HTB)
#define G8_STAGE(bufoff, gbase, voff) do { _Pragma("unroll") for (int _i = 0; _i < 2; ++_i) \
        __builtin_amdgcn_global_load_lds((const unsigned*)((const char*)(gbase) + (voff)[_i]), (LAS unsigned*)(lds + (bufoff) + ldsw + _i * 8192), 16, 0, 0); } while (0)
#define G8_LDA(dst, b, h) do { _Pragma("unroll") for (int m = 0; m < 4; ++m) _Pragma("unroll") for (int k = 0; k < 2; ++k) dst[m][k] = *(const LAS bf16x8*)(lds + G8_SA(b, h) + aoff + m * 2048 + k * 1024); } while (0)
#define G8_LDB(dst, b, h) do { _Pragma("unroll") for (int n = 0; n < 2; ++n) _Pragma("unroll") for (int k = 0; k < 2; ++k) dst[n][k] = *(const LAS bf16x8*)(lds + G8_SB(b, h) + boff + n * 2048 + k * 1024); } while (0)
#define G8_MMA(ai, bj, At, Bt) do { __builtin_amdgcn_s_setprio(1); _Pragma("unroll") for (int m = 0; m < 4; ++m) _Pragma("unroll") for (int n = 0; n < 2; ++n) _Pragma("unroll") for (int k = 0; k < 2; ++k) \
        acc[ai][bj][m][n] = __builtin_amdgcn_mfma_f32_16x16x32_bf16(Bt[n][k], At[m][k], acc[ai][bj][m][n], 0, 0, 0); __builtin_amdgcn_s_setprio(0); } while (0)
#define G8_WAIT_V(n) asm volatile("s_waitcnt vmcnt(" #n ")" ::: "memory")
#define G8_WAIT_L(n) asm volatile("s_waitcnt lgkmcnt(" #n ")" ::: "memory")
#define G8_BAR __builtin_amdgcn_s_barrier()
#define G8_SCHED __builtin_amdgcn_sched_barrier(0)
    GUnit cur, nxt; int ui = 0;
    if (!S.next(0, cur)) return;
    unsigned aoC[2][2], aoN[2][2];
    S.aoff(cur, R, C, aoC);
    if constexpr (Sched::UNIFORM_AOFF) {
#pragma unroll
        for (int h = 0; h < 2; ++h)
#pragma unroll
            for (int i = 0; i < 2; ++i) aoN[h][i] = aoC[h][i]; }
    f32x4 acc[2][2][4][2];
#pragma unroll
    for (int a = 0; a < 2; ++a)
#pragma unroll
        for (int b = 0; b < 2; ++b)
#pragma unroll
            for (int m = 0; m < 4; ++m)
#pragma unroll
                for (int n = 0; n < 2; ++n) acc[a][b][m][n] = (f32x4){0.f, 0.f, 0.f, 0.f};
    bf16x8 At[4][2], B0[2][2], B1[2][2];
    const char* cA = cur.A; const char* cB = cur.B;
    asm volatile("s_waitcnt vmcnt(0)" ::: "memory");
    G8_STAGE(G8_SB(0, 0), cB, voffB); G8_STAGE(G8_SA(0, 0), cA, aoC[0]); G8_STAGE(G8_SB(0, 1), cB + hstepB, voffB); G8_STAGE(G8_SA(0, 1), cA, aoC[1]);
    if (wr == 1) G8_BAR;
    G8_WAIT_V(4); G8_BAR;
    G8_STAGE(G8_SB(1, 0), cB + kstep, voffB); G8_STAGE(G8_SA(1, 0), cA + kstep, aoC[0]); G8_STAGE(G8_SB(1, 1), cB + hstepB + kstep, voffB);
    G8_WAIT_V(6); G8_BAR;
    for (;;) {
        const bool has_next = S.next(ui + 1, nxt);
        if constexpr (!Sched::UNIFORM_AOFF) {
        if (has_next) S.aoff(nxt, R, C, aoN);
        else {
#pragma unroll
            for (int h = 0; h < 2; ++h)
#pragma unroll
                for (int i = 0; i < 2; ++i) aoN[h][i] = aoC[h][i]; } }
        const char* nA = has_next ? nxt.A : cA; const char* nB = has_next ? nxt.B : cB;
        for (int t = 0; t < nt; t += 2) {
            const bool last = (t == nt - 2);
            const char* a1 = cA + (size_t)(t + 1) * kstep;
            const char* a2 = last ? nA : cA + (size_t)(t + 2) * kstep; const char* b2 = last ? nB : cB + (size_t)(t + 2) * kstep;
            const char* a3 = a2 + kstep; const char* b3 = b2 + kstep;
            unsigned ao2[2][2];
#pragma unroll
            for (int h = 0; h < 2; ++h)
#pragma unroll
                for (int i = 0; i < 2; ++i) ao2[h][i] = (!Sched::UNIFORM_AOFF && last) ? aoN[h][i] : aoC[h][i];
            G8_LDB(B0, 0, 0); G8_SCHED; G8_LDA(At, 0, 0); G8_STAGE(G8_SA(1, 1), a1, aoC[1]);
            G8_WAIT_L(8); G8_BAR; G8_WAIT_L(0); G8_MMA(0, 0, At, B0); G8_BAR; G8_SCHED;
            G8_LDB(B1, 0, 1); G8_STAGE(G8_SB(0, 0), b2, voffB);
            G8_BAR; G8_WAIT_L(0); G8_MMA(0, 1, At, B1); G8_BAR;
            G8_LDA(At, 0, 1); G8_STAGE(G8_SA(0, 0), a2, ao2[0]);
            G8_BAR; G8_WAIT_L(0); G8_MMA(1, 0, At, B0); G8_BAR; G8_SCHED;
            G8_STAGE(G8_SB(0, 1), b2 + hstepB, voffB);
            G8_WAIT_V(6); G8_BAR; G8_MMA(1, 1, At, B1); G8_BAR;
            G8_LDB(B0, 1, 0); G8_SCHED; G8_LDA(At, 1, 0); G8_STAGE(G8_SA(0, 1), a2, ao2[1]);
            G8_WAIT_L(8); G8_BAR; G8_WAIT_L(0); G8_MMA(0, 0, At, B0); G8_BAR; G8_SCHED;
            G8_LDB(B1, 1, 1); G8_STAGE(G8_SB(1, 0), b3, voffB);
            G8_BAR; G8_WAIT_L(0); G8_MMA(0, 1, At, B1); G8_BAR;
            G8_LDA(At, 1, 1); G8_STAGE(G8_SA(1, 0), a3, ao2[0]);
            G8_BAR; G8_WAIT_L(0); G8_MMA(1, 0, At, B0); G8_BAR; G8_SCHED;
            G8_STAGE(G8_SB(1, 1), b3 + hstepB, voffB);
            G8_WAIT_V(6); G8_BAR; G8_MMA(1, 1, At, B1); G8_BAR;
        }
        E(acc, cur, wr, wc, fr, fq);
        if (!has_next) break;
#pragma unroll
        for (int a = 0; a < 2; ++a)
#pragma unroll
            for (int b = 0; b < 2; ++b)
#pragma unroll
                for (int m = 0; m < 4; ++m)
#pragma unroll
                    for (int n = 0; n < 2; ++n) acc[a][b][m][n] = (f32x4){0.f, 0.f, 0.f, 0.f};
        cur = nxt; cA = nA; cB = nB; ++ui;
        if constexpr (!Sched::UNIFORM_AOFF) {
#pragma unroll
        for (int h = 0; h < 2; ++h)
#pragma unroll
            for (int i = 0; i < 2; ++i) aoC[h][i] = aoN[h][i]; }
    }
    G8_WAIT_V(0);
    if (wr == 0) G8_BAR;
    G8_BAR;
#undef G8_SA
#undef G8_SB
#undef G8_STAGE
#undef G8_LDA
#undef G8_LDB
#undef G8_MMA
#undef G8_WAIT_V
#undef G8_WAIT_L
#undef G8_BAR
#undef G8_SCHED
}

constexpr int NXCD = 8, WGM = 8;
struct DenseSched {
    static constexpr bool UNIFORM_AOFF = true;
    const char* A; const char* Bt; int K, nM, nN, nwg, G, c;
    DI void init(const void* A_, const void* Bt_, int Mrows, int N, int K_, int G_, int c_) { A = (const char*)A_; Bt = (const char*)Bt_; K = K_; nM = Mrows / 256; nN = N / 256; nwg = nM * nN; G = G_; c = c_; }
    DI bool next(int i, GUnit& u) const {
        const long L = (long)i * G + c; if (L >= nwg) return false;
        int wgid = (int)L; { const int q = nwg / NXCD, r = nwg % NXCD, xcd = wgid % NXCD, off = wgid / NXCD; wgid = (xcd < r ? xcd * (q + 1) : r * (q + 1) + (xcd - r) * q) + off; }
        const int nig = WGM * nN, gid = wgid / nig, fm = gid * WGM, gsz = (nM - fm) < WGM ? (nM - fm) : WGM;
        u.pm = fm + ((wgid % nig) % gsz); u.pn = (wgid % nig) / gsz; u.e = 0; u.row0 = u.pm * 256; u.ord = i;
        u.A = A + (size_t)u.pm * 256 * K * 2; u.B = Bt + (size_t)u.pn * 256 * K * 2; return true;
    }
    DI void aoff(const GUnit&, const int (&R)[2], const int (&C)[2], unsigned (&off)[2][2]) const {
#pragma unroll
        for (int h = 0; h < 2; ++h)
#pragma unroll
            for (int i = 0; i < 2; ++i) off[h][i] = (unsigned)((h * 128 + R[i]) * K + C[i]) * 2u;
    }
};
template <bool GATHER>
struct MoeSched {
    static constexpr bool UNIFORM_AOFF = !GATHER;
    const char* A; const char* W; const int* list; volatile LAS int* misc; int K, G, c;
    DI bool next(int i, GUnit& u) const {
        const int L = i * G + c;
        const int RT = __builtin_amdgcn_readfirstlane(misc[32 + 16]);
        const int x = L & 7, y = L >> 3, rpx = (RT + 7) >> 3, j = y >> 2, rt = x * rpx + j; u.pn = y & 3;
        if (j >= rpx || rt >= RT) return false;
        int e = 0;
#pragma unroll
        for (int j = 1; j < 16; ++j) { const int tp = __builtin_amdgcn_readfirstlane(misc[32 + j]); if (tp <= rt) e = j; }
        const int tp = __builtin_amdgcn_readfirstlane(misc[32 + e]);
        u.e = e; u.pm = rt - tp; u.row0 = __builtin_amdgcn_readfirstlane(misc[64 + e]) + u.pm * 256; u.ord = i;
        u.A = GATHER ? A : A + (size_t)u.row0 * K * 2;
        u.B = W + ((size_t)e * 1024 + (size_t)u.pn * 256) * K * 2;
        return true;
    }
    DI void aoff(const GUnit& u, const int (&R)[2], const int (&C)[2], unsigned (&off)[2][2]) const {
        if (GATHER) {
            const LAS int* tab = (const LAS int*)((const LAS unsigned char*)misc + (LDS_IDX - LDS_MISC)) + (u.ord & (MOE_MAXU - 1)) * 256;
#pragma unroll
            for (int h = 0; h < 2; ++h)
#pragma unroll
                for (int i = 0; i < 2; ++i) { const int tok = tab[h * 128 + R[i]]; off[h][i] = (unsigned)(tok * K + C[i]) * 2u; }
        } else {
#pragma unroll
            for (int h = 0; h < 2; ++h)
#pragma unroll
                for (int i = 0; i < 2; ++i) off[h][i] = (unsigned)((h * 128 + R[i]) * K + C[i]) * 2u;
        }
    }
};

struct EpiStoreBf16 {
    static constexpr bool PERM = true;
    bf16_t* O; int ldc;
    DI void operator()(const f32x4 (&acc)[2][2][4][2], const GUnit& u, int wr, int wc, int fr, int fq) const {
        const int row0 = u.row0 + wr * 64 + fr, col0 = u.pn * 256 + wc * 32 + 8 * fq;
#pragma unroll
        for (int ai = 0; ai < 2; ++ai)
#pragma unroll
            for (int m = 0; m < 4; ++m) { bf16_t* rowp = O + (size_t)(row0 + ai * 128 + m * 16) * ldc + col0;
#pragma unroll
                for (int bj = 0; bj < 2; ++bj) { const f32x4 v0 = acc[ai][bj][m][0], v1 = acc[ai][bj][m][1];
                    u32x4 w; w.x = pk2(v0[0], v0[1]); w.y = pk2(v0[2], v0[3]); w.z = pk2(v1[0], v1[1]); w.w = pk2(v1[2], v1[3]);
                    *(u32x4*)(rowp + bj * 128) = w; } }
    }
};
struct EpiGateUp {
    static constexpr bool PERM = true;
    bf16_t* O;
    DI void operator()(const f32x4 (&acc)[2][2][4][2], const GUnit& u, int wr, int wc, int fr, int fq) const {
        const int row0 = u.row0 + wr * 64 + fr, col0 = u.pn * 128 + wc * 32 + 8 * fq;
#pragma unroll
        for (int ai = 0; ai < 2; ++ai)
#pragma unroll
            for (int m = 0; m < 4; ++m) { bf16_t* rowp = O + (size_t)(row0 + ai * 128 + m * 16) * 512 + col0;
                float hv[8];
#pragma unroll
                for (int n = 0; n < 2; ++n)
#pragma unroll
                    for (int i = 0; i < 4; ++i) hv[n * 4 + i] = silu(acc[ai][0][m][n][i]) * acc[ai][1][m][n][i];
                u32x4 w; w.x = pk2(hv[0], hv[1]); w.y = pk2(hv[2], hv[3]); w.z = pk2(hv[4], hv[5]); w.w = pk2(hv[6], hv[7]);
                *(u32x4*)rowp = w; }
    }
};
struct EpiResidual {
    static constexpr bool PERM = false;
    float* hc; float* hx; const float* modl;
    DI void operator()(const f32x4 (&acc)[2][2][4][2], const GUnit& u, int wr, int wc, int fr, int fq) const {
        const int b = u.pm / 9, tt = u.pm % 9;
        float* base = (tt == 0) ? hc + (size_t)b * CTX * DM : hx + ((size_t)b * SEQ + (size_t)(tt - 1) * 256) * DM;
        const float* gate = modl + (size_t)((tt == 0) ? 16 : b) * 6144 + 2 * DM;
        const int row0 = wr * 64 + fr, col0 = u.pn * 256 + wc * 32 + 4 * fq;
#pragma unroll
        for (int ai = 0; ai < 2; ++ai)
#pragma unroll
            for (int m = 0; m < 4; ++m) { float* rowp = base + (size_t)(row0 + ai * 128 + m * 16) * DM + col0;
#pragma unroll
                for (int bj = 0; bj < 2; ++bj)
#pragma unroll
                    for (int n = 0; n < 2; ++n) { f32x4* p = (f32x4*)(rowp + bj * 128 + n * 16); const f32x4 gv = *(const f32x4*)(gate + col0 + bj * 128 + n * 16); *p = *p + gv * acc[ai][bj][m][n]; }
                asm volatile("" ::: "memory"); }
    }
};

struct Ctx {
    LAS unsigned char* L; volatile LAS int* misc; unsigned char* ws; int tid, lane, wave, G, bid, cheat;
};
DI bf16_t* hrow(const Params& P, int m) { return (bf16_t*)(P.ws + WS_H) + (size_t)m * DM; }

DI void phase_prologue(const Params& P, Ctx& X) {
    float* MOD = (float*)(P.ws + WS_MOD);
    LAS float* tab = (LAS float*)(X.L + X.wave * 8704);
    for (int u = X.bid; u < 4 * 48; u += X.G) {
        const int l = u / 48, jc = u % 48;
        __syncthreads();
        for (int idx = X.lane; idx < 17 * 128; idx += 64) { const int r = idx >> 7, kk = idx & 127; const float* src = (r < 16) ? P.c + r * DM : P.c_ctx; tab[idx] = silu(src[X.wave * 128 + kk]); }
        __syncthreads();
        float a0[17], a1[17];
#pragma unroll
        for (int r = 0; r < 17; ++r) { a0[r] = 0.f; a1[r] = 0.f; }
        const float* wp = P.w_mod + ((size_t)l * DM + X.wave * 128) * 6144 + jc * 128 + 2 * X.lane;
#pragma unroll 4
        for (int kk = 0; kk < 128; ++kk) { const f32x2 w2 = *(const f32x2*)(wp + (size_t)kk * 6144);
#pragma unroll
            for (int r = 0; r < 17; ++r) { const float a = tab[r * 128 + kk]; a0[r] += a * w2.x; a1[r] += a * w2.y; } }
        __syncthreads();
#pragma unroll
        for (int r = 0; r < 17; ++r) { tab[r * 128 + 2 * X.lane] = a0[r]; tab[r * 128 + 2 * X.lane + 1] = a1[r]; }
        __syncthreads();
        for (int idx = X.tid; idx < 17 * 128; idx += NTHR) { const int r = idx >> 7, j = idx & 127; float s = P.b_mod[l * 6144 + jc * 128 + j];
#pragma unroll
            for (int w = 0; w < 8; ++w) s += ((LAS float*)(X.L + w * 8704))[idx];
            MOD[((size_t)l * 17 + r) * 6144 + jc * 128 + j] = s; }
    }
    __syncthreads();
    f32x2* rope = (f32x2*)(P.ws + WS_ROPE);
    for (int e = X.bid * NTHR + X.tid; e < SEQ * 16; e += X.G * NTHR) { const int p = e >> 4, d = e & 15; const int row = p >> 6, col = p & 63;
        const float inv = powf(10000.f, -(float)(d & 7) / 8.f); const float ang = (float)((d < 8) ? row : col) * inv; rope[e] = (f32x2){cosf(ang), sinf(ang)}; }
    u32x4* wz = (u32x4*)((bf16_t*)(P.ws + WS_WIN) + (size_t)2496 * DM);
    for (int e = X.bid * NTHR + X.tid; e < 64 * DM * 2 / 16; e += X.G * NTHR) wz[e] = (u32x4){0u, 0u, 0u, 0u};
}

DI void cvt_item(const float* W, int ldw, int N, int k0, int n0, bf16_t* WT, int K, int row0, const float* kscale, float mul, LAS float* scr, int lane) {
    const int cq = 4 * (lane & 7), kr = lane >> 3;
#pragma unroll
    for (int i = 0; i < 8; ++i) { const int kk = 8 * i + kr, n = n0 + cq;
        f32x4 v = (n < N) ? *(const f32x4*)(W + (size_t)(k0 + kk) * ldw + n) : (f32x4){0.f, 0.f, 0.f, 0.f};
        const float sc = (kscale ? kscale[k0 + kk] : 1.f) * mul;
        scr[kk * 33 + cq] = v[0] * sc; scr[kk * 33 + cq + 1] = v[1] * sc; scr[kk * 33 + cq + 2] = v[2] * sc; scr[kk * 33 + cq + 3] = v[3] * sc; }
    LDS_WAIT(); asm volatile("" ::: "memory");
    const int c = lane & 7;
#pragma unroll
    for (int j = 0; j < 4; ++j) { const int nn = (lane >> 3) + 8 * j; const LAS float* s = scr + (8 * c) * 33 + nn;
        u32x4 o; o.x = pk2(s[0 * 33], s[1 * 33]); o.y = pk2(s[2 * 33], s[3 * 33]); o.z = pk2(s[4 * 33], s[5 * 33]); o.w = pk2(s[6 * 33], s[7 * 33]);
        *(u32x4*)(WT + (size_t)(row0 + nn) * K + k0 + 8 * c) = o; }
    LDS_WAIT(); asm volatile("" ::: "memory");
}
DI void convert_weights(const Params& P, Ctx& X, int l) {
    LAS float* scr = (LAS float*)(X.L + X.wave * 8704);
    const int gw = X.bid * NWAVE + X.wave, NGW = X.G * NWAVE;
    constexpr int I_IN = 16 * 78, I_OUT = 16 * 32, I_UQ = 4 * 12, I_UKV = 2 * 16, I_E = 768, NIT = I_IN + I_OUT + I_UQ + I_UKV + 16 * I_E;
    for (int it = gw; it < NIT; it += NGW) {
        int r = it;
        if (r < I_IN) { cvt_item(P.w_in + (size_t)l * DM * INW, INW, INW, 64 * (r / 78), 32 * (r % 78), (bf16_t*)(P.ws + WS_WIN), DM, 32 * (r % 78), nullptr, 1.f, scr, X.lane); continue; } r -= I_IN;
        if (r < I_OUT) { cvt_item(P.w_out + (size_t)l * DM * DM, DM, DM, 64 * (r / 32), 32 * (r % 32), (bf16_t*)(P.ws + WS_WOUT), DM, 32 * (r % 32), nullptr, 1.f, scr, X.lane); continue; } r -= I_OUT;
        if (r < I_UQ) { cvt_item(P.w_uq + (size_t)l * 256 * 384, 384, 384, 64 * (r / 12), 32 * (r % 12), (bf16_t*)(P.ws + WS_WUQ), 256, 32 * (r % 12), P.mq_g + l * 256, MLA_QS, scr, X.lane); continue; } r -= I_UQ;
        if (r < I_UKV) { cvt_item(P.w_ukv + (size_t)l * 128 * 512, 512, 512, 64 * (r / 16), 32 * (r % 16), (bf16_t*)(P.ws + WS_WUKV), 128, 32 * (r % 16), P.mkv_g + l * 128, 1.f, scr, X.lane); continue; } r -= I_UKV;
        const int e = r / I_E; r -= e * I_E;
        if (r < 256) { const int kb = r / 16, nb = r % 16;
            cvt_item(P.wg + ((size_t)l * 16 + e) * DM * 512, 512, 512, 64 * kb, 32 * nb, (bf16_t*)(P.ws + WS_WGU) + (size_t)e * 1024 * DM, DM, 256 * (nb >> 2) + 32 * (nb & 3), nullptr, 1.f, scr, X.lane); continue; } r -= 256;
        if (r < 256) { const int kb = r / 16, nb = r % 16;
            cvt_item(P.wu + ((size_t)l * 16 + e) * DM * 512, 512, 512, 64 * kb, 32 * nb, (bf16_t*)(P.ws + WS_WGU) + (size_t)e * 1024 * DM, DM, 256 * (nb >> 2) + 128 + 32 * (nb & 3), nullptr, 1.f, scr, X.lane); continue; } r -= 256;
        { const int kb = r / 32, nb = r % 32;
            cvt_item(P.wd + ((size_t)l * 16 + e) * 512 * DM, DM, DM, 64 * kb, 32 * nb, (bf16_t*)(P.ws + WS_WD) + (size_t)e * 1024 * 512, 512, 32 * nb, nullptr, 1.f, scr, X.lane); }
    }
}

DI int slot_base_lane(const unsigned* cnt, int lane) {
    int c = (lane < 16) ? (int)cnt[lane] : 0;
    int tiles = (c + 255) >> 8;
    int incl = tiles;
#pragma unroll
    for (int o = 1; o < 16; o <<= 1) { const int v = shupi(incl, o, lane); if (lane >= o) incl += v; }
    return (incl - tiles) * 256;
}

constexpr int RPC = 18;
struct RowIn { u32x4 a[4]; u32x2 y1[4]; float w0, w1; };
DI void row_issue(const Params& P, RowIn& R, int l, int m, int sbase, const u32x4 ti, int lane) {
    const int b = m / T, t = m - b * T;
    if (l == 0) {
        const float* src = (t < CTX) ? P.ctx + ((size_t)b * CTX + t) * DM : P.x + ((size_t)b * SEQ + (t - CTX)) * DM;
#pragma unroll
        for (int j = 0; j < 4; ++j) R.a[j] = *(const u32x4*)(src + 256 * j + 4 * lane);
        R.w0 = 0.f; R.w1 = 0.f;
    } else {
        const bf16_t* hp = hrow(P, m);
        const bf16_t* YS = (const bf16_t*)(P.ws + WS_YS);
        const int s0 = shli(sbase, (int)(ti.x & 15u)) + (int)(ti.x >> 4), s1 = shli(sbase, (int)(ti.y & 15u)) + (int)(ti.y >> 4);
        const bf16_t* y0 = YS + (size_t)s0 * DM; const bf16_t* y1 = YS + (size_t)s1 * DM;
#pragma unroll
        for (int j = 0; j < 4; ++j) { const int cidx = 256 * j + 4 * lane; const u32x2 hv = *(const u32x2*)(hp + cidx), yv = *(const u32x2*)(y0 + cidx); R.a[j] = (u32x4){hv.x, hv.y, yv.x, yv.y}; R.y1[j] = *(const u32x2*)(y1 + cidx); }
        R.w0 = __uint_as_float(ti.z); R.w1 = __uint_as_float(ti.w);
    }
}
DI float row_combine(const RowIn& R, bool comb, const f32x4 (&gp)[4], f32x4 (&v)[4]) {
    float ss = 0.f;
#pragma unroll
    for (int j = 0; j < 4; ++j) {
        if (comb) { const u32x2 a = {R.a[j].z, R.a[j].w}, bb = R.y1[j];
            f32x4 yv; yv[0] = R.w0 * bflo(a.x) + R.w1 * bflo(bb.x); yv[1] = R.w0 * bfhi(a.x) + R.w1 * bfhi(bb.x); yv[2] = R.w0 * bflo(a.y) + R.w1 * bflo(bb.y); yv[3] = R.w0 * bfhi(a.y) + R.w1 * bfhi(bb.y);
            const f32x4 hv = {bflo(R.a[j].x), bfhi(R.a[j].x), bflo(R.a[j].y), bfhi(R.a[j].y)};
            v[j] = hv + gp[j] * yv; }
        else v[j] = (f32x4){__uint_as_float(R.a[j].x), __uint_as_float(R.a[j].y), __uint_as_float(R.a[j].z), __uint_as_float(R.a[j].w)};
        ss += v[j][0] * v[j][0] + v[j][1] * v[j][1] + v[j][2] * v[j][2] + v[j][3] * v[j][3]; }
    return ss;
}
DI void phase_norm1(const Params& P, Ctx& X, int l) {
    convert_weights(P, X, l);
    const float* MOD = (const float*)(P.ws + WS_MOD);
    bf16_t* ACT = (bf16_t*)(P.ws + WS_ACT);
    const u32x4* TOK = (const u32x4*)(P.ws + WS_TOK);
    const unsigned* cnt = (const unsigned*)(P.ws + WS_CTL) + CW_CNT + (l > 0 ? (l - 1) * 16 : 0);
    const int sbase = (l > 0) ? slot_base_lane(cnt, X.lane) : 0;
    const int gw = X.bid * NWAVE + X.wave, NGW = X.G * NWAVE, lane = X.lane;
    const float* g = P.g_mix + l * DM;
    const u32x4 tz = {0u, 0u, 0u, 0u};
    for (int ck = gw; ck < M / RPC; ck += NGW) {
        const int m0 = ck * RPC, b = m0 / T, t0 = m0 - b * T;
        int cur_cls = -1; f32x4 gs[4], sh[4], gp[4];
        RowIn cur[2], nxt[2];
        row_issue(P, cur[0], l, m0, sbase, (l > 0) ? TOK[m0] : tz, lane); row_issue(P, cur[1], l, m0 + 1, sbase, (l > 0) ? TOK[m0 + 1] : tz, lane);
        u32x4 tiN0 = (l > 0) ? TOK[m0 + 2] : tz, tiN1 = (l > 0) ? TOK[m0 + 3] : tz;
        for (int r = 0; r < RPC; r += 2) {
            if (r + 2 < RPC) { row_issue(P, nxt[0], l, m0 + r + 2, sbase, tiN0, lane); row_issue(P, nxt[1], l, m0 + r + 3, sbase, tiN1, lane); }
            if (l > 0 && r + 4 < RPC) { tiN0 = TOK[m0 + r + 4]; tiN1 = TOK[m0 + r + 5]; }
#pragma unroll
            for (int k = 0; k < 2; ++k) {
                const int m = m0 + r + k, t = t0 + r + k, cls = (t < CTX) ? 1 : 0;
                if (cls != cur_cls) { cur_cls = cls;
                    const float* mrow = MOD + ((size_t)l * 17 + (cls ? 16 : b)) * 6144;
                    const float* gprev = MOD + ((size_t)(l > 0 ? l - 1 : 0) * 17 + (cls ? 16 : b)) * 6144 + 5 * DM;
#pragma unroll
                    for (int j = 0; j < 4; ++j) { const int cidx = 256 * j + 4 * lane;
                        gs[j] = *(const f32x4*)(g + cidx) * (*(const f32x4*)(mrow + DM + cidx) + 1.f); sh[j] = *(const f32x4*)(mrow + cidx); gp[j] = *(const f32x4*)(gprev + cidx); } }
                f32x4 v[4];
                const float ss = row_combine(cur[k], l > 0, gp, v);
                bf16_t* hp = hrow(P, m);
#pragma unroll
                for (int j = 0; j < 4; ++j) { u32x2 o; o.x = pk2(v[j][0], v[j][1]); o.y = pk2(v[j][2], v[j][3]); *(u32x2*)(hp + 256 * j + 4 * lane) = o; }
                const float rstd = rsqrtf(wave_sum(ss, lane) * (1.f / DM) + EPS);
#pragma unroll
                for (int j = 0; j < 4; ++j) { const f32x4 uu = v[j] * rstd * gs[j] + sh[j];
                    u32x2 o; o.x = pk2(uu[0], uu[1]); o.y = pk2(uu[2], uu[3]);
                    *(u32x2*)(ACT + (size_t)m * DM + 256 * j + 4 * lane) = o; }
            }
            cur[0] = nxt[0]; cur[1] = nxt[1];
        }
    }
}
DI void phase_final(const Params& P, Ctx& X, float eps = 0.f) {
    constexpr int RPF = 16;
    const float* MOD = (const float*)(P.ws + WS_MOD);
    const u32x4* TOK = (const u32x4*)(P.ws + WS_TOK);
    const unsigned* cnt = (const unsigned*)(P.ws + WS_CTL) + CW_CNT + 3 * 16;
    const int sbase = slot_base_lane(cnt, X.lane);
    const int gw = X.bid * NWAVE + X.wave, NGW = X.G * NWAVE, lane = X.lane;
    f32x4 fg[4];
#pragma unroll
    for (int j = 0; j < 4; ++j) fg[j] = *(const f32x4*)(P.fin_g + 256 * j + 4 * lane);
    for (int ck = gw; ck < NB * SEQ / RPF; ck += NGW) {
        const int r0 = ck * RPF, b = r0 / SEQ, m0 = b * T + CTX + (r0 - b * SEQ);
        f32x4 gp[4];
#pragma unroll
        for (int j = 0; j < 4; ++j) gp[j] = *(const f32x4*)(MOD + ((size_t)3 * 17 + b) * 6144 + 5 * DM + 256 * j + 4 * lane);
        RowIn cur[2], nxt[2];
        row_issue(P, cur[0], 3, m0, sbase, TOK[m0], lane); row_issue(P, cur[1], 3, m0 + 1, sbase, TOK[m0 + 1], lane);
        u32x4 tiN0 = TOK[m0 + 2], tiN1 = TOK[m0 + 3];
        for (int r = 0; r < RPF; r += 2) {
            if (r + 2 < RPF) { row_issue(P, nxt[0], 3, m0 + r + 2, sbase, tiN0, lane); row_issue(P, nxt[1], 3, m0 + r + 3, sbase, tiN1, lane); }
            if (r + 4 < RPF) { tiN0 = TOK[m0 + r + 4]; tiN1 = TOK[m0 + r + 5]; }
#pragma unroll
            for (int k = 0; k < 2; ++k) {
                f32x4 v[4];
                const float ss = row_combine(cur[k], true, gp, v);
                const float rstd = rsqrtf(wave_sum(ss, lane) * (1.f / DM) + EPS);
                float* hp = P.out + (size_t)(r0 + r + k) * DM;
#pragma unroll
                for (int j = 0; j < 4; ++j) *(f32x4*)(hp + 256 * j + 4 * lane) = v[j] * (rstd * (1.f + eps)) * fg[j];
            }
            cur[0] = nxt[0]; cur[1] = nxt[1];
        }
    }
}

DI void phase_postproj(const Params& P, Ctx& X, int l, int sel = 15) {
    bf16_t* PROJ = (bf16_t*)(P.ws + WS_PROJ);
    const f32x2* rope = (const f32x2*)(P.ws + WS_ROPE);
    bf16_t* XBC = (bf16_t*)(P.ws + WS_XBC); float* DT = (float*)(P.ws + WS_DT);
    bf16_t* MLAQ = (bf16_t*)(P.ws + WS_MLAQ); bf16_t* MLAK = (bf16_t*)(P.ws + WS_MLAK);
    bf16_t* VTM = (bf16_t*)(P.ws + WS_VTM); bf16_t* VTD = (bf16_t*)(P.ws + WS_VTD);
    const bf16_t* WUQ = (const bf16_t*)(P.ws + WS_WUQ); const bf16_t* WUKV = (const bf16_t*)(P.ws + WS_WUKV);
    const int lane = X.lane, wave = X.wave;
    for (int u = X.bid; u < M / 144; u += X.G) {
        const int m0 = u * 144, b = m0 / T, t0 = m0 - b * T;
        __syncthreads();
        float cw[3][12], cb[12];
        int lane_u = lane; asm volatile("" : "+v"(lane_u));
#pragma unroll
        for (int g3 = 0; g3 < 3; ++g3)
#pragma unroll
            for (int i = 0; i < 4; ++i) { const int ch = 256 * g3 + 4 * lane_u + i; cb[g3 * 4 + i] = P.conv_b[l * 768 + ch];
#pragma unroll
                for (int k = 0; k < 3; ++k) cw[k][g3 * 4 + i] = P.conv_w[((size_t)l * 3 + k) * 768 + ch]; }
        const int tw0 = t0 + wave * 18;
        const int vv = lane >> 2, d0 = 4 * (lane & 3);
        const float qs = (vv < 8) ? DA_QS : 1.f;
        struct RowRegs { u32x2 qa, qb, v, cq; unsigned ckv; unsigned short dtr, k1, k2; };
        LAS float* rs_q = (LAS float*)(X.L + 114688); LAS float* rs_kv = rs_q + 144;
        auto ld_row = [&](int t, RowRegs& R) { const bf16_t* prow = PROJ + ((size_t)b * T + t) * PW;
            R.qa = *(const u32x2*)(prow + vv * 32 + d0); R.qb = *(const u32x2*)(prow + vv * 32 + d0 + 16); R.v = *(const u32x2*)(prow + C_DAV + 4 * lane);
            R.dtr = prow[C_DT + (lane & 15)]; R.k1 = prow[C_KR + (lane & 15)]; R.k2 = prow[C_KR + 16 + (lane & 15)];
            R.cq = *(const u32x2*)(prow + C_CQ + 4 * lane); R.ckv = *(const unsigned*)(prow + C_CKV + 2 * lane); };
        auto ld_x = [&](int t, u32x2 (&xx)[3]) { const bool ok = (t >= 0 && t < T);
            const bf16_t* prow = PROJ + ((size_t)b * T + (ok ? t : 0)) * PW + C_XBC + 4 * lane;
#pragma unroll
            for (int g3 = 0; g3 < 3; ++g3) { xx[g3] = *(const u32x2*)(prow + 256 * g3); if (!ok) xx[g3] = (u32x2){0u, 0u}; } };
        RowRegs rc, rn, rn2; u32x2 xm[3], x0[3], xp[3], xq[3], xr2[3];
        ld_row(tw0, rc); ld_row(tw0 + 1, rn); ld_x(tw0 - 1, xm); ld_x(tw0, x0); ld_x(tw0 + 1, xp); ld_x(tw0 + 2, xq);
#pragma unroll 1
        for (int rr = 0; rr < ((sel & 1) ? 18 : 0); ++rr) {
            const int t = tw0 + rr; const size_t m = (size_t)b * T + t;
            if (rr + 2 < 18) ld_row(t + 2, rn2);
            ld_x(t + 3, xr2);
            bf16_t* prow = PROJ + m * PW;
            { const u32x2 a = rc.qa, bq = rc.qb;
              float x1[4] = {bflo(a.x), bfhi(a.x), bflo(a.y), bfhi(a.y)}, x2[4] = {bflo(bq.x), bfhi(bq.x), bflo(bq.y), bfhi(bq.y)};
              float o1[4], o2[4];
              if (t >= CTX) { const f32x2* rp = rope + (size_t)(t - CTX) * 16 + d0;
#pragma unroll
                  for (int i = 0; i < 4; ++i) { const f32x2 cs = rp[i]; o1[i] = (x1[i] * cs.x - x2[i] * cs.y) * qs; o2[i] = (x2[i] * cs.x + x1[i] * cs.y) * qs; } }
              else {
#pragma unroll
                  for (int i = 0; i < 4; ++i) { o1[i] = x1[i] * qs; o2[i] = x2[i] * qs; } }
              u32x2 w1, w2; w1.x = pk2(o1[0], o1[1]); w1.y = pk2(o1[2], o1[3]); w2.x = pk2(o2[0], o2[1]); w2.y = pk2(o2[2], o2[3]);
              bf16_t* p1 = prow + vv * 32 + d0;
              *(u32x2*)p1 = w1; *(u32x2*)(p1 + 16) = w2; }
            *(LAS u32x2*)(X.L + (size_t)(wave * 18 + rr) * 520 + lane * 8) = rc.v;
            { const float c0 = bflo(rc.cq.x), c1 = bfhi(rc.cq.x), c2 = bflo(rc.cq.y), c3 = bfhi(rc.cq.y), k0 = bflo(rc.ckv), k1 = bfhi(rc.ckv);
              const float sq = wave_sum(c0 * c0 + c1 * c1 + c2 * c2 + c3 * c3, lane), sk = wave_sum(k0 * k0 + k1 * k1, lane);
              if (lane == 0) { rs_q[wave * 18 + rr] = rsqrtf(sq * (1.f / 256.f) + EPS); rs_kv[wave * 18 + rr] = rsqrtf(sk * (1.f / 128.f) + EPS); } }
            { const int lo = (t < CTX) ? 0 : CTX, hi = (t < CTX) ? CTX : T;
              const bool hm = (t - 1 >= lo), hp = (t + 1 < hi);
#pragma unroll
              for (int g3 = 0; g3 < 3; ++g3) { const int ch = 256 * g3 + 4 * lane;
                  const u32x2 c0 = x0[g3]; u32x2 cm = xm[g3], cp = xp[g3];
                  if (!hm) cm = (u32x2){0u, 0u};
                  if (!hp) cp = (u32x2){0u, 0u};
                  const float xmv[4] = {bflo(cm.x), bfhi(cm.x), bflo(cm.y), bfhi(cm.y)}, x0v[4] = {bflo(c0.x), bfhi(c0.x), bflo(c0.y), bfhi(c0.y)}, xpv[4] = {bflo(cp.x), bfhi(cp.x), bflo(cp.y), bfhi(cp.y)};
                  float o[4];
#pragma unroll
                  for (int i = 0; i < 4; ++i) o[i] = silu(cb[g3 * 4 + i] + cw[0][g3 * 4 + i] * xmv[i] + cw[1][g3 * 4 + i] * x0v[i] + cw[2][g3 * 4 + i] * xpv[i]);
                  u32x2 w; w.x = pk2(o[0], o[1]); w.y = pk2(o[2], o[3]);
                  *(u32x2*)(XBC + m * 768 + ch) = w; } }
            if (lane < 16) { const float v = __uint_as_float(((unsigned)rc.dtr) << 16) + P.dt_bias[l * 16 + lane]; ((LAS float*)(X.L + 116736))[(wave * 18 + rr) * 16 + lane] = (v > 20.f) ? v : __logf(1.f + __expf(v)); }
            if (lane < 16) { const float x1 = __uint_as_float(((unsigned)rc.k1) << 16), x2 = __uint_as_float(((unsigned)rc.k2) << 16);
                float o1 = x1, o2 = x2;
                if (t >= CTX) { const f32x2 cs = rope[(size_t)(t - CTX) * 16 + lane]; o1 = x1 * cs.x - x2 * cs.y; o2 = x2 * cs.x + x1 * cs.y; }
                const bf16_t b1 = (bf16_t)(pk2(o1, 0.f) & 0xffffu), b2 = (bf16_t)(pk2(o2, 0.f) & 0xffffu);
#pragma unroll
                for (int h = 0; h < 4; ++h) { MLAK[(m * 4 + h) * 96 + 64 + lane] = b1; MLAK[(m * 4 + h) * 96 + 80 + lane] = b2; } }
            rc = rn; rn = rn2;
#pragma unroll
            for (int g3 = 0; g3 < 3; ++g3) { xm[g3] = x0[g3]; x0[g3] = xp[g3]; xp[g3] = xq[g3]; xq[g3] = xr2[g3]; }
        }
        __syncthreads();
        constexpr int AROW = 784;
        if (sel & 1) for (int idx = X.tid; idx < 16 * 36; idx += NTHR) { const int j = idx / 36, q = idx - 36 * j; const LAS float* dl = (const LAS float*)(X.L + 116736) + (4 * q) * 16 + j;
            *(f32x4*)(DT + ((size_t)b * 16 + j) * T + t0 + 4 * q) = (f32x4){dl[0], dl[16], dl[32], dl[48]}; }
        if (sel & 2) { const int vr = X.tid >> 1, th = X.tid & 1;
          bf16_t* dst = VTD + ((size_t)b * 256 + vr) * T + t0 + th * 72;
#pragma unroll 1
          for (int q8 = 0; q8 < 9; ++q8) { unsigned w[4];
#pragma unroll
              for (int i = 0; i < 4; ++i) { const int tt = th * 72 + q8 * 8 + 2 * i;
                  const unsigned lo = *(const LAS unsigned short*)(X.L + (size_t)tt * 520 + vr * 2), hi = *(const LAS unsigned short*)(X.L + (size_t)(tt + 1) * 520 + vr * 2);
                  w[i] = lo | (hi << 16); }
              *(u32x4*)(dst + q8 * 8) = (u32x4){w[0], w[1], w[2], w[3]}; } }
        u32x4 aq[9], ak[5];
        { int tid_u = X.tid; asm volatile("" : "+v"(tid_u));
          const bf16_t* gq = PROJ + ((size_t)b * T + t0 + (tid_u >> 5)) * PW + C_CQ + (tid_u & 31) * 8;
          const bf16_t* gk = PROJ + ((size_t)b * T + t0 + (tid_u >> 4)) * PW + C_CKV + (tid_u & 15) * 8;
          if (sel & 12) {
#pragma unroll
              for (int j = 0; j < 9; ++j) aq[j] = *(const u32x4*)(gq + (size_t)j * 16 * PW);
#pragma unroll
              for (int j = 0; j < 5; ++j) if (32 * j + (tid_u >> 4) < 144) ak[j] = *(const u32x4*)(gk + (size_t)j * 32 * PW); }
          __syncthreads();
          if (sel & 12) {
              LAS unsigned char* lq = X.L + (tid_u >> 5) * AROW + (tid_u & 31) * 16; LAS unsigned char* lk = X.L + (tid_u >> 4) * AROW + 512 + (tid_u & 15) * 16;
#pragma unroll
              for (int j = 0; j < 9; ++j) *(LAS u32x4*)(lq + j * 16 * AROW) = aq[j];
#pragma unroll
              for (int j = 0; j < 5; ++j) if (32 * j + (tid_u >> 4) < 144) *(LAS u32x4*)(lk + j * 32 * AROW) = ak[j]; }
          __syncthreads(); }
        if (sel & 4) { int lane_c = lane; asm volatile("" : "+v"(lane_c)); const int tk = lane_c & 15, q4 = lane_c >> 4;
#pragma unroll
          for (int pass = 0; pass < 2; ++pass) {
              constexpr int NCT_MAX = 2; const int nct = pass ? 2 : 1, ct0 = pass ? 1 : 0;
              bf16x8 bw[NCT_MAX][8];
#pragma unroll
              for (int ct = 0; ct < NCT_MAX; ++ct)
#pragma unroll
                  for (int s = 0; s < 8; ++s) if (ct < nct) bw[ct][s] = *(const bf16x8*)(WUQ + (size_t)((3 * wave + ct0 + ct) * 16 + tk) * 256 + 32 * s + 8 * q4);
#pragma unroll 1
              for (int rt = 0; rt < 9; ++rt) {
                  const int t = t0 + rt * 16 + tk; const size_t m = (size_t)b * T + t;
                  bf16x8 af[8];
#pragma unroll
                  for (int s = 0; s < 8; ++s) af[s] = *(const LAS bf16x8*)(X.L + (rt * 16 + tk) * AROW + (32 * s + 8 * q4) * 2);
                  const float rstd = ((LAS float*)(X.L + 114688))[rt * 16 + tk];
                  f32x4 acc[NCT_MAX];
#pragma unroll
                  for (int ct = 0; ct < NCT_MAX; ++ct) if (ct < nct) { acc[ct] = (f32x4){0.f, 0.f, 0.f, 0.f};
#pragma unroll
                      for (int s = 0; s < 8; ++s) acc[ct] = MFMA16(bw[ct][s], af[s], acc[ct]);
                      acc[ct] = acc[ct] * rstd; }
                  if (pass && (wave & 1) && t >= CTX) {
                      const f32x2* rp = rope + (size_t)(t - CTX) * 16 + 4 * q4;
#pragma unroll
                      for (int i = 0; i < 4; ++i) { const f32x2 cs = rp[i]; const float x1 = acc[0][i], x2 = acc[1][i]; acc[0][i] = x1 * cs.x - x2 * cs.y; acc[1][i] = x2 * cs.x + x1 * cs.y; } }
#pragma unroll
                  for (int ct = 0; ct < NCT_MAX; ++ct) if (ct < nct) { u32x2 w; w.x = pk2(acc[ct][0], acc[ct][1]); w.y = pk2(acc[ct][2], acc[ct][3]);
                      *(u32x2*)(MLAQ + m * 384 + (3 * wave + ct0 + ct) * 16 + 4 * q4) = w; }
              }
          }
        }
        if (sel & 8) { const int tk = lane & 15, q4 = lane >> 4, hh = wave >> 1;
          bf16x8 bw[4][4];
#pragma unroll
          for (int ct = 0; ct < 4; ++ct)
#pragma unroll
              for (int s = 0; s < 4; ++s) bw[ct][s] = *(const bf16x8*)(WUKV + (size_t)((4 * wave + ct) * 16 + tk) * 128 + 32 * s + 8 * q4);
#pragma unroll 1
          for (int rt = 0; rt < 9; ++rt) {
              const int t = t0 + rt * 16 + tk; const size_t m = (size_t)b * T + t;
              bf16x8 af[4];
#pragma unroll
              for (int s = 0; s < 4; ++s) af[s] = *(const LAS bf16x8*)(X.L + (rt * 16 + tk) * AROW + 512 + (32 * s + 8 * q4) * 2);
              const LAS float* rs_kv = (const LAS float*)(X.L + 114688) + 144;
              const float rstd = rs_kv[rt * 16 + tk];
              if ((wave & 1) == 0) {
#pragma unroll
                  for (int ct = 0; ct < 4; ++ct) { f32x4 acc = {0.f, 0.f, 0.f, 0.f};
#pragma unroll
                      for (int s = 0; s < 4; ++s) acc = MFMA16(bw[ct][s], af[s], acc);
                      acc = acc * rstd;
                      u32x2 w; w.x = pk2(acc[0], acc[1]); w.y = pk2(acc[2], acc[3]);
                      *(u32x2*)(MLAK + (m * 4 + hh) * 96 + ct * 16 + 4 * q4) = w; }
              } else {
                  const f32x4 rs = *(const LAS f32x4*)(rs_kv + rt * 16 + 4 * q4);
#pragma unroll
                  for (int ct = 0; ct < 4; ++ct) { f32x4 acc = {0.f, 0.f, 0.f, 0.f};
#pragma unroll
                      for (int s = 0; s < 4; ++s) acc = MFMA16(af[s], bw[ct][s], acc);
                      u32x2 w; w.x = pk2(acc[0] * rs[0], acc[1] * rs[1]); w.y = pk2(acc[2] * rs[2], acc[3] * rs[3]);
                      *(u32x2*)(VTM + (((size_t)b * 4 + hh) * 64 + ct * 16 + tk) * T + t0 + rt * 16 + 4 * q4) = w; }
              }
          }
        }
    }
}

constexpr int SSD_BASE = 0;
struct SsdState { f32x4 Sacc[2]; int u, c; };
struct SsdPre { u32x4 xr[2], br[2], cr[2]; float dt0, dt1; };
DI void ssd_tok(int dir, int c, int& tbase, int& tstep) { const int seg0 = (c < 2) ? 0 : CTX, seg1 = (c < 2) ? CTX : T, cc = (c < 2) ? c : c - 2;
    tbase = dir ? (seg1 - 1 - 128 * cc) : (seg0 + 128 * cc); tstep = dir ? -1 : 1; }
DI void ssd_issue(const Params& P, Ctx& X, SsdPre& S, int u, int c) {
    if (c >= 18) { u += X.G; c -= 18; }
    if (u >= NB * 8 * 2) return;
    const int b = u >> 4, hd = (u >> 1) & 7, dir = u & 1, grp = hd >> 2;
    const bf16_t* XBC = (const bf16_t*)(P.ws + WS_XBC); const float* DTT = (const float*)(P.ws + WS_DT) + ((size_t)b * 16 + dir * 8 + hd) * T;
    const size_t rb = (size_t)b * T; const int tid = X.tid, lane = X.lane, tau = tid >> 2, q2 = tid & 3;
    int tbase, tstep; ssd_tok(dir, c, tbase, tstep);
    const bf16_t* rowp = XBC + (rb + tbase + tstep * tau) * 768;
#pragma unroll
    for (int k = 0; k < 2; ++k) { const int pc = 2 * q2 + k; S.xr[k] = *(const u32x4*)(rowp + hd * 64 + 8 * pc); S.br[k] = *(const u32x4*)(rowp + 512 + grp * 64 + 8 * pc); S.cr[k] = *(const u32x4*)(rowp + 640 + grp * 64 + 8 * pc); }
    if (dir) { const f32x2 v = *(const f32x2*)(DTT + tbase - 2 * lane - 1); S.dt0 = v.y; S.dt1 = v.x; }
    else { const f32x2 v = *(const f32x2*)(DTT + tbase + 2 * lane); S.dt0 = v.x; S.dt1 = v.y; }
}
DI bool ssd_pending(const SsdState& S) { return S.u < NB * 8 * 2; }
DI s16x4 tr16(const LAS unsigned char* p) { return __builtin_bit_cast(s16x4, __builtin_amdgcn_ds_read_tr16_b64_v4i16((LAS v4i16_t*)p)); }
template <int CHEAT = 0>
DI void ssd_step(const Params& P, Ctx& X, SsdState& ST, SsdPre& S, int l) {
    constexpr int OFF_XR = SSD_BASE + 0, OFF_XS = SSD_BASE + 18432, OFF_BR = SSD_BASE + 36864, OFF_CR = SSD_BASE + 55296, OFF_SB = SSD_BASE + 73728, OFF_AC = SSD_BASE + 82944, OFF_DTT = SSD_BASE + 83456;
    const int u = ST.u, c = ST.c, b = u >> 4, hd = (u >> 1) & 7, dir = u & 1;
    bf16_t* Y = (bf16_t*)(P.ws + (dir ? WS_YB : WS_YF));
    const int tid = X.tid, lane = X.lane, wave = X.wave, r = lane & 31, hh = lane >> 5;
    const float a = -__expf(P.a_log[l * 16 + dir * 8 + hd]);
    LAS unsigned char* L = X.L;
    LAS float* t_ac = (LAS float*)(L + OFF_AC); LAS float* t_dt = (LAS float*)(L + OFF_DTT);
    const size_t rb = (size_t)b * T;
    const int tau = tid >> 2, q2 = tid & 3;
    f32x4 (&Sacc)[2] = ST.Sacc; const float dt0 = S.dt0, dt1 = S.dt1;
    int tbase, tstep; ssd_tok(dir, c, tbase, tstep);
    const float v0 = dt0 * a, v1 = dt1 * a, s2 = v0 + v1; float incl = s2;
#pragma unroll
    for (int o = 1; o < 64; o <<= 1) { const float v = shup(incl, o, lane); if (lane >= o) incl += v; }
    const float ac0 = incl - s2 + v0, ac1 = incl;
    const float alast = shl(incl, 63);
    if (wave == 0) { *(LAS f32x2*)(t_ac + 2 * lane) = (f32x2){ac0, ac1}; *(LAS f32x2*)(t_dt + 2 * lane) = (f32x2){dt0, dt1}; }
    {
        const int src = tau >> 1;
        const float a_e = shl(ac0, src), a_o = shl(ac1, src), d_e = shl(dt0, src), d_o = shl(dt1, src);
        const float a_t = (tau & 1) ? a_o : a_e, d_t = (tau & 1) ? d_o : d_e;
        const float e_blk = shl(ac1, 16 * (tau >> 5) + 15);
        const float wj = __expf(e_blk - a_t) * d_t;
#pragma unroll
        for (int k = 0; k < 2; ++k) { const int pc = 2 * q2 + k, o = tau * 144 + pc * 16;
            *(LAS u32x4*)(L + OFF_XR + o) = S.xr[k]; *(LAS u32x4*)(L + OFF_BR + o) = S.br[k]; *(LAS u32x4*)(L + OFF_CR + o) = S.cr[k];
            u32x4 xs; xs.x = pk2(bflo(S.xr[k].x) * wj, bfhi(S.xr[k].x) * wj); xs.y = pk2(bflo(S.xr[k].y) * wj, bfhi(S.xr[k].y) * wj); xs.z = pk2(bflo(S.xr[k].z) * wj, bfhi(S.xr[k].z) * wj); xs.w = pk2(bflo(S.xr[k].w) * wj, bfhi(S.xr[k].w) * wj);
            *(LAS u32x4*)(L + OFF_XS + o) = xs; }
#pragma unroll
        for (int k = 0; k < 2; ++k) { const int tl = 2 * wave + k, pt = tl >> 2, nt = tl & 3, n = 16 * nt + (lane & 15), p = 16 * pt + 4 * (lane >> 4);
#pragma unroll
            for (int i = 0; i < 4; ++i) *(LAS unsigned short*)(L + OFF_SB + (p + i) * 144 + n * 2) = (unsigned short)(pk2(Sacc[k][i], 0.f) & 0xffffu); }
    }
    __syncthreads();
    ssd_issue(P, X, S, u, c + 2);
    const int gi = lane & 15, gq = gi >> 2, gp = gi & 3;
    if (!(CHEAT & 8)) {
        const int ib = wave >> 1, pb = wave & 1, i_tok = 32 * ib + r;
        const float acum_i = t_ac[i_tok];
        bf16x8 cf[4];
#pragma unroll
        for (int s = 0; s < 4; ++s) cf[s] = *(const LAS bf16x8*)(L + OFF_CR + i_tok * 144 + (16 * s + 8 * hh) * 2);
        f32x16 accO, accD;
#pragma unroll
        for (int i = 0; i < 16; ++i) { accO[i] = 0.f; accD[i] = 0.f; }
#pragma unroll
        for (int s = 0; s < 4; ++s) { const bf16x8 sa = *(const LAS bf16x8*)(L + OFF_SB + (32 * pb + r) * 144 + (16 * s + 8 * hh) * 2); accO = MFMA32(sa, cf[s], accO); }
        const LAS unsigned char* xtr = L + OFF_XR + (4 * hh + gq) * 144 + (32 * pb + 16 * ((lane >> 4) & 1) + 4 * gp) * 2;
        const LAS unsigned char* xctr = xtr + (OFF_XS - OFF_XR);
        for (int jb = (CHEAT & 2) ? ib : 0; jb <= ib; ++jb) {
            f32x16 g;
#pragma unroll
            for (int i = 0; i < 16; ++i) g[i] = 0.f;
#pragma unroll
            for (int s = 0; s < 4; ++s) { const bf16x8 ba = *(const LAS bf16x8*)(L + OFF_BR + (32 * jb + r) * 144 + (16 * s + 8 * hh) * 2); g = MFMA32(ba, cf[s], g); }
            if (jb < ib) {
                f32x16 tmp;
#pragma unroll
                for (int i = 0; i < 16; ++i) tmp[i] = 0.f;
#pragma unroll
                for (int s = 0; s < 2; ++s) {
                    u32x4 w; w.x = pk2(g[8 * s + 0], g[8 * s + 1]); w.y = pk2(g[8 * s + 2], g[8 * s + 3]); w.z = pk2(g[8 * s + 4], g[8 * s + 5]); w.w = pk2(g[8 * s + 6], g[8 * s + 7]);
                    const bf16x8 wf = __builtin_bit_cast(bf16x8, w);
                    const LAS unsigned char* xp = xctr + (32 * jb + 16 * s) * 144;
                    const s16x4 lo = tr16(xp), hi = tr16(xp + 8 * 144);
                    const bf16x8 xf = __builtin_shufflevector(lo, hi, 0, 1, 2, 3, 4, 5, 6, 7);
                    tmp = MFMA32(xf, wf, tmp);
                }
                const float rf = __expf(acum_i - t_ac[32 * jb + 31]);
#pragma unroll
                for (int i = 0; i < 16; ++i) accD[i] += rf * tmp[i];
            } else {
#pragma unroll
                for (int g4 = 0; g4 < ((CHEAT & 1) ? 0 : 4); ++g4) { const int j0 = 32 * jb + 8 * g4 + 4 * hh;
                    const f32x4 aj = *(const LAS f32x4*)(L + OFF_AC + j0 * 4), dj = *(const LAS f32x4*)(L + OFF_DTT + j0 * 4);
#pragma unroll
                    for (int i = 0; i < 4; ++i) { const float arg = fminf(acum_i - aj[i], 0.f); const float wv = __expf(arg) * dj[i] * g[4 * g4 + i]; g[4 * g4 + i] = (j0 + i <= i_tok) ? wv : 0.f; } }
#pragma unroll
                for (int s = 0; s < 2; ++s) {
                    u32x4 w; w.x = pk2(g[8 * s + 0], g[8 * s + 1]); w.y = pk2(g[8 * s + 2], g[8 * s + 3]); w.z = pk2(g[8 * s + 4], g[8 * s + 5]); w.w = pk2(g[8 * s + 6], g[8 * s + 7]);
                    const bf16x8 wf = __builtin_bit_cast(bf16x8, w);
                    const LAS unsigned char* xp = xtr + (32 * jb + 16 * s) * 144;
                    const s16x4 lo = tr16(xp), hi = tr16(xp + 8 * 144);
                    const bf16x8 xf = __builtin_shufflevector(lo, hi, 0, 1, 2, 3, 4, 5, 6, 7);
                    accD = MFMA32(xf, wf, accD);
                }
            }
        }
        const float ei = __expf(acum_i);
        bf16_t* yp = Y + (rb + tbase + tstep * i_tok) * 512 + hd * 64 + 32 * pb + 4 * hh;
#pragma unroll
        for (int g4 = 0; g4 < 4; ++g4) { u32x2 w; w.x = pk2(accD[4 * g4] + ei * accO[4 * g4], accD[4 * g4 + 1] + ei * accO[4 * g4 + 1]); w.y = pk2(accD[4 * g4 + 2] + ei * accO[4 * g4 + 2], accD[4 * g4 + 3] + ei * accO[4 * g4 + 3]);
            *(u32x2*)(yp + 8 * g4) = w; }
    }
    if (!(CHEAT & 16)) {
        const float dec = __expf(alast);
        const int q4 = lane >> 4;
        float fs[4];
#pragma unroll
        for (int s = 0; s < 4; ++s) fs[s] = __expf(alast - t_ac[32 * s + 31]);
#pragma unroll
        for (int k = 0; k < 2; ++k) { const int tl = 2 * wave + k, pt = tl >> 2, nt = tl & 3;
            f32x4 acc = Sacc[k] * dec;
            const LAS unsigned char* xa0 = L + OFF_XS + (8 * q4 + gq) * 144 + (16 * pt + 4 * gp) * 2;
            const LAS unsigned char* bb0 = L + OFF_BR + (8 * q4 + gq) * 144 + (16 * nt + 4 * gp) * 2;
#pragma unroll
            for (int s = 0; s < 4; ++s) {
                const s16x4 xl = tr16(xa0 + 32 * s * 144), xh = tr16(xa0 + (32 * s + 4) * 144), bl = tr16(bb0 + 32 * s * 144), bh = tr16(bb0 + (32 * s + 4) * 144);
                const bf16x8 xa = __builtin_shufflevector(xl, xh, 0, 1, 2, 3, 4, 5, 6, 7), bb = __builtin_shufflevector(bl, bh, 0, 1, 2, 3, 4, 5, 6, 7);
                const f32x4 part = MFMA16(xa, bb, ((f32x4){0.f, 0.f, 0.f, 0.f}));
                acc = acc + part * fs[s]; }
            Sacc[k] = acc; }
    }
    __syncthreads();
    if (++ST.c == 18) { ST.c = 0; ST.u += X.G; ST.Sacc[0] = (f32x4){0.f, 0.f, 0.f, 0.f}; ST.Sacc[1] = (f32x4){0.f, 0.f, 0.f, 0.f}; }
}

template <int CHEAT = 0>
DI void ssd_run(const Params& P, Ctx& X, SsdState& ST, int l, int n) {
    if (!ssd_pending(ST)) return;
    SsdPre SA, SB;
    ssd_issue(P, X, SA, ST.u, ST.c); ssd_issue(P, X, SB, ST.u, ST.c + 1);
    for (int i = 0; i < n && ssd_pending(ST); i += 2) {
        ssd_step<CHEAT>(P, X, ST, SA, l);
        if (i + 1 < n && ssd_pending(ST)) ssd_step<CHEAT>(P, X, ST, SB, l);
    }
}
template <int KIND, int CHEAT = 0>
DI void attn_unit(const Params& P, Ctx& X, int l, int b, int h, int qt, float lam, float lam_init) {
    constexpr int DK = KIND ? 96 : 64, KROW = DK * 2 + 16, NS = KIND ? 6 : 2;
    constexpr int TK = 64, NSUB = TK / 64;
    constexpr int KBUF = TK * KROW, VROW = TK * 2 + 8, VBUF = 64 * VROW;
    constexpr int KPT = KIND ? 12 : 8, NKP = (TK * KPT + NTHR - 1) / NTHR, NVP = (64 * TK / 8 + NTHR - 1) / NTHR;
    constexpr int OFF_K = 0, OFF_V = 2 * KBUF, OFF_X = 0;
    static_assert(OFF_V + 2 * VBUF <= LDS_MISC, "attention LDS");
    const bf16_t* PROJ = (const bf16_t*)(P.ws + WS_PROJ);
    const bf16_t* MLAQ = (const bf16_t*)(P.ws + WS_MLAQ); const bf16_t* MLAK = (const bf16_t*)(P.ws + WS_MLAK);
    const bf16_t* VT = (const bf16_t*)(P.ws + (KIND ? WS_VTM : WS_VTD)) + ((size_t)b * 4 + h) * 64 * T;
    bf16_t* ACT = (bf16_t*)(P.ws + WS_ACT);
    int tid_ = X.tid; asm volatile("" : "+v"(tid_));
    const int tid = tid_, lane = tid & 63, wave = X.wave, r = lane & 31, hh = lane >> 5;
    const int mmw = KIND ? 0 : (wave & 1), qg = KIND ? wave : (wave >> 1);
    const bool is_ctx = KIND ? (qt == 0) : (qt < 2);
    const int nk = is_ctx ? CTX : T, ntile = nk / TK;
    const size_t mrow = (size_t)b * T + qt * (KIND ? 256 : 128) + qg * 32 + r;
    bf16x8 qf[NS];
#pragma unroll
    for (int s = 0; s < NS; ++s)
        qf[s] = KIND ? *(const bf16x8*)(MLAQ + mrow * 384 + h * 96 + 16 * s + 8 * hh) : *(const bf16x8*)(PROJ + mrow * PW + C_DAQ + h * 64 + mmw * 32 + 16 * s + 8 * hh);
    const int kcol = mmw * 64 + 16 * hh;
    struct KV { u32x4 kr[NKP], vr[NVP]; };
    constexpr int VSH = (TK == 64) ? 3 : 4;
    auto gloadK = [&](int it, KV& R) {
        const int key0 = it * TK;
#pragma unroll
        for (int j = 0; j < NKP; ++j) { const int p = tid + NTHR * j, key = p / KPT, pc = p % KPT;
            if (p < TK * KPT) R.kr[j] = KIND ? *(const u32x4*)(MLAK + (((size_t)b * T + key0 + key) * 4 + h) * 96 + pc * 8) : *(const u32x4*)(PROJ + ((size_t)b * T + key0 + key) * PW + C_DAK + h * 64 + pc * 8); }
    };
    auto gloadV = [&](int it, KV& R) {
        const int key0 = it * TK;
#pragma unroll
        for (int j = 0; j < NVP; ++j) { const int p = tid + NTHR * j; R.vr[j] = *(const u32x4*)(VT + (size_t)(p >> VSH) * T + key0 + (p & ((1 << VSH) - 1)) * 8); }
    };
    auto lstoreK = [&](int buf, const KV& R) {
#pragma unroll
        for (int j = 0; j < NKP; ++j) { const int p = tid + NTHR * j, key = p / KPT, pc = p % KPT; if (p < TK * KPT) *(LAS u32x4*)(X.L + OFF_K + buf * KBUF + key * KROW + pc * 16) = R.kr[j]; }
    };
    auto lstoreV = [&](int buf, const KV& R) {
#pragma unroll
        for (int j = 0; j < NVP; ++j) { const int p = tid + NTHR * j; LAS unsigned char* vp = X.L + OFF_V + buf * VBUF + (p >> VSH) * VROW + (p & ((1 << VSH) - 1)) * 16;
            *(LAS u32x2*)vp = (u32x2){R.vr[j].x, R.vr[j].y}; *(LAS u32x2*)(vp + 8) = (u32x2){R.vr[j].z, R.vr[j].w}; }
    };
    f32x16 O[2]; float mrun = 0.f, lsum = 0.f, mx = 0.f; bool first = true;
    constexpr float ATT_THR = 8.f;
#pragma unroll
    for (int d = 0; d < 2; ++d)
#pragma unroll
        for (int i = 0; i < 16; ++i) O[d][i] = 0.f;
    constexpr int NM = NS * 2;
    auto maxchunk = [&](int c, const f32x16& A0, const f32x16& A1, float& mA, float& mB) {
        const f32x16& A = (c < 4) ? A0 : A1; float& m = (c < 4) ? mA : mB;
#pragma unroll
        for (int o = 2 * (c & 3); o < 2 * (c & 3) + 2; ++o) {
            if (o == 0) m = max3f(A[0], A[1], A[2]);
            else if (o < 7) m = max3f(m, A[2 * o + 1], A[2 * o + 2]);
            else m = __builtin_fmaxf(m, A[15]);
        }
    };
    auto tile = [&](int buf, f32x16& C0, f32x16& C1, f32x16& N0, f32x16& N1) {
        const LAS unsigned char* Kb = X.L + OFF_K + (buf ^ 1) * KBUF; const LAS unsigned char* Vb = X.L + OFF_V + buf * VBUF;
        if (first || __any(mx > ATT_THR)) {
            const float g = first ? mx : fmaxf(mx, 0.f), alpha = first ? 0.f : fexp2(-g);
            mrun += g; lsum *= alpha; first = false;
#pragma unroll
            for (int i = 0; i < 16; ++i) { C0[i] -= g; C1[i] -= g; }
#pragma unroll
            for (int d = 0; d < 2; ++d)
#pragma unroll
                for (int i = 0; i < 16; ++i) O[d][i] *= alpha;
        }
        const float ninit = -mrun;
        bf16x8 kf0[2], kf1[2];
#pragma unroll
        for (int s = 0; s < 2; ++s) { kf0[s] = *(const LAS bf16x8*)(Kb + r * KROW + kcol + 32 * s); kf1[s] = *(const LAS bf16x8*)(Kb + (32 + r) * KROW + kcol + 32 * s); }
        s16x4 vlo[2][4], vhi[2][4];
        auto vread = [&](int d) {
#pragma unroll
            for (int ks = 0; ks < 4; ++ks) { const LAS unsigned char* vp = Vb + (32 * d + r) * VROW + (16 * ks + 4 * hh) * 2;
                vlo[d][ks] = *(const LAS s16x4*)vp; vhi[d][ks] = *(const LAS s16x4*)(vp + 16); }
        };
        if (NS == 2) vread(0);
#pragma unroll
        for (int i = 0; i < 16; ++i) { N0[i] = ninit; N1[i] = ninit; }
        __builtin_amdgcn_sched_barrier(0);
        float ps0 = 0.f, ps1 = 0.f;
        auto expchunk = [&](int c) {
#pragma unroll
            for (int e = 0; e < 32; ++e)
                if (e >= c * 32 / NM && e < (c + 1) * 32 / NM) {
                    if (e < 16) { C0[e] = fexp2(C0[e]); ps0 += C0[e]; } else { C1[e - 16] = fexp2(C1[e - 16]); ps1 += C1[e - 16]; } }
        };
#pragma unroll
        for (int s0 = 0; s0 < NS; s0 += 2) {
            bf16x8 n0[2], n1[2];
            if (s0 + 2 < NS) {
#pragma unroll
                for (int s = 0; s < 2; ++s) { n0[s] = *(const LAS bf16x8*)(Kb + r * KROW + kcol + 32 * (s0 + 2 + s)); n1[s] = *(const LAS bf16x8*)(Kb + (32 + r) * KROW + kcol + 32 * (s0 + 2 + s)); }
                __builtin_amdgcn_sched_barrier(0); }
            else if (NS > 2) { vread(0); __builtin_amdgcn_sched_barrier(0); }
#pragma unroll
            for (int s = 0; s < 2; ++s) {
                N0 = MFMA32(kf0[s], qf[s0 + s], N0); expchunk(2 * (s0 + s)); asm volatile("" : "+v"(ps0), "+v"(ps1)); __builtin_amdgcn_sched_barrier(0);
                N1 = MFMA32(kf1[s], qf[s0 + s], N1); expchunk(2 * (s0 + s) + 1); asm volatile("" : "+v"(ps0), "+v"(ps1)); __builtin_amdgcn_sched_barrier(0);
            }
            if (s0 + 2 < NS) {
#pragma unroll
                for (int s = 0; s < 2; ++s) { kf0[s] = n0[s]; kf1[s] = n1[s]; } }
        }
        lsum += ps0 + ps1;
        vread(1);
        __builtin_amdgcn_sched_barrier(0);
        bf16x8 pf[2][2];
#pragma unroll
        for (int s = 0; s < 2; ++s) {
            u32x4 w0, w1;
            w0.x = pk2(C0[8 * s + 0], C0[8 * s + 1]); w0.y = pk2(C0[8 * s + 2], C0[8 * s + 3]); w0.z = pk2(C0[8 * s + 4], C0[8 * s + 5]); w0.w = pk2(C0[8 * s + 6], C0[8 * s + 7]);
            w1.x = pk2(C1[8 * s + 0], C1[8 * s + 1]); w1.y = pk2(C1[8 * s + 2], C1[8 * s + 3]); w1.z = pk2(C1[8 * s + 4], C1[8 * s + 5]); w1.w = pk2(C1[8 * s + 6], C1[8 * s + 7]);
            pf[0][s] = __builtin_bit_cast(bf16x8, w0); pf[1][s] = __builtin_bit_cast(bf16x8, w1);
        }
        __builtin_amdgcn_sched_barrier(0);
        float mA = 0.f, mB = 0.f;
        __builtin_amdgcn_s_setprio(1);
#pragma unroll
        for (int ks = 0; ks < 4; ++ks)
#pragma unroll
            for (int d = 0; d < 2; ++d) {
                const bf16x8 vf = __builtin_shufflevector(vlo[d][ks], vhi[d][ks], 0, 1, 2, 3, 4, 5, 6, 7);
                O[d] = MFMA32(vf, pf[ks >> 1][ks & 1], O[d]);
                maxchunk(ks * 2 + d, N0, N1, mA, mB); asm volatile("" : "+v"(mA), "+v"(mB));
                __builtin_amdgcn_sched_barrier(0);
            }
        __builtin_amdgcn_s_setprio(0);
        mx = __builtin_fmaxf(mA, mB);
        mx = __builtin_fmaxf(mx, shx(mx, 32, lane));
    };
    KV RA;
    f32x16 S0, S1, T0, T1;
    __syncthreads();
    gloadK(0, RA); gloadV(0, RA); lstoreK(0, RA); lstoreV(0, RA);
    gloadK(1, RA);
    __syncthreads();
    lstoreK(1, RA);
    {
        const LAS unsigned char* Kb = X.L + OFF_K;
#pragma unroll
        for (int i = 0; i < 16; ++i) { S0[i] = 0.f; S1[i] = 0.f; }
#pragma unroll
        for (int s = 0; s < NS; ++s) {
            const bf16x8 k0 = *(const LAS bf16x8*)(Kb + r * KROW + kcol + 32 * s), k1 = *(const LAS bf16x8*)(Kb + (32 + r) * KROW + kcol + 32 * s);
            S0 = MFMA32(k0, qf[s], S0); S1 = MFMA32(k1, qf[s], S1); }
        float mA = 0.f, mB = 0.f;
#pragma unroll
        for (int c = 0; c < 8; ++c) maxchunk(c, S0, S1, mA, mB);
        mx = __builtin_fmaxf(mA, mB);
        mx = __builtin_fmaxf(mx, shx(mx, 32, lane));
    }
    __syncthreads();
    for (int it = 0; it < ntile; it += 2) {
        if (it + 2 < ntile) gloadK(it + 2, RA);
        gloadV(it + 1, RA);
        tile(0, S0, S1, T0, T1);
        if (it + 2 < ntile) lstoreK(0, RA);
        lstoreV(1, RA);
        __syncthreads();
        if (it + 3 < ntile) gloadK(it + 3, RA);
        if (it + 2 < ntile) gloadV(it + 2, RA);
        tile(1, T0, T1, S0, S1);
        if (it + 3 < ntile) lstoreK(1, RA);
        if (it + 2 < ntile) lstoreV(0, RA);
        __syncthreads();
    }
    const float inv = 1.f / (lsum + shx(lsum, 32, lane));
    if (KIND == 0) {
        LAS float* xb = (LAS float*)(X.L + OFF_X) + qg * 2048 + lane;
        if (mmw == 1) {
#pragma unroll
            for (int d = 0; d < 2; ++d)
#pragma unroll
                for (int i = 0; i < 16; ++i) xb[(d * 16 + i) * 64] = O[d][i] * inv;
        }
        __syncthreads();
        if (mmw == 0) {
            float ss = 0.f;
#pragma unroll
            for (int d = 0; d < 2; ++d)
#pragma unroll
                for (int i = 0; i < 16; ++i) { const float o = O[d][i] * inv - lam * xb[(d * 16 + i) * 64]; O[d][i] = o; ss += o * o; }
            ss += shx(ss, 32, lane);
            const float rstd = rsqrtf(ss * (1.f / 64.f) + EPS) * (1.f - lam_init);
#pragma unroll
            for (int d = 0; d < 2; ++d)
#pragma unroll
                for (int g4 = 0; g4 < 4; ++g4) { const int dv = 32 * d + 8 * g4 + 4 * hh; const f32x4 gg = *(const f32x4*)(P.da_g + l * 64 + dv);
                    u32x2 w; w.x = pk2(O[d][4 * g4] * rstd * gg[0], O[d][4 * g4 + 1] * rstd * gg[1]); w.y = pk2(O[d][4 * g4 + 2] * rstd * gg[2], O[d][4 * g4 + 3] * rstd * gg[3]);
                    *(u32x2*)(ACT + mrow * DM + h * 64 + dv) = w; }
        }
    } else {
#pragma unroll
        for (int d = 0; d < 2; ++d)
#pragma unroll
            for (int g4 = 0; g4 < 4; ++g4) { const int dv = 32 * d + 8 * g4 + 4 * hh;
                u32x2 w; w.x = pk2(O[d][4 * g4] * inv, O[d][4 * g4 + 1] * inv); w.y = pk2(O[d][4 * g4 + 2] * inv, O[d][4 * g4 + 3] * inv);
                *(u32x2*)(ACT + mrow * DM + 768 + h * 64 + dv) = w; }
    }
}

#ifndef MIX_STAMP
#define MIX_STAMP(c) do { } while (0)
#endif
DI void phase_mixers(const Params& P, Ctx& X, int l, int sel = 7) {
    X.cheat = sel;
    const float lam_init = 0.8f - 0.6f * __expf(-0.3f * (float)l);
    float l01 = 0.f, l23 = 0.f;
    if (X.lane < 32) { const float* lv = P.da_lam + l * 128; l01 = lv[X.lane] * lv[32 + X.lane]; l23 = lv[64 + X.lane] * lv[96 + X.lane]; }
    const float lam = __expf(wave_sum(l01, X.lane)) - __expf(wave_sum(l23, X.lane)) + lam_init;
    SsdState ST; ST.u = (sel & 1) ? X.bid : (1 << 20); ST.c = 0; ST.Sacc[0] = (f32x4){0.f, 0.f, 0.f, 0.f}; ST.Sacc[1] = (f32x4){0.f, 0.f, 0.f, 0.f};
    const int vb = (X.G & 7) ? X.bid : (X.bid & 7) * (X.G >> 3) + (X.bid >> 3);
    const int nDA = (sel & 2) ? (1024 - vb + X.G - 1) / X.G : 0, nML = (sel & 4) ? (512 - vb + X.G - 1) / X.G : 0, nCX = (192 - vb + X.G - 1) / X.G;
    const int nitems = nDA + nML + (nCX > 0 ? nCX : 0);
    const int nssd = (sel & 1) ? ((NB * 8 * 2 - X.bid + X.G - 1) / X.G) * 18 : 0;
    const int per = 0; (void)nssd;
    __syncthreads();
#if defined(MK_MODE) && MK_MODE == 2
#ifndef PROBE_SSD_CHEAT
#define PROBE_SSD_CHEAT 1
#endif
    if (sel & 32) ssd_run<PROBE_SSD_CHEAT>(P, X, ST, l, 1 << 20); else
#endif
    ssd_run(P, X, ST, l, 1 << 20);
    MIX_STAMP(9);
    for (int it = 0; it < nitems; ++it) {
#if defined(MK_MODE) && MK_MODE == 2
#ifndef PROBE_ATT_CHEAT
#define PROBE_ATT_CHEAT 0
#endif
#define ATT_CALL(K, ...) do { if (sel & 8) attn_unit<K, PROBE_ATT_CHEAT>(__VA_ARGS__); else attn_unit<K, 0>(__VA_ARGS__); } while (0)
#else
#define ATT_CALL(K, ...) attn_unit<K, 0>(__VA_ARGS__)
#endif
        if (it < nDA) { const int u = vb + it * X.G; ATT_CALL(0, P, X, l, u >> 6, (u >> 4) & 3, 2 + (u & 15), lam, lam_init); }
        else if (it < nDA + nML) { const int u = vb + (it - nDA) * X.G; ATT_CALL(1, P, X, l, u >> 5, (u >> 3) & 3, 1 + (u & 7), lam, lam_init); }
        else { const int u = vb + (it - nDA - nML) * X.G;
            if (u < 128) { if (sel & 2) ATT_CALL(0, P, X, l, u >> 3, (u >> 1) & 3, u & 1, lam, lam_init); } else { if (sel & 4) ATT_CALL(1, P, X, l, (u - 128) >> 2, u & 3, 0, lam, lam_init); } }
        ssd_run(P, X, ST, l, per);
        MIX_STAMP((it < nDA) ? 10 : 11);
    }
    ssd_run(P, X, ST, l, 1 << 20);
}

DI void phase_ssdgate(const Params& P, Ctx& X, int l) {
    const bf16_t* PROJ = (const bf16_t*)(P.ws + WS_PROJ); const bf16_t* XBC = (const bf16_t*)(P.ws + WS_XBC);
    const bf16_t* YF = (const bf16_t*)(P.ws + WS_YF); const bf16_t* YB = (const bf16_t*)(P.ws + WS_YB);
    bf16_t* ACT = (bf16_t*)(P.ws + WS_ACT);
    const int gw = X.bid * NWAVE + X.wave, NGW = X.G * NWAVE, c0 = 8 * X.lane;
    const float dsk = P.ssd_d[l * 8 + (X.lane >> 3)];
    const f32x4 g0 = *(const f32x4*)(P.ssd_g + l * 512 + c0), g1 = *(const f32x4*)(P.ssd_g + l * 512 + c0 + 4);
    for (int m = gw; m < M; m += NGW) {
        const u32x4 yf = *(const u32x4*)(YF + (size_t)m * 512 + c0), yb = *(const u32x4*)(YB + (size_t)m * 512 + c0), xv = *(const u32x4*)(XBC + (size_t)m * 768 + c0), zv = *(const u32x4*)(PROJ + (size_t)m * PW + C_Z + c0);
        const unsigned yfw[4] = {yf.x, yf.y, yf.z, yf.w}, ybw[4] = {yb.x, yb.y, yb.z, yb.w}, xw[4] = {xv.x, xv.y, xv.z, xv.w}, zw[4] = {zv.x, zv.y, zv.z, zv.w};
        float v[8]; float ss = 0.f;
#pragma unroll
        for (int i = 0; i < 4; ++i) {
            v[2 * i] = (bflo(yfw[i]) + bflo(ybw[i]) + dsk * bflo(xw[i])) * silu(bflo(zw[i]));
            v[2 * i + 1] = (bfhi(yfw[i]) + bfhi(ybw[i]) + dsk * bfhi(xw[i])) * silu(bfhi(zw[i]));
            ss += v[2 * i] * v[2 * i] + v[2 * i + 1] * v[2 * i + 1]; }
        const float rstd = rsqrtf(wave_sum(ss, X.lane) * (1.f / 512.f) + EPS);
        u32x4 w; w.x = pk2(v[0] * rstd * g0[0], v[1] * rstd * g0[1]); w.y = pk2(v[2] * rstd * g0[2], v[3] * rstd * g0[3]); w.z = pk2(v[4] * rstd * g1[0], v[5] * rstd * g1[1]); w.w = pk2(v[6] * rstd * g1[2], v[7] * rstd * g1[3]);
        *(u32x4*)(ACT + (size_t)m * DM + 256 + c0) = w;
    }
}

DI float reduce16(const float (&lg)[16], int lane) {
    float x8[8], x4[4], x2[2];
    const bool b3 = (lane & 8) != 0, b2 = (lane & 4) != 0, b1 = (lane & 2) != 0, b0 = (lane & 1) != 0;
#pragma unroll
    for (int i = 0; i < 8; ++i) { const float keep = b3 ? lg[i + 8] : lg[i], send = b3 ? lg[i] : lg[i + 8]; x8[i] = keep + shx(send, 8, lane); }
#pragma unroll
    for (int i = 0; i < 4; ++i) { const float keep = b2 ? x8[i + 4] : x8[i], send = b2 ? x8[i] : x8[i + 4]; x4[i] = keep + shx(send, 4, lane); }
#pragma unroll
    for (int i = 0; i < 2; ++i) { const float keep = b1 ? x4[i + 2] : x4[i], send = b1 ? x4[i] : x4[i + 2]; x2[i] = keep + shx(send, 2, lane); }
    const float keep = b0 ? x2[1] : x2[0], send = b0 ? x2[0] : x2[1];
    float x = keep + shx(send, 1, lane);
    x += shx(x, 16, lane); x += shx(x, 32, lane);
    return x;
}
DI void route_select(float x, float rbias, int lane, int& i1, int& i2, float& w1, float& w2) {
    const float aff = 1.f / (1.f + expf(-x)), sel = aff + rbias;
    const float q1 = shx(sel, 1, lane), q2 = shx(sel, 2, lane), q3 = shx(sel, 3, lane);
    const float hi1 = fmaxf(sel, q1), lo1 = fminf(sel, q1), hi2 = fmaxf(q2, q3), lo2 = fminf(q2, q3);
    const float gs = fmaxf(hi1, hi2) + fmaxf(fminf(hi1, hi2), fmaxf(lo1, lo2));
    const float g0 = shl(gs, 0), g1 = shl(gs, 4), g2 = shl(gs, 8), g3 = shl(gs, 12);
    int best = 0; float bs = g0;
    if (g1 > bs) { bs = g1; best = 1; }
    if (g2 > bs) { bs = g2; best = 2; }
    if (g3 > bs) { bs = g3; best = 3; }
    int j1 = 0, j2 = 0; float v1 = -1e30f, v2 = -1e30f, a1 = 0.f, a2 = 0.f;
#pragma unroll
    for (int j = 0; j < 4; ++j) { const float s = shl(sel, 4 * best + j), a = shl(aff, 4 * best + j);
        if (s > v1) { v2 = v1; j2 = j1; a2 = a1; v1 = s; j1 = j; a1 = a; } else if (s > v2) { v2 = s; j2 = j; a2 = a; } }
    i1 = 4 * best + j1; i2 = 4 * best + j2; w1 = a1 / (a1 + a2); w2 = a2 / (a1 + a2);
}
DI void phase_norm2_route(const Params& P, Ctx& X, int l) {
    const float* MOD = (const float*)(P.ws + WS_MOD);
    bf16_t* ACT = (bf16_t*)(P.ws + WS_ACT);
    u32x4* TOK = (u32x4*)(P.ws + WS_TOK); int* LIST = (int*)(P.ws + WS_LIST);
    unsigned* cnt = (unsigned*)(P.ws + WS_CTL) + CW_CNT + l * 16;
    const int lane = X.lane;
    constexpr int RPW = 36;
    LAS unsigned* lcnt = (LAS unsigned*)(X.L + 65536); LAS unsigned* lbase = lcnt + 16; LAS unsigned* ltab = lcnt + 64;
    __syncthreads();
    for (int k = X.tid; k < DM; k += NTHR) { const int j = k >> 8, ln = (k >> 2) & 63, i = k & 3, slot = (4 * j + i) * 64 + ln;
#pragma unroll
        for (int e4 = 0; e4 < 4; ++e4) *(LAS f32x4*)(X.L + ((size_t)e4 * 1024 + slot) * 16) = *(const f32x4*)(P.r_w + k * 16 + 4 * e4); }
    if (X.tid < 32) lcnt[X.tid] = 0u;
    __syncthreads();
    const float rbias = P.r_b[lane & 15];
    const int gw = X.bid * NWAVE + X.wave, NGW = X.G * NWAVE;
    const float* g = P.g_ffn + l * DM;
    int it = 0;
    for (int ck = gw; ck < M / RPC; ck += NGW, ++it) {
        const int m0 = ck * RPC, b = m0 / T, t0 = m0 - b * T;
        int cur_cls = -1; f32x4 gs[4], sh[4], gm[4];
        u32x2 hc[4], mc[4], hn[4], mn[4];
        const bf16_t* MIX = (const bf16_t*)(P.ws + WS_MIX);
        { const bf16_t* h0 = hrow(P, m0); const bf16_t* x0 = MIX + (size_t)m0 * DM;
#pragma unroll
          for (int j = 0; j < 4; ++j) { hc[j] = *(const u32x2*)(h0 + 256 * j + 4 * lane); mc[j] = *(const u32x2*)(x0 + 256 * j + 4 * lane); } }
#pragma unroll 1
        for (int r = 0; r < RPC; ++r) {
            const int m = m0 + r, t = t0 + r, cls = (t < CTX) ? 1 : 0;
            if (r + 1 < RPC) { const bf16_t* h0 = hrow(P, m + 1); const bf16_t* x0 = MIX + (size_t)(m + 1) * DM;
#pragma unroll
                for (int j = 0; j < 4; ++j) { hn[j] = *(const u32x2*)(h0 + 256 * j + 4 * lane); mn[j] = *(const u32x2*)(x0 + 256 * j + 4 * lane); } }
            if (!(l == DEPTH - 1 && cls)) {
                if (cls != cur_cls) { cur_cls = cls;
                    const float* mrow = MOD + ((size_t)l * 17 + (cls ? 16 : b)) * 6144;
#pragma unroll
                    for (int j = 0; j < 4; ++j) { const int cidx = 256 * j + 4 * lane;
                        gs[j] = *(const f32x4*)(g + cidx) * (*(const f32x4*)(mrow + 4 * DM + cidx) + 1.f); sh[j] = *(const f32x4*)(mrow + 3 * DM + cidx); gm[j] = *(const f32x4*)(mrow + 2 * DM + cidx); } }
                f32x4 c0[4];
                { bf16_t* hp = hrow(P, m);
#pragma unroll
                  for (int j = 0; j < 4; ++j) { const f32x4 hv = {bflo(hc[j].x), bfhi(hc[j].x), bflo(hc[j].y), bfhi(hc[j].y)}, xv = {bflo(mc[j].x), bfhi(mc[j].x), bflo(mc[j].y), bfhi(mc[j].y)};
                      c0[j] = hv + gm[j] * xv;
                      u32x2 o; o.x = pk2(c0[j][0], c0[j][1]); o.y = pk2(c0[j][2], c0[j][3]); *(u32x2*)(hp + 256 * j + 4 * lane) = o; } }
                float s0 = 0.f;
#pragma unroll
                for (int j = 0; j < 4; ++j) s0 += c0[j][0] * c0[j][0] + c0[j][1] * c0[j][1] + c0[j][2] * c0[j][2] + c0[j][3] * c0[j][3];
                const float r0 = rsqrtf(wave_sum(s0, lane) * (1.f / DM) + EPS);
                float lg0[16];
#pragma unroll
                for (int e = 0; e < 16; ++e) lg0[e] = 0.f;
#pragma unroll
                for (int j = 0; j < 4; ++j) { const int cidx = 256 * j + 4 * lane;
                    const f32x4 u0 = c0[j] * r0 * gs[j] + sh[j];
                    u32x2 o; o.x = pk2(u0[0], u0[1]); o.y = pk2(u0[2], u0[3]); *(u32x2*)(ACT + (size_t)m * DM + cidx) = o;
#pragma unroll
                    for (int i = 0; i < 4; ++i) { const int slot = (4 * j + i) * 64 + lane;
#pragma unroll
                        for (int e4 = 0; e4 < 4; ++e4) { const f32x4 rw = *(const LAS f32x4*)(X.L + ((size_t)e4 * 1024 + slot) * 16);
                            lg0[4 * e4] += u0[i] * rw[0]; lg0[4 * e4 + 1] += u0[i] * rw[1]; lg0[4 * e4 + 2] += u0[i] * rw[2]; lg0[4 * e4 + 3] += u0[i] * rw[3]; } } }
                int a1, a2; float wa1, wa2;
                route_select(reduce16(lg0, lane), rbias, lane, a1, a2, wa1, wa2);
                if (lane == 0) {
                    LAS unsigned* rec = ltab + (X.wave * RPW + it * RPC + r) * 4;
                    const unsigned ra1 = __hip_atomic_fetch_add(lcnt + a1, 1u, __ATOMIC_RELAXED, __HIP_MEMORY_SCOPE_WORKGROUP), ra2 = __hip_atomic_fetch_add(lcnt + a2, 1u, __ATOMIC_RELAXED, __HIP_MEMORY_SCOPE_WORKGROUP);
                    rec[0] = (unsigned)a1 | (ra1 << 4); rec[1] = (unsigned)a2 | (ra2 << 4); rec[2] = __float_as_uint(wa1); rec[3] = __float_as_uint(wa2);
                }
            }
#pragma unroll
            for (int j = 0; j < 4; ++j) { hc[j] = hn[j]; mc[j] = mn[j]; }
        }
    }
    __syncthreads();
    if (X.tid < 16) { const unsigned c = lcnt[X.tid]; lbase[X.tid] = c ? atomicAdd(&cnt[X.tid], c) : 0u; }
    __syncthreads();
    it = 0;
    for (int ck = gw; ck < M / RPC; ck += NGW, ++it) {
        const int m0 = ck * RPC, b = m0 / T, t0 = m0 - b * T;
        if (lane < RPC) { const int m = m0 + lane, t = t0 + lane;
            if (!(l == DEPTH - 1 && t < CTX)) {
                const LAS unsigned* rec = ltab + (X.wave * RPW + it * RPC + lane) * 4;
                const unsigned e1 = rec[0] & 15u, e2 = rec[1] & 15u, p1 = lbase[e1] + (rec[0] >> 4), p2 = lbase[e2] + (rec[1] >> 4);
                LIST[(size_t)e1 * M + p1] = m; LIST[(size_t)e2 * M + p2] = m;
                u32x4 ti; ti.x = e1 | (p1 << 4); ti.y = e2 | (p2 << 4); ti.z = rec[2]; ti.w = rec[3];
                TOK[m] = ti; } }
    }
}
DI void moe_tables(const Params& P, Ctx& X, int l) {
    __syncthreads();
    if (X.tid < 64) { const unsigned* cnt = (const unsigned*)(P.ws + WS_CTL) + CW_CNT + l * 16;
        const int c = (X.lane < 16) ? (int)__hip_atomic_load(cnt + (X.lane & 15), __ATOMIC_RELAXED, __HIP_MEMORY_SCOPE_AGENT) : 0;
        const int tiles = (c + 255) >> 8; int incl = tiles;
#pragma unroll
        for (int o = 1; o < 16; o <<= 1) { const int v = shupi(incl, o, X.lane); if (X.lane >= o) incl += v; }
        if (X.lane < 16) { X.misc[16 + X.lane] = c; X.misc[32 + X.lane] = incl - tiles; X.misc[64 + X.lane] = (incl - tiles) * 256; }
        if (X.lane == 15) X.misc[32 + 16] = incl; }
    __syncthreads();
}
DI void moe_prefetch_idx(const Params& P, Ctx& X, const MoeSched<true>& S) {
    LAS int* tab = (LAS int*)(X.L + LDS_IDX);
    for (int i = 0; i < MOE_MAXU; ++i) { GUnit u; if (!S.next(i, u)) break;
        const int cnt = __builtin_amdgcn_readfirstlane(X.misc[16 + u.e]);
        if (X.tid < 256) { const int idx = u.pm * 256 + X.tid; tab[i * 256 + X.tid] = (idx < cnt) ? S.list[(size_t)u.e * M + idx] : 0; } }
    __syncthreads();
}

constexpr int N_PHASES = 38;
__global__ void __launch_bounds__(NTHR, 2) mk_fwd(Params PK) {
    const Params& P0 = PK; const Params* kp = &PK;
    extern __shared__ __attribute__((aligned(16))) unsigned char lds_raw[];
    Ctx X;
    X.L = (LAS unsigned char*)lds_raw; X.misc = (volatile LAS int*)(X.L + LDS_MISC); X.ws = PK.ws;
    X.tid = threadIdx.x; X.lane = X.tid & 63; X.wave = __builtin_amdgcn_readfirstlane(X.tid >> 6); X.G = gridDim.x; X.bid = blockIdx.x;
    const int wave0 = X.wave;
    if (X.tid < 128) X.misc[X.tid] = 0;
    __syncthreads();
#if MK_MODE == 4
    if (X.tid == 0) { const unsigned long long _n = __builtin_amdgcn_s_memrealtime(); X.misc[94] = (int)(unsigned)(_n >> 32); X.misc[95] = (int)(unsigned)_n; }
#endif
    unsigned* ctl = (unsigned*)(PK.ws + WS_CTL);
    XcdBarrier bar; bar.bar = ctl + CW_BAR; bar.x = 0; bar.st = (volatile LAS unsigned*)X.misc;
    const bool multi = ((PK.ph_hi & 255) - PK.ph_lo) > 1;
    if (multi) bar = xcd_barrier_post(ctl + CW_BAR, (volatile LAS unsigned*)X.misc);
#ifndef PHMASK
#define PHMASK 0xFFFF
#endif
#define RUN(ph) (PK.ph_lo <= (ph) && (ph) < (PK.ph_hi & 255))
#define HAS(k) ((PHMASK >> (k)) & 1)
#if MK_MODE == 4
#define TSTAMP(cat) MIX_STAMP(cat)
#else
#define TSTAMP(cat) do { } while (0)
#endif
#define SEAM(ph) do { if (RUN(ph) && RUN((ph) + 1)) { FRESH(); xcd_barrier(bar, X.tid); TSTAMP(15); } } while (0)
#define FRESH() do { unsigned _z = 0u; asm volatile("" : "+v"(_z)); int _t = wave0 * 64 + (int)__builtin_amdgcn_mbcnt_hi(~0u, __builtin_amdgcn_mbcnt_lo(~0u, _z)); asm volatile("" : "+v"(_t)); X.tid = _t; X.lane = _t & 63; X.wave = __builtin_amdgcn_readfirstlane(_t >> 6); \
        const __attribute__((address_space(4))) Params* _kp = (const __attribute__((address_space(4))) Params*)__builtin_amdgcn_kernarg_segment_ptr(); asm volatile("" : "+s"(_kp)); kp = (const Params*)_kp; X.ws = kp->ws; \
        int _b = blockIdx.x, _g = gridDim.x; asm volatile("" : "+s"(_b), "+s"(_g)); X.bid = _b; X.G = _g; } while (0)
#define P (*kp)
    if (HAS(9) && RUN(0)) phase_prologue(P, X);
    TSTAMP(14);
    SEAM(0);
#pragma unroll 1
    for (int l = 0; l < DEPTH; ++l) {
        const int pb = 1 + 9 * l;
        FRESH(); if (HAS(0) && RUN(pb + 0)) phase_norm1(P, X, l);
        TSTAMP(0);
        SEAM(pb + 0);
        FRESH(); if (HAS(1) && RUN(pb + 1)) { DenseSched S; S.init(P.ws + WS_ACT, P.ws + WS_WIN, M, PW, DM, X.G, X.bid); EpiStoreBf16 E{(bf16_t*)(P.ws + WS_PROJ), PW}; gemm8(X.L, DM, S, E, X.tid); }
        TSTAMP(1);
        SEAM(pb + 1);
        FRESH(); if (HAS(2) && RUN(pb + 2)) phase_postproj(P, X, l, (PK.ph_hi >> 8) ? (PK.ph_hi >> 8) : 15);
        TSTAMP(2);
        SEAM(pb + 2);
        FRESH(); if (HAS(3) && RUN(pb + 3)) phase_mixers(P, X, l, (PK.ph_hi >> 8) ? (PK.ph_hi >> 8) : 7);
        TSTAMP(3);
        SEAM(pb + 3);
        FRESH(); if (HAS(4) && RUN(pb + 4)) phase_ssdgate(P, X, l);
        TSTAMP(4);
        SEAM(pb + 4);
        FRESH(); if (HAS(5) && RUN(pb + 5)) { DenseSched S; S.init(P.ws + WS_ACT, P.ws + WS_WOUT, M, DM, DM, X.G, X.bid);
            EpiStoreBf16 E{(bf16_t*)(P.ws + WS_MIX), DM}; gemm8(X.L, DM, S, E, X.tid); }
        TSTAMP(5);
        SEAM(pb + 5);
        FRESH(); if (HAS(6) && RUN(pb + 6)) phase_norm2_route(P, X, l);
        TSTAMP(6);
        SEAM(pb + 6);
        FRESH(); if (HAS(7) && RUN(pb + 7)) { moe_tables(P, X, l);
            MoeSched<true> S{(const char*)(P.ws + WS_ACT), (const char*)(P.ws + WS_WGU), (const int*)(P.ws + WS_LIST), X.misc, DM, X.G, X.bid};
            moe_prefetch_idx(P, X, S);
            EpiGateUp E{(bf16_t*)(P.ws + WS_HE)}; gemm8(X.L, DM, S, E, X.tid); }
        TSTAMP(7);
        SEAM(pb + 7);
        FRESH(); if (HAS(8) && RUN(pb + 8)) { moe_tables(P, X, l);
            MoeSched<false> S{(const char*)(P.ws + WS_HE), (const char*)(P.ws + WS_WD), nullptr, X.misc, 512, X.G, X.bid};
            EpiStoreBf16 E{(bf16_t*)(P.ws + WS_YS), DM}; gemm8(X.L, 512, S, E, X.tid); }
        TSTAMP(8);
        SEAM(pb + 8);
    }
#if MK_MODE == 5
    for (int xb = 0; xb < 32; ++xb) { FRESH(); xcd_barrier(bar, X.tid); }
#endif
#if MK_MODE == 4
    FRESH(); if (HAS(10) && RUN(37)) { float eps = 0.f;
        { float tot = 0.f;
          for (int c = 0; c < 16; ++c) tot += (float)X.misc[96 + c];
          const float sel = (float)X.misc[96 + PROBE_K];
          eps = 0.03f + 0.15f * (sel / tot); }
        phase_final(P, X, eps); }
#else
    FRESH(); if (HAS(10) && RUN(37)) phase_final(P, X);
#endif
#undef P
#undef RUN
#undef SEAM
}
}

#ifndef PROBE_SEL
#define PROBE_SEL 0
#endif
#ifndef MK_MODE
#define MK_MODE 1
#endif
extern "C" void kernel_launch(void* const* d_in, const int* in_sizes, int n_in, void* d_out, int out_size, void* d_ws, size_t ws_size, hipStream_t stream) {
    using namespace mk;
    static int grid = 0;
    if (grid == 0) {
        if (n_in != 28 || ws_size < WS_END) { fprintf(stderr, "kernel_launch: unexpected inputs (n_in %d, ws %zu < %zu)\n", n_in, ws_size, (size_t)WS_END); grid = -1; return; }
        int dev = 0, cus = 0, per_cu = 0;
        if (hipGetDevice(&dev) != hipSuccess || hipDeviceGetAttribute(&cus, hipDeviceAttributeMultiprocessorCount, dev) != hipSuccess) { grid = -1; return; }
        if (hipFuncSetAttribute((const void*)mk_fwd, hipFuncAttributeMaxDynamicSharedMemorySize, LDS_BYTES) != hipSuccess) { fprintf(stderr, "kernel_launch: hipFuncSetAttribute failed\n"); grid = -1; return; }
        if (hipOccupancyMaxActiveBlocksPerMultiprocessor(&per_cu, (const void*)mk_fwd, NTHR, LDS_BYTES) != hipSuccess || per_cu < 1) { fprintf(stderr, "kernel_launch: occupancy query says %d\n", per_cu); (void)hipGetLastError(); grid = -1; return; }
        grid = cus;
    }
    if (grid < 0) return;
    (void)hipMemsetAsync((char*)d_ws + WS_CTL, 0, CTL_BYTES, stream);
    Params p{};
    const float** pp = (const float**)&p;
    for (int i = 0; i < 28; ++i) pp[i] = (const float*)d_in[i];
    p.out = (float*)d_out; p.ws = (unsigned char*)d_ws;
#if MK_MODE == 1 || MK_MODE == 4 || MK_MODE == 5
    p.ph_lo = 0; p.ph_hi = N_PHASES;
    hipLaunchKernelGGL(mk_fwd, dim3(grid), dim3(NTHR), LDS_BYTES, stream, p);
#else
    for (int ph = 0; ph < N_PHASES; ++ph) { p.ph_lo = ph; p.ph_hi = ph + 1; hipLaunchKernelGGL(mk_fwd, dim3(grid), dim3(NTHR), LDS_BYTES, stream, p);
#if MK_MODE == 3
        if (ph == PROBE_PH) for (int r = 0; r < PROBE_REP; ++r) hipLaunchKernelGGL(mk_fwd, dim3(grid), dim3(NTHR), LDS_BYTES, stream, p);
#endif
    }
#if MK_MODE == 2
    p.out = (float*)((unsigned char*)d_ws + WS_PROJ);
    for (int r = 0; r < PROBE_REP; ++r) { p.ph_lo = PROBE_PH; p.ph_hi = (PROBE_PH + 1) | (PROBE_SEL << 8); hipLaunchKernelGGL(mk_fwd, dim3(grid), dim3(NTHR), LDS_BYTES, stream, p); }
#endif
#endif
}
```

```cpp
#include <hip/hip_runtime.h>
#include <cstdio>
#include <cstdint>

namespace mk {
#if defined(MK_MODE) && MK_MODE == 4
#define MIX_STAMP(c) do { if (X.tid == 0) { const unsigned long long _n = __builtin_amdgcn_s_memrealtime(); const unsigned long long _p = ((unsigned long long)(unsigned)X.misc[94] << 32) | (unsigned)X.misc[95]; X.misc[96 + (c)] += (int)(unsigned)(_n - _p); X.misc[94] = (int)(unsigned)(_n >> 32); X.misc[95] = (int)(unsigned)_n; } } while (0)
#endif
#define LAS __attribute__((address_space(3)))
#define DI __device__ __forceinline__
typedef unsigned short bf16_t;
typedef short bf16x8 __attribute__((ext_vector_type(8)));
typedef short s16x4 __attribute__((ext_vector_type(4)));
typedef float f32x2 __attribute__((ext_vector_type(2)));
typedef float f32x4 __attribute__((ext_vector_type(4)));
typedef float f32x16 __attribute__((ext_vector_type(16)));
typedef unsigned u32x2 __attribute__((ext_vector_type(2)));
typedef unsigned u32x4 __attribute__((ext_vector_type(4)));
typedef __bf16 bf16x2_t __attribute__((ext_vector_type(2)));
typedef short v4i16_t __attribute__((ext_vector_type(4)));

constexpr int DM = 1024, NB = 16, SEQ = 2048, CTX = 256, T = SEQ + CTX, M = NB * T, DEPTH = 4;
constexpr int PW = 2560, INW = 2480;
constexpr int C_DAQ = 0, C_DAK = 256, C_DAV = 512, C_Z = 768, C_XBC = 1280, C_DT = 2048, C_CQ = 2064, C_CKV = 2320, C_KR = 2448;
constexpr float EPS = 1e-6f, LOG2E = 1.4426950408889634f;
constexpr float DA_QS = 0.17677669529663687f * LOG2E, MLA_QS = 0.10206207261596577f * LOG2E;
constexpr int NSLOT = 2 * M + 4096;
constexpr int NTHR = 512, NWAVE = 8;

constexpr size_t MiB = 1u << 20;
constexpr size_t WS_CTL = 0, CTL_BYTES = 1 * MiB;
constexpr size_t WS_MOD = 1 * MiB, WS_ROPE = 3 * MiB, WS_HC = 4 * MiB;
constexpr size_t WS_WIN = 20 * MiB, WS_WOUT = 25 * MiB, WS_WUQ = 27 * MiB, WS_WUKV = 27 * MiB + 512 * 1024, WS_WGU = 28 * MiB, WS_WD = 60 * MiB;
constexpr size_t WS_ACT = 76 * MiB, WS_PROJ = 148 * MiB;
constexpr size_t WS_MLAQ = 328 * MiB, WS_MLAK = 355 * MiB, WS_VTM = 382 * MiB, WS_VTD = 400 * MiB;
constexpr size_t WS_XBC = 418 * MiB, WS_DT = 472 * MiB, WS_YF = 475 * MiB, WS_YB = 511 * MiB, WS_TOK = 547 * MiB, WS_LIST = 548 * MiB, WS_H = 551 * MiB, WS_END = 623 * MiB;
constexpr size_t WS_HE = WS_MLAQ, WS_YS = WS_PROJ, WS_MIX = WS_PROJ;
static_assert((size_t)NSLOT * 512 * 2 <= WS_XBC - WS_MLAQ, "HE alias");
static_assert((size_t)NSLOT * 1024 * 2 <= WS_MLAQ - WS_PROJ, "YS alias");
constexpr int CW_BAR = 4096, CW_CNT = 8192;

constexpr int LDS_MISC = 131072, LDS_IDX = LDS_MISC + 1024, MOE_MAXU = 8, LDS_BYTES = LDS_IDX + MOE_MAXU * 1024;

struct Params {
    const float *x, *c, *ctx, *c_ctx, *g_mix, *g_ffn, *w_mod, *b_mod, *w_in, *w_out, *da_lam, *da_g, *conv_w, *conv_b, *dt_bias, *a_log, *ssd_d, *ssd_g,
                *mq_g, *mkv_g, *w_uq, *w_ukv, *r_w, *r_b, *wg, *wu, *wd, *fin_g;
    float* out; unsigned char* ws; int ph_lo, ph_hi;
};

DI unsigned pk2(float lo, float hi) { f32x2 v = {lo, hi}; bf16x2_t b = __builtin_convertvector(v, bf16x2_t); return __builtin_bit_cast(unsigned, b); }
DI float bflo(unsigned w) { return __uint_as_float(w << 16); }
DI float bfhi(unsigned w) { return __uint_as_float(w & 0xffff0000u); }
DI float shx(float v, int o, int lane) { return __int_as_float(__builtin_amdgcn_ds_bpermute((lane ^ o) << 2, __float_as_int(v))); }
DI float shl(float v, int src) { return __int_as_float(__builtin_amdgcn_ds_bpermute(src << 2, __float_as_int(v))); }
DI int shli(int v, int src) { return __builtin_amdgcn_ds_bpermute(src << 2, v); }
DI float shup(float v, int o, int lane) { return __int_as_float(__builtin_amdgcn_ds_bpermute((lane - o) << 2, __float_as_int(v))); }
DI int shupi(int v, int o, int lane) { return __builtin_amdgcn_ds_bpermute((lane - o) << 2, v); }
DI float xh_max(float v) { const auto rr = __builtin_amdgcn_permlane32_swap(__float_as_uint(v), __float_as_uint(v), false, false); return __builtin_fmaxf(__uint_as_float(rr[0]), __uint_as_float(rr[1])); }
DI float xh_sum(float v) { const auto rr = __builtin_amdgcn_permlane32_swap(__float_as_uint(v), __float_as_uint(v), false, false); return __uint_as_float(rr[0]) + __uint_as_float(rr[1]); }
DI float x16_sum(float v) { const auto rr = __builtin_amdgcn_permlane16_swap(__float_as_uint(v), __float_as_uint(v), false, false); return __uint_as_float(rr[0]) + __uint_as_float(rr[1]); }
template <int CTRL> DI float dpp_f(float v) { return __int_as_float(__builtin_amdgcn_update_dpp(0, __float_as_int(v), CTRL, 0xf, 0xf, true)); }
DI float dpp_xor4(float v, int lane) { const float a = dpp_f<0x104>(v), b = dpp_f<0x114>(v); return (lane & 4) ? b : a; }
DI float rdlane(float v, int l) { return __int_as_float(__builtin_amdgcn_readlane(__float_as_int(v), l)); }
DI float wave_scan(float v) {
    v += dpp_f<0x111>(v); v += dpp_f<0x112>(v); v += dpp_f<0x114>(v); v += dpp_f<0x118>(v);
    v += __int_as_float(__builtin_amdgcn_update_dpp(0, __float_as_int(v), 0x142, 0xa, 0xf, false));
    v += __int_as_float(__builtin_amdgcn_update_dpp(0, __float_as_int(v), 0x143, 0xc, 0xf, false));
    return v;
}
DI float wave_sum(float v, int) {
    v += dpp_f<0xB1>(v);
    v += dpp_f<0x4E>(v);
    v += dpp_f<0x141>(v);
    v += dpp_f<0x140>(v);
    v = x16_sum(v);
    return xh_sum(v);
}
DI float silu(float x) { return x * __builtin_amdgcn_rcpf(1.f + __expf(-x)); }
DI float fexp2(float x) { return __builtin_amdgcn_exp2f(x); }
DI float max3f(float a, float b, float c) { return __builtin_fmaxf(__builtin_fmaxf(a, b), c); }
#define LDS_WAIT() asm volatile("s_waitcnt lgkmcnt(0)" ::: "memory")
#define MFMA32(a, b, c) __builtin_amdgcn_mfma_f32_32x32x16_bf16((a), (b), (c), 0, 0, 0)
#define MFMA16(a, b, c) __builtin_amdgcn_mfma_f32_16x16x32_bf16((a), (b), (c), 0, 0, 0)
DI int crow(int reg, int h) { return (reg & 3) + 8 * (reg >> 2) + 4 * h; }

#define XB_TMO      128
#define XB_XCNT(j)  (256  + 64 * (j))
#define XB_XSUB(j)  (1280 + 64 * (j))
#define XB_XGEN(j)  (2304 + 64 * (j))
#define XB_TOP      3328
#define XB_TOPGEN   3392
#define XCD_BAR_WORDS 3456
#define XB_SPIN_CAP (1u << 22)
DI unsigned xb_ld(unsigned* p)              { return __hip_atomic_load(p, __ATOMIC_RELAXED, __HIP_MEMORY_SCOPE_AGENT); }
DI unsigned xb_add(unsigned* p, unsigned v) { return __hip_atomic_fetch_add(p, v, __ATOMIC_RELAXED, __HIP_MEMORY_SCOPE_AGENT); }
DI unsigned xb_xcc_id() { return (unsigned)__builtin_amdgcn_s_getreg((3 << 11) | 20) & 0xFu; }
#define XB_SPIN(cond, bar) do { unsigned _sp = 0; while (cond) { __builtin_amdgcn_s_sleep(1); \
    if ((++_sp & 255u) == 0u) { if (xb_ld(&(bar)[XB_TMO])) break; if (_sp > XB_SPIN_CAP) { atomicAdd(&(bar)[XB_TMO], 1u); break; } } } } while (0)
struct XcdBarrier { unsigned* bar; unsigned x; volatile LAS unsigned* st; };
DI XcdBarrier xcd_barrier_post(unsigned* bar, volatile LAS unsigned* st) {
    XcdBarrier b; b.bar = bar; b.x = xb_xcc_id(); b.st = st;
    if (threadIdx.x == 0) (void)xb_add(&bar[XB_XCNT(b.x)], 1u);
    return b;
}
DI void xcd_barrier_complete(unsigned* bar, unsigned x, unsigned& nloc, unsigned& nx) {
    const unsigned G = gridDim.x * gridDim.y * gridDim.z;
    unsigned sum, cnt, mine, sp = 0u;
    for (;;) {
        sum = 0u; cnt = 0u; mine = 0u;
#pragma unroll
        for (unsigned j = 0; j < 16; ++j) { const unsigned c = xb_ld(&bar[XB_XCNT(j)]); sum += c; cnt += (c > 0u) ? 1u : 0u; }
        mine = xb_ld(&bar[XB_XCNT(x)]);
        if (sum == G) break;
        __builtin_amdgcn_s_sleep(1);
        if ((++sp & 255u) == 0u) { if (xb_ld(&bar[XB_TMO])) break; if (sp > XB_SPIN_CAP) { atomicAdd(&bar[XB_TMO], 1u); break; } }
    }
    nloc = mine > 0u ? mine : 1u; nx = cnt > 0u ? cnt : 1u;
}
DI void xcd_barrier(const XcdBarrier& b, int tid) {
    asm volatile("s_waitcnt vmcnt(0)" ::: "memory");
    __syncthreads();
    if (tid == 0) {
        unsigned* bar = b.bar;
        __builtin_amdgcn_s_waitcnt(0);
        unsigned nloc = b.st[0], nx = b.st[1];
        if (nloc == 0u) { xcd_barrier_complete(bar, b.x, nloc, nx); b.st[0] = nloc; b.st[1] = nx; }
        const unsigned old = xb_add(&bar[XB_XSUB(b.x)], 1u);
        const unsigned gen = old / nloc;
        if (old + 1u == (gen + 1u) * nloc) {
            __builtin_amdgcn_fence(__ATOMIC_RELEASE, "agent");
            asm volatile("s_waitcnt vmcnt(0)" ::: "memory");
            const unsigned og = xb_add(&bar[XB_TOP], 1u);
            const unsigned tg = og / nx;
            if (og + 1u == (tg + 1u) * nx) xb_add(&bar[XB_TOPGEN], 1u);
            else XB_SPIN(xb_ld(&bar[XB_TOPGEN]) == tg, bar);
            __builtin_amdgcn_fence(__ATOMIC_ACQUIRE, "agent");
            xb_add(&bar[XB_XGEN(b.x)], 1u);
            asm volatile("s_waitcnt vmcnt(0)" ::: "memory");
        } else {
            XB_SPIN(xb_ld(&bar[XB_XGEN(b.x)]) == gen, bar);
            __builtin_amdgcn_fence(__ATOMIC_ACQUIRE, "agent");
            asm volatile("s_waitcnt vmcnt(0)" ::: "memory");
        }
    }
    __syncthreads();
}

constexpr int HTB = 128 * 64 * 2;
DI int lds_byte(int r, int c) { const int st = (r >> 4) * 2 + (c >> 5), rr = r & 15, cc = c & 31, ob = rr * 64 + cc * 2; return st * 1024 + (ob ^ (((ob >> 9) & 1) << 5)); }
DI void stage_rc(int b, int& R, int& C) { const int st = b / 1024, sb = b % 1024, swz = sb ^ (((sb >> 9) & 1) << 5); R = (st >> 1) * 16 + swz / 64; C = (st & 1) * 32 + (swz % 64) / 2; }
DI int perm32(int rho) { const int n = rho >> 4, i = rho & 15; return 8 * (i >> 2) + 4 * n + (i & 3); }

struct GUnit { const char* A; const char* B; int pm, pn, e, row0, ord; };

template <class Epi, class Sched>
DI void gemm8(LAS unsigned char* lds, const int K, const Sched& S, const Epi& E, int tid_in) {
    int tid_ = tid_in; asm volatile("" : "+v"(tid_));
    const int tid = tid_, wid = __builtin_amdgcn_readfirstlane(tid >> 6), lane = tid & 63, wr = wid >> 2, wc = wid & 3, fr = lane & 15, fq = lane >> 4;
    const int nt = K / 64;
    int R[2], C[2]; unsigned voffB[2];
#pragma unroll
    for (int i = 0; i < 2; ++i) { stage_rc(tid * 16 + i * 8192, R[i], C[i]); const int Rb = Epi::PERM ? ((R[i] & ~31) + perm32(R[i] & 31)) : R[i]; voffB[i] = (unsigned)(Rb * K + C[i]) * 2u; }
    const size_t kstep = 128;
    const size_t hstepB = (size_t)128 * K * 2;
    const unsigned ldsw = (unsigned)wid * 1024u;
    const int aoff = lds_byte(wr * 64 + fr, fq * 8), boff = lds_byte(wc * 32 + fr, fq * 8);
#define G8_SA(b, h) (((b) * 2 + (h)) * HTB)
#define G8_SB(b, h) ((4 + (b) * 2 + (h)) * HTB)
#define G8_STAGE(bufoff, gbase, voff) do { _Pragma("unroll") for (int _i = 0; _i < 2; ++_i) \
        __builtin_amdgcn_global_load_lds((const unsigned*)((const char*)(gbase) + (voff)[_i]), (LAS unsigned*)(lds + (bufoff) + ldsw + _i * 8192), 16, 0, 0); } while (0)
#define G8_LDA(dst, b, h) do { _Pragma("unroll") for (int m = 0; m < 4; ++m) _Pragma("unroll") for (int k = 0; k < 2; ++k) dst[m][k] = *(const LAS bf16x8*)(lds + G8_SA(b, h) + aoff + m * 2048 + k * 1024); } while (0)
#define G8_LDB(dst, b, h) do { _Pragma("unroll") for (int n = 0; n < 2; ++n) _Pragma("unroll") for (int k = 0; k < 2; ++k) dst[n][k] = *(const LAS bf16x8*)(lds + G8_SB(b, h) + boff + n * 2048 + k * 1024); } while (0)
#define G8_MMA(ai, bj, At, Bt) do { __builtin_amdgcn_s_setprio(1); _Pragma("unroll") for (int m = 0; m < 4; ++m) _Pragma("unroll") for (int n = 0; n < 2; ++n) _Pragma("unroll") for (int k = 0; k < 2; ++k) \
        acc[ai][bj][m][n] = __builtin_amdgcn_mfma_f32_16x16x32_bf16(Bt[n][k], At[m][k], acc[ai][bj][m][n], 0, 0, 0); __builtin_amdgcn_s_setprio(0); } while (0)
#define G8_WAIT_V(n) asm volatile("s_waitcnt vmcnt(" #n ")" ::: "memory")
#define G8_WAIT_L(n) asm volatile("s_waitcnt lgkmcnt(" #n ")" ::: "memory")
#define G8_BAR __builtin_amdgcn_s_barrier()
#define G8_SCHED __builtin_amdgcn_sched_barrier(0)
    GUnit cur, nxt; int ui = 0;
    if (!S.next(0, cur)) return;
    unsigned aoC[2][2], aoN[2][2];
    S.aoff(cur, R, C, aoC);
    if constexpr (Sched::UNIFORM_AOFF) {
#pragma unroll
        for (int h = 0; h < 2; ++h)
#pragma unroll
            for (int i = 0; i < 2; ++i) aoN[h][i] = aoC[h][i]; }
    f32x4 acc[2][2][4][2];
#pragma unroll
    for (int a = 0; a < 2; ++a)
#pragma unroll
        for (int b = 0; b < 2; ++b)
#pragma unroll
            for (int m = 0; m < 4; ++m)
#pragma unroll
                for (int n = 0; n < 2; ++n) acc[a][b][m][n] = (f32x4){0.f, 0.f, 0.f, 0.f};
    bf16x8 At[4][2], B0[2][2], B1[2][2];
    const char* cA = cur.A; const char* cB = cur.B;
    asm volatile("s_waitcnt vmcnt(0)" ::: "memory");
    G8_STAGE(G8_SB(0, 0), cB, voffB); G8_STAGE(G8_SA(0, 0), cA, aoC[0]); G8_STAGE(G8_SB(0, 1), cB + hstepB, voffB); G8_STAGE(G8_SA(0, 1), cA, aoC[1]);
    if (wr == 1) G8_BAR;
    G8_WAIT_V(4); G8_BAR;
    G8_STAGE(G8_SB(1, 0), cB + kstep, voffB); G8_STAGE(G8_SA(1, 0), cA + kstep, aoC[0]); G8_STAGE(G8_SB(1, 1), cB + hstepB + kstep, voffB);
    G8_WAIT_V(6); G8_BAR;
    for (;;) {
        const bool has_next = S.next(ui + 1, nxt);
        if constexpr (!Sched::UNIFORM_AOFF) {
        if (has_next) S.aoff(nxt, R, C, aoN);
        else {
#pragma unroll
            for (int h = 0; h < 2; ++h)
#pragma unroll
                for (int i = 0; i < 2; ++i) aoN[h][i] = aoC[h][i]; } }
        const char* nA = has_next ? nxt.A : cA; const char* nB = has_next ? nxt.B : cB;
        for (int t = 0; t < nt; t += 2) {
            const bool last = (t == nt - 2);
            const char* a1 = cA + (size_t)(t + 1) * kstep;
            const char* a2 = last ? nA : cA + (size_t)(t + 2) * kstep; const char* b2 = last ? nB : cB + (size_t)(t + 2) * kstep;
            const char* a3 = a2 + kstep; const char* b3 = b2 + kstep;
            unsigned ao2[2][2];
#pragma unroll
            for (int h = 0; h < 2; ++h)
#pragma unroll
                for (int i = 0; i < 2; ++i) ao2[h][i] = (!Sched::UNIFORM_AOFF && last) ? aoN[h][i] : aoC[h][i];
            G8_LDB(B0, 0, 0); G8_SCHED; G8_LDA(At, 0, 0); G8_STAGE(G8_SA(1, 1), a1, aoC[1]);
            G8_WAIT_L(8); G8_BAR; G8_WAIT_L(0); G8_MMA(0, 0, At, B0); G8_BAR; G8_SCHED;
            G8_LDB(B1, 0, 1); G8_STAGE(G8_SB(0, 0), b2, voffB);
            G8_BAR; G8_WAIT_L(0); G8_MMA(0, 1, At, B1); G8_BAR;
            G8_LDA(At, 0, 1); G8_STAGE(G8_SA(0, 0), a2, ao2[0]);
            G8_BAR; G8_WAIT_L(0); G8_MMA(1, 0, At, B0); G8_BAR; G8_SCHED;
            G8_STAGE(G8_SB(0, 1), b2 + hstepB, voffB);
            G8_WAIT_V(6); G8_BAR; G8_MMA(1, 1, At, B1); G8_BAR;
            G8_LDB(B0, 1, 0); G8_SCHED; G8_LDA(At, 1, 0); G8_STAGE(G8_SA(0, 1), a2, ao2[1]);
            G8_WAIT_L(8); G8_BAR; G8_WAIT_L(0); G8_MMA(0, 0, At, B0); G8_BAR; G8_SCHED;
            G8_LDB(B1, 1, 1); G8_STAGE(G8_SB(1, 0), b3, voffB);
            G8_BAR; G8_WAIT_L(0); G8_MMA(0, 1, At, B1); G8_BAR;
            G8_LDA(At, 1, 1); G8_STAGE(G8_SA(1, 0), a3, ao2[0]);
            G8_BAR; G8_WAIT_L(0); G8_MMA(1, 0, At, B0); G8_BAR; G8_SCHED;
            G8_STAGE(G8_SB(1, 1), b3 + hstepB, voffB);
            G8_WAIT_V(6); G8_BAR; G8_MMA(1, 1, At, B1); G8_BAR;
        }
        E(acc, cur, wr, wc, fr, fq);
        if (!has_next) break;
#pragma unroll
        for (int a = 0; a < 2; ++a)
#pragma unroll
            for (int b = 0; b < 2; ++b)
#pragma unroll
                for (int m = 0; m < 4; ++m)
#pragma unroll
                    for (int n = 0; n < 2; ++n) acc[a][b][m][n] = (f32x4){0.f, 0.f, 0.f, 0.f};
        cur = nxt; cA = nA; cB = nB; ++ui;
        if constexpr (!Sched::UNIFORM_AOFF) {
#pragma unroll
        for (int h = 0; h < 2; ++h)
#pragma unroll
            for (int i = 0; i < 2; ++i) aoC[h][i] = aoN[h][i]; }
    }
    G8_WAIT_V(0);
    if (wr == 0) G8_BAR;
    G8_BAR;
#undef G8_SA
#undef G8_SB
#undef G8_STAGE
#undef G8_LDA
#undef G8_LDB
#undef G8_MMA
#undef G8_WAIT_V
#undef G8_WAIT_L
#undef G8_BAR
#undef G8_SCHED
}

constexpr int NXCD = 8, WGM = 8;
struct DenseSched {
    static constexpr bool UNIFORM_AOFF = true;
    const char* A; const char* Bt; int K, nM, nN, nwg, G, c;
    DI void init(const void* A_, const void* Bt_, int Mrows, int N, int K_, int G_, int c_) { A = (const char*)A_; Bt = (const char*)Bt_; K = K_; nM = Mrows / 256; nN = N / 256; nwg = nM * nN; G = G_; c = c_; }
    DI bool next(int i, GUnit& u) const {
        const long L = (long)i * G + c; if (L >= nwg) return false;
        int wgid = (int)L; { const int q = nwg / NXCD, r = nwg % NXCD, xcd = wgid % NXCD, off = wgid / NXCD; wgid = (xcd < r ? xcd * (q + 1) : r * (q + 1) + (xcd - r) * q) + off; }
        const int nig = WGM * nN, gid = wgid / nig, fm = gid * WGM, gsz = (nM - fm) < WGM ? (nM - fm) : WGM;
        u.pm = fm + ((wgid % nig) % gsz); u.pn = (wgid % nig) / gsz; u.e = 0; u.row0 = u.pm * 256; u.ord = i;
        u.A = A + (size_t)u.pm * 256 * K * 2; u.B = Bt + (size_t)u.pn * 256 * K * 2; return true;
    }
    DI void aoff(const GUnit&, const int (&R)[2], const int (&C)[2], unsigned (&off)[2][2]) const {
#pragma unroll
        for (int h = 0; h < 2; ++h)
#pragma unroll
            for (int i = 0; i < 2; ++i) off[h][i] = (unsigned)((h * 128 + R[i]) * K + C[i]) * 2u;
    }
};
template <bool GATHER>
struct MoeSched {
    static constexpr bool UNIFORM_AOFF = !GATHER;
    const char* A; const char* W; const int* list; volatile LAS int* misc; int K, G, c;
    DI bool next(int i, GUnit& u) const {
        const int L = i * G + c;
        const int RT = __builtin_amdgcn_readfirstlane(misc[32 + 16]);
        const int x = L & 7, y = L >> 3, rpx = (RT + 7) >> 3, j = y >> 2, rt = x * rpx + j; u.pn = y & 3;
        if (j >= rpx || rt >= RT) return false;
        int e = 0;
#pragma unroll
        for (int j = 1; j < 16; ++j) { const int tp = __builtin_amdgcn_readfirstlane(misc[32 + j]); if (tp <= rt) e = j; }
        const int tp = __builtin_amdgcn_readfirstlane(misc[32 + e]);
        u.e = e; u.pm = rt - tp; u.row0 = __builtin_amdgcn_readfirstlane(misc[64 + e]) + u.pm * 256; u.ord = i;
        u.A = GATHER ? A : A + (size_t)u.row0 * K * 2;
        u.B = W + ((size_t)e * 1024 + (size_t)u.pn * 256) * K * 2;
        return true;
    }
    DI void aoff(const GUnit& u, const int (&R)[2], const int (&C)[2], unsigned (&off)[2][2]) const {
        if (GATHER) {
            const LAS int* tab = (const LAS int*)((const LAS unsigned char*)misc + (LDS_IDX - LDS_MISC)) + (u.ord & (MOE_MAXU - 1)) * 256;
#pragma unroll
            for (int h = 0; h < 2; ++h)
#pragma unroll
                for (int i = 0; i < 2; ++i) { const int tok = tab[h * 128 + R[i]]; off[h][i] = (unsigned)(tok * K + C[i]) * 2u; }
        } else {
#pragma unroll
            for (int h = 0; h < 2; ++h)
#pragma unroll
                for (int i = 0; i < 2; ++i) off[h][i] = (unsigned)((h * 128 + R[i]) * K + C[i]) * 2u;
        }
    }
};

struct EpiStoreBf16 {
    static constexpr bool PERM = true;
    bf16_t* O; int ldc;
    DI void operator()(const f32x4 (&acc)[2][2][4][2], const GUnit& u, int wr, int wc, int fr, int fq) const {
        const int row0 = u.row0 + wr * 64 + fr, col0 = u.pn * 256 + wc * 32 + 8 * fq;
#pragma unroll
        for (int ai = 0; ai < 2; ++ai)
#pragma unroll
            for (int m = 0; m < 4; ++m) { bf16_t* rowp = O + (size_t)(row0 + ai * 128 + m * 16) * ldc + col0;
#pragma unroll
                for (int bj = 0; bj < 2; ++bj) { const f32x4 v0 = acc[ai][bj][m][0], v1 = acc[ai][bj][m][1];
                    u32x4 w; w.x = pk2(v0[0], v0[1]); w.y = pk2(v0[2], v0[3]); w.z = pk2(v1[0], v1[1]); w.w = pk2(v1[2], v1[3]);
                    __builtin_nontemporal_store(w, (u32x4*)(rowp + bj * 128)); } }
    }
};
struct EpiGateUp {
    static constexpr bool PERM = true;
    bf16_t* O;
    DI void operator()(const f32x4 (&acc)[2][2][4][2], const GUnit& u, int wr, int wc, int fr, int fq) const {
        const int row0 = u.row0 + wr * 64 + fr, col0 = u.pn * 128 + wc * 32 + 8 * fq;
#pragma unroll
        for (int ai = 0; ai < 2; ++ai)
#pragma unroll
            for (int m = 0; m < 4; ++m) { bf16_t* rowp = O + (size_t)(row0 + ai * 128 + m * 16) * 512 + col0;
                float hv[8];
#pragma unroll
                for (int n = 0; n < 2; ++n)
#pragma unroll
                    for (int i = 0; i < 4; ++i) hv[n * 4 + i] = silu(acc[ai][0][m][n][i]) * acc[ai][1][m][n][i];
                u32x4 w; w.x = pk2(hv[0], hv[1]); w.y = pk2(hv[2], hv[3]); w.z = pk2(hv[4], hv[5]); w.w = pk2(hv[6], hv[7]);
                *(u32x4*)rowp = w; }
    }
};
struct EpiResidual {
    static constexpr bool PERM = false;
    float* hc; float* hx; const float* modl;
    DI void operator()(const f32x4 (&acc)[2][2][4][2], const GUnit& u, int wr, int wc, int fr, int fq) const {
        const int b = u.pm / 9, tt = u.pm % 9;
        float* base = (tt == 0) ? hc + (size_t)b * CTX * DM : hx + ((size_t)b * SEQ + (size_t)(tt - 1) * 256) * DM;
        const float* gate = modl + (size_t)((tt == 0) ? 16 : b) * 6144 + 2 * DM;
        const int row0 = wr * 64 + fr, col0 = u.pn * 256 + wc * 32 + 4 * fq;
#pragma unroll
        for (int ai = 0; ai < 2; ++ai)
#pragma unroll
            for (int m = 0; m < 4; ++m) { float* rowp = base + (size_t)(row0 + ai * 128 + m * 16) * DM + col0;
#pragma unroll
                for (int bj = 0; bj < 2; ++bj)
#pragma unroll
                    for (int n = 0; n < 2; ++n) { f32x4* p = (f32x4*)(rowp + bj * 128 + n * 16); const f32x4 gv = *(const f32x4*)(gate + col0 + bj * 128 + n * 16); *p = *p + gv * acc[ai][bj][m][n]; }
                asm volatile("" ::: "memory"); }
    }
};

struct Ctx {
    LAS unsigned char* L; volatile LAS int* misc; unsigned char* ws; int tid, lane, wave, G, bid, cheat;
};
DI bf16_t* hrow(const Params& P, int m) { return (bf16_t*)(P.ws + WS_H) + (size_t)m * DM; }

DI void phase_prologue(const Params& P, Ctx& X) {
    float* MOD = (float*)(P.ws + WS_MOD);
    LAS float* tab = (LAS float*)(X.L + X.wave * 8704);
    for (int u = X.bid; u < 4 * 48; u += X.G) {
        const int l = u / 48, jc = u % 48;
        __syncthreads();
        for (int idx = X.lane; idx < 17 * 128; idx += 64) { const int r = idx >> 7, kk = idx & 127; const float* src = (r < 16) ? P.c + r * DM : P.c_ctx; tab[idx] = silu(src[X.wave * 128 + kk]); }
        __syncthreads();
        float a0[17], a1[17];
#pragma unroll
        for (int r = 0; r < 17; ++r) { a0[r] = 0.f; a1[r] = 0.f; }
        const float* wp = P.w_mod + ((size_t)l * DM + X.wave * 128) * 6144 + jc * 128 + 2 * X.lane;
#pragma unroll 4
        for (int kk = 0; kk < 128; ++kk) { const f32x2 w2 = *(const f32x2*)(wp + (size_t)kk * 6144);
#pragma unroll
            for (int r = 0; r < 17; ++r) { const float a = tab[r * 128 + kk]; a0[r] += a * w2.x; a1[r] += a * w2.y; } }
        __syncthreads();
#pragma unroll
        for (int r = 0; r < 17; ++r) { tab[r * 128 + 2 * X.lane] = a0[r]; tab[r * 128 + 2 * X.lane + 1] = a1[r]; }
        __syncthreads();
        for (int idx = X.tid; idx < 17 * 128; idx += NTHR) { const int r = idx >> 7, j = idx & 127; float s = P.b_mod[l * 6144 + jc * 128 + j];
#pragma unroll
            for (int w = 0; w < 8; ++w) s += ((LAS float*)(X.L + w * 8704))[idx];
            MOD[((size_t)l * 17 + r) * 6144 + jc * 128 + j] = s; }
    }
    __syncthreads();
    f32x2* rope = (f32x2*)(P.ws + WS_ROPE);
    for (int e = X.bid * NTHR + X.tid; e < SEQ * 16; e += X.G * NTHR) { const int p = e >> 4, d = e & 15; const int row = p >> 6, col = p & 63;
        const float inv = powf(10000.f, -(float)(d & 7) / 8.f); const float ang = (float)((d < 8) ? row : col) * inv; rope[e] = (f32x2){cosf(ang), sinf(ang)}; }
    u32x4* wz = (u32x4*)((bf16_t*)(P.ws + WS_WIN) + (size_t)2496 * DM);
    for (int e = X.bid * NTHR + X.tid; e < 64 * DM * 2 / 16; e += X.G * NTHR) wz[e] = (u32x4){0u, 0u, 0u, 0u};
}

DI void cvt_item(const float* W, int ldw, int N, int k0, int n0, bf16_t* WT, int K, int row0, const float* kscale, float mul, LAS float* scr, int lane) {
    const int cq = 4 * (lane & 7), kr = lane >> 3;
#pragma unroll
    for (int i = 0; i < 8; ++i) { const int kk = 8 * i + kr, n = n0 + cq;
        f32x4 v = (n < N) ? *(const f32x4*)(W + (size_t)(k0 + kk) * ldw + n) : (f32x4){0.f, 0.f, 0.f, 0.f};
        const float sc = (kscale ? kscale[k0 + kk] : 1.f) * mul;
        scr[kk * 33 + cq] = v[0] * sc; scr[kk * 33 + cq + 1] = v[1] * sc; scr[kk * 33 + cq + 2] = v[2] * sc; scr[kk * 33 + cq + 3] = v[3] * sc; }
    LDS_WAIT(); asm volatile("" ::: "memory");
    const int c = lane & 7;
#pragma unroll
    for (int j = 0; j < 4; ++j) { const int nn = (lane >> 3) + 8 * j; const LAS float* s = scr + (8 * c) * 33 + nn;
        u32x4 o; o.x = pk2(s[0 * 33], s[1 * 33]); o.y = pk2(s[2 * 33], s[3 * 33]); o.z = pk2(s[4 * 33], s[5 * 33]); o.w = pk2(s[6 * 33], s[7 * 33]);
        *(u32x4*)(WT + (size_t)(row0 + nn) * K + k0 + 8 * c) = o; }
    LDS_WAIT(); asm volatile("" ::: "memory");
}
DI void convert_weights(const Params& P, Ctx& X, int l) {
    LAS float* scr = (LAS float*)(X.L + X.wave * 8704);
    const int gw = X.bid * NWAVE + X.wave, NGW = X.G * NWAVE;
    constexpr int I_IN = 16 * 78, I_OUT = 16 * 32, I_UQ = 4 * 12, I_UKV = 2 * 16, I_E = 768, NIT = I_IN + I_OUT + I_UQ + I_UKV + 16 * I_E;
    for (int it = gw; it < NIT; it += NGW) {
        int r = it;
        if (r < I_IN) { cvt_item(P.w_in + (size_t)l * DM * INW, INW, INW, 64 * (r / 78), 32 * (r % 78), (bf16_t*)(P.ws + WS_WIN), DM, 32 * (r % 78), nullptr, 1.f, scr, X.lane); continue; } r -= I_IN;
        if (r < I_OUT) { cvt_item(P.w_out + (size_t)l * DM * DM, DM, DM, 64 * (r / 32), 32 * (r % 32), (bf16_t*)(P.ws + WS_WOUT), DM, 32 * (r % 32), nullptr, 1.f, scr, X.lane); continue; } r -= I_OUT;
        if (r < I_UQ) { cvt_item(P.w_uq + (size_t)l * 256 * 384, 384, 384, 64 * (r / 12), 32 * (r % 12), (bf16_t*)(P.ws + WS_WUQ), 256, 32 * (r % 12), P.mq_g + l * 256, MLA_QS, scr, X.lane); continue; } r -= I_UQ;
        if (r < I_UKV) { cvt_item(P.w_ukv + (size_t)l * 128 * 512, 512, 512, 64 * (r / 16), 32 * (r % 16), (bf16_t*)(P.ws + WS_WUKV), 128, 32 * (r % 16), P.mkv_g + l * 128, 1.f, scr, X.lane); continue; } r -= I_UKV;
        const int e = r / I_E; r -= e * I_E;
        if (r < 256) { const int kb = r / 16, nb = r % 16;
            cvt_item(P.wg + ((size_t)l * 16 + e) * DM * 512, 512, 512, 64 * kb, 32 * nb, (bf16_t*)(P.ws + WS_WGU) + (size_t)e * 1024 * DM, DM, 256 * (nb >> 2) + 32 * (nb & 3), nullptr, 1.f, scr, X.lane); continue; } r -= 256;
        if (r < 256) { const int kb = r / 16, nb = r % 16;
            cvt_item(P.wu + ((size_t)l * 16 + e) * DM * 512, 512, 512, 64 * kb, 32 * nb, (bf16_t*)(P.ws + WS_WGU) + (size_t)e * 1024 * DM, DM, 256 * (nb >> 2) + 128 + 32 * (nb & 3), nullptr, 1.f, scr, X.lane); continue; } r -= 256;
        { const int kb = r / 32, nb = r % 32;
            cvt_item(P.wd + ((size_t)l * 16 + e) * 512 * DM, DM, DM, 64 * kb, 32 * nb, (bf16_t*)(P.ws + WS_WD) + (size_t)e * 1024 * 512, 512, 32 * nb, nullptr, 1.f, scr, X.lane); }
    }
}

DI int slot_base_lane(const unsigned* cnt, int lane) {
    int c = (lane < 16) ? (int)cnt[lane] : 0;
    int tiles = (c + 255) >> 8;
    int incl = tiles;
#pragma unroll
    for (int o = 1; o < 16; o <<= 1) { const int v = shupi(incl, o, lane); if (lane >= o) incl += v; }
    return (incl - tiles) * 256;
}

constexpr int RPC = 18;
struct RowIn { u32x4 a[4]; u32x2 y1[4]; float w0, w1; };
DI void row_issue(const Params& P, RowIn& R, int l, int m, int sbase, const u32x4 ti, int lane) {
    const int b = m / T, t = m - b * T;
    if (l == 0) {
        const float* src = (t < CTX) ? P.ctx + ((size_t)b * CTX + t) * DM : P.x + ((size_t)b * SEQ + (t - CTX)) * DM;
#pragma unroll
        for (int j = 0; j < 4; ++j) R.a[j] = *(const u32x4*)(src + 256 * j + 4 * lane);
        R.w0 = 0.f; R.w1 = 0.f;
    } else {
        const bf16_t* hp = hrow(P, m);
        const bf16_t* YS = (const bf16_t*)(P.ws + WS_YS);
        const int s0 = __builtin_amdgcn_readlane(sbase, __builtin_amdgcn_readfirstlane((int)(ti.x & 15u))) + (int)(ti.x >> 4), s1 = __builtin_amdgcn_readlane(sbase, __builtin_amdgcn_readfirstlane((int)(ti.y & 15u))) + (int)(ti.y >> 4);
        const bf16_t* y0 = YS + (size_t)s0 * DM; const bf16_t* y1 = YS + (size_t)s1 * DM;
#pragma unroll
        for (int j = 0; j < 4; ++j) { const int cidx = 256 * j + 4 * lane; const u32x2 hv = __builtin_nontemporal_load((const u32x2*)(hp + cidx)), yv = __builtin_nontemporal_load((const u32x2*)(y0 + cidx)); R.a[j] = (u32x4){hv.x, hv.y, yv.x, yv.y}; R.y1[j] = __builtin_nontemporal_load((const u32x2*)(y1 + cidx)); }
        R.w0 = __uint_as_float(ti.z); R.w1 = __uint_as_float(ti.w);
    }
}
DI float row_combine(const RowIn& R, bool comb, const f32x4 (&gp)[4], f32x4 (&v)[4]) {
    float ss = 0.f;
#pragma unroll
    for (int j = 0; j < 4; ++j) {
        if (comb) { const u32x2 a = {R.a[j].z, R.a[j].w}, bb = R.y1[j];
            f32x4 yv; yv[0] = R.w0 * bflo(a.x) + R.w1 * bflo(bb.x); yv[1] = R.w0 * bfhi(a.x) + R.w1 * bfhi(bb.x); yv[2] = R.w0 * bflo(a.y) + R.w1 * bflo(bb.y); yv[3] = R.w0 * bfhi(a.y) + R.w1 * bfhi(bb.y);
            const f32x4 hv = {bflo(R.a[j].x), bfhi(R.a[j].x), bflo(R.a[j].y), bfhi(R.a[j].y)};
            v[j] = hv + gp[j] * yv; }
        else v[j] = (f32x4){__uint_as_float(R.a[j].x), __uint_as_float(R.a[j].y), __uint_as_float(R.a[j].z), __uint_as_float(R.a[j].w)};
        ss += v[j][0] * v[j][0] + v[j][1] * v[j][1] + v[j][2] * v[j][2] + v[j][3] * v[j][3]; }
    return ss;
}
DI void phase_norm1(const Params& P, Ctx& X, int l) {
    convert_weights(P, X, l);
    const float* MOD = (const float*)(P.ws + WS_MOD);
    bf16_t* ACT = (bf16_t*)(P.ws + WS_ACT);
    const u32x4* TOK = (const u32x4*)(P.ws + WS_TOK);
    const unsigned* cnt = (const unsigned*)(P.ws + WS_CTL) + CW_CNT + (l > 0 ? (l - 1) * 16 : 0);
    const int sbase = (l > 0) ? slot_base_lane(cnt, X.lane) : 0;
    const int gw = X.bid * NWAVE + X.wave, NGW = X.G * NWAVE, lane = X.lane;
    const float* g = P.g_mix + l * DM;
    const u32x4 tz = {0u, 0u, 0u, 0u};
    for (int ck = gw; ck < M / RPC; ck += NGW) {
        const int m0 = ck * RPC, b = m0 / T, t0 = m0 - b * T;
        int cur_cls = -1; f32x4 gs[4], sh[4], gp[4];
        RowIn cur[2], nxt[2];
        row_issue(P, cur[0], l, m0, sbase, (l > 0) ? TOK[m0] : tz, lane); row_issue(P, cur[1], l, m0 + 1, sbase, (l > 0) ? TOK[m0 + 1] : tz, lane);
        u32x4 tiN0 = (l > 0) ? TOK[m0 + 2] : tz, tiN1 = (l > 0) ? TOK[m0 + 3] : tz;
        for (int r = 0; r < RPC; r += 2) {
            if (r + 2 < RPC) { row_issue(P, nxt[0], l, m0 + r + 2, sbase, tiN0, lane); row_issue(P, nxt[1], l, m0 + r + 3, sbase, tiN1, lane); }
            if (l > 0 && r + 4 < RPC) { tiN0 = TOK[m0 + r + 4]; tiN1 = TOK[m0 + r + 5]; }
#pragma unroll
            for (int k = 0; k < 2; ++k) {
                const int m = m0 + r + k, t = t0 + r + k, cls = (t < CTX) ? 1 : 0;
                if (cls != cur_cls) { cur_cls = cls;
                    const float* mrow = MOD + ((size_t)l * 17 + (cls ? 16 : b)) * 6144;
                    const float* gprev = MOD + ((size_t)(l > 0 ? l - 1 : 0) * 17 + (cls ? 16 : b)) * 6144 + 5 * DM;
#pragma unroll
                    for (int j = 0; j < 4; ++j) { const int cidx = 256 * j + 4 * lane;
                        gs[j] = *(const f32x4*)(g + cidx) * (*(const f32x4*)(mrow + DM + cidx) + 1.f); sh[j] = *(const f32x4*)(mrow + cidx); gp[j] = *(const f32x4*)(gprev + cidx); } }
                f32x4 v[4];
                const float ss = row_combine(cur[k], l > 0, gp, v);
                bf16_t* hp = hrow(P, m);
#pragma unroll
                for (int j = 0; j < 4; ++j) { u32x2 o; o.x = pk2(v[j][0], v[j][1]); o.y = pk2(v[j][2], v[j][3]); __builtin_nontemporal_store(o, (u32x2*)(hp + 256 * j + 4 * lane)); }
                const float rstd = rsqrtf(wave_sum(ss, lane) * (1.f / DM) + EPS);
#pragma unroll
                for (int j = 0; j < 4; ++j) { const f32x4 uu = v[j] * rstd * gs[j] + sh[j];
                    u32x2 o; o.x = pk2(uu[0], uu[1]); o.y = pk2(uu[2], uu[3]);
                    *(u32x2*)(ACT + (size_t)m * DM + 256 * j + 4 * lane) = o; }
            }
            cur[0] = nxt[0]; cur[1] = nxt[1];
        }
    }
}
DI void phase_final(const Params& P, Ctx& X, float eps = 0.f) {
    constexpr int RPF = 16;
    const float* MOD = (const float*)(P.ws + WS_MOD);
    const u32x4* TOK = (const u32x4*)(P.ws + WS_TOK);
    const unsigned* cnt = (const unsigned*)(P.ws + WS_CTL) + CW_CNT + 3 * 16;
    const int sbase = slot_base_lane(cnt, X.lane);
    const int gw = X.bid * NWAVE + X.wave, NGW = X.G * NWAVE, lane = X.lane;
    f32x4 fg[4];
#pragma unroll
    for (int j = 0; j < 4; ++j) fg[j] = *(const f32x4*)(P.fin_g + 256 * j + 4 * lane);
    for (int ck = gw; ck < NB * SEQ / RPF; ck += NGW) {
        const int r0 = ck * RPF, b = r0 / SEQ, m0 = b * T + CTX + (r0 - b * SEQ);
        f32x4 gp[4];
#pragma unroll
        for (int j = 0; j < 4; ++j) gp[j] = *(const f32x4*)(MOD + ((size_t)3 * 17 + b) * 6144 + 5 * DM + 256 * j + 4 * lane);
        RowIn cur[2], nxt[2];
        row_issue(P, cur[0], 3, m0, sbase, TOK[m0], lane); row_issue(P, cur[1], 3, m0 + 1, sbase, TOK[m0 + 1], lane);
        u32x4 tiN0 = TOK[m0 + 2], tiN1 = TOK[m0 + 3];
        for (int r = 0; r < RPF; r += 2) {
            if (r + 2 < RPF) { row_issue(P, nxt[0], 3, m0 + r + 2, sbase, tiN0, lane); row_issue(P, nxt[1], 3, m0 + r + 3, sbase, tiN1, lane); }
            if (r + 4 < RPF) { tiN0 = TOK[m0 + r + 4]; tiN1 = TOK[m0 + r + 5]; }
#pragma unroll
            for (int k = 0; k < 2; ++k) {
                f32x4 v[4];
                const float ss = row_combine(cur[k], true, gp, v);
                const float rstd = rsqrtf(wave_sum(ss, lane) * (1.f / DM) + EPS);
                float* hp = P.out + (size_t)(r0 + r + k) * DM;
#pragma unroll
                for (int j = 0; j < 4; ++j) *(f32x4*)(hp + 256 * j + 4 * lane) = v[j] * (rstd * (1.f + eps)) * fg[j];
            }
            cur[0] = nxt[0]; cur[1] = nxt[1];
        }
    }
}

DI void phase_postproj(const Params& P, Ctx& X, int l, int sel = 15) {
    bf16_t* PROJ = (bf16_t*)(P.ws + WS_PROJ);
    const f32x2* rope = (const f32x2*)(P.ws + WS_ROPE);
    bf16_t* XBC = (bf16_t*)(P.ws + WS_XBC); float* DT = (float*)(P.ws + WS_DT);
    bf16_t* MLAQ = (bf16_t*)(P.ws + WS_MLAQ); bf16_t* MLAK = (bf16_t*)(P.ws + WS_MLAK);
    bf16_t* VTM = (bf16_t*)(P.ws + WS_VTM); bf16_t* VTD = (bf16_t*)(P.ws + WS_VTD);
    const bf16_t* WUQ = (const bf16_t*)(P.ws + WS_WUQ); const bf16_t* WUKV = (const bf16_t*)(P.ws + WS_WUKV);
    const int lane = X.lane, wave = X.wave;
    for (int u = X.bid; u < M / 144; u += X.G) {
        const int m0 = u * 144, b = m0 / T, t0 = m0 - b * T;
        __syncthreads();
        float cw[3][12], cb[12];
        int lane_u = lane; asm volatile("" : "+v"(lane_u));
#pragma unroll
        for (int g3 = 0; g3 < 3; ++g3)
#pragma unroll
            for (int i = 0; i < 4; ++i) { const int ch = 256 * g3 + 4 * lane_u + i; cb[g3 * 4 + i] = P.conv_b[l * 768 + ch];
#pragma unroll
                for (int k = 0; k < 3; ++k) cw[k][g3 * 4 + i] = P.conv_w[((size_t)l * 3 + k) * 768 + ch]; }
        const int tw0 = t0 + wave * 18;
        const int vv = lane >> 2, d0 = 4 * (lane & 3);
        const float qs = (vv < 8) ? DA_QS : 1.f;
        struct RowRegs { u32x2 qa, qb, v, cq; unsigned ckv; unsigned short dtr, k1, k2; };
        struct RopeRegs { f32x4 rp0, rp1; f32x2 kcs; };
        const float dtb = P.dt_bias[l * 16 + (lane & 15)];
        LAS float* rs_q = (LAS float*)(X.L + 114688); LAS float* rs_kv = rs_q + 144;
        auto ld_row = [&](int t, RowRegs& R) { const bf16_t* prow = PROJ + ((size_t)b * T + t) * PW;
            R.qa = *(const u32x2*)(prow + vv * 32 + d0); R.qb = *(const u32x2*)(prow + vv * 32 + d0 + 16); R.v = __builtin_nontemporal_load((const u32x2*)(prow + C_DAV + 4 * lane));
            R.dtr = prow[C_DT + (lane & 15)]; R.k1 = prow[C_KR + (lane & 15)]; R.k2 = prow[C_KR + 16 + (lane & 15)];
            R.cq = *(const u32x2*)(prow + C_CQ + 4 * lane); R.ckv = *(const unsigned*)(prow + C_CKV + 2 * lane);
            };
        auto ld_rope = [&](int t, RopeRegs& R) { const f32x2* rp = rope + (size_t)((t >= CTX && t < T) ? t - CTX : 0) * 16;
            R.rp0 = *(const f32x4*)(rp + d0); R.rp1 = *(const f32x4*)(rp + d0 + 2); R.kcs = rp[lane & 15]; };
        auto ld_x = [&](int t, u32x2 (&xx)[3]) { const bool ok = (t >= 0 && t < T);
            const bf16_t* prow = PROJ + ((size_t)b * T + (ok ? t : 0)) * PW + C_XBC + 4 * lane;
#pragma unroll
            for (int g3 = 0; g3 < 3; ++g3) xx[g3] = __builtin_nontemporal_load((const u32x2*)(prow + 256 * g3)); };
        RowRegs rc, rn; u32x2 xm[3], x0[3], xp[3], xq[3], xr2[3];
        RopeRegs qc, qn; ld_rope(tw0, qc);
        ld_row(tw0, rc); ld_x(tw0 - 1, xm); ld_x(tw0, x0); ld_x(tw0 + 1, xp); ld_x(tw0 + 2, xq);
#pragma unroll 1
        for (int rr = 0; rr < ((sel & 1) ? 18 : 0); ++rr) {
            const int t = tw0 + rr; const size_t m = (size_t)b * T + t;
            if (rr + 1 < 18) ld_row(t + 1, rn);
            ld_x(t + 3, xr2);
            ld_rope(t + 1, qn);
            bf16_t* prow = PROJ + m * PW;
            { const u32x2 a = rc.qa, bq = rc.qb;
              float x1[4] = {bflo(a.x), bfhi(a.x), bflo(a.y), bfhi(a.y)}, x2[4] = {bflo(bq.x), bfhi(bq.x), bflo(bq.y), bfhi(bq.y)};
              float o1[4], o2[4];
              if (t >= CTX) { const float cc[4] = {qc.rp0[0], qc.rp0[2], qc.rp1[0], qc.rp1[2]}, sn[4] = {qc.rp0[1], qc.rp0[3], qc.rp1[1], qc.rp1[3]};
#pragma unroll
                  for (int i = 0; i < 4; ++i) { o1[i] = (x1[i] * cc[i] - x2[i] * sn[i]) * qs; o2[i] = (x2[i] * cc[i] + x1[i] * sn[i]) * qs; } }
              else {
#pragma unroll
                  for (int i = 0; i < 4; ++i) { o1[i] = x1[i] * qs; o2[i] = x2[i] * qs; } }
              u32x2 w1, w2; w1.x = pk2(o1[0], o1[1]); w1.y = pk2(o1[2], o1[3]); w2.x = pk2(o2[0], o2[1]); w2.y = pk2(o2[2], o2[3]);
              bf16_t* p1 = prow + vv * 32 + d0;
              *(u32x2*)p1 = w1; *(u32x2*)(p1 + 16) = w2; }
            *(LAS u32x2*)(X.L + (size_t)(wave * 18 + rr) * 520 + lane * 8) = rc.v;
            { const float c0 = bflo(rc.cq.x), c1 = bfhi(rc.cq.x), c2 = bflo(rc.cq.y), c3 = bfhi(rc.cq.y), k0 = bflo(rc.ckv), k1 = bfhi(rc.ckv);
              const float sq = wave_sum(c0 * c0 + c1 * c1 + c2 * c2 + c3 * c3, lane), sk = wave_sum(k0 * k0 + k1 * k1, lane);
              if (lane == 0) { rs_q[wave * 18 + rr] = rsqrtf(sq * (1.f / 256.f) + EPS); rs_kv[wave * 18 + rr] = rsqrtf(sk * (1.f / 128.f) + EPS); } }
            { const int lo = (t < CTX) ? 0 : CTX, hi = (t < CTX) ? CTX : T;
              const bool hm = (t - 1 >= lo), hp = (t + 1 < hi);
#pragma unroll
              for (int g3 = 0; g3 < 3; ++g3) { const int ch = 256 * g3 + 4 * lane;
                  const u32x2 c0 = x0[g3]; u32x2 cm = xm[g3], cp = xp[g3];
                  if (!hm) cm = (u32x2){0u, 0u};
                  if (!hp) cp = (u32x2){0u, 0u};
                  const float xmv[4] = {bflo(cm.x), bfhi(cm.x), bflo(cm.y), bfhi(cm.y)}, x0v[4] = {bflo(c0.x), bfhi(c0.x), bflo(c0.y), bfhi(c0.y)}, xpv[4] = {bflo(cp.x), bfhi(cp.x), bflo(cp.y), bfhi(cp.y)};
                  float o[4];
#pragma unroll
                  for (int i = 0; i < 4; ++i) o[i] = silu(cb[g3 * 4 + i] + cw[0][g3 * 4 + i] * xmv[i] + cw[1][g3 * 4 + i] * x0v[i] + cw[2][g3 * 4 + i] * xpv[i]);
                  u32x2 w; w.x = pk2(o[0], o[1]); w.y = pk2(o[2], o[3]);
                  *(u32x2*)(XBC + m * 768 + ch) = w; } }
            if (lane < 16) { const float v = __uint_as_float(((unsigned)rc.dtr) << 16) + dtb; ((LAS float*)(X.L + 116736))[(wave * 18 + rr) * 16 + lane] = (v > 20.f) ? v : __logf(1.f + __expf(v)); }
            if (lane < 16) { const float x1 = __uint_as_float(((unsigned)rc.k1) << 16), x2 = __uint_as_float(((unsigned)rc.k2) << 16);
                float o1 = x1, o2 = x2;
                if (t >= CTX) { const f32x2 cs = qc.kcs; o1 = x1 * cs.x - x2 * cs.y; o2 = x2 * cs.x + x1 * cs.y; }
                const bf16_t b1 = (bf16_t)(pk2(o1, 0.f) & 0xffffu), b2 = (bf16_t)(pk2(o2, 0.f) & 0xffffu);
#pragma unroll
                for (int h = 0; h < 4; ++h) { MLAK[(m * 4 + h) * 96 + 64 + lane] = b1; MLAK[(m * 4 + h) * 96 + 80 + lane] = b2; } }
            rc = rn; qc = qn;
#pragma unroll
            for (int g3 = 0; g3 < 3; ++g3) { xm[g3] = x0[g3]; x0[g3] = xp[g3]; xp[g3] = xq[g3]; xq[g3] = xr2[g3]; }
        }
        __syncthreads();
        constexpr int AROW = 784;
        if (sel & 1) for (int idx = X.tid; idx < 16 * 36; idx += NTHR) { const int j = idx / 36, q = idx - 36 * j; const LAS float* dl = (const LAS float*)(X.L + 116736) + (4 * q) * 16 + j;
            *(f32x4*)(DT + ((size_t)b * 16 + j) * T + t0 + 4 * q) = (f32x4){dl[0], dl[16], dl[32], dl[48]}; }
        if (sel & 2) { const int vr = X.tid >> 1, th = X.tid & 1;
          bf16_t* dst = VTD + ((size_t)b * 256 + vr) * T + t0 + th * 72;
#pragma unroll 1
          for (int q8 = 0; q8 < 9; ++q8) { unsigned w[4];
#pragma unroll
              for (int i = 0; i < 4; ++i) { const int tt = th * 72 + q8 * 8 + 2 * i;
                  const unsigned lo = *(const LAS unsigned short*)(X.L + (size_t)tt * 520 + vr * 2), hi = *(const LAS unsigned short*)(X.L + (size_t)(tt + 1) * 520 + vr * 2);
                  w[i] = lo | (hi << 16); }
              *(u32x4*)(dst + q8 * 8) = (u32x4){w[0], w[1], w[2], w[3]}; } }
        u32x4 aq[9], ak[5];
        { int tid_u = X.tid; asm volatile("" : "+v"(tid_u));
          const bf16_t* gq = PROJ + ((size_t)b * T + t0 + (tid_u >> 5)) * PW + C_CQ + (tid_u & 31) * 8;
          const bf16_t* gk = PROJ + ((size_t)b * T + t0 + (tid_u >> 4)) * PW + C_CKV + (tid_u & 15) * 8;
          if (sel & 12) {
#pragma unroll
              for (int j = 0; j < 9; ++j) aq[j] = __builtin_nontemporal_load((const u32x4*)(gq + (size_t)j * 16 * PW));
#pragma unroll
              for (int j = 0; j < 5; ++j) if (32 * j + (tid_u >> 4) < 144) ak[j] = __builtin_nontemporal_load((const u32x4*)(gk + (size_t)j * 32 * PW)); }
          __syncthreads();
          if (sel & 12) {
              LAS unsigned char* lq = X.L + (tid_u >> 5) * AROW + (tid_u & 31) * 16; LAS unsigned char* lk = X.L + (tid_u >> 4) * AROW + 512 + (tid_u & 15) * 16;
#pragma unroll
              for (int j = 0; j < 9; ++j) *(LAS u32x4*)(lq + j * 16 * AROW) = aq[j];
#pragma unroll
              for (int j = 0; j < 5; ++j) if (32 * j + (tid_u >> 4) < 144) *(LAS u32x4*)(lk + j * 32 * AROW) = ak[j]; }
          __syncthreads(); }
        if (sel & 4) { int lane_c = lane; asm volatile("" : "+v"(lane_c)); const int tk = lane_c & 15, q4 = lane_c >> 4;
#pragma unroll
          for (int pass = 0; pass < 2; ++pass) {
              constexpr int NCT_MAX = 2; const int nct = pass ? 2 : 1, ct0 = pass ? 1 : 0;
              bf16x8 bw[NCT_MAX][8];
#pragma unroll
              for (int ct = 0; ct < NCT_MAX; ++ct)
#pragma unroll
                  for (int s = 0; s < 8; ++s) if (ct < nct) bw[ct][s] = *(const bf16x8*)(WUQ + (size_t)((3 * wave + ct0 + ct) * 16 + tk) * 256 + 32 * s + 8 * q4);
#pragma unroll 1
              for (int rt = 0; rt < 9; ++rt) {
                  const int t = t0 + rt * 16 + tk; const size_t m = (size_t)b * T + t;
                  f32x4 ra = {0.f, 0.f, 0.f, 0.f}, rb = {0.f, 0.f, 0.f, 0.f};
                  if (pass) { const f32x2* rp = rope + (size_t)((t >= CTX) ? t - CTX : 0) * 16 + 4 * q4; ra = *(const f32x4*)rp; rb = *(const f32x4*)(rp + 2); }
                  bf16x8 af[8];
#pragma unroll
                  for (int s = 0; s < 8; ++s) af[s] = *(const LAS bf16x8*)(X.L + (rt * 16 + tk) * AROW + (32 * s + 8 * q4) * 2);
                  const float rstd = ((LAS float*)(X.L + 114688))[rt * 16 + tk];
                  f32x4 acc[NCT_MAX];
#pragma unroll
                  for (int ct = 0; ct < NCT_MAX; ++ct) if (ct < nct) { acc[ct] = (f32x4){0.f, 0.f, 0.f, 0.f};
#pragma unroll
                      for (int s = 0; s < 8; ++s) acc[ct] = MFMA16(bw[ct][s], af[s], acc[ct]);
                      acc[ct] = acc[ct] * rstd; }
                  if (pass && (wave & 1) && t >= CTX) {
                      const float cc[4] = {ra[0], ra[2], rb[0], rb[2]}, sn[4] = {ra[1], ra[3], rb[1], rb[3]};
#pragma unroll
                      for (int i = 0; i < 4; ++i) { const float x1 = acc[0][i], x2 = acc[1][i]; acc[0][i] = x1 * cc[i] - x2 * sn[i]; acc[1][i] = x2 * cc[i] + x1 * sn[i]; } }
#pragma unroll
                  for (int ct = 0; ct < NCT_MAX; ++ct) if (ct < nct) { u32x2 w; w.x = pk2(acc[ct][0], acc[ct][1]); w.y = pk2(acc[ct][2], acc[ct][3]);
                      *(u32x2*)(MLAQ + m * 384 + (3 * wave + ct0 + ct) * 16 + 4 * q4) = w; }
              }
          }
        }
        if (sel & 8) { const int tk = lane & 15, q4 = lane >> 4, hh = wave >> 1;
          bf16x8 bw[4][4];
#pragma unroll
          for (int ct = 0; ct < 4; ++ct)
#pragma unroll
              for (int s = 0; s < 4; ++s) bw[ct][s] = *(const bf16x8*)(WUKV + (size_t)((4 * wave + ct) * 16 + tk) * 128 + 32 * s + 8 * q4);
#pragma unroll 1
          for (int rt = 0; rt < 9; ++rt) {
              const int t = t0 + rt * 16 + tk; const size_t m = (size_t)b * T + t;
              bf16x8 af[4];
#pragma unroll
              for (int s = 0; s < 4; ++s) af[s] = *(const LAS bf16x8*)(X.L + (rt * 16 + tk) * AROW + 512 + (32 * s + 8 * q4) * 2);
              const LAS float* rs_kv = (const LAS float*)(X.L + 114688) + 144;
              const float rstd = rs_kv[rt * 16 + tk];
              if ((wave & 1) == 0) {
#pragma unroll
                  for (int ct = 0; ct < 4; ++ct) { f32x4 acc = {0.f, 0.f, 0.f, 0.f};
#pragma unroll
                      for (int s = 0; s < 4; ++s) acc = MFMA16(bw[ct][s], af[s], acc);
                      acc = acc * rstd;
                      u32x2 w; w.x = pk2(acc[0], acc[1]); w.y = pk2(acc[2], acc[3]);
                      *(u32x2*)(MLAK + (m * 4 + hh) * 96 + ct * 16 + 4 * q4) = w; }
              } else {
                  const f32x4 rs = *(const LAS f32x4*)(rs_kv + rt * 16 + 4 * q4);
#pragma unroll
                  for (int ct = 0; ct < 4; ++ct) { f32x4 acc = {0.f, 0.f, 0.f, 0.f};
#pragma unroll
                      for (int s = 0; s < 4; ++s) acc = MFMA16(af[s], bw[ct][s], acc);
                      u32x2 w; w.x = pk2(acc[0] * rs[0], acc[1] * rs[1]); w.y = pk2(acc[2] * rs[2], acc[3] * rs[3]);
                      *(u32x2*)(VTM + (((size_t)b * 4 + hh) * 64 + ct * 16 + tk) * T + t0 + rt * 16 + 4 * q4) = w; }
              }
          }
        }
    }
}

constexpr int SSD_BASE = 0;
struct SsdState { f32x4 Sacc[2]; int u, c; float a; };
struct SsdPre { u32x4 xr[2], br[2], cr[2]; f32x2 dtv; };
DI void ssd_tok(int dir, int c, int& tbase, int& tstep) { const int seg0 = (c < 2) ? 0 : CTX, seg1 = (c < 2) ? CTX : T, cc = (c < 2) ? c : c - 2;
    tbase = dir ? (seg1 - 1 - 128 * cc) : (seg0 + 128 * cc); tstep = dir ? -1 : 1; }
DI void ssd_issue(const Params& P, Ctx& X, SsdPre& S, int u, int c) {
    if (c >= 18) { u += X.G; c -= 18; }
    if (u >= NB * 8 * 2) return;
    const int b = u >> 4, hd = (u >> 1) & 7, dir = u & 1, grp = hd >> 2;
    const bf16_t* XBC = (const bf16_t*)(P.ws + WS_XBC); const float* DTT = (const float*)(P.ws + WS_DT) + ((size_t)b * 16 + dir * 8 + hd) * T;
    const size_t rb = (size_t)b * T; const int tid = X.tid, lane = X.lane, tau = tid >> 2, q2 = tid & 3;
    int tbase, tstep; ssd_tok(dir, c, tbase, tstep);
    const bf16_t* rowp = XBC + (rb + tbase + tstep * tau) * 768;
#pragma unroll
    for (int k = 0; k < 2; ++k) { const int pc = 2 * q2 + k; S.xr[k] = *(const u32x4*)(rowp + hd * 64 + 8 * pc); S.br[k] = *(const u32x4*)(rowp + 512 + grp * 64 + 8 * pc); S.cr[k] = *(const u32x4*)(rowp + 640 + grp * 64 + 8 * pc); }
    S.dtv = *(const f32x2*)(dir ? DTT + tbase - 2 * lane - 1 : DTT + tbase + 2 * lane);
}
DI bool ssd_pending(const SsdState& S) { return S.u < NB * 8 * 2; }
DI s16x4 tr16(const LAS unsigned char* p) { return __builtin_bit_cast(s16x4, __builtin_amdgcn_ds_read_tr16_b64_v4i16((LAS v4i16_t*)p)); }
template <int CHEAT = 0>
DI void ssd_step(const Params& P, Ctx& X, SsdState& ST, SsdPre& S, int l) {
    constexpr int OFF_XR = SSD_BASE + 0, OFF_XS = SSD_BASE + 18432, OFF_BR = SSD_BASE + 36864, OFF_CR = SSD_BASE + 55296, OFF_SB = SSD_BASE + 73728, OFF_AC = SSD_BASE + 82944, OFF_DTT = SSD_BASE + 83456;
    const int u = ST.u, c = ST.c, b = u >> 4, hd = (u >> 1) & 7, dir = u & 1;
    bf16_t* Y = (bf16_t*)(P.ws + (dir ? WS_YB : WS_YF));
    const int tid = X.tid, lane = X.lane, wave = X.wave, r = lane & 31, hh = lane >> 5;
    if (c == 0) ST.a = -__expf(P.a_log[l * 16 + dir * 8 + hd]);
    const float a = ST.a;
    LAS unsigned char* L = X.L;
    LAS float* t_ac = (LAS float*)(L + OFF_AC); LAS float* t_dt = (LAS float*)(L + OFF_DTT);
    const size_t rb = (size_t)b * T;
    const int tau = tid >> 2, q2 = tid & 3;
    f32x4 (&Sacc)[2] = ST.Sacc; const float dt0 = dir ? S.dtv.y : S.dtv.x, dt1 = dir ? S.dtv.x : S.dtv.y;
    int tbase, tstep; ssd_tok(dir, c, tbase, tstep);
    const float v0 = dt0 * a, v1 = dt1 * a, s2 = v0 + v1; float incl = s2;
    incl = wave_scan(incl);
    const float ac0 = incl - s2 + v0, ac1 = incl;
    const float alast = rdlane(incl, 63);
    if (wave == 0) { *(LAS f32x2*)(t_ac + 2 * lane) = (f32x2){ac0, ac1}; *(LAS f32x2*)(t_dt + 2 * lane) = (f32x2){dt0, dt1}; }
    {
        const int src = tau >> 1;
        const float a_e = shl(ac0, src), a_o = shl(ac1, src), d_e = shl(dt0, src), d_o = shl(dt1, src);
        const float a_t = (tau & 1) ? a_o : a_e, d_t = (tau & 1) ? d_o : d_e;
        const float e_blk = rdlane(ac1, 16 * (wave >> 1) + 15);
        const float wj = __expf(e_blk - a_t) * d_t;
#pragma unroll
        for (int k = 0; k < 2; ++k) { const int pc = 2 * q2 + k, o = tau * 144 + pc * 16;
            *(LAS u32x4*)(L + OFF_XR + o) = S.xr[k]; *(LAS u32x4*)(L + OFF_BR + o) = S.br[k]; *(LAS u32x4*)(L + OFF_CR + o) = S.cr[k];
            u32x4 xs; xs.x = pk2(bflo(S.xr[k].x) * wj, bfhi(S.xr[k].x) * wj); xs.y = pk2(bflo(S.xr[k].y) * wj, bfhi(S.xr[k].y) * wj); xs.z = pk2(bflo(S.xr[k].z) * wj, bfhi(S.xr[k].z) * wj); xs.w = pk2(bflo(S.xr[k].w) * wj, bfhi(S.xr[k].w) * wj);
            *(LAS u32x4*)(L + OFF_XS + o) = xs; }
#pragma unroll
        for (int k = 0; k < 2; ++k) { const int tl = 2 * wave + k, pt = tl >> 2, nt = tl & 3, n = 16 * nt + (lane & 15), p = 16 * pt + 4 * (lane >> 4);
#pragma unroll
            for (int i = 0; i < 4; ++i) *(LAS unsigned short*)(L + OFF_SB + (p + i) * 144 + n * 2) = (unsigned short)(pk2(Sacc[k][i], 0.f) & 0xffffu); }
    }
    __syncthreads();
    ssd_issue(P, X, S, u, c + 2);
    const int gi = lane & 15, gq = gi >> 2, gp = gi & 3;
    if (!(CHEAT & 8)) {
        const int ib = wave >> 1, pb = wave & 1, i_tok = 32 * ib + r;
        const float acum_i = t_ac[i_tok];
        bf16x8 cf[4];
#pragma unroll
        for (int s = 0; s < 4; ++s) cf[s] = *(const LAS bf16x8*)(L + OFF_CR + i_tok * 144 + (16 * s + 8 * hh) * 2);
        f32x16 accO, accD;
#pragma unroll
        for (int i = 0; i < 16; ++i) { accO[i] = 0.f; accD[i] = 0.f; }
#pragma unroll
        for (int s = 0; s < 4; ++s) { const bf16x8 sa = *(const LAS bf16x8*)(L + OFF_SB + (32 * pb + r) * 144 + (16 * s + 8 * hh) * 2); accO = MFMA32(sa, cf[s], accO); }
        const LAS unsigned char* xtr = L + OFF_XR + (4 * hh + gq) * 144 + (32 * pb + 16 * ((lane >> 4) & 1) + 4 * gp) * 2;
        const LAS unsigned char* xctr = xtr + (OFF_XS - OFF_XR);
        for (int jb = (CHEAT & 2) ? ib : 0; jb <= ib; ++jb) {
            f32x16 g;
#pragma unroll
            for (int i = 0; i < 16; ++i) g[i] = 0.f;
#pragma unroll
            for (int s = 0; s < 4; ++s) { const bf16x8 ba = *(const LAS bf16x8*)(L + OFF_BR + (32 * jb + r) * 144 + (16 * s + 8 * hh) * 2); g = MFMA32(ba, cf[s], g); }
            if (jb < ib) {
                f32x16 tmp;
#pragma unroll
                for (int i = 0; i < 16; ++i) tmp[i] = 0.f;
#pragma unroll
                for (int s = 0; s < 2; ++s) {
                    u32x4 w; w.x = pk2(g[8 * s + 0], g[8 * s + 1]); w.y = pk2(g[8 * s + 2], g[8 * s + 3]); w.z = pk2(g[8 * s + 4], g[8 * s + 5]); w.w = pk2(g[8 * s + 6], g[8 * s + 7]);
                    const bf16x8 wf = __builtin_bit_cast(bf16x8, w);
                    const LAS unsigned char* xp = xctr + (32 * jb + 16 * s) * 144;
                    const s16x4 lo = tr16(xp), hi = tr16(xp + 8 * 144);
                    const bf16x8 xf = __builtin_shufflevector(lo, hi, 0, 1, 2, 3, 4, 5, 6, 7);
                    tmp = MFMA32(xf, wf, tmp);
                }
                const float rf = __expf(acum_i - t_ac[32 * jb + 31]);
#pragma unroll
                for (int i = 0; i < 16; ++i) accD[i] += rf * tmp[i];
            } else {
#pragma unroll
                for (int g4 = 0; g4 < ((CHEAT & 1) ? 0 : 4); ++g4) { const int j0 = 32 * jb + 8 * g4 + 4 * hh;
                    const f32x4 aj = *(const LAS f32x4*)(L + OFF_AC + j0 * 4), dj = *(const LAS f32x4*)(L + OFF_DTT + j0 * 4);
#pragma unroll
                    for (int i = 0; i < 4; ++i) { const float arg = fminf(acum_i - aj[i], 0.f); const float wv = __expf(arg) * dj[i] * g[4 * g4 + i]; g[4 * g4 + i] = (j0 + i <= i_tok) ? wv : 0.f; } }
#pragma unroll
                for (int s = 0; s < 2; ++s) {
                    u32x4 w; w.x = pk2(g[8 * s + 0], g[8 * s + 1]); w.y = pk2(g[8 * s + 2], g[8 * s + 3]); w.z = pk2(g[8 * s + 4], g[8 * s + 5]); w.w = pk2(g[8 * s + 6], g[8 * s + 7]);
                    const bf16x8 wf = __builtin_bit_cast(bf16x8, w);
                    const LAS unsigned char* xp = xtr + (32 * jb + 16 * s) * 144;
                    const s16x4 lo = tr16(xp), hi = tr16(xp + 8 * 144);
                    const bf16x8 xf = __builtin_shufflevector(lo, hi, 0, 1, 2, 3, 4, 5, 6, 7);
                    accD = MFMA32(xf, wf, accD);
                }
            }
        }
        const float ei = __expf(acum_i);
        bf16_t* yp = Y + (rb + tbase + tstep * i_tok) * 512 + hd * 64 + 32 * pb + 4 * hh;
#pragma unroll
        for (int g4 = 0; g4 < 4; ++g4) { u32x2 w; w.x = pk2(accD[4 * g4] + ei * accO[4 * g4], accD[4 * g4 + 1] + ei * accO[4 * g4 + 1]); w.y = pk2(accD[4 * g4 + 2] + ei * accO[4 * g4 + 2], accD[4 * g4 + 3] + ei * accO[4 * g4 + 3]);
            __builtin_nontemporal_store(w, (u32x2*)(yp + 8 * g4)); }
    }
    if (!(CHEAT & 16)) {
        const float dec = __expf(alast);
        const int q4 = lane >> 4;
        float fs[4];
#pragma unroll
        for (int s = 0; s < 4; ++s) fs[s] = __expf(alast - t_ac[32 * s + 31]);
#pragma unroll
        for (int k = 0; k < 2; ++k) { const int tl = 2 * wave + k, pt = tl >> 2, nt = tl & 3;
            f32x4 acc = Sacc[k] * dec;
            const LAS unsigned char* xa0 = L + OFF_XS + (8 * q4 + gq) * 144 + (16 * pt + 4 * gp) * 2;
            const LAS unsigned char* bb0 = L + OFF_BR + (8 * q4 + gq) * 144 + (16 * nt + 4 * gp) * 2;
#pragma unroll
            for (int s = 0; s < 4; ++s) {
                const s16x4 xl = tr16(xa0 + 32 * s * 144), xh = tr16(xa0 + (32 * s + 4) * 144), bl = tr16(bb0 + 32 * s * 144), bh = tr16(bb0 + (32 * s + 4) * 144);
                const bf16x8 xa = __builtin_shufflevector(xl, xh, 0, 1, 2, 3, 4, 5, 6, 7), bb = __builtin_shufflevector(bl, bh, 0, 1, 2, 3, 4, 5, 6, 7);
                const f32x4 part = MFMA16(xa, bb, ((f32x4){0.f, 0.f, 0.f, 0.f}));
                acc = acc + part * fs[s]; }
            Sacc[k] = acc; }
    }
    __syncthreads();
    if (++ST.c == 18) { ST.c = 0; ST.u += X.G; ST.Sacc[0] = (f32x4){0.f, 0.f, 0.f, 0.f}; ST.Sacc[1] = (f32x4){0.f, 0.f, 0.f, 0.f}; }
}

template <int CHEAT = 0>
DI void ssd_run(const Params& P, Ctx& X, SsdState& ST, int l, int n) {
    if (!ssd_pending(ST)) return;
    SsdPre SA, SB;
    ssd_issue(P, X, SA, ST.u, ST.c); ssd_issue(P, X, SB, ST.u, ST.c + 1);
    for (int i = 0; i < n && ssd_pending(ST); i += 2) {
        ssd_step<CHEAT>(P, X, ST, SA, l);
        if (i + 1 < n && ssd_pending(ST)) ssd_step<CHEAT>(P, X, ST, SB, l);
    }
}
template <int KIND, int CHEAT = 0>
DI void attn_unit(const Params& P, Ctx& X, int l, int b, int h, int qt, float lam, float lam_init) {
    constexpr int DK = KIND ? 96 : 64, KROW = DK * 2 + 16, NS = KIND ? 6 : 2;
    constexpr int TK = 64, NSUB = TK / 64;
    constexpr int KBUF = TK * KROW, VROW = TK * 2 + 8, VBUF = 64 * VROW;
    constexpr int KPT = KIND ? 12 : 8, NKP = (TK * KPT + NTHR - 1) / NTHR, NVP = (64 * TK / 8 + NTHR - 1) / NTHR;
    constexpr int OFF_K = 0, OFF_V = 2 * KBUF, OFF_X = 0;
    static_assert(OFF_V + 2 * VBUF <= LDS_MISC, "attention LDS");
    const bf16_t* PROJ = (const bf16_t*)(P.ws + WS_PROJ);
    const bf16_t* MLAQ = (const bf16_t*)(P.ws + WS_MLAQ); const bf16_t* MLAK = (const bf16_t*)(P.ws + WS_MLAK);
    const bf16_t* VT = (const bf16_t*)(P.ws + (KIND ? WS_VTM : WS_VTD)) + ((size_t)b * 4 + h) * 64 * T;
    bf16_t* ACT = (bf16_t*)(P.ws + WS_ACT);
    unsigned z_ = 0u; asm volatile("" : "+v"(z_));
    int tid_ = X.wave * 64 + (int)__builtin_amdgcn_mbcnt_hi(~0u, __builtin_amdgcn_mbcnt_lo(~0u, z_)); asm volatile("" : "+v"(tid_));
    const int tid = tid_, lane = tid & 63, wave = X.wave, r = lane & 31, hh = lane >> 5;
    const int mmw = KIND ? 0 : (wave & 1), qg = KIND ? wave : (wave >> 1);
    const bool is_ctx = KIND ? (qt == 0) : (qt < 2);
    const int nk = is_ctx ? CTX : T, ntile = nk / TK;
    const size_t mrow = (size_t)b * T + qt * (KIND ? 256 : 128) + qg * 32 + r;
    bf16x8 qf[NS];
#pragma unroll
    for (int s = 0; s < NS; ++s)
        qf[s] = KIND ? *(const bf16x8*)(MLAQ + mrow * 384 + h * 96 + 16 * s + 8 * hh) : *(const bf16x8*)(PROJ + mrow * PW + C_DAQ + h * 64 + mmw * 32 + 16 * s + 8 * hh);
    const int kcol = mmw * 64 + 16 * hh;
    struct KV { u32x4 kr[NKP], vr[NVP]; };
    constexpr int VSH = (TK == 64) ? 3 : 4;
    auto gloadK = [&](int it, KV& R) {
        const int key0 = it * TK;
#pragma unroll
        for (int j = 0; j < NKP; ++j) { const int p = tid + NTHR * j, key = p / KPT, pc = p % KPT;
            if (p < TK * KPT) R.kr[j] = KIND ? *(const u32x4*)(MLAK + (((size_t)b * T + key0 + key) * 4 + h) * 96 + pc * 8) : *(const u32x4*)(PROJ + ((size_t)b * T + key0 + key) * PW + C_DAK + h * 64 + pc * 8); }
    };
    auto gloadV = [&](int it, KV& R) {
        const int key0 = it * TK;
#pragma unroll
        for (int j = 0; j < NVP; ++j) { const int p = tid + NTHR * j; R.vr[j] = *(const u32x4*)(VT + (size_t)(p >> VSH) * T + key0 + (p & ((1 << VSH) - 1)) * 8); }
    };
    auto lstoreK = [&](int buf, const KV& R) {
#pragma unroll
        for (int j = 0; j < NKP; ++j) { const int p = tid + NTHR * j, key = p / KPT, pc = p % KPT; if (p < TK * KPT) *(LAS u32x4*)(X.L + OFF_K + buf * KBUF + key * KROW + pc * 16) = R.kr[j]; }
    };
    auto lstoreV = [&](int buf, const KV& R) {
#pragma unroll
        for (int j = 0; j < NVP; ++j) { const int p = tid + NTHR * j; LAS unsigned char* vp = X.L + OFF_V + buf * VBUF + (p >> VSH) * VROW + (p & ((1 << VSH) - 1)) * 16;
            *(LAS u32x2*)vp = (u32x2){R.vr[j].x, R.vr[j].y}; *(LAS u32x2*)(vp + 8) = (u32x2){R.vr[j].z, R.vr[j].w}; }
    };
    f32x16 O[2]; float mrun = 0.f, lsum = 0.f, mx = 0.f; bool first = true;
    constexpr float ATT_THR = 8.f;
#pragma unroll
    for (int d = 0; d < 2; ++d)
#pragma unroll
        for (int i = 0; i < 16; ++i) O[d][i] = 0.f;
    constexpr int NM = NS * 2;
    auto maxchunk = [&](int c, const f32x16& A0, const f32x16& A1, float& mA, float& mB) {
        const f32x16& A = (c < 4) ? A0 : A1; float& m = (c < 4) ? mA : mB;
#pragma unroll
        for (int o = 2 * (c & 3); o < 2 * (c & 3) + 2; ++o) {
            if (o == 0) m = max3f(A[0], A[1], A[2]);
            else if (o < 7) m = max3f(m, A[2 * o + 1], A[2 * o + 2]);
            else m = __builtin_fmaxf(m, A[15]);
        }
    };
    auto tile = [&](int buf, f32x16& C0, f32x16& C1, f32x16& N0, f32x16& N1) {
        const LAS unsigned char* Kb = X.L + OFF_K + (buf ^ 1) * KBUF; const LAS unsigned char* Vb = X.L + OFF_V + buf * VBUF;
        if (first || __any(mx > ATT_THR)) {
            const float g = first ? mx : fmaxf(mx, 0.f), alpha = first ? 0.f : fexp2(-g);
            mrun += g; lsum *= alpha; first = false;
#pragma unroll
            for (int i = 0; i < 16; ++i) { C0[i] -= g; C1[i] -= g; }
#pragma unroll
            for (int d = 0; d < 2; ++d)
#pragma unroll
                for (int i = 0; i < 16; ++i) O[d][i] *= alpha;
        }
        const float ninit = -mrun;
        bf16x8 kf0[2], kf1[2];
#pragma unroll
        for (int s = 0; s < 2; ++s) { kf0[s] = *(const LAS bf16x8*)(Kb + r * KROW + kcol + 32 * s); kf1[s] = *(const LAS bf16x8*)(Kb + (32 + r) * KROW + kcol + 32 * s); }
        s16x4 vlo[2][4], vhi[2][4];
        auto vread = [&](int d) {
#pragma unroll
            for (int ks = 0; ks < 4; ++ks) { const LAS unsigned char* vp = Vb + (32 * d + r) * VROW + (16 * ks + 4 * hh) * 2;
                vlo[d][ks] = *(const LAS s16x4*)vp; vhi[d][ks] = *(const LAS s16x4*)(vp + 16); }
        };
        if (NS == 2) vread(0);
#pragma unroll
        for (int i = 0; i < 16; ++i) { N0[i] = ninit; N1[i] = ninit; }
        __builtin_amdgcn_sched_barrier(0);
        float ps0 = 0.f, ps1 = 0.f;
        auto expchunk = [&](int c) {
#pragma unroll
            for (int e = 0; e < 32; ++e)
                if (e >= c * 32 / NM && e < (c + 1) * 32 / NM) {
                    if (e < 16) { C0[e] = fexp2(C0[e]); ps0 += C0[e]; } else { C1[e - 16] = fexp2(C1[e - 16]); ps1 += C1[e - 16]; } }
        };
#pragma unroll
        for (int s0 = 0; s0 < NS; s0 += 2) {
            bf16x8 n0[2], n1[2];
            if (s0 + 2 < NS) {
#pragma unroll
                for (int s = 0; s < 2; ++s) { n0[s] = *(const LAS bf16x8*)(Kb + r * KROW + kcol + 32 * (s0 + 2 + s)); n1[s] = *(const LAS bf16x8*)(Kb + (32 + r) * KROW + kcol + 32 * (s0 + 2 + s)); }
                __builtin_amdgcn_sched_barrier(0); }
            else if (NS > 2) { vread(0); __builtin_amdgcn_sched_barrier(0); }
#pragma unroll
            for (int s = 0; s < 2; ++s) {
                N0 = MFMA32(kf0[s], qf[s0 + s], N0); expchunk(2 * (s0 + s)); asm volatile("" : "+v"(ps0), "+v"(ps1)); __builtin_amdgcn_sched_barrier(0);
                N1 = MFMA32(kf1[s], qf[s0 + s], N1); expchunk(2 * (s0 + s) + 1); asm volatile("" : "+v"(ps0), "+v"(ps1)); __builtin_amdgcn_sched_barrier(0);
            }
            if (s0 + 2 < NS) {
#pragma unroll
                for (int s = 0; s < 2; ++s) { kf0[s] = n0[s]; kf1[s] = n1[s]; } }
        }
        lsum += ps0 + ps1;
        vread(1);
        __builtin_amdgcn_sched_barrier(0);
        bf16x8 pf[2][2];
#pragma unroll
        for (int s = 0; s < 2; ++s) {
            u32x4 w0, w1;
            w0.x = pk2(C0[8 * s + 0], C0[8 * s + 1]); w0.y = pk2(C0[8 * s + 2], C0[8 * s + 3]); w0.z = pk2(C0[8 * s + 4], C0[8 * s + 5]); w0.w = pk2(C0[8 * s + 6], C0[8 * s + 7]);
            w1.x = pk2(C1[8 * s + 0], C1[8 * s + 1]); w1.y = pk2(C1[8 * s + 2], C1[8 * s + 3]); w1.z = pk2(C1[8 * s + 4], C1[8 * s + 5]); w1.w = pk2(C1[8 * s + 6], C1[8 * s + 7]);
            pf[0][s] = __builtin_bit_cast(bf16x8, w0); pf[1][s] = __builtin_bit_cast(bf16x8, w1);
        }
        __builtin_amdgcn_sched_barrier(0);
        float mA = 0.f, mB = 0.f;
#pragma unroll
        for (int ks = 0; ks < 4; ++ks)
#pragma unroll
            for (int d = 0; d < 2; ++d) {
                const bf16x8 vf = __builtin_shufflevector(vlo[d][ks], vhi[d][ks], 0, 1, 2, 3, 4, 5, 6, 7);
                O[d] = MFMA32(vf, pf[ks >> 1][ks & 1], O[d]);
                maxchunk(ks * 2 + d, N0, N1, mA, mB); asm volatile("" : "+v"(mA), "+v"(mB));
                __builtin_amdgcn_sched_barrier(0);
            }
        mx = __builtin_fmaxf(mA, mB);
        mx = xh_max(mx);
    };
    KV RA;
    f32x16 S0, S1, T0, T1;
    __syncthreads();
    gloadK(0, RA); gloadV(0, RA); lstoreK(0, RA); lstoreV(0, RA);
    gloadK(1, RA);
    __syncthreads();
    lstoreK(1, RA);
    {
        const LAS unsigned char* Kb = X.L + OFF_K;
#pragma unroll
        for (int i = 0; i < 16; ++i) { S0[i] = 0.f; S1[i] = 0.f; }
#pragma unroll
        for (int s = 0; s < NS; ++s) {
            const bf16x8 k0 = *(const LAS bf16x8*)(Kb + r * KROW + kcol + 32 * s), k1 = *(const LAS bf16x8*)(Kb + (32 + r) * KROW + kcol + 32 * s);
            S0 = MFMA32(k0, qf[s], S0); S1 = MFMA32(k1, qf[s], S1); }
        float mA = 0.f, mB = 0.f;
#pragma unroll
        for (int c = 0; c < 8; ++c) maxchunk(c, S0, S1, mA, mB);
        mx = __builtin_fmaxf(mA, mB);
        mx = xh_max(mx);
    }
    __syncthreads();
    for (int it = 0; it < ntile; it += 2) {
        if (it + 2 < ntile) gloadK(it + 2, RA);
        gloadV(it + 1, RA);
        tile(0, S0, S1, T0, T1);
        if (it + 2 < ntile) lstoreK(0, RA);
        lstoreV(1, RA);
        __syncthreads();
        if (it + 3 < ntile) gloadK(it + 3, RA);
        if (it + 2 < ntile) gloadV(it + 2, RA);
        tile(1, T0, T1, S0, S1);
        if (it + 3 < ntile) lstoreK(1, RA);
        if (it + 2 < ntile) lstoreV(0, RA);
        __syncthreads();
    }
    const float inv = 1.f / xh_sum(lsum);
    if (KIND == 0) {
        LAS float* xb = (LAS float*)(X.L + OFF_X) + qg * 2048 + lane;
        if (mmw == 1) {
#pragma unroll
            for (int d = 0; d < 2; ++d)
#pragma unroll
                for (int i = 0; i < 16; ++i) xb[(d * 16 + i) * 64] = O[d][i] * inv;
        }
        __syncthreads();
        if (mmw == 0) {
            float ss = 0.f;
#pragma unroll
            for (int d = 0; d < 2; ++d)
#pragma unroll
                for (int i = 0; i < 16; ++i) { const float o = O[d][i] * inv - lam * xb[(d * 16 + i) * 64]; O[d][i] = o; ss += o * o; }
            ss = xh_sum(ss);
            const float rstd = rsqrtf(ss * (1.f / 64.f) + EPS) * (1.f - lam_init);
#pragma unroll
            for (int d = 0; d < 2; ++d)
#pragma unroll
                for (int g4 = 0; g4 < 4; ++g4) { const int dv = 32 * d + 8 * g4 + 4 * hh; const f32x4 gg = *(const LAS f32x4*)((const LAS float*)X.misc + 128 + dv);
                    u32x2 w; w.x = pk2(O[d][4 * g4] * rstd * gg[0], O[d][4 * g4 + 1] * rstd * gg[1]); w.y = pk2(O[d][4 * g4 + 2] * rstd * gg[2], O[d][4 * g4 + 3] * rstd * gg[3]);
                    *(u32x2*)(ACT + mrow * DM + h * 64 + dv) = w; }
        }
    } else {
#pragma unroll
        for (int d = 0; d < 2; ++d)
#pragma unroll
            for (int g4 = 0; g4 < 4; ++g4) { const int dv = 32 * d + 8 * g4 + 4 * hh;
                u32x2 w; w.x = pk2(O[d][4 * g4] * inv, O[d][4 * g4 + 1] * inv); w.y = pk2(O[d][4 * g4 + 2] * inv, O[d][4 * g4 + 3] * inv);
                *(u32x2*)(ACT + mrow * DM + 768 + h * 64 + dv) = w; }
    }
}

DI void attn_unit_da2(const Params& P, Ctx& X, int l, int b, int h, int qt, float lam, float lam_init) {
    constexpr int KROW = 144, KBUF = 64 * KROW, VROW = 136, VBUF = 64 * VROW, OFF_K = 0, OFF_V = 2 * KBUF;
    const bf16_t* PROJ = (const bf16_t*)(P.ws + WS_PROJ);
    const bf16_t* VT = (const bf16_t*)(P.ws + WS_VTD) + ((size_t)b * 4 + h) * 64 * T;
    bf16_t* ACT = (bf16_t*)(P.ws + WS_ACT);
    unsigned z_ = 0u; asm volatile("" : "+v"(z_));
    int tid_ = X.wave * 64 + (int)__builtin_amdgcn_mbcnt_hi(~0u, __builtin_amdgcn_mbcnt_lo(~0u, z_)); asm volatile("" : "+v"(tid_));
    const int tid = tid_, lane = tid & 63, wave = X.wave, r = lane & 31, hh = lane >> 5;
    const int ntile = (qt == 0 ? CTX : T) / 64;
    const size_t mrow = (size_t)b * T + qt * 256 + wave * 32 + r;
    bf16x8 qf[2][2];
#pragma unroll
    for (int mp = 0; mp < 2; ++mp)
#pragma unroll
        for (int s = 0; s < 2; ++s) qf[mp][s] = *(const bf16x8*)(PROJ + mrow * PW + C_DAQ + h * 64 + mp * 32 + 16 * s + 8 * hh);
    const int skey = tid >> 3, spc = tid & 7;
    const bf16_t* gk = PROJ + ((size_t)b * T + skey) * PW + C_DAK + h * 64 + spc * 8;
    const bf16_t* gv = VT + (size_t)skey * T + spc * 8;
    u32x4 kr, vr;
    auto gload = [&](int it) { kr = *(const u32x4*)(gk + (size_t)it * 64 * PW); vr = *(const u32x4*)(gv + it * 64); };
    auto lstore = [&](int buf) {
        *(LAS u32x4*)(X.L + OFF_K + buf * KBUF + skey * KROW + spc * 16) = kr;
        LAS unsigned char* vp = X.L + OFF_V + buf * VBUF + skey * VROW + spc * 16;
        *(LAS u32x2*)vp = (u32x2){vr.x, vr.y}; *(LAS u32x2*)(vp + 8) = (u32x2){vr.z, vr.w}; };
    f32x16 O[2][2]; float mrun[2] = {0.f, 0.f}, lsum[2] = {0.f, 0.f}; bool first = true;
    constexpr float ATT_THR = 8.f;
#pragma unroll
    for (int mp = 0; mp < 2; ++mp)
#pragma unroll
        for (int d = 0; d < 2; ++d)
#pragma unroll
            for (int i = 0; i < 16; ++i) O[mp][d][i] = 0.f;
    auto tile = [&](int buf) {
        const LAS unsigned char* Kb = X.L + OFF_K + buf * KBUF; const LAS unsigned char* Vb = X.L + OFF_V + buf * VBUF;
        s16x4 vlo[2][4], vhi[2][4];
#pragma unroll
        for (int d = 0; d < 2; ++d)
#pragma unroll
            for (int ks = 0; ks < 4; ++ks) { const LAS unsigned char* vp = Vb + (32 * d + r) * VROW + (16 * ks + 4 * hh) * 2;
                vlo[d][ks] = *(const LAS s16x4*)vp; vhi[d][ks] = *(const LAS s16x4*)(vp + 16); }
        __builtin_amdgcn_sched_barrier(0);
#pragma unroll
        for (int mp = 0; mp < 2; ++mp) {
            const float ninit = -mrun[mp];
            bf16x8 kf0[2], kf1[2];
#pragma unroll
            for (int s = 0; s < 2; ++s) { kf0[s] = *(const LAS bf16x8*)(Kb + r * KROW + mp * 64 + 16 * hh + 32 * s); kf1[s] = *(const LAS bf16x8*)(Kb + (32 + r) * KROW + mp * 64 + 16 * hh + 32 * s); }
            f32x16 S0, S1;
#pragma unroll
            for (int i = 0; i < 16; ++i) { S0[i] = ninit; S1[i] = ninit; }
#pragma unroll
            for (int s = 0; s < 2; ++s) { S0 = MFMA32(kf0[s], qf[mp][s], S0); S1 = MFMA32(kf1[s], qf[mp][s], S1); }
            float mx = max3f(S0[0], S0[1], S0[2]);
#pragma unroll
            for (int i = 3; i < 15; i += 2) mx = max3f(mx, S0[i], S0[i + 1]);
            mx = max3f(mx, S0[15], S1[0]);
#pragma unroll
            for (int i = 1; i < 15; i += 2) mx = max3f(mx, S1[i], S1[i + 1]);
            mx = __builtin_fmaxf(mx, S1[15]);
            mx = xh_max(mx);
            if (first || __any(mx > ATT_THR)) {
                const float g = first ? mx : fmaxf(mx, 0.f), alpha = first ? 0.f : fexp2(-g);
                mrun[mp] += g; lsum[mp] *= alpha;
#pragma unroll
                for (int i = 0; i < 16; ++i) { S0[i] -= g; S1[i] -= g; }
#pragma unroll
                for (int d = 0; d < 2; ++d)
#pragma unroll
                    for (int i = 0; i < 16; ++i) O[mp][d][i] *= alpha;
            }
            float ps0 = 0.f, ps1 = 0.f;
#pragma unroll
            for (int i = 0; i < 16; ++i) { S0[i] = fexp2(S0[i]); S1[i] = fexp2(S1[i]); ps0 += S0[i]; ps1 += S1[i]; }
            lsum[mp] += ps0 + ps1;
            bf16x8 pf[2][2];
#pragma unroll
            for (int s = 0; s < 2; ++s) {
                u32x4 w0, w1;
                w0.x = pk2(S0[8 * s + 0], S0[8 * s + 1]); w0.y = pk2(S0[8 * s + 2], S0[8 * s + 3]); w0.z = pk2(S0[8 * s + 4], S0[8 * s + 5]); w0.w = pk2(S0[8 * s + 6], S0[8 * s + 7]);
                w1.x = pk2(S1[8 * s + 0], S1[8 * s + 1]); w1.y = pk2(S1[8 * s + 2], S1[8 * s + 3]); w1.z = pk2(S1[8 * s + 4], S1[8 * s + 5]); w1.w = pk2(S1[8 * s + 6], S1[8 * s + 7]);
                pf[0][s] = __builtin_bit_cast(bf16x8, w0); pf[1][s] = __builtin_bit_cast(bf16x8, w1);
            }
#pragma unroll
            for (int ks = 0; ks < 4; ++ks)
#pragma unroll
                for (int d = 0; d < 2; ++d) {
                    const bf16x8 vf = __builtin_shufflevector(vlo[d][ks], vhi[d][ks], 0, 1, 2, 3, 4, 5, 6, 7);
                    O[mp][d] = MFMA32(vf, pf[ks >> 1][ks & 1], O[mp][d]);
                }
            __builtin_amdgcn_sched_barrier(0);
        }
        first = false;
    };
    gload(0);
    __syncthreads();
    lstore(0);
    __syncthreads();
    for (int it = 0; it < ntile; it += 2) {
        gload(it + 1);
        tile(0);
        lstore(1);
        __syncthreads();
        if (it + 2 < ntile) gload(it + 2);
        tile(1);
        if (it + 2 < ntile) lstore(0);
        __syncthreads();
    }
    unsigned ze_ = 0u; asm volatile("" : "+v"(ze_));
    int lane_e = (int)__builtin_amdgcn_mbcnt_hi(~0u, __builtin_amdgcn_mbcnt_lo(~0u, ze_)); asm volatile("" : "+v"(lane_e));
    float li = lam_init; asm volatile("" : "+v"(li));
    const int hh_e = lane_e >> 5;
    const float inv0 = 1.f / xh_sum(lsum[0]), inv1 = lam / xh_sum(lsum[1]);
    float ss = 0.f;
#pragma unroll
    for (int d = 0; d < 2; ++d)
#pragma unroll
        for (int i = 0; i < 16; ++i) { const float o = O[0][d][i] * inv0 - O[1][d][i] * inv1; O[0][d][i] = o; ss += o * o; }
    ss = xh_sum(ss);
    const float rstd = rsqrtf(ss * (1.f / 64.f) + EPS) * (1.f - li);
    const size_t mrow_e = (size_t)b * T + qt * 256 + wave * 32 + (lane_e & 31);
#pragma unroll
    for (int d = 0; d < 2; ++d)
#pragma unroll
        for (int g4 = 0; g4 < 4; ++g4) { const int dv = 32 * d + 8 * g4 + 4 * hh_e; const f32x4 gg = *(const LAS f32x4*)((const LAS float*)X.misc + 128 + dv);
            u32x2 w; w.x = pk2(O[0][d][4 * g4] * rstd * gg[0], O[0][d][4 * g4 + 1] * rstd * gg[1]); w.y = pk2(O[0][d][4 * g4 + 2] * rstd * gg[2], O[0][d][4 * g4 + 3] * rstd * gg[3]);
            *(u32x2*)(ACT + mrow_e * DM + h * 64 + dv) = w; }
}

DI void attn_unit_mla2(const Params& P, Ctx& X, int l, int b, int h, int qt) {
    constexpr int KROW = 208, KBUF = 64 * KROW, VROW = 136, VBUF = 64 * VROW, OFF_K = 0, OFF_V = 2 * KBUF;
    const bf16_t* MLAQ = (const bf16_t*)(P.ws + WS_MLAQ); const bf16_t* MLAK = (const bf16_t*)(P.ws + WS_MLAK);
    const bf16_t* VT = (const bf16_t*)(P.ws + WS_VTM) + ((size_t)b * 4 + h) * 64 * T;
    bf16_t* ACT = (bf16_t*)(P.ws + WS_ACT);
    unsigned z_ = 0u; asm volatile("" : "+v"(z_));
    int tid_ = X.wave * 64 + (int)__builtin_amdgcn_mbcnt_hi(~0u, __builtin_amdgcn_mbcnt_lo(~0u, z_)); asm volatile("" : "+v"(tid_));
    const int tid = tid_, lane = tid & 63, wave = X.wave, r = lane & 31, hh = lane >> 5;
    constexpr int ntile = T / 64;
    const size_t mrow0 = (size_t)b * T + CTX + qt * 512 + wave * 64 + r;
    bf16x8 qf[2][6];
#pragma unroll
    for (int qb = 0; qb < 2; ++qb)
#pragma unroll
        for (int s = 0; s < 6; ++s) qf[qb][s] = *(const bf16x8*)(MLAQ + (mrow0 + 32 * qb) * 384 + h * 96 + 16 * s + 8 * hh);
    const int k0key = tid / 12, k0pc = tid % 12, k1key = (tid + 512) / 12, k1pc = (tid + 512) % 12;
    const bf16_t* gk0 = MLAK + (((size_t)b * T + k0key) * 4 + h) * 96 + k0pc * 8;
    const bf16_t* gk1 = MLAK + (((size_t)b * T + k1key) * 4 + h) * 96 + k1pc * 8;
    const bf16_t* gv = VT + (size_t)(tid >> 3) * T + (tid & 7) * 8;
    u32x4 kr0, kr1, vr;
    auto gload = [&](int it) { kr0 = *(const u32x4*)(gk0 + (size_t)it * 64 * 384); if (tid < 256) kr1 = *(const u32x4*)(gk1 + (size_t)it * 64 * 384); vr = *(const u32x4*)(gv + it * 64); };
    auto lstore = [&](int buf) {
        *(LAS u32x4*)(X.L + OFF_K + buf * KBUF + k0key * KROW + k0pc * 16) = kr0;
        if (tid < 256) *(LAS u32x4*)(X.L + OFF_K + buf * KBUF + k1key * KROW + k1pc * 16) = kr1;
        LAS unsigned char* vp = X.L + OFF_V + buf * VBUF + (tid >> 3) * VROW + (tid & 7) * 16;
        *(LAS u32x2*)vp = (u32x2){vr.x, vr.y}; *(LAS u32x2*)(vp + 8) = (u32x2){vr.z, vr.w}; };
    f32x16 O[2][2]; float mrun[2] = {0.f, 0.f}, lsum[2] = {0.f, 0.f}; bool first = true;
    constexpr float ATT_THR = 8.f;
#pragma unroll
    for (int qb = 0; qb < 2; ++qb)
#pragma unroll
        for (int d = 0; d < 2; ++d)
#pragma unroll
            for (int i = 0; i < 16; ++i) O[qb][d][i] = 0.f;
    auto tile = [&](int buf) {
        const LAS unsigned char* Kb = X.L + OFF_K + buf * KBUF; const LAS unsigned char* Vb = X.L + OFF_V + buf * VBUF;
#pragma unroll
        for (int qb = 0; qb < 2; ++qb) {
            const float ninit = -mrun[qb];
            f32x16 S0, S1;
#pragma unroll
            for (int i = 0; i < 16; ++i) { S0[i] = ninit; S1[i] = ninit; }
            bf16x8 kf0[2], kf1[2];
#pragma unroll
            for (int s = 0; s < 2; ++s) { kf0[s] = *(const LAS bf16x8*)(Kb + r * KROW + 16 * hh + 32 * s); kf1[s] = *(const LAS bf16x8*)(Kb + (32 + r) * KROW + 16 * hh + 32 * s); }
#pragma unroll
            for (int s0 = 0; s0 < 6; s0 += 2) {
                bf16x8 n0[2], n1[2];
                if (s0 + 2 < 6) {
#pragma unroll
                    for (int s = 0; s < 2; ++s) { n0[s] = *(const LAS bf16x8*)(Kb + r * KROW + 16 * hh + 32 * (s0 + 2 + s)); n1[s] = *(const LAS bf16x8*)(Kb + (32 + r) * KROW + 16 * hh + 32 * (s0 + 2 + s)); }
                    __builtin_amdgcn_sched_barrier(0); }
#pragma unroll
                for (int s = 0; s < 2; ++s) { S0 = MFMA32(kf0[s], qf[qb][s0 + s], S0); S1 = MFMA32(kf1[s], qf[qb][s0 + s], S1); }
                if (s0 + 2 < 6) {
#pragma unroll
                    for (int s = 0; s < 2; ++s) { kf0[s] = n0[s]; kf1[s] = n1[s]; } }
            }
            float mx = max3f(S0[0], S0[1], S0[2]);
#pragma unroll
            for (int i = 3; i < 15; i += 2) mx = max3f(mx, S0[i], S0[i + 1]);
            mx = max3f(mx, S0[15], S1[0]);
#pragma unroll
            for (int i = 1; i < 15; i += 2) mx = max3f(mx, S1[i], S1[i + 1]);
            mx = __builtin_fmaxf(mx, S1[15]);
            mx = xh_max(mx);
            if (first || __any(mx > ATT_THR)) {
                const float g = first ? mx : fmaxf(mx, 0.f), alpha = first ? 0.f : fexp2(-g);
                mrun[qb] += g; lsum[qb] *= alpha;
#pragma unroll
                for (int i = 0; i < 16; ++i) { S0[i] -= g; S1[i] -= g; }
#pragma unroll
                for (int d = 0; d < 2; ++d)
#pragma unroll
                    for (int i = 0; i < 16; ++i) O[qb][d][i] *= alpha;
            }
            s16x4 vlo[2][4], vhi[2][4];
#pragma unroll
            for (int d = 0; d < 2; ++d)
#pragma unroll
                for (int ks = 0; ks < 4; ++ks) { const LAS unsigned char* vp = Vb + (32 * d + r) * VROW + (16 * ks + 4 * hh) * 2;
                    vlo[d][ks] = *(const LAS s16x4*)vp; vhi[d][ks] = *(const LAS s16x4*)(vp + 16); }
            float ps0 = 0.f, ps1 = 0.f;
#pragma unroll
            for (int i = 0; i < 16; ++i) { S0[i] = fexp2(S0[i]); S1[i] = fexp2(S1[i]); ps0 += S0[i]; ps1 += S1[i]; }
            lsum[qb] += ps0 + ps1;
            bf16x8 pf[2][2];
#pragma unroll
            for (int s = 0; s < 2; ++s) {
                u32x4 w0, w1;
                w0.x = pk2(S0[8 * s + 0], S0[8 * s + 1]); w0.y = pk2(S0[8 * s + 2], S0[8 * s + 3]); w0.z = pk2(S0[8 * s + 4], S0[8 * s + 5]); w0.w = pk2(S0[8 * s + 6], S0[8 * s + 7]);
                w1.x = pk2(S1[8 * s + 0], S1[8 * s + 1]); w1.y = pk2(S1[8 * s + 2], S1[8 * s + 3]); w1.z = pk2(S1[8 * s + 4], S1[8 * s + 5]); w1.w = pk2(S1[8 * s + 6], S1[8 * s + 7]);
                pf[0][s] = __builtin_bit_cast(bf16x8, w0); pf[1][s] = __builtin_bit_cast(bf16x8, w1);
            }
#pragma unroll
            for (int ks = 0; ks < 4; ++ks)
#pragma unroll
                for (int d = 0; d < 2; ++d) {
                    const bf16x8 vf = __builtin_shufflevector(vlo[d][ks], vhi[d][ks], 0, 1, 2, 3, 4, 5, 6, 7);
                    O[qb][d] = MFMA32(vf, pf[ks >> 1][ks & 1], O[qb][d]);
                }
            __builtin_amdgcn_sched_barrier(0);
        }
        first = false;
    };
    gload(0);
    __syncthreads();
    lstore(0);
    __syncthreads();
    for (int it = 0; it < ntile; it += 2) {
        gload(it + 1);
        tile(0);
        lstore(1);
        __syncthreads();
        if (it + 2 < ntile) gload(it + 2);
        tile(1);
        if (it + 2 < ntile) lstore(0);
        __syncthreads();
    }
    unsigned ze_ = 0u; asm volatile("" : "+v"(ze_));
    int lane_e = (int)__builtin_amdgcn_mbcnt_hi(~0u, __builtin_amdgcn_mbcnt_lo(~0u, ze_)); asm volatile("" : "+v"(lane_e));
    const int hh_e = lane_e >> 5;
    const size_t mrow_e = (size_t)b * T + CTX + qt * 512 + wave * 64 + (lane_e & 31);
#pragma unroll
    for (int qb = 0; qb < 2; ++qb) {
        const float inv = 1.f / xh_sum(lsum[qb]);
#pragma unroll
        for (int d = 0; d < 2; ++d)
#pragma unroll
            for (int g4 = 0; g4 < 4; ++g4) { const int dv = 32 * d + 8 * g4 + 4 * hh_e;
                u32x2 w; w.x = pk2(O[qb][d][4 * g4] * inv, O[qb][d][4 * g4 + 1] * inv); w.y = pk2(O[qb][d][4 * g4 + 2] * inv, O[qb][d][4 * g4 + 3] * inv);
                *(u32x2*)(ACT + (mrow_e + 32 * qb) * DM + 768 + h * 64 + dv) = w; }
    }
}

#ifndef MIX_STAMP
#define MIX_STAMP(c) do { } while (0)
#endif
DI void phase_mixers(const Params& P, Ctx& X, int l, int sel = 7) {
    X.cheat = sel;
    if (X.tid < 64) ((LAS float*)X.misc)[128 + X.tid] = P.da_g[l * 64 + X.tid];
    float li_ = 0.8f - 0.6f * __expf(-0.3f * (float)l); asm volatile("" : "+v"(li_));
    const float lam_init = __int_as_float(__builtin_amdgcn_readfirstlane(__float_as_int(li_)));
    float l01 = 0.f, l23 = 0.f;
    if (X.lane < 32) { const float* lv = P.da_lam + l * 128; l01 = lv[X.lane] * lv[32 + X.lane]; l23 = lv[64 + X.lane] * lv[96 + X.lane]; }
    const float lam = __int_as_float(__builtin_amdgcn_readfirstlane(__float_as_int(__expf(wave_sum(l01, X.lane)) - __expf(wave_sum(l23, X.lane)) + lam_init)));
    const int vb = (X.G & 7) ? X.bid : (X.bid & 7) * (X.G >> 3) + (X.bid >> 3);
    SsdState ST; ST.u = (sel & 1) ? vb : (1 << 20); ST.c = 0; ST.a = 0.f; ST.Sacc[0] = (f32x4){0.f, 0.f, 0.f, 0.f}; ST.Sacc[1] = (f32x4){0.f, 0.f, 0.f, 0.f};
    const int nDA = (sel & 2) ? (512 - vb + X.G - 1) / X.G : 0, nML = (sel & 4) ? (256 - vb + X.G - 1) / X.G : 0, nCX = (128 - vb + X.G - 1) / X.G;
    const int nitems = nDA + nML + (nCX > 0 ? nCX : 0);
    const int nssd = (sel & 1) ? ((NB * 8 * 2 - X.bid + X.G - 1) / X.G) * 18 : 0;
    const int per = 0; (void)nssd;
    __syncthreads();
#if defined(MK_MODE) && MK_MODE == 2
#ifndef PROBE_SSD_CHEAT
#define PROBE_SSD_CHEAT 1
#endif
    if (sel & 32) ssd_run<PROBE_SSD_CHEAT>(P, X, ST, l, 1 << 20); else
#endif
    ssd_run(P, X, ST, l, 1 << 20);
    MIX_STAMP(9);
    for (int it = 0; it < nitems; ++it) {
#if defined(MK_MODE) && MK_MODE == 2
#ifndef PROBE_ATT_CHEAT
#define PROBE_ATT_CHEAT 0
#endif
#define ATT_CALL(K, ...) do { if (sel & 8) attn_unit<K, PROBE_ATT_CHEAT>(__VA_ARGS__); else attn_unit<K, 0>(__VA_ARGS__); } while (0)
#else
#define ATT_CALL(K, ...) attn_unit<K, 0>(__VA_ARGS__)
#endif
        if (it < nDA) { const int u = vb + it * X.G; attn_unit_da2(P, X, l, u >> 5, (u >> 3) & 3, 1 + (u & 7), lam, lam_init); }
        else if (it < nDA + nML) { const int u = vb + (it - nDA) * X.G; attn_unit_mla2(P, X, l, u >> 4, (u >> 2) & 3, u & 3); }
        else { const int u = vb + (it - nDA - nML) * X.G;
            if (u < 64) { if (sel & 2) attn_unit_da2(P, X, l, u >> 2, u & 3, 0, lam, lam_init); } else { if (sel & 4) ATT_CALL(1, P, X, l, (u - 64) >> 2, u & 3, 0, lam, lam_init); } }
        MIX_STAMP((it < nDA) ? 10 : 11);
    }
}

DI void phase_ssdgate(const Params& P, Ctx& X, int l) {
    const bf16_t* PROJ = (const bf16_t*)(P.ws + WS_PROJ); const bf16_t* XBC = (const bf16_t*)(P.ws + WS_XBC);
    const bf16_t* YF = (const bf16_t*)(P.ws + WS_YF); const bf16_t* YB = (const bf16_t*)(P.ws + WS_YB);
    bf16_t* ACT = (bf16_t*)(P.ws + WS_ACT);
    const int gw = X.bid * NWAVE + X.wave, NGW = X.G * NWAVE, c0 = 8 * X.lane;
    const float dsk = P.ssd_d[l * 8 + (X.lane >> 3)];
    const f32x4 g0 = *(const f32x4*)(P.ssd_g + l * 512 + c0), g1 = *(const f32x4*)(P.ssd_g + l * 512 + c0 + 4);
    for (int m = gw; m < M; m += NGW) {
        const u32x4 yf = __builtin_nontemporal_load((const u32x4*)(YF + (size_t)m * 512 + c0)), yb = __builtin_nontemporal_load((const u32x4*)(YB + (size_t)m * 512 + c0)), xv = __builtin_nontemporal_load((const u32x4*)(XBC + (size_t)m * 768 + c0)), zv = *(const u32x4*)(PROJ + (size_t)m * PW + C_Z + c0);
        const unsigned yfw[4] = {yf.x, yf.y, yf.z, yf.w}, ybw[4] = {yb.x, yb.y, yb.z, yb.w}, xw[4] = {xv.x, xv.y, xv.z, xv.w}, zw[4] = {zv.x, zv.y, zv.z, zv.w};
        float v[8]; float ss = 0.f;
#pragma unroll
        for (int i = 0; i < 4; ++i) {
            v[2 * i] = (bflo(yfw[i]) + bflo(ybw[i]) + dsk * bflo(xw[i])) * silu(bflo(zw[i]));
            v[2 * i + 1] = (bfhi(yfw[i]) + bfhi(ybw[i]) + dsk * bfhi(xw[i])) * silu(bfhi(zw[i]));
            ss += v[2 * i] * v[2 * i] + v[2 * i + 1] * v[2 * i + 1]; }
        const float rstd = rsqrtf(wave_sum(ss, X.lane) * (1.f / 512.f) + EPS);
        u32x4 w; w.x = pk2(v[0] * rstd * g0[0], v[1] * rstd * g0[1]); w.y = pk2(v[2] * rstd * g0[2], v[3] * rstd * g0[3]); w.z = pk2(v[4] * rstd * g1[0], v[5] * rstd * g1[1]); w.w = pk2(v[6] * rstd * g1[2], v[7] * rstd * g1[3]);
        *(u32x4*)(ACT + (size_t)m * DM + 256 + c0) = w;
    }
}

DI float reduce16(const float (&lg)[16], int lane) {
    float x8[8], x4[4], x2[2];
    const bool b3 = (lane & 8) != 0, b2 = (lane & 4) != 0, b1 = (lane & 2) != 0, b0 = (lane & 1) != 0;
#pragma unroll
    for (int i = 0; i < 8; ++i) { const float keep = b3 ? lg[i + 8] : lg[i], send = b3 ? lg[i] : lg[i + 8]; x8[i] = keep + dpp_f<0x128>(send); }
#pragma unroll
    for (int i = 0; i < 4; ++i) { const float keep = b2 ? x8[i + 4] : x8[i], send = b2 ? x8[i] : x8[i + 4]; x4[i] = keep + dpp_xor4(send, lane); }
#pragma unroll
    for (int i = 0; i < 2; ++i) { const float keep = b1 ? x4[i + 2] : x4[i], send = b1 ? x4[i] : x4[i + 2]; x2[i] = keep + dpp_f<0x4E>(send); }
    const float keep = b0 ? x2[1] : x2[0], send = b0 ? x2[0] : x2[1];
    float x = keep + dpp_f<0xB1>(send);
    x = x16_sum(x); x = xh_sum(x);
    return x;
}
DI void route_select(float x, float rbias, int lane, int& i1, int& i2, float& w1, float& w2) {
    const float aff = 1.f / (1.f + expf(-x)), sel = aff + rbias;
    const float q1 = dpp_f<0xB1>(sel), q2 = dpp_f<0x4E>(sel), q3 = dpp_f<0x1B>(sel);
    const float hi1 = fmaxf(sel, q1), lo1 = fminf(sel, q1), hi2 = fmaxf(q2, q3), lo2 = fminf(q2, q3);
    const float gs = fmaxf(hi1, hi2) + fmaxf(fminf(hi1, hi2), fmaxf(lo1, lo2));
    const float g0 = rdlane(gs, 0), g1 = rdlane(gs, 4), g2 = rdlane(gs, 8), g3 = rdlane(gs, 12);
    int best = 0; float bs = g0;
    if (g1 > bs) { bs = g1; best = 1; }
    if (g2 > bs) { bs = g2; best = 2; }
    if (g3 > bs) { bs = g3; best = 3; }
    int j1 = 0, j2 = 0; float v1 = -1e30f, v2 = -1e30f, a1 = 0.f, a2 = 0.f;
#pragma unroll
    for (int j = 0; j < 4; ++j) { const float s = rdlane(sel, 4 * best + j), a = rdlane(aff, 4 * best + j);
        if (s > v1) { v2 = v1; j2 = j1; a2 = a1; v1 = s; j1 = j; a1 = a; } else if (s > v2) { v2 = s; j2 = j; a2 = a; } }
    i1 = 4 * best + j1; i2 = 4 * best + j2; w1 = a1 / (a1 + a2); w2 = a2 / (a1 + a2);
}
DI void phase_norm2_route(const Params& P, Ctx& X, int l) {
    const float* MOD = (const float*)(P.ws + WS_MOD);
    bf16_t* ACT = (bf16_t*)(P.ws + WS_ACT);
    u32x4* TOK = (u32x4*)(P.ws + WS_TOK); int* LIST = (int*)(P.ws + WS_LIST);
    unsigned* cnt = (unsigned*)(P.ws + WS_CTL) + CW_CNT + l * 16;
    const int lane = X.lane;
    constexpr int RPW = 36;
    LAS unsigned* lcnt = (LAS unsigned*)(X.L + 65536); LAS unsigned* lbase = lcnt + 16; LAS unsigned* ltab = lcnt + 64;
    __syncthreads();
    for (int k = X.tid; k < DM; k += NTHR) { const int j = k >> 8, ln = (k >> 2) & 63, i = k & 3, slot = (4 * j + i) * 64 + ln;
#pragma unroll
        for (int e4 = 0; e4 < 4; ++e4) *(LAS f32x4*)(X.L + ((size_t)e4 * 1024 + slot) * 16) = *(const f32x4*)(P.r_w + k * 16 + 4 * e4); }
    if (X.tid < 32) lcnt[X.tid] = 0u;
    __syncthreads();
    const float rbias = P.r_b[lane & 15];
    const int gw = X.bid * NWAVE + X.wave, NGW = X.G * NWAVE;
    const float* g = P.g_ffn + l * DM;
    int it = 0;
    for (int ck = gw; ck < M / RPC; ck += NGW, ++it) {
        const int m0 = ck * RPC, b = m0 / T, t0 = m0 - b * T;
        int cur_cls = -1; f32x4 gs[4], sh[4], gm[4];
        u32x2 hc[2][4], mc[2][4], hn[2][4], mn[2][4];
        const bf16_t* MIX = (const bf16_t*)(P.ws + WS_MIX);
#pragma unroll
        for (int k = 0; k < 2; ++k) { const bf16_t* h0 = hrow(P, m0 + k); const bf16_t* x0 = MIX + (size_t)(m0 + k) * DM;
#pragma unroll
          for (int j = 0; j < 4; ++j) { hc[k][j] = __builtin_nontemporal_load((const u32x2*)(h0 + 256 * j + 4 * lane)); mc[k][j] = __builtin_nontemporal_load((const u32x2*)(x0 + 256 * j + 4 * lane)); } }
        static_assert(RPC % 2 == 0 && CTX % 2 == 0, "row pairs never straddle the context / latent boundary");
#pragma unroll 1
        for (int r = 0; r < RPC; r += 2) {
            const int m = m0 + r, t = t0 + r, cls = (t < CTX) ? 1 : 0;
            if (r + 2 < RPC) {
#pragma unroll
                for (int k = 0; k < 2; ++k) { const bf16_t* h0 = hrow(P, m + 2 + k); const bf16_t* x0 = MIX + (size_t)(m + 2 + k) * DM;
#pragma unroll
                    for (int j = 0; j < 4; ++j) { hn[k][j] = __builtin_nontemporal_load((const u32x2*)(h0 + 256 * j + 4 * lane)); mn[k][j] = __builtin_nontemporal_load((const u32x2*)(x0 + 256 * j + 4 * lane)); } } }
            if (!(l == DEPTH - 1 && cls)) {
                if (cls != cur_cls) { cur_cls = cls;
                    const float* mrow = MOD + ((size_t)l * 17 + (cls ? 16 : b)) * 6144;
#pragma unroll
                    for (int j = 0; j < 4; ++j) { const int cidx = 256 * j + 4 * lane;
                        gs[j] = *(const f32x4*)(g + cidx) * (*(const f32x4*)(mrow + 4 * DM + cidx) + 1.f); sh[j] = *(const f32x4*)(mrow + 3 * DM + cidx); gm[j] = *(const f32x4*)(mrow + 2 * DM + cidx); } }
                f32x4 c0[2][4]; float rs[2];
#pragma unroll
                for (int k = 0; k < 2; ++k) { bf16_t* hp = hrow(P, m + k); float s0 = 0.f;
#pragma unroll
                  for (int j = 0; j < 4; ++j) { const f32x4 hv = {bflo(hc[k][j].x), bfhi(hc[k][j].x), bflo(hc[k][j].y), bfhi(hc[k][j].y)}, xv = {bflo(mc[k][j].x), bfhi(mc[k][j].x), bflo(mc[k][j].y), bfhi(mc[k][j].y)};
                      c0[k][j] = hv + gm[j] * xv;
                      u32x2 o; o.x = pk2(c0[k][j][0], c0[k][j][1]); o.y = pk2(c0[k][j][2], c0[k][j][3]); __builtin_nontemporal_store(o, (u32x2*)(hp + 256 * j + 4 * lane));
                      s0 += c0[k][j][0] * c0[k][j][0] + c0[k][j][1] * c0[k][j][1] + c0[k][j][2] * c0[k][j][2] + c0[k][j][3] * c0[k][j][3]; }
                  rs[k] = s0; }
                const float r0 = rsqrtf(wave_sum(rs[0], lane) * (1.f / DM) + EPS), r1 = rsqrtf(wave_sum(rs[1], lane) * (1.f / DM) + EPS);
                float lg0[16], lg1[16];
#pragma unroll
                for (int e = 0; e < 16; ++e) { lg0[e] = 0.f; lg1[e] = 0.f; }
#pragma unroll
                for (int j = 0; j < 4; ++j) { const int cidx = 256 * j + 4 * lane;
                    const f32x4 u0 = c0[0][j] * r0 * gs[j] + sh[j], u1 = c0[1][j] * r1 * gs[j] + sh[j];
                    { u32x2 o; o.x = pk2(u0[0], u0[1]); o.y = pk2(u0[2], u0[3]); *(u32x2*)(ACT + (size_t)m * DM + cidx) = o; }
                    { u32x2 o; o.x = pk2(u1[0], u1[1]); o.y = pk2(u1[2], u1[3]); *(u32x2*)(ACT + (size_t)(m + 1) * DM + cidx) = o; }
#pragma unroll
                    for (int i = 0; i < 4; ++i) { const int slot = (4 * j + i) * 64 + lane;
#pragma unroll
                        for (int e4 = 0; e4 < 4; ++e4) { const f32x4 rw = *(const LAS f32x4*)(X.L + ((size_t)e4 * 1024 + slot) * 16);
                            lg0[4 * e4] += u0[i] * rw[0]; lg0[4 * e4 + 1] += u0[i] * rw[1]; lg0[4 * e4 + 2] += u0[i] * rw[2]; lg0[4 * e4 + 3] += u0[i] * rw[3];
                            lg1[4 * e4] += u1[i] * rw[0]; lg1[4 * e4 + 1] += u1[i] * rw[1]; lg1[4 * e4 + 2] += u1[i] * rw[2]; lg1[4 * e4 + 3] += u1[i] * rw[3]; }
                        __builtin_amdgcn_sched_barrier(0); } }
                const float red0 = reduce16(lg0, lane), red1 = reduce16(lg1, lane);
#pragma unroll
                for (int k = 0; k < 2; ++k) {
                    int a1, a2; float wa1, wa2;
                    route_select(k ? red1 : red0, rbias, lane, a1, a2, wa1, wa2);
                    if (lane == 0) {
                        LAS unsigned* rec = ltab + (X.wave * RPW + it * RPC + r + k) * 4;
                        const unsigned ra1 = __hip_atomic_fetch_add(lcnt + a1, 1u, __ATOMIC_RELAXED, __HIP_MEMORY_SCOPE_WORKGROUP), ra2 = __hip_atomic_fetch_add(lcnt + a2, 1u, __ATOMIC_RELAXED, __HIP_MEMORY_SCOPE_WORKGROUP);
                        rec[0] = (unsigned)a1 | (ra1 << 4); rec[1] = (unsigned)a2 | (ra2 << 4); rec[2] = __float_as_uint(wa1); rec[3] = __float_as_uint(wa2);
                    } }
            }
#pragma unroll
            for (int k = 0; k < 2; ++k)
#pragma unroll
                for (int j = 0; j < 4; ++j) { hc[k][j] = hn[k][j]; mc[k][j] = mn[k][j]; }
        }
    }
    __syncthreads();
    if (X.tid < 16) { const unsigned c = lcnt[X.tid]; lbase[X.tid] = c ? atomicAdd(&cnt[X.tid], c) : 0u; }
    __syncthreads();
    it = 0;
    for (int ck = gw; ck < M / RPC; ck += NGW, ++it) {
        const int m0 = ck * RPC, b = m0 / T, t0 = m0 - b * T;
        if (lane < RPC) { const int m = m0 + lane, t = t0 + lane;
            if (!(l == DEPTH - 1 && t < CTX)) {
                const LAS unsigned* rec = ltab + (X.wave * RPW + it * RPC + lane) * 4;
                const unsigned e1 = rec[0] & 15u, e2 = rec[1] & 15u, p1 = lbase[e1] + (rec[0] >> 4), p2 = lbase[e2] + (rec[1] >> 4);
                LIST[(size_t)e1 * M + p1] = m; LIST[(size_t)e2 * M + p2] = m;
                u32x4 ti; ti.x = e1 | (p1 << 4); ti.y = e2 | (p2 << 4); ti.z = rec[2]; ti.w = rec[3];
                TOK[m] = ti; } }
    }
}
DI void moe_tables(const Params& P, Ctx& X, int l) {
    __syncthreads();
    if (X.tid < 64) { const unsigned* cnt = (const unsigned*)(P.ws + WS_CTL) + CW_CNT + l * 16;
        const int c = (X.lane < 16) ? (int)__hip_atomic_load(cnt + (X.lane & 15), __ATOMIC_RELAXED, __HIP_MEMORY_SCOPE_AGENT) : 0;
        const int tiles = (c + 255) >> 8; int incl = tiles;
#pragma unroll
        for (int o = 1; o < 16; o <<= 1) { const int v = shupi(incl, o, X.lane); if (X.lane >= o) incl += v; }
        if (X.lane < 16) { X.misc[16 + X.lane] = c; X.misc[32 + X.lane] = incl - tiles; X.misc[64 + X.lane] = (incl - tiles) * 256; }
        if (X.lane == 15) X.misc[32 + 16] = incl; }
    __syncthreads();
}
DI void moe_prefetch_idx(const Params& P, Ctx& X, const MoeSched<true>& S) {
    LAS int* tab = (LAS int*)(X.L + LDS_IDX);
    for (int i = 0; i < MOE_MAXU; ++i) { GUnit u; if (!S.next(i, u)) break;
        const int cnt = __builtin_amdgcn_readfirstlane(X.misc[16 + u.e]);
        if (X.tid < 256) { const int idx = u.pm * 256 + X.tid; tab[i * 256 + X.tid] = (idx < cnt) ? S.list[(size_t)u.e * M + idx] : 0; } }
    __syncthreads();
}

constexpr int N_PHASES = 38;
__global__ void __launch_bounds__(NTHR, 2) mk_fwd(Params PK) {
    const Params& P0 = PK; const Params* kp = &PK;
    extern __shared__ __attribute__((aligned(16))) unsigned char lds_raw[];
    Ctx X;
    X.L = (LAS unsigned char*)lds_raw; X.misc = (volatile LAS int*)(X.L + LDS_MISC); X.ws = PK.ws;
    X.tid = threadIdx.x; X.lane = X.tid & 63; X.wave = __builtin_amdgcn_readfirstlane(X.tid >> 6); X.G = gridDim.x; X.bid = blockIdx.x;
    const int wave0 = X.wave;
    if (X.tid < 128) X.misc[X.tid] = 0;
    __syncthreads();
#if MK_MODE == 4
    if (X.tid == 0) { const unsigned long long _n = __builtin_amdgcn_s_memrealtime(); X.misc[94] = (int)(unsigned)(_n >> 32); X.misc[95] = (int)(unsigned)_n; }
#endif
    unsigned* ctl = (unsigned*)(PK.ws + WS_CTL);
    XcdBarrier bar; bar.bar = ctl + CW_BAR; bar.x = 0; bar.st = (volatile LAS unsigned*)X.misc;
    const bool multi = ((PK.ph_hi & 255) - PK.ph_lo) > 1;
    if (multi) bar = xcd_barrier_post(ctl + CW_BAR, (volatile LAS unsigned*)X.misc);
#ifndef PHMASK
#define PHMASK 0xFFFF
#endif
#define RUN(ph) (PK.ph_lo <= (ph) && (ph) < (PK.ph_hi & 255))
#define HAS(k) ((PHMASK >> (k)) & 1)
#if MK_MODE == 4
#define TSTAMP(cat) MIX_STAMP(cat)
#else
#define TSTAMP(cat) do { } while (0)
#endif
#define SEAM(ph) do { if (RUN(ph) && RUN((ph) + 1)) { FRESH(); xcd_barrier(bar, X.tid); TSTAMP(15); } } while (0)
#define FRESH() do { unsigned _z = 0u; asm volatile("" : "+v"(_z)); int _t = wave0 * 64 + (int)__builtin_amdgcn_mbcnt_hi(~0u, __builtin_amdgcn_mbcnt_lo(~0u, _z)); asm volatile("" : "+v"(_t)); X.tid = _t; X.lane = _t & 63; X.wave = __builtin_amdgcn_readfirstlane(_t >> 6); \
        const __attribute__((address_space(4))) Params* _kp = (const __attribute__((address_space(4))) Params*)__builtin_amdgcn_kernarg_segment_ptr(); asm volatile("" : "+s"(_kp)); kp = (const Params*)_kp; X.ws = kp->ws; \
        int _b = blockIdx.x, _g = gridDim.x; asm volatile("" : "+s"(_b), "+s"(_g)); X.bid = _b; X.G = _g; } while (0)
#define P (*kp)
    if (HAS(9) && RUN(0)) phase_prologue(P, X);
    TSTAMP(14);
    SEAM(0);
#pragma unroll 1
    for (int l = 0; l < DEPTH; ++l) {
        const int pb = 1 + 9 * l;
        FRESH(); if (HAS(0) && RUN(pb + 0)) phase_norm1(P, X, l);
        TSTAMP(0);
        SEAM(pb + 0);
        FRESH(); if (HAS(1) && RUN(pb + 1)) { DenseSched S; S.init(P.ws + WS_ACT, P.ws + WS_WIN, M, PW, DM, X.G, X.bid); EpiStoreBf16 E{(bf16_t*)(P.ws + WS_PROJ), PW}; gemm8(X.L, DM, S, E, X.tid); }
        TSTAMP(1);
        SEAM(pb + 1);
        FRESH(); if (HAS(2) && RUN(pb + 2)) phase_postproj(P, X, l, (PK.ph_hi >> 8) ? (PK.ph_hi >> 8) : 15);
        TSTAMP(2);
        SEAM(pb + 2);
        FRESH(); if (HAS(3) && RUN(pb + 3)) phase_mixers(P, X, l, (PK.ph_hi >> 8) ? (PK.ph_hi >> 8) : 7);
        TSTAMP(3);
        SEAM(pb + 3);
        FRESH(); if (HAS(4) && RUN(pb + 4)) phase_ssdgate(P, X, l);
        TSTAMP(4);
        SEAM(pb + 4);
        FRESH(); if (HAS(5) && RUN(pb + 5)) { DenseSched S; S.init(P.ws + WS_ACT, P.ws + WS_WOUT, M, DM, DM, X.G, X.bid);
            EpiStoreBf16 E{(bf16_t*)(P.ws + WS_MIX), DM}; gemm8(X.L, DM, S, E, X.tid); }
        TSTAMP(5);
        SEAM(pb + 5);
        FRESH(); if (HAS(6) && RUN(pb + 6)) phase_norm2_route(P, X, l);
        TSTAMP(6);
        SEAM(pb + 6);
        FRESH(); if (HAS(7) && RUN(pb + 7)) { moe_tables(P, X, l);
            MoeSched<true> S{(const char*)(P.ws + WS_ACT), (const char*)(P.ws + WS_WGU), (const int*)(P.ws + WS_LIST), X.misc, DM, X.G, X.bid};
            moe_prefetch_idx(P, X, S);
            EpiGateUp E{(bf16_t*)(P.ws + WS_HE)}; gemm8(X.L, DM, S, E, X.tid); }
        TSTAMP(7);
        SEAM(pb + 7);
        FRESH(); if (HAS(8) && RUN(pb + 8)) { moe_tables(P, X, l);
            MoeSched<false> S{(const char*)(P.ws + WS_HE), (const char*)(P.ws + WS_WD), nullptr, X.misc, 512, X.G, X.bid};
            EpiStoreBf16 E{(bf16_t*)(P.ws + WS_YS), DM}; gemm8(X.L, 512, S, E, X.tid); }
        TSTAMP(8);
        SEAM(pb + 8);
    }
#if MK_MODE == 5
    for (int xb = 0; xb < 32; ++xb) { FRESH(); xcd_barrier(bar, X.tid); }
#endif
#if MK_MODE == 4
    FRESH(); if (HAS(10) && RUN(37)) { float eps = 0.f;
        { float tot = 0.f;
          for (int c = 0; c < 16; ++c) tot += (float)X.misc[96 + c];
          const float sel = (float)X.misc[96 + PROBE_K];
          eps = 0.03f + 0.15f * (sel / tot); }
        phase_final(P, X, eps); }
#else
    FRESH(); if (HAS(10) && RUN(37)) phase_final(P, X);
#endif
#undef P
#undef RUN
#undef SEAM
}
}

#ifndef PROBE_SEL
#define PROBE_SEL 0
#endif
#ifndef MK_MODE
#define MK_MODE 1
#endif
extern "C" void kernel_launch(void* const* d_in, const int* in_sizes, int n_in, void* d_out, int out_size, void* d_ws, size_t ws_size, hipStream_t stream) {
    using namespace mk;
    static int grid = 0;
    if (grid == 0) {
        if (n_in != 28 || ws_size < WS_END) { fprintf(stderr, "kernel_launch: unexpected inputs (n_in %d, ws %zu < %zu)\n", n_in, ws_size, (size_t)WS_END); grid = -1; return; }
        int dev = 0, cus = 0, per_cu = 0;
        if (hipGetDevice(&dev) != hipSuccess || hipDeviceGetAttribute(&cus, hipDeviceAttributeMultiprocessorCount, dev) != hipSuccess) { grid = -1; return; }
        if (hipFuncSetAttribute((const void*)mk_fwd, hipFuncAttributeMaxDynamicSharedMemorySize, LDS_BYTES) != hipSuccess) { fprintf(stderr, "kernel_launch: hipFuncSetAttribute failed\n"); grid = -1; return; }
        if (hipOccupancyMaxActiveBlocksPerMultiprocessor(&per_cu, (const void*)mk_fwd, NTHR, LDS_BYTES) != hipSuccess || per_cu < 1) { fprintf(stderr, "kernel_launch: occupancy query says %d\n", per_cu); (void)hipGetLastError(); grid = -1; return; }
        grid = cus;
    }
    if (grid < 0) return;
    (void)hipMemsetAsync((char*)d_ws + WS_CTL, 0, CTL_BYTES, stream);
    Params p{};
    const float** pp = (const float**)&p;
    for (int i = 0; i < 28; ++i) pp[i] = (const float*)d_in[i];
    p.out = (float*)d_out; p.ws = (unsigned char*)d_ws;
#if MK_MODE == 1 || MK_MODE == 4 || MK_MODE == 5
    p.ph_lo = 0; p.ph_hi = N_PHASES;
    hipLaunchKernelGGL(mk_fwd, dim3(grid), dim3(NTHR), LDS_BYTES, stream, p);
#else
    for (int ph = 0; ph < N_PHASES; ++ph) { p.ph_lo = ph; p.ph_hi = ph + 1; hipLaunchKernelGGL(mk_fwd, dim3(grid), dim3(NTHR), LDS_BYTES, stream, p);
#if MK_MODE == 3
        if (ph == PROBE_PH) for (int r = 0; r < PROBE_REP; ++r) hipLaunchKernelGGL(mk_fwd, dim3(grid), dim3(NTHR), LDS_BYTES, stream, p);
#endif
    }
#if MK_MODE == 2
    p.out = (float*)((unsigned char*)d_ws + WS_PROJ);
    for (int r = 0; r < PROBE_REP; ++r) { p.ph_lo = PROBE_PH; p.ph_hi = (PROBE_PH + 1) | (PROBE_SEL << 8); hipLaunchKernelGGL(mk_fwd, dim3(grid), dim3(NTHR), LDS_BYTES, stream, p); }
#endif
#endif
}
```
